# Optimizing an MI355X kernel written in HIP

```python
import jax, jax.numpy as jnp
from jax import lax
import numpy as np

D_MODEL = 1024
BATCH = 8
SEQ = 4096
DEPTH = 4
DEC_BATCH = 4
DEC_SEQ = 4096
PAST_LEN = 128

CHUNK = 128
A_GROUPS = 8
A_WIDTH = D_MODEL
A_GROUP_DIM = A_WIDTH // A_GROUPS
B_PATTERNS = ((128, 1), (512, 4), (2048, 16))
B_HEADS = 4
B_HEAD_DIM = 128
B_GROUP_WIDTH = B_HEADS * B_HEAD_DIM
N_ATTN_HEADS = len(B_PATTERNS) * B_HEADS
ALIBI_SLOPES = np.array([2.0 ** (-8.0 * (h + 1) / N_ATTN_HEADS) for h in range(N_ATTN_HEADS)], dtype=np.float32).reshape(len(B_PATTERNS), B_HEADS)
IN_SIZES = (A_WIDTH, A_WIDTH) + (B_GROUP_WIDTH,) * (3 * len(B_PATTERNS)) + (D_MODEL, D_MODEL)
D_IN = sum(IN_SIZES)
N_EXPERTS = 32
TOP_K = 4
D_EXPERT = D_MODEL
SWIGLU_LIMIT = 7.0
SWIGLU_ALPHA = 1.702
ROUTE_BLOCK = 128
DN_ALPHA = (2.0 * DEPTH) ** 0.25
DN_BETA = (8.0 * DEPTH) ** -0.25
LN_EPS = 1e-5
NEG_INF = -1e30

kernel_name = 'hybrid_gmlp_dilated_moe_encoder'


def layer_norm(x, g, b):
    xf = x.astype(jnp.float32)
    xc = xf - xf.mean(-1, keepdims=True)
    var = jnp.mean(xc * xc, -1, keepdims=True)
    return (xc * lax.rsqrt(var + LN_EPS) * g.astype(jnp.float32) + b.astype(jnp.float32)).astype(x.dtype)


def spatial_gating(u, v, ln_g, ln_b, w_s, b_s):
    bsz, s, _ = v.shape
    vn = layer_norm(v, ln_g, ln_b).reshape(bsz, s // CHUNK, CHUNK, A_GROUPS, A_GROUP_DIM)
    mixed = jnp.einsum('gts,bnsgc->bntgc', w_s, vn) + b_s.T[None, None, :, :, None]
    return u * mixed.reshape(bsz, s, A_WIDTH)


def dilated_window_attention(q, k, v, dilation, n_side, slopes):
    bsz, s, h, hd = q.shape
    L = s // dilation
    nb = -(-L // n_side)
    Lp = nb * n_side

    def to_sub(t):
        return t.reshape(bsz, L, dilation, h, hd).transpose(0, 2, 1, 3, 4)

    qb = jnp.pad(to_sub(q), ((0, 0), (0, 0), (0, Lp - L), (0, 0), (0, 0))).reshape(bsz, dilation, nb, n_side, h, hd)
    pad_kv = ((0, 0), (0, 0), (n_side, Lp - L + n_side), (0, 0), (0, 0))
    kb = jnp.pad(to_sub(k), pad_kv).reshape(bsz, dilation, nb + 2, n_side, h, hd)
    vb = jnp.pad(to_sub(v), pad_kv).reshape(bsz, dilation, nb + 2, n_side, h, hd)

    def band(t):
        return jnp.concatenate([t[:, :, 0:nb], t[:, :, 1:nb + 1], t[:, :, 2:nb + 2]], axis=3)

    kw, vw = band(kb), band(vb)
    a_idx = np.arange(n_side)[:, None]
    c_idx = np.arange(3 * n_side)[None, :]
    rel = c_idx - n_side - a_idx
    q_sub = np.arange(nb)[:, None, None] * n_side + a_idx[None]
    k_sub = q_sub + rel[None]
    valid = (np.abs(rel)[None] <= n_side) & (k_sub >= 0) & (k_sub < L)
    alibi = (-(slopes[:, None, None] * (dilation * np.abs(rel))[None])).astype(np.float32)

    scores = jnp.einsum('bdiahk,bdichk->bdihac', qb, kw, preferred_element_type=jnp.float32) * (hd ** -0.5)
    scores = jnp.where(valid[None, None, :, None], scores + alibi[None, None, None], NEG_INF)
    m = scores.max(-1, keepdims=True)
    p = jnp.exp(scores - m)
    den = p.sum(-1, keepdims=True)
    out = jnp.einsum('bdihac,bdichk->bdiahk', (p / den).astype(v.dtype), vw)
    lse = (m + jnp.log(den))[..., 0]
    out = out.reshape(bsz, dilation, Lp, h, hd)[:, :, :L].transpose(0, 2, 1, 3, 4).reshape(bsz, s, h, hd)
    lse = lse.transpose(0, 1, 2, 4, 3).reshape(bsz, dilation, Lp, h)[:, :, :L].transpose(0, 2, 1, 3).reshape(bsz, s, h)
    return out, lse


def token_mixer(x, w_in, b_in, ln_v_g, ln_v_b, w_s, b_s, w_pa, w_pb, w_o):
    bsz, s, _ = x.shape
    z = jnp.dot(x, w_in) + b_in
    parts = jnp.split(z, [int(i) for i in np.cumsum(IN_SIZES)[:-1]], axis=-1)
    a_out = spatial_gating(jax.nn.gelu(parts[0], approximate=False), jax.nn.gelu(parts[1], approximate=False),
                           ln_v_g, ln_v_b, w_s, b_s)
    outs, lses = [], []
    for g, (window, dilation) in enumerate(B_PATTERNS):
        q, k, v = [t.reshape(bsz, s, B_HEADS, B_HEAD_DIM) for t in parts[2 + 3 * g: 5 + 3 * g]]
        o, lse = dilated_window_attention(q, k, v, dilation, (window // 2) // dilation, ALIBI_SLOPES[g])
        outs.append(o)
        lses.append(lse)
    wts = jax.nn.softmax(jnp.stack(lses), axis=0)
    b_out = jnp.einsum('gbsh,gbshk->bshk', wts.astype(x.dtype), jnp.stack(outs)).reshape(bsz, s, B_GROUP_WIDTH)
    gate_a = jax.nn.sigmoid(parts[-2])
    gate_b = jax.nn.sigmoid(parts[-1])
    merged = gate_a * jnp.dot(a_out, w_pa) + gate_b * jnp.dot(b_out, w_pb)
    return jnp.dot(merged, w_o)


def expert_ffn(xb, e, w_gu, b_gu, w_down, b_down):
    gu = jnp.dot(xb, w_gu[e]) + b_gu[e]
    gate, up = jnp.split(gu, 2, axis=-1)
    gate = jnp.minimum(gate, SWIGLU_LIMIT)
    up = jnp.clip(up, -SWIGLU_LIMIT, SWIGLU_LIMIT)
    h = (up + 1.0) * gate * jax.nn.sigmoid(SWIGLU_ALPHA * gate)
    return jnp.dot(h, w_down[e]) + b_down[e]


def moe(x, w_r, b_r, w_gu, b_gu, w_down, b_down):
    bsz, s, dm = x.shape
    t = bsz * s
    xf = x.reshape(t, dm)
    logits = jnp.dot(xf, w_r, preferred_element_type=jnp.float32) + b_r.astype(jnp.float32)
    top_v, top_i = lax.top_k(logits, TOP_K)
    gates = jax.nn.softmax(top_v, axis=-1).astype(x.dtype)
    n = t * TOP_K
    flat_e = top_i.reshape(n).astype(jnp.int32)
    flat_tok = jnp.repeat(jnp.arange(t, dtype=jnp.int32), TOP_K)
    order = jnp.argsort(flat_e)
    se, stok, sg = flat_e[order], flat_tok[order], gates.reshape(n)[order]
    counts = jnp.bincount(flat_e, length=N_EXPERTS)
    padded = (counts + ROUTE_BLOCK - 1) // ROUTE_BLOCK * ROUTE_BLOCK
    start = jnp.cumsum(counts) - counts
    pend = jnp.cumsum(padded)
    pstart = pend - padded
    dest = pstart[se] + jnp.arange(n, dtype=jnp.int32) - start[se]
    cap = -(-n // ROUTE_BLOCK) * ROUTE_BLOCK + N_EXPERTS * ROUTE_BLOCK
    n_blk = cap // ROUTE_BLOCK
    buf_tok = jnp.full((cap,), t, jnp.int32).at[dest].set(stok)
    blk_e = jnp.minimum(jnp.searchsorted(pend, jnp.arange(n_blk, dtype=jnp.int32) * ROUTE_BLOCK, side='right'), N_EXPERTS - 1)
    xpad = jnp.concatenate([xf, jnp.zeros((1, dm), xf.dtype)], axis=0)
    xb = xpad[buf_tok].reshape(n_blk, ROUTE_BLOCK, dm)
    yb = lax.map(lambda args: expert_ffn(args[0], args[1], w_gu, b_gu, w_down, b_down), (xb, blk_e))
    ya = yb.reshape(cap, dm)[dest] * sg[:, None]
    y = jax.ops.segment_sum(ya, stok, num_segments=t)
    return y.reshape(bsz, s, dm)


def encoder_trunk(x, params):
    (w_in, b_in, ln_v_g, ln_v_b, w_s, b_s, w_pa, w_pb, w_o, ln1_g, ln1_b,
     w_r, b_r, w_gu, b_gu, w_down, b_down, ln2_g, ln2_b) = params
    for l in range(DEPTH):
        mix = token_mixer(x, w_in[l], b_in[l], ln_v_g[l], ln_v_b[l], w_s[l], b_s[l], w_pa[l], w_pb[l], w_o[l])
        x = layer_norm(DN_ALPHA * x + mix, ln1_g[l], ln1_b[l])
        ffn = moe(x, w_r[l], b_r[l], w_gu[l], b_gu[l], w_down[l], b_down[l])
        x = layer_norm(DN_ALPHA * x + ffn, ln2_g[l], ln2_b[l])
    return x


def setup_inputs(seed: int = 0) -> dict:
    key = jax.random.key(seed)
    ks = jax.random.split(key, 24)
    nrm = jax.random.normal
    f32 = jnp.float32
    L, D, E, F = DEPTH, D_MODEL, N_EXPERTS, D_EXPERT
    return {
        'x_prompt': nrm(ks[0], (BATCH, SEQ, D), f32),
        'x_sample': nrm(ks[1], (DEC_BATCH, DEC_SEQ, D), f32),
        'w_in': nrm(ks[2], (L, D, D_IN), f32) * D ** -0.5,
        'b_in': nrm(ks[3], (L, D_IN), f32) * 0.02,
        'ln_v_g': 1.0 + 0.1 * nrm(ks[4], (L, A_WIDTH), f32),
        'ln_v_b': 0.02 * nrm(ks[5], (L, A_WIDTH), f32),
        'w_s': nrm(ks[6], (L, A_GROUPS, CHUNK, CHUNK), f32) * CHUNK ** -0.5,
        'b_s': 1.0 + 0.1 * nrm(ks[7], (L, A_GROUPS, CHUNK), f32),
        'w_pa': nrm(ks[8], (L, A_WIDTH, D), f32) * (A_WIDTH ** -0.5 * DN_BETA),
        'w_pb': nrm(ks[9], (L, B_GROUP_WIDTH, D), f32) * (B_GROUP_WIDTH ** -0.5 * DN_BETA),
        'w_o': nrm(ks[10], (L, D, D), f32) * (D ** -0.5 * DN_BETA),
        'ln1_g': 1.0 + 0.1 * nrm(ks[11], (L, D), f32),
        'ln1_b': 0.02 * nrm(ks[12], (L, D), f32),
        'w_r': nrm(ks[13], (L, D, E), f32) * D ** -0.5,
        'b_r': 0.01 * nrm(ks[14], (L, E), f32),
        'w_gu': nrm(ks[15], (L, E, D, 2 * F), f32) * (D ** -0.5 * DN_BETA),
        'b_gu': 0.02 * nrm(ks[16], (L, E, 2 * F), f32),
        'w_down': nrm(ks[17], (L, E, F, D), f32) * (F ** -0.5 * DN_BETA),
        'b_down': 0.02 * nrm(ks[18], (L, E, D), f32),
        'ln2_g': 1.0 + 0.1 * nrm(ks[19], (L, D), f32),
        'ln2_b': 0.02 * nrm(ks[20], (L, D), f32),
    }


def reference(x_prompt, x_sample, w_in, b_in, ln_v_g, ln_v_b, w_s, b_s, w_pa, w_pb, w_o, ln1_g, ln1_b,
              w_r, b_r, w_gu, b_gu, w_down, b_down, ln2_g, ln2_b):
    params = (w_in, b_in, ln_v_g, ln_v_b, w_s, b_s, w_pa, w_pb, w_o, ln1_g, ln1_b,
              w_r, b_r, w_gu, b_gu, w_down, b_down, ln2_g, ln2_b)
    y_prompt = encoder_trunk(x_prompt, params)
    y_sample = encoder_trunk(x_sample, params)
    return (y_prompt, y_sample)
```

```cpp
#include <hip/hip_runtime.h>
#include <cstdio>
#include <cstdint>

#ifndef MK_SPLIT
#define MK_SPLIT 1
#endif

#define LAS __attribute__((address_space(3)))
#define GAS __attribute__((address_space(1)))
typedef unsigned short bf16_t;
typedef short bf16x8 __attribute__((ext_vector_type(8)));
typedef short s16x4 __attribute__((ext_vector_type(4)));
typedef float f32x4 __attribute__((ext_vector_type(4)));
typedef float f32x2 __attribute__((ext_vector_type(2)));
typedef unsigned u32x4 __attribute__((ext_vector_type(4)));
typedef unsigned u32x2 __attribute__((ext_vector_type(2)));

constexpr int D = 1024, T = 49152, TP = 32768, SEQ = 4096, DEPTH = 4, DIN = 8704, NE = 32, TOPK = 4, QKVW = 4608;
constexpr int NSLOT = T * TOPK + NE * 256;
constexpr float DN_ALPHA = 1.6817928305074290f;
constexpr float LN_EPS = 1e-5f;
constexpr float LOG2E = 1.4426950408889634f, LN2 = 0.6931471805599453f;
constexpr int NPH = 9, NPHASE = 1 + DEPTH * NPH;

constexpr size_t MiB = 1u << 20;
constexpr size_t WS_CTL = 0, CTL_BYTES = 1 * MiB;
constexpr size_t WS_PRM = 1 * MiB;
constexpr int PR_BIN = 0, PR_LNVG = PR_BIN + DEPTH * DIN, PR_LNVB = PR_LNVG + DEPTH * D, PR_BS = PR_LNVB + DEPTH * D, PR_LN1G = PR_BS + DEPTH * D, PR_LN1B = PR_LN1G + DEPTH * D,
              PR_WR = PR_LN1B + DEPTH * D, PR_BR = PR_WR + DEPTH * D * NE, PR_BGU = PR_BR + DEPTH * NE, PR_BD = PR_BGU + DEPTH * NE * 2048, PR_LN2G = PR_BD + DEPTH * NE * D, PR_LN2B = PR_LN2G + DEPTH * D,
              PR_END = PR_LN2B + DEPTH * D;
static_assert((size_t)PR_END * 4 <= 4 * MiB, "params region");
constexpr size_t WS_WIN = 5 * MiB;
constexpr size_t WS_WPA = WS_WIN + (size_t)DEPTH * DIN * D * 2;
constexpr size_t WS_WPB = WS_WPA + (size_t)DEPTH * D * D * 2;
constexpr size_t WS_WO = WS_WPB + (size_t)DEPTH * D * 512 * 2;
constexpr size_t WS_WS = WS_WO + (size_t)DEPTH * D * D * 2;
constexpr size_t WS_WGU = WS_WS + (size_t)DEPTH * 8 * 128 * 128 * 2;
constexpr size_t WS_WD = WS_WGU + (size_t)DEPTH * NE * 2048 * D * 2;
constexpr size_t WS_XF = WS_WD + (size_t)DEPTH * NE * D * D * 2;
constexpr size_t WS_XB = WS_XF + (size_t)T * D * 4;
constexpr size_t WS_TOKLIST = WS_XB + (size_t)T * D * 2;
constexpr size_t WS_TOKE = WS_TOKLIST + (size_t)NE * T * 4;
constexpr size_t WS_TOKPOS = WS_TOKE + (size_t)T * 4 * 4;
constexpr size_t WS_GATE = WS_TOKPOS + (size_t)T * 4 * 4;
constexpr size_t WS_R = WS_GATE + (size_t)T * 4 * 4;
constexpr size_t WS_U = WS_R;
constexpr size_t WS_V = WS_U + (size_t)T * D * 2;
constexpr size_t WS_QKV = WS_V + (size_t)T * D * 2;
constexpr size_t WS_GA = WS_QKV + (size_t)T * QKVW * 2;
constexpr size_t WS_GB = WS_GA + (size_t)T * D * 2;
constexpr size_t WS_AOUT = WS_GB + (size_t)T * D * 2;
constexpr size_t WS_OG = WS_AOUT + (size_t)T * D * 2;
constexpr size_t WS_LSE = WS_OG + (size_t)3 * T * 512 * 2;
constexpr size_t WS_BOUT = WS_LSE + (size_t)3 * T * 4 * 4;
constexpr size_t WS_T1 = WS_BOUT + (size_t)T * 512 * 2;
constexpr size_t WS_MG = WS_T1 + (size_t)T * D * 4;
constexpr size_t WS_END_A = WS_MG + (size_t)T * D * 2;
constexpr size_t WS_H = WS_R;
constexpr size_t WS_YK = WS_H + (size_t)NSLOT * D * 2;
constexpr size_t WS_END_B = WS_YK + (size_t)NSLOT * D * 2;
constexpr size_t WS_END = WS_END_A > WS_END_B ? WS_END_A : WS_END_B;
constexpr int CW_BAR = 4096;
constexpr int CW_CNT = 16384;

constexpr int LDS_BYTES = 160 * 1024;
constexpr int MISC_OFF = LDS_BYTES - 2048, IDS_OFF = MISC_OFF + 1024;
constexpr int MISC_DOC = 0;
constexpr int SCR_BYTES = MISC_OFF;

__device__ __forceinline__ int opaque_v(int x) { asm volatile("" : "+v"(x)); return x; }
template <class P> __device__ __forceinline__ P* opaque_p(P* p) { unsigned long long v = (unsigned long long)p; asm volatile("" : "+s"(v)); return (P*)v; }
__device__ __forceinline__ unsigned f2bf(float f) { unsigned u = __builtin_bit_cast(unsigned, f); return (u + 0x7fffu + ((u >> 16) & 1u)) >> 16; }
__device__ __forceinline__ unsigned pk2(float lo, float hi) { return f2bf(lo) | (f2bf(hi) << 16); }
__device__ __forceinline__ unsigned cvt_pk_bf16(float lo, float hi) { unsigned r; asm volatile("v_cvt_pk_bf16_f32 %0, %1, %2" : "=v"(r) : "v"(lo), "v"(hi)); return r; }
__device__ __forceinline__ float bflo(unsigned w) { return __builtin_bit_cast(float, w << 16); }
__device__ __forceinline__ float bfhi(unsigned w) { return __builtin_bit_cast(float, w & 0xffff0000u); }
__device__ __forceinline__ float wave_sum(float v) {
#pragma unroll
    for (int o = 1; o < 64; o <<= 1) v += __shfl_xor(v, o);
    return v;
}
__device__ __forceinline__ float sigmoidf_(float x) { return __builtin_amdgcn_rcpf(1.0f + __builtin_amdgcn_exp2f(-x * LOG2E)); }
__device__ __forceinline__ f32x2 gelu_pk(f32x2 v) {
    const f32x2 av = __builtin_elementwise_abs(v), d = av * 0.2316418882f + 1.0f;
    f32x2 t; t.x = __builtin_amdgcn_rcpf(d.x); t.y = __builtin_amdgcn_rcpf(d.y);
    f32x2 q = t * 0.5307027145f + (-0.7265760135f); q = q * t + 0.7107068705f; q = q * t + (-0.142248368f); q = q * t + 0.127414796f; q = q * t;
    const f32x2 s = (v * v) * (-0.72134752044f);
    f32x2 e; e.x = __builtin_amdgcn_exp2f(s.x); e.y = __builtin_amdgcn_exp2f(s.y);
    const f32x2 m = v * (q * e), r = v - m;
    f32x2 o; o.x = v.x < 0.f ? m.x : r.x; o.y = v.y < 0.f ? m.y : r.y; return o;
}

#define XB_TMO      128
#define XB_XCNT(j)  (256  + 64 * (j))
#define XB_XSUB(j)  (1280 + 64 * (j))
#define XB_XGEN(j)  (2304 + 64 * (j))
#define XB_TOP      3328
#define XB_TOPGEN   3392
#define XCD_BAR_WORDS 3456
#define XB_SPIN_CAP (1u << 18)
__device__ __forceinline__ unsigned xb_ld(unsigned* p)              { return __hip_atomic_load(p, __ATOMIC_RELAXED, __HIP_MEMORY_SCOPE_AGENT); }
__device__ __forceinline__ unsigned xb_add(unsigned* p, unsigned v) { return __hip_atomic_fetch_add(p, v, __ATOMIC_RELAXED, __HIP_MEMORY_SCOPE_AGENT); }
__device__ __forceinline__ unsigned xb_xcc_id() { return (unsigned)__builtin_amdgcn_s_getreg((3 << 11) | 20) & 0xFu; }
#define XB_SPIN(cond, bar) do { unsigned _sp = 0; while (cond) { __builtin_amdgcn_s_sleep(1); \
    if ((++_sp & 255u) == 0u) { if (xb_ld(&(bar)[XB_TMO])) break; if (_sp > XB_SPIN_CAP) { atomicAdd(&(bar)[XB_TMO], 1u); break; } } } } while (0)
struct XcdBarrier { unsigned* bar; unsigned x; volatile LAS unsigned* st; };
__device__ __forceinline__ XcdBarrier xcd_barrier_post(unsigned* bar, volatile LAS unsigned* st) {
    XcdBarrier b; b.bar = bar; b.x = xb_xcc_id(); b.st = st;
    if (threadIdx.x == 0) (void)xb_add(&bar[XB_XCNT(b.x)], 1u);
    return b;
}
__device__ __forceinline__ void xcd_barrier_complete(unsigned* bar, unsigned x, unsigned& nloc, unsigned& nx) {
    const unsigned G = gridDim.x * gridDim.y * gridDim.z;
    unsigned sum, cnt, mine, sp = 0u;
    for (;;) {
        sum = 0u; cnt = 0u; mine = 0u;
#pragma unroll
        for (unsigned j = 0; j < 16; ++j) { const unsigned c = xb_ld(&bar[XB_XCNT(j)]); sum += c; cnt += (c > 0u) ? 1u : 0u; mine = (j == x) ? c : mine; }
        if (sum == G) break;
        __builtin_amdgcn_s_sleep(1);
        if ((++sp & 255u) == 0u) { if (xb_ld(&bar[XB_TMO])) break; if (sp > XB_SPIN_CAP) { atomicAdd(&bar[XB_TMO], 1u); break; } }
    }
    nloc = mine > 0u ? mine : 1u; nx = cnt > 0u ? cnt : 1u;
}
__device__ __forceinline__ void xcd_barrier(const XcdBarrier& b) {
    asm volatile("s_waitcnt vmcnt(0)" ::: "memory");
    __syncthreads();
    if (threadIdx.x == 0) {
        unsigned* bar = b.bar;
        __builtin_amdgcn_s_waitcnt(0);
        unsigned nloc = b.st[0], nx = b.st[1];
        if (nloc == 0u) { xcd_barrier_complete(bar, b.x, nloc, nx); b.st[0] = nloc; b.st[1] = nx; }
        const unsigned old = xb_add(&bar[XB_XSUB(b.x)], 1u);
        const unsigned gen = old / nloc;
        if (old + 1u == (gen + 1u) * nloc) {
            __builtin_amdgcn_fence(__ATOMIC_RELEASE, "agent");
            asm volatile("s_waitcnt vmcnt(0)" ::: "memory");
            const unsigned og = xb_add(&bar[XB_TOP], 1u);
            const unsigned tg = og / nx;
            if (og + 1u == (tg + 1u) * nx) xb_add(&bar[XB_TOPGEN], 1u);
            else XB_SPIN(xb_ld(&bar[XB_TOPGEN]) == tg, bar);
            __builtin_amdgcn_fence(__ATOMIC_ACQUIRE, "agent");
            xb_add(&bar[XB_XGEN(b.x)], 1u);
            asm volatile("s_waitcnt vmcnt(0)" ::: "memory");
        } else {
            XB_SPIN(xb_ld(&bar[XB_XGEN(b.x)]) == gen, bar);
            __builtin_amdgcn_fence(__ATOMIC_ACQUIRE, "agent");
            asm volatile("s_waitcnt vmcnt(0)" ::: "memory");
        }
    }
    __syncthreads();
}

namespace pg8 {
constexpr int BM = 256, BK = 64, HALF = 128, HTB = HALF * BK * 2, STAGE_BYTES = 8 * HTB, NXCD = 8, WGM = 8;
__host__ __device__ __forceinline__ int lds_byte(int r, int c) { const int st = (r >> 4) * 2 + (c >> 5), rr = r & 15, cc = c & 31, ob = rr * 64 + cc * 2; return st * 1024 + (ob ^ (((ob >> 9) & 1) << 5)); }
__host__ __device__ __forceinline__ void stage_rc(int b, int& R, int& C) { const int st = b / 1024, sb = b % 1024, swz = sb ^ (((sb >> 9) & 1) << 5); R = (st >> 1) * 16 + swz / 64; C = (st & 1) * 32 + (swz % 64) / 2; }
__host__ __device__ __forceinline__ int perm32(int rho) { const int n = rho >> 4, i = rho & 15; return 8 * (i >> 2) + 4 * n + (i & 3); }

struct Unit { int pm, pn, e, r0; };

__device__ __forceinline__ bool static_order(int i, int G, int c, int nM, int nN, int& pm, int& pn) {
    const int nwg = nM * nN; const long L = (long)i * G + c; if (L >= nwg) return false;
    int wgid = (int)L; { const int q = nwg / NXCD, r = nwg % NXCD, xcd = wgid % NXCD, off = wgid / NXCD; wgid = (xcd < r ? xcd * (q + 1) : r * (q + 1) + (xcd - r) * q) + off; }
    const int nig = WGM * nN, gid = wgid / nig, fm = gid * WGM, gsz = (nM - fm) < WGM ? (nM - fm) : WGM;
    pm = fm + ((wgid % nig) % gsz); pn = (wgid % nig) / gsz; return true;
}
struct DenseSched {
    static constexpr bool GATHER = false;
    const bf16_t* A; const bf16_t* Bt; int K, nM, nN, G, c;
    __device__ __forceinline__ bool next(int i, Unit& u) const { u.e = 0; u.r0 = 0; return static_order(i, G, c, nM, nN, u.pm, u.pn); }
    __device__ __forceinline__ const char* a_base(const Unit& u) const { return (const char*)A + (size_t)u.pm * BM * K * 2; }
    __device__ __forceinline__ const char* b_base(const Unit& u) const { return (const char*)Bt + (size_t)u.pn * BM * K * 2; }
    __device__ __forceinline__ void a_offs(const Unit& u, const int (&R)[2], const int (&C)[2], unsigned (&o)[2][2]) const {
#pragma unroll
        for (int h = 0; h < 2; ++h)
#pragma unroll
            for (int i = 0; i < 2; ++i) o[h][i] = (unsigned)((u.pm * BM + h * HALF + R[i]) * K + C[i]) * 2u;
    }
    __device__ __forceinline__ int load_id(const Unit&, int) const { return 0; }
    __device__ __forceinline__ void a_offs_lds(const LAS int*, const int (&)[2], const int (&)[2], unsigned (&)[2][2]) const {}
};
template <bool GATHER_> struct MoeSched {
    static constexpr bool GATHER = GATHER_;
    const bf16_t* A; const bf16_t* Bt; int K, nN, G, c; size_t bstride;
    const LAS int* tb; const LAS int* cnt; const int* tokList;
    __device__ __forceinline__ bool next(int i, Unit& u) const {
        const int nM = tb[NE];
        if (!static_order(i, G, c, nM, nN, u.pm, u.pn)) return false;
        int e = 0;
#pragma unroll 1
        for (int j = 1; j < NE; ++j) e += (u.pm >= tb[j]) ? 1 : 0;
        u.e = e; u.r0 = (u.pm - tb[e]) * BM; return true;
    }
    __device__ __forceinline__ const char* a_base(const Unit& u) const { return GATHER ? (const char*)A : (const char*)A + (size_t)u.pm * BM * K * 2; }
    __device__ __forceinline__ const char* b_base(const Unit& u) const { return (const char*)Bt + (size_t)u.e * bstride + (size_t)u.pn * BM * K * 2; }
    __device__ __forceinline__ int load_id(const Unit& u, int i) const { const int r = u.r0 + i; return (r < cnt[u.e]) ? tokList[(size_t)u.e * T + r] : 0; }
    __device__ __forceinline__ void a_offs(const Unit& u, const int (&R)[2], const int (&C)[2], unsigned (&o)[2][2]) const {
#pragma unroll
        for (int h = 0; h < 2; ++h)
#pragma unroll
            for (int i = 0; i < 2; ++i) o[h][i] = (unsigned)(load_id(u, h * HALF + R[i]) * K + C[i]) * 2u;
    }
    __device__ __forceinline__ void a_offs_lds(const LAS int* ids, const int (&R)[2], const int (&C)[2], unsigned (&o)[2][2]) const {
#pragma unroll
        for (int h = 0; h < 2; ++h)
#pragma unroll
            for (int i = 0; i < 2; ++i) o[h][i] = (unsigned)(ids[h * HALF + R[i]] * K + C[i]) * 2u;
    }
};


template <class Epi, class Sched, bool ALIGN_EPI>
__device__ __forceinline__ void gemm_phase(LAS unsigned char* lds, const Sched& S, const Epi& E) {
    constexpr bool GATHER = Sched::GATHER;
    const int tid = opaque_v(threadIdx.x), wid = __builtin_amdgcn_readfirstlane(tid >> 6), lane = tid & 63, wr = wid >> 2, wc = wid & 3, fr = lane & 15, fq = lane >> 4;
    const int K = S.K, nt = K / BK;
    int R[2], C[2]; unsigned voffA[2], voffB[2];
#pragma unroll
    for (int i = 0; i < 2; ++i) { stage_rc(tid * 16 + i * 8192, R[i], C[i]); const int Rb = Epi::PERM ? ((R[i] & ~31) + perm32(R[i] & 31)) : R[i];
        voffA[i] = (unsigned)(R[i] * K + C[i]) * 2u; voffB[i] = (unsigned)(Rb * K + C[i]) * 2u; }
    const size_t kstep = (size_t)(BK * 2);
    const size_t hstep = (size_t)HALF * K * 2;
    const unsigned ldsw = (unsigned)wid * 1024u;
    const int aoff = lds_byte(wr * 64 + fr, fq * 8), boff = lds_byte(wc * 32 + fr, fq * 8);
#define PG8_SA(b, h) (((b) * 2 + (h)) * HTB)
#define PG8_SB(b, h) ((4 + (b) * 2 + (h)) * HTB)
#define PG8_STAGE(bufoff, gbase, voff) do { _Pragma("unroll") for (int _i = 0; _i < 2; ++_i) \
        __builtin_amdgcn_global_load_lds((const unsigned*)((const char*)(gbase) + (voff)[_i]), (LAS unsigned*)(lds + (bufoff) + ldsw + _i * 8192), 16, 0, 0); } while (0)
#define PG8_STAGE_A(bufoff, ab, ao, h, kb) do { if constexpr (GATHER) { PG8_STAGE(bufoff, (ab) + (kb), (ao)[h]); } else { PG8_STAGE(bufoff, (ab) + (kb) + (h) * hstep, voffA); } } while (0)
#define PG8_LDA(dst, b, h) do { _Pragma("unroll") for (int m = 0; m < 4; ++m) _Pragma("unroll") for (int k = 0; k < 2; ++k) dst[m][k] = *(const LAS bf16x8*)(lds + PG8_SA(b, h) + aoff + m * 2048 + k * 1024); } while (0)
#define PG8_LDB(dst, b, h) do { _Pragma("unroll") for (int n = 0; n < 2; ++n) _Pragma("unroll") for (int k = 0; k < 2; ++k) dst[n][k] = *(const LAS bf16x8*)(lds + PG8_SB(b, h) + boff + n * 2048 + k * 1024); } while (0)
#define PG8_MMA(ai, bj, At, Bt) do { __builtin_amdgcn_s_setprio(1); _Pragma("unroll") for (int m = 0; m < 4; ++m) _Pragma("unroll") for (int n = 0; n < 2; ++n) _Pragma("unroll") for (int k = 0; k < 2; ++k) \
        acc[ai][bj][m][n] = __builtin_amdgcn_mfma_f32_16x16x32_bf16(Bt[n][k], At[m][k], acc[ai][bj][m][n], 0, 0, 0); __builtin_amdgcn_s_setprio(0); } while (0)
#define PG8_WAIT_V(n) asm volatile("s_waitcnt vmcnt(" #n ")" ::: "memory")
#define PG8_WAIT_L(n) asm volatile("s_waitcnt lgkmcnt(" #n ")" ::: "memory")
#define PG8_BAR __builtin_amdgcn_s_barrier()
#define PG8_SCHED __builtin_amdgcn_sched_barrier(0)
    Unit cur, nxt; int ui = 0;
    if (!S.next(0, cur)) return;
    f32x4 acc[2][2][4][2];
#pragma unroll
    for (int a = 0; a < 2; ++a)
#pragma unroll
        for (int b = 0; b < 2; ++b)
#pragma unroll
            for (int m = 0; m < 4; ++m)
#pragma unroll
                for (int n = 0; n < 2; ++n) acc[a][b][m][n] = (f32x4){0.f, 0.f, 0.f, 0.f};
    bf16x8 At[4][2], B0[2][2], B1[2][2];
    unsigned ca[2][2];
    LAS int* ids = (LAS int*)(lds + IDS_OFF);
    if constexpr (GATHER) { S.a_offs(cur, R, C, ca); Unit n1; if (S.next(1, n1) && tid < 256) ids[tid] = S.load_id(n1, tid); }
    const char* cA = S.a_base(cur);
    const char* cB = S.b_base(cur);
    PG8_STAGE(PG8_SB(0, 0), cB, voffB); PG8_STAGE(PG8_SB(0, 1), cB + hstep, voffB); PG8_STAGE_A(PG8_SA(0, 0), cA, ca, 0, 0); PG8_STAGE_A(PG8_SA(0, 1), cA, ca, 1, 0);
    if (wr == 1) PG8_BAR;
    PG8_WAIT_V(2); PG8_BAR;
    PG8_STAGE(PG8_SB(1, 0), cB + kstep, voffB); PG8_STAGE_A(PG8_SA(1, 0), cA, ca, 0, kstep); PG8_STAGE(PG8_SB(1, 1), cB + hstep + kstep, voffB);
    PG8_WAIT_V(6); PG8_BAR;
    for (;;) {
        const bool has_next = S.next(ui + 1, nxt);
        const char* nA = has_next ? S.a_base(nxt) : cA; const char* nB = has_next ? S.b_base(nxt) : cB;
        for (int t = 0; t < nt; t += 2) {
            const bool last = (t == nt - 2);
            const size_t k1 = (size_t)(t + 1) * kstep;
            const size_t k2 = last ? 0 : (size_t)(t + 2) * kstep, k3 = k2 + kstep;
            const char* a2 = last ? nA : cA; const char* b2 = (last ? nB : cB) + k2; const char* b3 = b2 + kstep;
            PG8_LDB(B0, 0, 0); PG8_LDB(B1, 0, 1); PG8_SCHED; PG8_LDA(At, 0, 0); PG8_STAGE_A(PG8_SA(1, 1), cA, ca, 1, k1);
            PG8_WAIT_V(8); PG8_WAIT_L(0); PG8_BAR; PG8_MMA(0, 0, At, B0); PG8_MMA(0, 1, At, B1); PG8_BAR; PG8_SCHED;
            if constexpr (GATHER) { if (last && has_next) S.a_offs_lds(ids, R, C, ca); }
            PG8_LDA(At, 0, 1); PG8_STAGE(PG8_SB(0, 0), b2, voffB); PG8_STAGE(PG8_SB(0, 1), b2 + hstep, voffB); PG8_STAGE_A(PG8_SA(0, 0), a2, ca, 0, k2);
            PG8_WAIT_V(8); PG8_WAIT_L(0); PG8_BAR; PG8_MMA(1, 0, At, B0); PG8_MMA(1, 1, At, B1); PG8_BAR; PG8_SCHED;
            PG8_LDB(B0, 1, 0); PG8_LDB(B1, 1, 1); PG8_SCHED; PG8_LDA(At, 1, 0); PG8_STAGE_A(PG8_SA(0, 1), a2, ca, 1, k2);
            PG8_WAIT_V(8); PG8_WAIT_L(0); PG8_BAR; PG8_MMA(0, 0, At, B0); PG8_MMA(0, 1, At, B1); PG8_BAR; PG8_SCHED;
            PG8_LDA(At, 1, 1); PG8_STAGE(PG8_SB(1, 0), b3, voffB); PG8_STAGE(PG8_SB(1, 1), b3 + hstep, voffB); PG8_STAGE_A(PG8_SA(1, 0), a2, ca, 0, k3);
            PG8_WAIT_V(8); PG8_WAIT_L(0); PG8_BAR; PG8_MMA(1, 0, At, B0); PG8_MMA(1, 1, At, B1); PG8_BAR; PG8_SCHED;
        }
        if constexpr (ALIGN_EPI) { if (wr == 0) PG8_BAR; }
        int idv = 0; bool fill = false;
        if constexpr (GATHER) { Unit n2; fill = S.next(ui + 2, n2) && tid < 256; if (fill) idv = S.load_id(n2, tid); }
        E(acc, cur, wr, wc, fr, fq);
        if constexpr (GATHER) { if (fill) ids[tid] = idv; }
        if (!has_next) break;
#pragma unroll
        for (int a = 0; a < 2; ++a)
#pragma unroll
            for (int b = 0; b < 2; ++b)
#pragma unroll
                for (int m = 0; m < 4; ++m)
#pragma unroll
                    for (int n = 0; n < 2; ++n) acc[a][b][m][n] = (f32x4){0.f, 0.f, 0.f, 0.f};
        cur = nxt; cA = nA; cB = nB; ++ui;
        if constexpr (ALIGN_EPI) { if (wr == 1) PG8_BAR; }
    }
    PG8_WAIT_V(0);
    if constexpr (!ALIGN_EPI) { if (wr == 0) PG8_BAR; }
    PG8_BAR;
#undef PG8_SA
#undef PG8_SB
#undef PG8_STAGE
#undef PG8_STAGE_A
#undef PG8_LDA
#undef PG8_LDB
#undef PG8_MMA
#undef PG8_WAIT_V
#undef PG8_WAIT_L
#undef PG8_BAR
#undef PG8_SCHED
}

typedef const f32x4 (&AccRef)[2][2][4][2];

struct EpiIn {
    static constexpr bool PERM = true;
    const float* bias; bf16_t *U, *V, *QKV, *GA, *GB;
    __device__ __forceinline__ void operator()(AccRef acc, const Unit& u, int wr, int wc, int fr, int fq) const {
        const int pn = u.pn; bf16_t* base; int ldc = D, colt, act;
        if (pn < 4) { base = U; colt = pn * 256; act = 1; }
        else if (pn < 8) { base = V; colt = (pn - 4) * 256; act = 1; }
        else if (pn < 26) { base = QKV; ldc = QKVW; colt = (pn - 8) * 256; act = 0; }
        else if (pn < 30) { base = GA; colt = (pn - 26) * 256; act = 2; }
        else { base = GB; colt = (pn - 30) * 256; act = 2; }
        const int row0 = u.pm * BM + wr * 64 + fr, col0 = colt + wc * 32 + 8 * fq, bcol0 = pn * BM + wc * 32 + 8 * fq;
        f32x4 bv[2][2];
#pragma unroll
        for (int bj = 0; bj < 2; ++bj)
#pragma unroll
            for (int n = 0; n < 2; ++n) bv[bj][n] = *(const f32x4*)(bias + bcol0 + bj * HALF + 4 * n);
#pragma unroll
        for (int ai = 0; ai < 2; ++ai)
#pragma unroll
            for (int m = 0; m < 4; ++m) { bf16_t* rowp = base + (size_t)(row0 + ai * HALF + m * 16) * ldc + col0;
#pragma unroll
                for (int bj = 0; bj < 2; ++bj) { f32x4 v0 = acc[ai][bj][m][0] + bv[bj][0], v1 = acc[ai][bj][m][1] + bv[bj][1];
                    if (act == 1) { f32x2 a = gelu_pk((f32x2){v0[0], v0[1]}), b = gelu_pk((f32x2){v0[2], v0[3]}), c = gelu_pk((f32x2){v1[0], v1[1]}), d = gelu_pk((f32x2){v1[2], v1[3]});
                        v0 = (f32x4){a.x, a.y, b.x, b.y}; v1 = (f32x4){c.x, c.y, d.x, d.y}; }
                    if (act == 2) {
#pragma unroll
                        for (int j = 0; j < 4; ++j) { v0[j] = sigmoidf_(v0[j]); v1[j] = sigmoidf_(v1[j]); } }
                    u32x4 w; w.x = cvt_pk_bf16(v0[0], v0[1]); w.y = cvt_pk_bf16(v0[2], v0[3]); w.z = cvt_pk_bf16(v1[0], v1[1]); w.w = cvt_pk_bf16(v1[2], v1[3]);
                    *(u32x4*)(rowp + bj * HALF) = w; } }
    }
};
struct EpiT1 {
    static constexpr bool PERM = true;
    const bf16_t* GA; float* T1;
    __device__ __forceinline__ void operator()(AccRef acc, const Unit& u, int wr, int wc, int fr, int fq) const {
        const int row0 = u.pm * BM + wr * 64 + fr, col0 = u.pn * BM + wc * 32 + 8 * fq;
#pragma unroll
        for (int ai = 0; ai < 2; ++ai)
#pragma unroll
            for (int m = 0; m < 4; ++m) { const size_t off = (size_t)(row0 + ai * HALF + m * 16) * D + col0;
#pragma unroll
                for (int bj = 0; bj < 2; ++bj) { const u32x4 g = *(const u32x4*)(GA + off + bj * HALF);
                    const f32x4 g0 = (f32x4){bflo(g.x), bfhi(g.x), bflo(g.y), bfhi(g.y)}, g1 = (f32x4){bflo(g.z), bfhi(g.z), bflo(g.w), bfhi(g.w)};
                    *(f32x4*)(T1 + off + bj * HALF) = acc[ai][bj][m][0] * g0; *(f32x4*)(T1 + off + bj * HALF + 4) = acc[ai][bj][m][1] * g1; }
                asm volatile("" ::: "memory"); }
    }
};
struct EpiMg {
    static constexpr bool PERM = true;
    const bf16_t* GB; const float* T1; bf16_t* MG;
    __device__ __forceinline__ void operator()(AccRef acc, const Unit& u, int wr, int wc, int fr, int fq) const {
        const int row0 = u.pm * BM + wr * 64 + fr, col0 = u.pn * BM + wc * 32 + 8 * fq;
#pragma unroll
        for (int ai = 0; ai < 2; ++ai)
#pragma unroll
            for (int m = 0; m < 4; ++m) { const size_t off = (size_t)(row0 + ai * HALF + m * 16) * D + col0;
#pragma unroll
                for (int bj = 0; bj < 2; ++bj) { const u32x4 g = *(const u32x4*)(GB + off + bj * HALF);
                    const f32x4 t0 = *(const f32x4*)(T1 + off + bj * HALF), t1 = *(const f32x4*)(T1 + off + bj * HALF + 4);
                    const f32x4 g0 = (f32x4){bflo(g.x), bfhi(g.x), bflo(g.y), bfhi(g.y)}, g1 = (f32x4){bflo(g.z), bfhi(g.z), bflo(g.w), bfhi(g.w)};
                    const f32x4 v0 = t0 + acc[ai][bj][m][0] * g0, v1 = t1 + acc[ai][bj][m][1] * g1;
                    u32x4 w; w.x = cvt_pk_bf16(v0[0], v0[1]); w.y = cvt_pk_bf16(v0[2], v0[3]); w.z = cvt_pk_bf16(v1[0], v1[1]); w.w = cvt_pk_bf16(v1[2], v1[3]);
                    *(u32x4*)(MG + off + bj * HALF) = w; }
                asm volatile("" ::: "memory"); }
    }
};
struct EpiWo {
    static constexpr bool PERM = false;
    const float* xa; const float* xb; float* XF;
    __device__ __forceinline__ void operator()(AccRef acc, const Unit& u, int wr, int wc, int fr, int fq) const {
        const int row0 = u.pm * BM + wr * 64 + fr, col0 = u.pn * BM + wc * 32 + 4 * fq;
        const float* xr = (u.pm * BM < TP) ? xa : xb;
#pragma unroll
        for (int ai = 0; ai < 2; ++ai)
#pragma unroll
            for (int m = 0; m < 4; ++m) { const size_t off = (size_t)(row0 + ai * HALF + m * 16) * D + col0;
#pragma unroll
                for (int bj = 0; bj < 2; ++bj)
#pragma unroll
                    for (int n = 0; n < 2; ++n) { const f32x4 x = *(const f32x4*)(xr + off + bj * HALF + n * 16); *(f32x4*)(XF + off + bj * HALF + n * 16) = x * DN_ALPHA + acc[ai][bj][m][n]; }
                asm volatile("" ::: "memory"); }
    }
};
struct EpiGU {
    static constexpr bool PERM = true;
    const float* bgu; bf16_t* H;
    __device__ __forceinline__ void operator()(AccRef acc, const Unit& u, int wr, int wc, int fr, int fq) const {
        const int row0 = u.pm * BM + wr * 64 + fr, cc = u.pn * HALF + wc * 32 + 8 * fq;
        const float* bg = bgu + (size_t)u.e * 2048 + cc;
        const f32x4 bg0 = *(const f32x4*)(bg), bg1 = *(const f32x4*)(bg + 4), bu0 = *(const f32x4*)(bg + 1024), bu1 = *(const f32x4*)(bg + 1028);
#pragma unroll
        for (int ai = 0; ai < 2; ++ai)
#pragma unroll
            for (int m = 0; m < 4; ++m) {
                f32x4 g0 = acc[ai][0][m][0] + bg0, g1 = acc[ai][0][m][1] + bg1, u0 = acc[ai][1][m][0] + bu0, u1 = acc[ai][1][m][1] + bu1, h0, h1;
#pragma unroll
                for (int j = 0; j < 4; ++j) {
                    const float ga = fminf(g0[j], 7.0f), gb = fminf(g1[j], 7.0f);
                    const float ua = fminf(fmaxf(u0[j], -7.0f), 7.0f), ub = fminf(fmaxf(u1[j], -7.0f), 7.0f);
                    h0[j] = (ua + 1.0f) * ga * sigmoidf_(1.702f * ga); h1[j] = (ub + 1.0f) * gb * sigmoidf_(1.702f * gb); }
                u32x4 w; w.x = cvt_pk_bf16(h0[0], h0[1]); w.y = cvt_pk_bf16(h0[2], h0[3]); w.z = cvt_pk_bf16(h1[0], h1[1]); w.w = cvt_pk_bf16(h1[2], h1[3]);
                *(u32x4*)(H + (size_t)(row0 + ai * HALF + m * 16) * D + cc) = w; }
    }
};
struct EpiDown {
    static constexpr bool PERM = true;
    const float* bd; bf16_t* YK;
    __device__ __forceinline__ void operator()(AccRef acc, const Unit& u, int wr, int wc, int fr, int fq) const {
        const int row0 = u.pm * BM + wr * 64 + fr, col0 = u.pn * BM + wc * 32 + 8 * fq;
        f32x4 bv[2][2];
#pragma unroll
        for (int bj = 0; bj < 2; ++bj)
#pragma unroll
            for (int n = 0; n < 2; ++n) bv[bj][n] = *(const f32x4*)(bd + (size_t)u.e * D + col0 + bj * HALF + 4 * n);
#pragma unroll
        for (int ai = 0; ai < 2; ++ai)
#pragma unroll
            for (int m = 0; m < 4; ++m) { bf16_t* rowp = YK + (size_t)(row0 + ai * HALF + m * 16) * D + col0;
#pragma unroll
                for (int bj = 0; bj < 2; ++bj) { const f32x4 v0 = acc[ai][bj][m][0] + bv[bj][0], v1 = acc[ai][bj][m][1] + bv[bj][1];
                    u32x4 w; w.x = cvt_pk_bf16(v0[0], v0[1]); w.y = cvt_pk_bf16(v0[2], v0[3]); w.z = cvt_pk_bf16(v1[0], v1[1]); w.w = cvt_pk_bf16(v1[2], v1[3]);
                    *(u32x4*)(rowp + bj * HALF) = w; } }
    }
};
}

struct Args { const float* in[21]; float* out; unsigned char* ws; int ph_lo, ph_hi; };
enum { I_XP = 0, I_XS, I_WIN, I_BIN, I_LNVG, I_LNVB, I_WS, I_BS, I_WPA, I_WPB, I_WO, I_LN1G, I_LN1B, I_WR, I_BR, I_WGU, I_BGU, I_WD, I_BD, I_LN2G, I_LN2B };

__device__ __forceinline__ void tr_item(const float* W, int K, int N, bf16_t* WT, int k0, int n0, int nd0, LAS unsigned* scr, int lane) {
    const int i = lane & 15, kp = lane >> 4;
    f32x4 a[8], b[8];
#pragma unroll
    for (int it = 0; it < 8; ++it) { const int k = it * 8 + kp * 2; a[it] = *(const f32x4*)(W + (size_t)(k0 + k) * N + n0 + 4 * i); b[it] = *(const f32x4*)(W + (size_t)(k0 + k + 1) * N + n0 + 4 * i); }
#pragma unroll
    for (int it = 0; it < 8; ++it) {
#pragma unroll
        for (int j = 0; j < 4; ++j) scr[(4 * i + j) * 33 + it * 4 + kp] = pk2(a[it][j], b[it][j]); }
    asm volatile("s_waitcnt lgkmcnt(0)" ::: "memory");
    const int nn = lane >> 3, c = lane & 7;
#pragma unroll
    for (int j = 0; j < 8; ++j) { const int n = nn + 8 * j; u32x4 o; o.x = scr[n * 33 + 4 * c]; o.y = scr[n * 33 + 4 * c + 1]; o.z = scr[n * 33 + 4 * c + 2]; o.w = scr[n * 33 + 4 * c + 3];
        *(u32x4*)(WT + (size_t)(nd0 + n) * K + k0 + 8 * c) = o; }
    asm volatile("s_waitcnt lgkmcnt(0)" ::: "memory");
}
__device__ __forceinline__ void p0_prologue(const Args& a, LAS unsigned char* lds, int G) {
    const int tid = opaque_v(threadIdx.x), lane = tid & 63, wave = tid >> 6;
    LAS unsigned* scr = (LAS unsigned*)(lds + wave * 8704);
    const int gw = blockIdx.x * 8 + wave, NGW = G * 8;
    unsigned char* ws = a.ws;
    constexpr int I_GU = DEPTH * NE * 16 * 32, I_D = DEPTH * NE * 16 * 16, I_IN = DEPTH * 16 * 136, I_PA = DEPTH * 256, I_PB = DEPTH * 8 * 16, I_O = DEPTH * 256;
    constexpr int NITEMS = I_GU + I_D + I_IN + I_PA + I_PB + I_O;
    for (int it = gw; it < NITEMS; it += NGW) {
        int r = it;
        if (r < I_GU) { const int mat = r / 512, q = r % 512, kb = q / 32, nb = q % 32, n0 = nb * 64, c = n0 & 1023, nd0 = (c >> 7) * 256 + ((n0 >= 1024) ? 128 : 0) + (c & 127);
            tr_item(a.in[I_WGU] + (size_t)mat * 1024 * 2048, 1024, 2048, (bf16_t*)(ws + WS_WGU) + (size_t)mat * 2048 * 1024, kb * 64, n0, nd0, scr, lane); continue; }
        r -= I_GU;
        if (r < I_D) { const int mat = r / 256, q = r % 256, kb = q / 16, nb = q % 16;
            tr_item(a.in[I_WD] + (size_t)mat * 1024 * 1024, 1024, 1024, (bf16_t*)(ws + WS_WD) + (size_t)mat * 1024 * 1024, kb * 64, nb * 64, nb * 64, scr, lane); continue; }
        r -= I_D;
        if (r < I_IN) { const int mat = r / (16 * 136), q = r % (16 * 136), kb = q / 136, nb = q % 136;
            tr_item(a.in[I_WIN] + (size_t)mat * 1024 * DIN, 1024, DIN, (bf16_t*)(ws + WS_WIN) + (size_t)mat * DIN * 1024, kb * 64, nb * 64, nb * 64, scr, lane); continue; }
        r -= I_IN;
        if (r < I_PA) { const int mat = r / 256, q = r % 256, kb = q / 16, nb = q % 16;
            tr_item(a.in[I_WPA] + (size_t)mat * 1024 * 1024, 1024, 1024, (bf16_t*)(ws + WS_WPA) + (size_t)mat * 1024 * 1024, kb * 64, nb * 64, nb * 64, scr, lane); continue; }
        r -= I_PA;
        if (r < I_PB) { const int mat = r / 128, q = r % 128, kb = q / 16, nb = q % 16;
            tr_item(a.in[I_WPB] + (size_t)mat * 512 * 1024, 512, 1024, (bf16_t*)(ws + WS_WPB) + (size_t)mat * 1024 * 512, kb * 64, nb * 64, nb * 64, scr, lane); continue; }
        r -= I_PB;
        { const int mat = r / 256, q = r % 256, kb = q / 16, nb = q % 16;
            tr_item(a.in[I_WO] + (size_t)mat * 1024 * 1024, 1024, 1024, (bf16_t*)(ws + WS_WO) + (size_t)mat * 1024 * 1024, kb * 64, nb * 64, nb * 64, scr, lane); }
    }
    const size_t gt = (size_t)blockIdx.x * 512 + tid, NGT = (size_t)G * 512;
    { float* prm = (float*)(ws + WS_PRM);
#define CPY(idx, off, n) for (size_t i = gt; i < (size_t)(n) / 4; i += NGT) *(f32x4*)(prm + (off) + i * 4) = *(const f32x4*)(a.in[idx] + i * 4)
      CPY(I_BIN, PR_BIN, DEPTH * DIN); CPY(I_LNVG, PR_LNVG, DEPTH * D); CPY(I_LNVB, PR_LNVB, DEPTH * D); CPY(I_BS, PR_BS, DEPTH * D); CPY(I_LN1G, PR_LN1G, DEPTH * D); CPY(I_LN1B, PR_LN1B, DEPTH * D);
      CPY(I_WR, PR_WR, DEPTH * D * NE); CPY(I_BR, PR_BR, DEPTH * NE); CPY(I_BGU, PR_BGU, DEPTH * NE * 2048); CPY(I_BD, PR_BD, DEPTH * NE * D); CPY(I_LN2G, PR_LN2G, DEPTH * D); CPY(I_LN2B, PR_LN2B, DEPTH * D);
#undef CPY
    }
    { const float* src = a.in[I_WS]; bf16_t* dst = (bf16_t*)(ws + WS_WS);
      for (size_t i = gt; i < (size_t)DEPTH * 8 * 128 * 128 / 8; i += NGT) { const f32x4 x = *(const f32x4*)(src + i * 8), y = *(const f32x4*)(src + i * 8 + 4);
          u32x4 o; o.x = pk2(x[0], x[1]); o.y = pk2(x[2], x[3]); o.z = pk2(y[0], y[1]); o.w = pk2(y[2], y[3]); *(u32x4*)(dst + i * 8) = o; } }
    { bf16_t* dst = (bf16_t*)(ws + WS_XB);
      for (size_t i = gt; i < (size_t)T * D / 8; i += NGT) { const size_t e = i * 8; const float* src = (e < (size_t)TP * D) ? a.in[I_XP] + e : a.in[I_XS] + (e - (size_t)TP * D);
          const f32x4 x = *(const f32x4*)(src), y = *(const f32x4*)(src + 4);
          u32x4 o; o.x = pk2(x[0], x[1]); o.y = pk2(x[2], x[3]); o.z = pk2(y[0], y[1]); o.w = pk2(y[2], y[3]); *(u32x4*)(dst + e) = o; } }
}

template <int BASE> __device__ __forceinline__ void tr8(unsigned addr, s16x4 (&r)[8]) {
    asm volatile("ds_read_b64_tr_b16 %0, %8 offset:%9\n\tds_read_b64_tr_b16 %1, %8 offset:%10\n\tds_read_b64_tr_b16 %2, %8 offset:%11\n\tds_read_b64_tr_b16 %3, %8 offset:%12\n\t"
                 "ds_read_b64_tr_b16 %4, %8 offset:%13\n\tds_read_b64_tr_b16 %5, %8 offset:%14\n\tds_read_b64_tr_b16 %6, %8 offset:%15\n\tds_read_b64_tr_b16 %7, %8 offset:%16\n\t"
                 : "=&v"(r[0]), "=&v"(r[1]), "=&v"(r[2]), "=&v"(r[3]), "=&v"(r[4]), "=&v"(r[5]), "=&v"(r[6]), "=&v"(r[7])
                 : "v"(addr), "n"(BASE), "n"(BASE + 32), "n"(BASE + 64), "n"(BASE + 96), "n"(BASE + 128), "n"(BASE + 160), "n"(BASE + 192), "n"(BASE + 224) : "memory");
}
__device__ __forceinline__ bf16x8 cat4(s16x4 a, s16x4 b) { return (bf16x8){a[0], a[1], a[2], a[3], b[0], b[1], b[2], b[3]}; }

constexpr int AT_KSTR = 272, AT_VSTR = 288, AT_KBYTES = 256 * AT_KSTR, AT_VOFF = AT_KBYTES, AT_VBYTES = 256 * AT_VSTR;
static_assert(AT_VOFF + AT_VBYTES <= SCR_BYTES, "attention LDS");

template <int ST> __device__ __forceinline__ void attn_pv_step(unsigned vaddr, const f32x4 (&s)[9], f32x4 (&o)[8]) {
    s16x4 r0[8], r1[8];
    tr8<ST * 32 * AT_VSTR>(vaddr, r0);
    tr8<ST * 32 * AT_VSTR + (ST < 4 ? 16 * AT_VSTR : 0)>(vaddr, r1);
    asm volatile("s_waitcnt lgkmcnt(0)" ::: "memory");
    __builtin_amdgcn_sched_barrier(0);
    u32x4 pw; pw.x = cvt_pk_bf16(s[2 * ST][0], s[2 * ST][1]); pw.y = cvt_pk_bf16(s[2 * ST][2], s[2 * ST][3]);
    if (ST < 4) { pw.z = cvt_pk_bf16(s[2 * ST + (ST < 4 ? 1 : 0)][0], s[2 * ST + (ST < 4 ? 1 : 0)][1]); pw.w = cvt_pk_bf16(s[2 * ST + (ST < 4 ? 1 : 0)][2], s[2 * ST + (ST < 4 ? 1 : 0)][3]); }
    else { pw.z = 0u; pw.w = 0u; }
    const bf16x8 pf = __builtin_bit_cast(bf16x8, pw);
#pragma unroll
    for (int db = 0; db < 8; ++db) o[db] = __builtin_amdgcn_mfma_f32_16x16x32_bf16(cat4(r0[db], r1[db]), pf, o[db], 0, 0, 0);
}

__device__ __forceinline__ void attn_unit(LAS unsigned char* lds, const bf16_t* QKV, bf16_t* OG, float* LSE, int unit) {
    const int tid = opaque_v(threadIdx.x), lane = tid & 63, w = tid >> 6, ql = lane & 15, quad = lane >> 4;
    const int wsub = unit & 31, h = (unit >> 5) & 3, bg = unit >> 7, g = bg % 3, b = bg / 3;
    const int dsh = 2 * g, dil = 1 << dsh, L = SEQ >> dsh, nblk = L >> 7, r = wsub / nblk, blk = wsub % nblk, p0 = blk * 128;
    const int qc = g * 1536 + h * 128, kc = qc + 512, vc = qc + 1024;
    const float slope = __builtin_amdgcn_exp2f(-(2.0f / 3.0f) * (float)(4 * g + h + 1));
    const float ca = slope * (float)dil * LOG2E, SC = 0.08838834764831845f * LOG2E;
    const int qrow = b * SEQ + (p0 + 16 * w + ql) * dil + r;
    bf16x8 qf[4];
#pragma unroll
    for (int ks = 0; ks < 4; ++ks) qf[ks] = *(const bf16x8*)(QKV + (size_t)qrow * QKVW + qc + 32 * ks + 8 * quad);
    {
        u32x4 kr[8], vr[8];
#pragma unroll
        for (int j = 0; j < 8; ++j) { const int id = tid + 512 * j, kk = id >> 4, ch = id & 15, pk = p0 - 64 + kk;
            if (pk >= 0 && pk < L) { const size_t ro = (size_t)(b * SEQ + pk * dil + r) * QKVW; kr[j] = *(const u32x4*)(QKV + ro + kc + ch * 8); vr[j] = *(const u32x4*)(QKV + ro + vc + ch * 8); }
            else { kr[j] = (u32x4){0u, 0u, 0u, 0u}; vr[j] = (u32x4){0u, 0u, 0u, 0u}; } }
#pragma unroll
        for (int j = 0; j < 8; ++j) { const int id = tid + 512 * j, kk = id >> 4, ch = id & 15;
            *(LAS u32x4*)(lds + kk * AT_KSTR + ch * 16) = kr[j]; *(LAS u32x4*)(lds + AT_VOFF + kk * AT_VSTR + ch * 16) = vr[j]; }
    }
    __syncthreads();
    f32x4 s[9];
#pragma unroll
    for (int j = 0; j < 9; ++j) { s[j] = (f32x4){0.f, 0.f, 0.f, 0.f};
#pragma unroll
        for (int ks = 0; ks < 4; ++ks) { const bf16x8 kf = *(const LAS bf16x8*)(lds + (16 * w + 16 * j + ql) * AT_KSTR + (32 * ks + 8 * quad) * 2);
            s[j] = __builtin_amdgcn_mfma_f32_16x16x32_bf16(kf, qf[ks], s[j], 0, 0, 0); } }
    float mx = -1e30f;
#pragma unroll
    for (int j = 0; j < 9; ++j)
#pragma unroll
        for (int i = 0; i < 4; ++i) { const int rel = 16 * j + 4 * quad + i - 64 - ql, pk = p0 + 16 * w + ql + rel, ar = rel < 0 ? -rel : rel;
            const bool ok = (ar <= 64) && (pk >= 0) && (pk < L);
            const float v = ok ? (s[j][i] * SC - ca * (float)ar) : -1e30f; s[j][i] = v; mx = fmaxf(mx, v); }
    mx = fmaxf(mx, __shfl_xor(mx, 16)); mx = fmaxf(mx, __shfl_xor(mx, 32));
    float den = 0.f;
#pragma unroll
    for (int j = 0; j < 9; ++j)
#pragma unroll
        for (int i = 0; i < 4; ++i) { const float p = __builtin_amdgcn_exp2f(s[j][i] - mx); s[j][i] = p; den += p; }
    den += __shfl_xor(den, 16); den += __shfl_xor(den, 32);
    f32x4 o[8];
#pragma unroll
    for (int db = 0; db < 8; ++db) o[db] = (f32x4){0.f, 0.f, 0.f, 0.f};
    const unsigned vaddr = (unsigned)(uintptr_t)(lds + AT_VOFF) + (unsigned)((16 * w + 4 * quad + (ql >> 2)) * AT_VSTR + (ql & 3) * 8);
    attn_pv_step<0>(vaddr, s, o); attn_pv_step<1>(vaddr, s, o); attn_pv_step<2>(vaddr, s, o); attn_pv_step<3>(vaddr, s, o); attn_pv_step<4>(vaddr, s, o);
    const float inv = 1.0f / den;
    bf16_t* orow = OG + ((size_t)g * T + qrow) * 512 + h * 128 + 4 * quad;
#pragma unroll
    for (int db = 0; db < 8; ++db) { u32x2 wv; wv.x = cvt_pk_bf16(o[db][0] * inv, o[db][1] * inv); wv.y = cvt_pk_bf16(o[db][2] * inv, o[db][3] * inv); *(u32x2*)(orow + 16 * db) = wv; }
    if (quad == 0) LSE[((size_t)g * T + qrow) * 4 + h] = (mx + __builtin_amdgcn_logf(den)) * LN2;
    __syncthreads();
}

constexpr int SG_STR = 288, SG_TILE = 128 * SG_STR, SG_STATS = 2 * SG_TILE;
template <int KS> __device__ __forceinline__ void sg_step(unsigned vaddr, const bf16x8 wf, f32x4 (&acc)[8]) {
    s16x4 r0[8], r1[8];
    tr8<KS * 32 * SG_STR>(vaddr, r0);
    tr8<KS * 32 * SG_STR + 4 * SG_STR>(vaddr, r1);
    asm volatile("s_waitcnt lgkmcnt(0)" ::: "memory");
    __builtin_amdgcn_sched_barrier(0);
#pragma unroll
    for (int cb = 0; cb < 8; ++cb) acc[cb] = __builtin_amdgcn_mfma_f32_16x16x32_bf16(cat4(r0[cb], r1[cb]), wf, acc[cb], 0, 0, 0);
}
__device__ __forceinline__ void sg_unit(LAS unsigned char* lds, const bf16_t* U, const bf16_t* V, bf16_t* AOUT, const bf16_t* WsB, const float* bs, const float* lng, const float* lnb, int unit) {
    const int tid = opaque_v(threadIdx.x), lane = tid & 63, w = tid >> 6, ql = lane & 15, quad = lane >> 4;
    const int ci = unit >> 1, hh = unit & 1, row0 = ci * 128;
    LAS float* stats = (LAS float*)(lds + SG_STATS);
#pragma unroll 4
    for (int rr = 0; rr < 16; ++rr) { const int row = row0 + 16 * w + rr;
        const u32x4 x0 = *(const u32x4*)(V + (size_t)row * D + lane * 16), x1 = *(const u32x4*)(V + (size_t)row * D + lane * 16 + 8);
        float f[16] = {bflo(x0.x), bfhi(x0.x), bflo(x0.y), bfhi(x0.y), bflo(x0.z), bfhi(x0.z), bflo(x0.w), bfhi(x0.w), bflo(x1.x), bfhi(x1.x), bflo(x1.y), bfhi(x1.y), bflo(x1.z), bfhi(x1.z), bflo(x1.w), bfhi(x1.w)};
        float sm = 0.f;
#pragma unroll
        for (int j = 0; j < 16; ++j) sm += f[j];
        const float mean = wave_sum(sm) * (1.0f / D); float s2 = 0.f;
#pragma unroll
        for (int j = 0; j < 16; ++j) { const float d = f[j] - mean; s2 += d * d; }
        const float rstd = 1.0f / sqrtf(wave_sum(s2) * (1.0f / D) + LN_EPS);
        if (lane == 0) { stats[2 * (16 * w + rr)] = mean; stats[2 * (16 * w + rr) + 1] = rstd; } }
    __syncthreads();
    const int ch = tid & 15;
#pragma unroll 1
    for (int gi = 0; gi < 4; ++gi) {
        const int g = 4 * hh + gi; LAS unsigned char* tile = lds + (gi & 1) * SG_TILE;
        const f32x4 ga0 = *(const f32x4*)(lng + g * 128 + ch * 8), ga1 = *(const f32x4*)(lng + g * 128 + ch * 8 + 4), be0 = *(const f32x4*)(lnb + g * 128 + ch * 8), be1 = *(const f32x4*)(lnb + g * 128 + ch * 8 + 4);
#pragma unroll
        for (int j = 0; j < 4; ++j) { const int sr = (tid >> 4) + 32 * j; const u32x4 x = *(const u32x4*)(V + (size_t)(row0 + sr) * D + g * 128 + ch * 8);
            const float mean = stats[2 * sr], rstd = stats[2 * sr + 1];
            const f32x4 a = ((f32x4){bflo(x.x), bfhi(x.x), bflo(x.y), bfhi(x.y)} - mean) * rstd * ga0 + be0, bq = ((f32x4){bflo(x.z), bfhi(x.z), bflo(x.w), bfhi(x.w)} - mean) * rstd * ga1 + be1;
            u32x4 o; o.x = cvt_pk_bf16(a[0], a[1]); o.y = cvt_pk_bf16(a[2], a[3]); o.z = cvt_pk_bf16(bq[0], bq[1]); o.w = cvt_pk_bf16(bq[2], bq[3]);
            *(LAS u32x4*)(tile + sr * SG_STR + ch * 16) = o; }
        const bf16_t* Wg = WsB + (size_t)g * 128 * 128 + (size_t)(16 * w + ql) * 128 + 8 * quad;
        bf16x8 wf[4];
#pragma unroll
        for (int ks = 0; ks < 4; ++ks) wf[ks] = *(const bf16x8*)(Wg + 32 * ks);
        __syncthreads();
        f32x4 acc[8];
#pragma unroll
        for (int cb = 0; cb < 8; ++cb) acc[cb] = (f32x4){0.f, 0.f, 0.f, 0.f};
        const unsigned vaddr = (unsigned)(uintptr_t)tile + (unsigned)((8 * quad + (ql >> 2)) * SG_STR + (ql & 3) * 8);
        sg_step<0>(vaddr, wf[0], acc); sg_step<1>(vaddr, wf[1], acc); sg_step<2>(vaddr, wf[2], acc); sg_step<3>(vaddr, wf[3], acc);
        const int t = 16 * w + ql; const float bst = bs[g * 128 + t];
        const size_t off = (size_t)(row0 + t) * D + g * 128 + 4 * quad;
#pragma unroll
        for (int cb = 0; cb < 8; ++cb) { const u32x2 uu = *(const u32x2*)(U + off + 16 * cb);
            u32x2 o; o.x = cvt_pk_bf16(bflo(uu.x) * (acc[cb][0] + bst), bfhi(uu.x) * (acc[cb][1] + bst)); o.y = cvt_pk_bf16(bflo(uu.y) * (acc[cb][2] + bst), bfhi(uu.y) * (acc[cb][3] + bst));
            *(u32x2*)(AOUT + off + 16 * cb) = o; }
    }
    __syncthreads();
}

__device__ __forceinline__ void merge_phase(const bf16_t* OG, const float* LSE, bf16_t* BOUT, int G) {
    const int tid = opaque_v(threadIdx.x), lane = tid & 63, gw = blockIdx.x * 8 + (tid >> 6), NGW = G * 8, hd = lane >> 4;
    for (int row = gw; row < T; row += NGW) {
        const float l0 = LSE[((size_t)0 * T + row) * 4 + hd], l1 = LSE[((size_t)1 * T + row) * 4 + hd], l2 = LSE[((size_t)2 * T + row) * 4 + hd];
        const float m = fmaxf(l0, fmaxf(l1, l2));
        float w0 = __builtin_amdgcn_exp2f((l0 - m) * LOG2E), w1 = __builtin_amdgcn_exp2f((l1 - m) * LOG2E), w2 = __builtin_amdgcn_exp2f((l2 - m) * LOG2E);
        const float inv = 1.0f / (w0 + w1 + w2); w0 *= inv; w1 *= inv; w2 *= inv;
        const u32x4 a = *(const u32x4*)(OG + ((size_t)0 * T + row) * 512 + lane * 8), b = *(const u32x4*)(OG + ((size_t)1 * T + row) * 512 + lane * 8), c = *(const u32x4*)(OG + ((size_t)2 * T + row) * 512 + lane * 8);
        u32x4 o;
        o.x = cvt_pk_bf16(w0 * bflo(a.x) + w1 * bflo(b.x) + w2 * bflo(c.x), w0 * bfhi(a.x) + w1 * bfhi(b.x) + w2 * bfhi(c.x));
        o.y = cvt_pk_bf16(w0 * bflo(a.y) + w1 * bflo(b.y) + w2 * bflo(c.y), w0 * bfhi(a.y) + w1 * bfhi(b.y) + w2 * bfhi(c.y));
        o.z = cvt_pk_bf16(w0 * bflo(a.z) + w1 * bflo(b.z) + w2 * bflo(c.z), w0 * bfhi(a.z) + w1 * bfhi(b.z) + w2 * bfhi(c.z));
        o.w = cvt_pk_bf16(w0 * bflo(a.w) + w1 * bflo(b.w) + w2 * bflo(c.w), w0 * bfhi(a.w) + w1 * bfhi(b.w) + w2 * bfhi(c.w));
        *(u32x4*)(BOUT + (size_t)row * 512 + lane * 8) = o;
    }
}

constexpr int RT_WSTR = 36, RT_WBYTES = 1024 * RT_WSTR * 4, RT_ENT = RT_WBYTES;
static_assert(RT_ENT + 64 * 4 * 8 <= SCR_BYTES, "router LDS");
__device__ __forceinline__ void ln1_router_phase(LAS unsigned char* lds, volatile LAS unsigned* MISC, float* XF, bf16_t* XB, const float* g1, const float* b1, const float* wr, const float* br,
                                                 unsigned* gcnt, int* tokList, int* tokE, int* tokPos, float* gate, int G) {
    const int tid = opaque_v(threadIdx.x), lane = tid & 63, w = tid >> 6;
    LAS float* wl = (LAS float*)lds;
    for (int i = tid; i < 1024 * 8; i += 512) { const int k = i >> 3, c4 = i & 7; const f32x4 v = *(const f32x4*)(wr + (size_t)k * 32 + c4 * 4);
        const int slot = ((k >> 8) * 4 + (k & 3)) * 64 + ((k >> 2) & 63); *(LAS f32x4*)(wl + slot * RT_WSTR + c4 * 4) = v; }
    LAS int* ent = (LAS int*)(lds + RT_ENT);
    volatile LAS unsigned* lcnt = MISC + 128; volatile LAS unsigned* gbase = MISC + 160;
    if (tid < 32) lcnt[tid] = 0u;
    f32x4 gv[4], bv[4];
#pragma unroll
    for (int j = 0; j < 4; ++j) { gv[j] = *(const f32x4*)(g1 + 256 * j + 4 * lane); bv[j] = *(const f32x4*)(b1 + 256 * j + 4 * lane); }
    const float myb = br[(lane >> 1) & 31];
    __syncthreads();
    for (int bt = blockIdx.x; bt < T / 64; bt += G) {
#pragma unroll 1
        for (int rr = 0; rr < 8; ++rr) {
            const int row = bt * 64 + w * 8 + rr;
            f32x4 v[4]; float s = 0.f;
#pragma unroll
            for (int j = 0; j < 4; ++j) { v[j] = *(const f32x4*)(XF + (size_t)row * D + 256 * j + 4 * lane); s += (v[j][0] + v[j][1]) + (v[j][2] + v[j][3]); }
            const float mean = wave_sum(s) * (1.0f / D); float s2 = 0.f;
#pragma unroll
            for (int j = 0; j < 4; ++j) { v[j] = v[j] - mean; s2 += (v[j][0] * v[j][0] + v[j][1] * v[j][1]) + (v[j][2] * v[j][2] + v[j][3] * v[j][3]); }
            const float rstd = 1.0f / sqrtf(wave_sum(s2) * (1.0f / D) + LN_EPS);
#pragma unroll
            for (int j = 0; j < 4; ++j) { v[j] = v[j] * rstd * gv[j] + bv[j];
                *(f32x4*)(XF + (size_t)row * D + 256 * j + 4 * lane) = v[j];
                u32x2 o; o.x = cvt_pk_bf16(v[j][0], v[j][1]); o.y = cvt_pk_bf16(v[j][2], v[j][3]); *(u32x2*)(XB + (size_t)row * D + 256 * j + 4 * lane) = o; }
            float acc[32];
#pragma unroll
            for (int e = 0; e < 32; ++e) acc[e] = 0.f;
#pragma unroll
            for (int j = 0; j < 4; ++j)
#pragma unroll
                for (int jj = 0; jj < 4; ++jj) { const LAS float* wp = wl + ((j * 4 + jj) * 64 + lane) * RT_WSTR; const float x = v[j][jj];
#pragma unroll
                    for (int c4 = 0; c4 < 8; ++c4) { const f32x4 wv = *(const LAS f32x4*)(wp + c4 * 4); acc[c4 * 4] += x * wv[0]; acc[c4 * 4 + 1] += x * wv[1]; acc[c4 * 4 + 2] += x * wv[2]; acc[c4 * 4 + 3] += x * wv[3]; } }
            float r16[16], r8[8], r4[4], r2[2], lg;
            { const bool hi = (lane & 32) != 0;
#pragma unroll
              for (int i = 0; i < 16; ++i) { const float mine = hi ? acc[16 + i] : acc[i], oth = hi ? acc[i] : acc[16 + i]; r16[i] = mine + __shfl_xor(oth, 32); } }
            { const bool hi = (lane & 16) != 0;
#pragma unroll
              for (int i = 0; i < 8; ++i) { const float mine = hi ? r16[8 + i] : r16[i], oth = hi ? r16[i] : r16[8 + i]; r8[i] = mine + __shfl_xor(oth, 16); } }
            { const bool hi = (lane & 8) != 0;
#pragma unroll
              for (int i = 0; i < 4; ++i) { const float mine = hi ? r8[4 + i] : r8[i], oth = hi ? r8[i] : r8[4 + i]; r4[i] = mine + __shfl_xor(oth, 8); } }
            { const bool hi = (lane & 4) != 0;
#pragma unroll
              for (int i = 0; i < 2; ++i) { const float mine = hi ? r4[2 + i] : r4[i], oth = hi ? r4[i] : r4[2 + i]; r2[i] = mine + __shfl_xor(oth, 4); } }
            { const bool hi = (lane & 2) != 0; const float mine = hi ? r2[1] : r2[0], oth = hi ? r2[0] : r2[1]; lg = mine + __shfl_xor(oth, 2); }
            lg += __shfl_xor(lg, 1);
            lg += myb;
            const int me = (lane >> 1) & 31;
            float tv[4]; int ti[4]; float cur = lg;
#pragma unroll
            for (int k = 0; k < 4; ++k) { float bvv = cur; int bi = me;
#pragma unroll
                for (int o = 1; o < 64; o <<= 1) { const float ov = __shfl_xor(bvv, o); const int oi = __shfl_xor(bi, o); if (ov > bvv || (ov == bvv && oi < bi)) { bvv = ov; bi = oi; } }
                tv[k] = bvv; ti[k] = bi; if (me == bi) cur = -3.0e38f; }
            const float e1 = __builtin_amdgcn_exp2f((tv[1] - tv[0]) * LOG2E), e2 = __builtin_amdgcn_exp2f((tv[2] - tv[0]) * LOG2E), e3 = __builtin_amdgcn_exp2f((tv[3] - tv[0]) * LOG2E);
            const float inv = 1.0f / (1.0f + e1 + e2 + e3);
            if (lane < 4) { const int e = lane == 0 ? ti[0] : lane == 1 ? ti[1] : lane == 2 ? ti[2] : ti[3]; const float gt = (lane == 0 ? 1.0f : lane == 1 ? e1 : lane == 2 ? e2 : e3) * inv;
                const unsigned lp = __hip_atomic_fetch_add((LAS unsigned*)&lcnt[e], 1u, __ATOMIC_RELAXED, __HIP_MEMORY_SCOPE_WORKGROUP);
                ent[((w * 8 + rr) * 4 + lane) * 2] = e; ent[((w * 8 + rr) * 4 + lane) * 2 + 1] = (int)lp;
                gate[(size_t)row * 4 + lane] = gt; tokE[(size_t)row * 4 + lane] = e; }
        }
        __syncthreads();
        if (tid < 32) { const unsigned n = lcnt[tid]; gbase[tid] = n ? __hip_atomic_fetch_add(gcnt + tid, n, __ATOMIC_RELAXED, __HIP_MEMORY_SCOPE_AGENT) : 0u; }
        __syncthreads();
        if (tid < 256) { const int e = ent[tid * 2], lp = ent[tid * 2 + 1], row = bt * 64 + (tid >> 2), pos = (int)gbase[e] + lp;
            tokList[(size_t)e * T + pos] = row; tokPos[(size_t)row * 4 + (tid & 3)] = pos; }
        if (tid < 32) lcnt[tid] = 0u;
        __syncthreads();
    }
}

__device__ __forceinline__ void combine_ln2_phase(volatile LAS unsigned* MISC, const float* XF, const bf16_t* YK, const int* tokE, const int* tokPos, const float* gate, const float* g2, const float* b2,
                                                  float* outF, bf16_t* XB, int G) {
    const int tid = opaque_v(threadIdx.x), lane = tid & 63, gw = blockIdx.x * 8 + (tid >> 6), NGW = G * 8;
    const volatile LAS int* tb = (const volatile LAS int*)(MISC + 16);
    f32x4 gv[4], bv[4];
#pragma unroll
    for (int j = 0; j < 4; ++j) { gv[j] = *(const f32x4*)(g2 + 256 * j + 4 * lane); bv[j] = *(const f32x4*)(b2 + 256 * j + 4 * lane); }
    for (int row = gw; row < T; row += NGW) {
        f32x4 v[4];
#pragma unroll
        for (int j = 0; j < 4; ++j) v[j] = *(const f32x4*)(XF + (size_t)row * D + 256 * j + 4 * lane) * DN_ALPHA;
#pragma unroll
        for (int k = 0; k < 4; ++k) { const int e = tokE[(size_t)row * 4 + k], pos = tokPos[(size_t)row * 4 + k]; const float gt = gate[(size_t)row * 4 + k];
            const size_t slot = (size_t)tb[e] * 256 + pos;
#pragma unroll
            for (int j = 0; j < 4; ++j) { const u32x2 y = *(const u32x2*)(YK + slot * D + 256 * j + 4 * lane); v[j] += (f32x4){bflo(y.x), bfhi(y.x), bflo(y.y), bfhi(y.y)} * gt; } }
        float s = 0.f;
#pragma unroll
        for (int j = 0; j < 4; ++j) s += (v[j][0] + v[j][1]) + (v[j][2] + v[j][3]);
        const float mean = wave_sum(s) * (1.0f / D); float s2 = 0.f;
#pragma unroll
        for (int j = 0; j < 4; ++j) { v[j] = v[j] - mean; s2 += (v[j][0] * v[j][0] + v[j][1] * v[j][1]) + (v[j][2] * v[j][2] + v[j][3] * v[j][3]); }
        const float rstd = 1.0f / sqrtf(wave_sum(s2) * (1.0f / D) + LN_EPS);
#pragma unroll
        for (int j = 0; j < 4; ++j) { v[j] = v[j] * rstd * gv[j] + bv[j];
            *(f32x4*)(outF + (size_t)row * D + 256 * j + 4 * lane) = v[j];
            u32x2 o; o.x = cvt_pk_bf16(v[j][0], v[j][1]); o.y = cvt_pk_bf16(v[j][2], v[j][3]); *(u32x2*)(XB + (size_t)row * D + 256 * j + 4 * lane) = o; }
    }
}

__device__ __forceinline__ void moe_tables(volatile LAS unsigned* MISC, const unsigned* gcnt) {
    if (threadIdx.x == 0) { int acc = 0;
        for (int e = 0; e < NE; ++e) { const int n = (int)__hip_atomic_load(gcnt + e, __ATOMIC_RELAXED, __HIP_MEMORY_SCOPE_AGENT); MISC[64 + e] = (unsigned)n; MISC[16 + e] = (unsigned)acc; acc += (n + 255) >> 8; }
        MISC[16 + NE] = (unsigned)acc; }
    __syncthreads();
}

__global__ void __launch_bounds__(512, 2) fwd_kernel(Args args) {
    extern __shared__ __attribute__((aligned(16))) unsigned char lds_raw[];
    LAS unsigned char* lds = (LAS unsigned char*)lds_raw;
    volatile LAS unsigned* MISC = (volatile LAS unsigned*)(lds + MISC_OFF);
    const int tid = threadIdx.x, G = gridDim.x;
    unsigned char* const ws0 = args.ws;
    unsigned* ctl = (unsigned*)(ws0 + WS_CTL);
    for (int u = tid; u < 256; u += 512) MISC[u] = 0u;
    __syncthreads();
    const int lo = args.ph_lo, hi = args.ph_hi;
    XcdBarrier bar; bar.bar = ctl + CW_BAR; bar.x = 0; bar.st = MISC;
    if (hi - lo > 1) bar = xcd_barrier_post(ctl + CW_BAR, MISC);
#ifndef PH_MASK
#define PH_MASK 0x3ff
#endif
#define IN(k) (lo <= (k) && (k) < hi)
#define PON(p) (((PH_MASK) >> (p)) & 1)
#define SEAM(k) do { if (IN((k) + 1)) xcd_barrier(bar); } while (0)
#define WSP(T_, off) ((T_*)(ws + (off)))
#define PRM(off) ((const float*)(ws + WS_PRM) + (off))

    if (PON(9) && IN(0)) { p0_prologue(args, lds, G); SEAM(0); }

#pragma unroll 1
    for (int l = 0; l < DEPTH; ++l) {
        const int pb = 1 + l * NPH;
        if (PON(0) && IN(pb + 0)) { unsigned char* ws = opaque_p(ws0); unsigned* ctl = (unsigned*)(ws + WS_CTL); (void)ctl;
            pg8::DenseSched S{WSP(const bf16_t, WS_XB), WSP(const bf16_t, WS_WIN) + (size_t)l * DIN * D, D, T / 256, DIN / 256, G, (int)blockIdx.x};
            pg8::EpiIn E{PRM(PR_BIN) + (size_t)l * DIN, WSP(bf16_t, WS_U), WSP(bf16_t, WS_V), WSP(bf16_t, WS_QKV), WSP(bf16_t, WS_GA), WSP(bf16_t, WS_GB)};
            pg8::gemm_phase<pg8::EpiIn, pg8::DenseSched, true>(lds, S, E);
            SEAM(pb + 0);
        }
        if (PON(1) && IN(pb + 1)) { unsigned char* ws = opaque_p(ws0); unsigned* ctl = (unsigned*)(ws + WS_CTL); (void)ctl;
            for (int u = blockIdx.x; u < 12 * 3 * 4 * 32; u += G) attn_unit(lds, WSP(const bf16_t, WS_QKV), WSP(bf16_t, WS_OG), WSP(float, WS_LSE), u);
            for (int u = blockIdx.x; u < 768; u += G)
                sg_unit(lds, WSP(const bf16_t, WS_U), WSP(const bf16_t, WS_V), WSP(bf16_t, WS_AOUT), WSP(const bf16_t, WS_WS) + (size_t)l * 8 * 128 * 128, PRM(PR_BS) + (size_t)l * 1024, PRM(PR_LNVG) + (size_t)l * 1024, PRM(PR_LNVB) + (size_t)l * 1024, u);
            SEAM(pb + 1);
        }
        if (PON(2) && IN(pb + 2)) { unsigned char* ws = opaque_p(ws0); unsigned* ctl = (unsigned*)(ws + WS_CTL); (void)ctl; merge_phase(WSP(const bf16_t, WS_OG), WSP(const float, WS_LSE), WSP(bf16_t, WS_BOUT), G); SEAM(pb + 2); }
        if (PON(3) && IN(pb + 3)) { unsigned char* ws = opaque_p(ws0); unsigned* ctl = (unsigned*)(ws + WS_CTL); (void)ctl;
            pg8::DenseSched S{WSP(const bf16_t, WS_AOUT), WSP(const bf16_t, WS_WPA) + (size_t)l * D * D, D, T / 256, D / 256, G, (int)blockIdx.x};
            pg8::EpiT1 E{WSP(const bf16_t, WS_GA), WSP(float, WS_T1)};
            pg8::gemm_phase<pg8::EpiT1, pg8::DenseSched, true>(lds, S, E);
        }
        if (PON(3) && IN(pb + 3)) { unsigned char* ws = opaque_p(ws0); unsigned* ctl = (unsigned*)(ws + WS_CTL); (void)ctl;
            pg8::DenseSched S{WSP(const bf16_t, WS_BOUT), WSP(const bf16_t, WS_WPB) + (size_t)l * D * 512, 512, T / 256, D / 256, G, (int)blockIdx.x};
            pg8::EpiMg E{WSP(const bf16_t, WS_GB), WSP(const float, WS_T1), WSP(bf16_t, WS_MG)};
            pg8::gemm_phase<pg8::EpiMg, pg8::DenseSched, true>(lds, S, E);
            SEAM(pb + 3);
        }
        if (PON(4) && IN(pb + 4)) { unsigned char* ws = opaque_p(ws0); unsigned* ctl = (unsigned*)(ws + WS_CTL); (void)ctl;
            pg8::DenseSched S{WSP(const bf16_t, WS_MG), WSP(const bf16_t, WS_WO) + (size_t)l * D * D, D, T / 256, D / 256, G, (int)blockIdx.x};
            pg8::EpiWo E{l == 0 ? args.in[I_XP] : WSP(const float, WS_XF), l == 0 ? args.in[I_XS] - (size_t)TP * D : WSP(const float, WS_XF), WSP(float, WS_XF)};
            pg8::gemm_phase<pg8::EpiWo, pg8::DenseSched, true>(lds, S, E);
            SEAM(pb + 4);
        }
        if (PON(5) && IN(pb + 5)) { unsigned char* ws = opaque_p(ws0); unsigned* ctl = (unsigned*)(ws + WS_CTL); (void)ctl;
            ln1_router_phase(lds, MISC, WSP(float, WS_XF), WSP(bf16_t, WS_XB), PRM(PR_LN1G) + (size_t)l * D, PRM(PR_LN1B) + (size_t)l * D, PRM(PR_WR) + (size_t)l * D * NE, PRM(PR_BR) + (size_t)l * NE,
                             ctl + CW_CNT + l * 64, WSP(int, WS_TOKLIST), WSP(int, WS_TOKE), WSP(int, WS_TOKPOS), WSP(float, WS_GATE), G);
            SEAM(pb + 5);
        }
        if (PON(6) && IN(pb + 6)) { unsigned char* ws = opaque_p(ws0); unsigned* ctl = (unsigned*)(ws + WS_CTL); (void)ctl;
            moe_tables(MISC, ctl + CW_CNT + l * 64);
            pg8::MoeSched<true> S{WSP(const bf16_t, WS_XB), WSP(const bf16_t, WS_WGU) + (size_t)l * NE * 2048 * D, D, 8, G, (int)blockIdx.x, (size_t)2048 * D * 2, (const LAS int*)(lds + MISC_OFF + 64), (const LAS int*)(lds + MISC_OFF + 256), WSP(const int, WS_TOKLIST)};
            pg8::EpiGU E{PRM(PR_BGU) + (size_t)l * NE * 2048, WSP(bf16_t, WS_H)};
            pg8::gemm_phase<pg8::EpiGU, pg8::MoeSched<true>, true>(lds, S, E);
            SEAM(pb + 6);
        }
        if (PON(7) && IN(pb + 7)) { unsigned char* ws = opaque_p(ws0); unsigned* ctl = (unsigned*)(ws + WS_CTL); (void)ctl;
            moe_tables(MISC, ctl + CW_CNT + l * 64);
            pg8::MoeSched<false> S{WSP(const bf16_t, WS_H), WSP(const bf16_t, WS_WD) + (size_t)l * NE * D * D, D, 4, G, (int)blockIdx.x, (size_t)D * D * 2, (const LAS int*)(lds + MISC_OFF + 64), (const LAS int*)(lds + MISC_OFF + 256), nullptr};
            pg8::EpiDown E{PRM(PR_BD) + (size_t)l * NE * D, WSP(bf16_t, WS_YK)};
            pg8::gemm_phase<pg8::EpiDown, pg8::MoeSched<false>, true>(lds, S, E);
            SEAM(pb + 7);
        }
        if (PON(8) && IN(pb + 8)) { unsigned char* ws = opaque_p(ws0); unsigned* ctl = (unsigned*)(ws + WS_CTL); (void)ctl;
            moe_tables(MISC, ctl + CW_CNT + l * 64);
            combine_ln2_phase(MISC, WSP(const float, WS_XF), WSP(const bf16_t, WS_YK), WSP(const int, WS_TOKE), WSP(const int, WS_TOKPOS), WSP(const float, WS_GATE), PRM(PR_LN2G) + (size_t)l * D, PRM(PR_LN2B) + (size_t)l * D,
                              l == DEPTH - 1 ? args.out : WSP(float, WS_XF), WSP(bf16_t, WS_XB), G);
            SEAM(pb + 8);
        }
    }
#undef IN
#undef SEAM
}

extern "C" void kernel_launch(void* const* d_in, const int* in_sizes, int n_in, void* d_out, int out_size, void* d_ws, size_t ws_size, hipStream_t stream) {
    static int grid = 0;
    if (grid == 0) {
        if (n_in != 21 || out_size != T * D || ws_size < WS_END) { fprintf(stderr, "kernel_launch: unexpected shapes (n_in %d, out %d, ws %zu < %zu)\n", n_in, out_size, ws_size, (size_t)WS_END); grid = -1; return; }
        int dev = 0, cus = 0, per_cu = 0;
        if (hipGetDevice(&dev) != hipSuccess || hipDeviceGetAttribute(&cus, hipDeviceAttributeMultiprocessorCount, dev) != hipSuccess) { grid = -1; return; }
        if (hipFuncSetAttribute((const void*)fwd_kernel, hipFuncAttributeMaxDynamicSharedMemorySize, LDS_BYTES) != hipSuccess) { fprintf(stderr, "kernel_launch: hipFuncSetAttribute failed\n"); grid = -1; return; }
        if (hipOccupancyMaxActiveBlocksPerMultiprocessor(&per_cu, (const void*)fwd_kernel, 512, LDS_BYTES) != hipSuccess || per_cu < 1) fprintf(stderr, "kernel_launch: occupancy query says %d\n", per_cu);
        (void)hipGetLastError();
        grid = cus;
    }
    if (grid < 0) return;
    (void)hipMemsetAsync((char*)d_ws + WS_CTL, 0, CTL_BYTES, stream);
    Args a{};
    for (int i = 0; i < 21; ++i) a.in[i] = (const float*)d_in[i];
    a.out = (float*)d_out; a.ws = (unsigned char*)d_ws;
#if MK_SPLIT
    for (int p = 0; p < NPHASE; ++p) { a.ph_lo = p; a.ph_hi = p + 1; hipLaunchKernelGGL(fwd_kernel, dim3(grid), dim3(512), LDS_BYTES, stream, a); }
#else
    a.ph_lo = 0; a.ph_hi = NPHASE;
    hipLaunchKernelGGL(fwd_kernel, dim3(grid), dim3(512), LDS_BYTES, stream, a);
#endif
}
```

```cpp
#include <hip/hip_runtime.h>
#include <cstdio>
#include <cstdint>

#ifndef MK_SPLIT
#define MK_SPLIT 0
#endif

#define LAS __attribute__((address_space(3)))
#define GAS __attribute__((address_space(1)))
typedef unsigned short bf16_t;
typedef short bf16x8 __attribute__((ext_vector_type(8)));
typedef short s16x4 __attribute__((ext_vector_type(4)));
typedef float f32x4 __attribute__((ext_vector_type(4)));
typedef float f32x2 __attribute__((ext_vector_type(2)));
typedef unsigned u32x4 __attribute__((ext_vector_type(4)));
typedef unsigned u32x2 __attribute__((ext_vector_type(2)));

constexpr int D = 1024, T = 49152, TP = 32768, SEQ = 4096, DEPTH = 4, DIN = 8704, NE = 32, TOPK = 4, QKVW = 4608;
constexpr int NSLOT = T * TOPK + NE * 256;
constexpr float DN_ALPHA = 1.6817928305074290f;
constexpr float LN_EPS = 1e-5f;
constexpr float LOG2E = 1.4426950408889634f, LN2 = 0.6931471805599453f;
constexpr int NPH = 9, NPHASE = 1 + DEPTH * NPH;

constexpr size_t MiB = 1u << 20;
constexpr size_t WS_CTL = 0, CTL_BYTES = 1 * MiB;
constexpr size_t WS_PRM = 1 * MiB;
constexpr int PR_BIN = 0, PR_LNVG = PR_BIN + DEPTH * DIN, PR_LNVB = PR_LNVG + DEPTH * D, PR_BS = PR_LNVB + DEPTH * D, PR_LN1G = PR_BS + DEPTH * D, PR_LN1B = PR_LN1G + DEPTH * D,
              PR_WR = PR_LN1B + DEPTH * D, PR_BR = PR_WR + DEPTH * D * NE, PR_BGU = PR_BR + DEPTH * NE, PR_BD = PR_BGU + DEPTH * NE * 2048, PR_LN2G = PR_BD + DEPTH * NE * D, PR_LN2B = PR_LN2G + DEPTH * D,
              PR_END = PR_LN2B + DEPTH * D;
static_assert((size_t)PR_END * 4 <= 4 * MiB, "params region");
constexpr size_t WS_WIN = 5 * MiB;
constexpr size_t WS_WPA = WS_WIN + (size_t)DEPTH * DIN * D * 2;
constexpr size_t WS_WPB = WS_WPA + (size_t)DEPTH * D * D * 2;
constexpr size_t WS_WO = WS_WPB + (size_t)DEPTH * D * 512 * 2;
constexpr size_t WS_WS = WS_WO + (size_t)DEPTH * D * D * 2;
constexpr size_t WS_WGU = WS_WS + (size_t)DEPTH * 8 * 128 * 128 * 2;
constexpr size_t WS_WD = WS_WGU + (size_t)DEPTH * NE * 2048 * D * 2;
constexpr size_t WS_XF = WS_WD + (size_t)DEPTH * NE * D * D * 2;
constexpr size_t WS_XB = WS_XF + (size_t)T * D * 4;
constexpr size_t WS_TOKLIST = WS_XB + (size_t)T * D * 2;
constexpr size_t WS_TOKE = WS_TOKLIST + (size_t)NE * T * 4;
constexpr size_t WS_TOKPOS = WS_TOKE + (size_t)T * 4 * 4;
constexpr size_t WS_GATE = WS_TOKPOS + (size_t)T * 4 * 4;
constexpr size_t WS_R = WS_GATE + (size_t)T * 4 * 4;
constexpr size_t WS_U = WS_R;
constexpr size_t WS_V = WS_U + (size_t)T * D * 2;
constexpr size_t WS_QKV = WS_V + (size_t)T * D * 2;
constexpr size_t WS_GA = WS_QKV + (size_t)T * QKVW * 2;
constexpr size_t WS_GB = WS_GA + (size_t)T * D * 2;
constexpr size_t WS_AOUT = WS_GB + (size_t)T * D * 2;
constexpr size_t WS_OG = WS_AOUT + (size_t)T * D * 2;
constexpr size_t WS_LSE = WS_OG + (size_t)3 * T * 512 * 2;
constexpr size_t WS_BOUT = WS_LSE + (size_t)3 * T * 4 * 4;
constexpr size_t WS_T1 = WS_BOUT + (size_t)T * 512 * 2;
constexpr size_t WS_MG = WS_T1 + (size_t)T * D * 4;
constexpr size_t WS_END_A = WS_MG + (size_t)T * D * 2;
constexpr size_t WS_H = WS_R;
constexpr size_t WS_YK = WS_H + (size_t)NSLOT * D * 2;
constexpr size_t WS_END_B = WS_YK + (size_t)NSLOT * D * 2;
constexpr size_t WS_END = WS_END_A > WS_END_B ? WS_END_A : WS_END_B;
constexpr int CW_BAR = 4096;
constexpr int CW_CNT = 16384;

constexpr int LDS_BYTES = 160 * 1024;
constexpr int MISC_OFF = LDS_BYTES - 2048, IDS_OFF = MISC_OFF + 1024;
constexpr int MISC_DOC = 0;
constexpr int SCR_BYTES = MISC_OFF;

__device__ __forceinline__ int opaque_v(int x) { asm volatile("" : "+v"(x)); return x; }
template <class P> __device__ __forceinline__ P* opaque_p(P* p) { unsigned long long v = (unsigned long long)p; asm volatile("" : "+s"(v)); return (P*)v; }
__device__ __forceinline__ unsigned f2bf(float f) { unsigned u = __builtin_bit_cast(unsigned, f); return (u + 0x7fffu + ((u >> 16) & 1u)) >> 16; }
__device__ __forceinline__ unsigned pk2(float lo, float hi) { return f2bf(lo) | (f2bf(hi) << 16); }
__device__ __forceinline__ unsigned cvt_pk_bf16(float lo, float hi) { unsigned r; asm volatile("v_cvt_pk_bf16_f32 %0, %1, %2" : "=v"(r) : "v"(lo), "v"(hi)); return r; }
__device__ __forceinline__ float bflo(unsigned w) { return __builtin_bit_cast(float, w << 16); }
__device__ __forceinline__ float bfhi(unsigned w) { return __builtin_bit_cast(float, w & 0xffff0000u); }
__device__ __forceinline__ float wave_sum(float v) {
#pragma unroll
    for (int o = 1; o < 64; o <<= 1) v += __shfl_xor(v, o);
    return v;
}
__device__ __forceinline__ float sigmoidf_(float x) { return __builtin_amdgcn_rcpf(1.0f + __builtin_amdgcn_exp2f(-x * LOG2E)); }
__device__ __forceinline__ f32x2 gelu_pk(f32x2 v) {
    const f32x2 av = __builtin_elementwise_abs(v), d = av * 0.2316418882f + 1.0f;
    f32x2 t; t.x = __builtin_amdgcn_rcpf(d.x); t.y = __builtin_amdgcn_rcpf(d.y);
    f32x2 q = t * 0.5307027145f + (-0.7265760135f); q = q * t + 0.7107068705f; q = q * t + (-0.142248368f); q = q * t + 0.127414796f; q = q * t;
    const f32x2 s = (v * v) * (-0.72134752044f);
    f32x2 e; e.x = __builtin_amdgcn_exp2f(s.x); e.y = __builtin_amdgcn_exp2f(s.y);
    const f32x2 m = v * (q * e), r = v - m;
    f32x2 o; o.x = v.x < 0.f ? m.x : r.x; o.y = v.y < 0.f ? m.y : r.y; return o;
}

#define XB_TMO      128
#define XB_XCNT(j)  (256  + 64 * (j))
#define XB_XSUB(j)  (1280 + 64 * (j))
#define XB_XGEN(j)  (2304 + 64 * (j))
#define XB_TOP      3328
#define XB_TOPGEN   3392
#define XCD_BAR_WORDS 3456
#define XB_SPIN_CAP (1u << 18)
__device__ __forceinline__ unsigned xb_ld(unsigned* p)              { return __hip_atomic_load(p, __ATOMIC_RELAXED, __HIP_MEMORY_SCOPE_AGENT); }
__device__ __forceinline__ unsigned xb_add(unsigned* p, unsigned v) { return __hip_atomic_fetch_add(p, v, __ATOMIC_RELAXED, __HIP_MEMORY_SCOPE_AGENT); }
__device__ __forceinline__ unsigned xb_xcc_id() { return (unsigned)__builtin_amdgcn_s_getreg((3 << 11) | 20) & 0xFu; }
#define XB_SPIN(cond, bar) do { unsigned _sp = 0; while (cond) { __builtin_amdgcn_s_sleep(1); \
    if ((++_sp & 255u) == 0u) { if (xb_ld(&(bar)[XB_TMO])) break; if (_sp > XB_SPIN_CAP) { atomicAdd(&(bar)[XB_TMO], 1u); break; } } } } while (0)
struct XcdBarrier { unsigned* bar; unsigned x; volatile LAS unsigned* st; };
__device__ __forceinline__ XcdBarrier xcd_barrier_post(unsigned* bar, volatile LAS unsigned* st) {
    XcdBarrier b; b.bar = bar; b.x = xb_xcc_id(); b.st = st;
    if (threadIdx.x == 0) (void)xb_add(&bar[XB_XCNT(b.x)], 1u);
    return b;
}
__device__ __forceinline__ void xcd_barrier_complete(unsigned* bar, unsigned x, unsigned& nloc, unsigned& nx) {
    const unsigned G = gridDim.x * gridDim.y * gridDim.z;
    unsigned sum, cnt, mine, sp = 0u;
    for (;;) {
        sum = 0u; cnt = 0u; mine = 0u;
#pragma unroll
        for (unsigned j = 0; j < 16; ++j) { const unsigned c = xb_ld(&bar[XB_XCNT(j)]); sum += c; cnt += (c > 0u) ? 1u : 0u; mine = (j == x) ? c : mine; }
        if (sum == G) break;
        __builtin_amdgcn_s_sleep(1);
        if ((++sp & 255u) == 0u) { if (xb_ld(&bar[XB_TMO])) break; if (sp > XB_SPIN_CAP) { atomicAdd(&bar[XB_TMO], 1u); break; } }
    }
    nloc = mine > 0u ? mine : 1u; nx = cnt > 0u ? cnt : 1u;
}
__device__ __forceinline__ void xcd_barrier(const XcdBarrier& b) {
    asm volatile("s_waitcnt vmcnt(0)" ::: "memory");
    __syncthreads();
    if (threadIdx.x == 0) {
        unsigned* bar = b.bar;
        __builtin_amdgcn_s_waitcnt(0);
        unsigned nloc = b.st[0], nx = b.st[1];
        if (nloc == 0u) { xcd_barrier_complete(bar, b.x, nloc, nx); b.st[0] = nloc; b.st[1] = nx; }
        const unsigned old = xb_add(&bar[XB_XSUB(b.x)], 1u);
        const unsigned gen = old / nloc;
        if (old + 1u == (gen + 1u) * nloc) {
            __builtin_amdgcn_fence(__ATOMIC_RELEASE, "agent");
            asm volatile("s_waitcnt vmcnt(0)" ::: "memory");
            const unsigned og = xb_add(&bar[XB_TOP], 1u);
            const unsigned tg = og / nx;
            if (og + 1u == (tg + 1u) * nx) xb_add(&bar[XB_TOPGEN], 1u);
            else XB_SPIN(xb_ld(&bar[XB_TOPGEN]) == tg, bar);
            __builtin_amdgcn_fence(__ATOMIC_ACQUIRE, "agent");
            xb_add(&bar[XB_XGEN(b.x)], 1u);
            asm volatile("s_waitcnt vmcnt(0)" ::: "memory");
        } else {
            XB_SPIN(xb_ld(&bar[XB_XGEN(b.x)]) == gen, bar);
            __builtin_amdgcn_fence(__ATOMIC_ACQUIRE, "agent");
            asm volatile("s_waitcnt vmcnt(0)" ::: "memory");
        }
    }
    __syncthreads();
}

namespace pg8 {
constexpr int BM = 256, BK = 64, HALF = 128, HTB = HALF * BK * 2, STAGE_BYTES = 8 * HTB, NXCD = 8, WGM = 8;
__host__ __device__ __forceinline__ int lds_byte(int r, int c) { const int st = (r >> 4) * 2 + (c >> 5), rr = r & 15, cc = c & 31, ob = rr * 64 + cc * 2; return st * 1024 + (ob ^ (((ob >> 9) & 1) << 5)); }
__host__ __device__ __forceinline__ void stage_rc(int b, int& R, int& C) { const int st = b / 1024, sb = b % 1024, swz = sb ^ (((sb >> 9) & 1) << 5); R = (st >> 1) * 16 + swz / 64; C = (st & 1) * 32 + (swz % 64) / 2; }
__host__ __device__ __forceinline__ int perm32(int rho) { const int n = rho >> 4, i = rho & 15; return 8 * (i >> 2) + 4 * n + (i & 3); }

struct Unit { int pm, pn, e, r0; };

__device__ __forceinline__ bool static_order(int i, int G, int c, int nM, int nN, int& pm, int& pn) {
    const int nwg = nM * nN; const long L = (long)i * G + c; if (L >= nwg) return false;
    int wgid = (int)L; { const int q = nwg / NXCD, r = nwg % NXCD, xcd = wgid % NXCD, off = wgid / NXCD; wgid = (xcd < r ? xcd * (q + 1) : r * (q + 1) + (xcd - r) * q) + off; }
    const int nig = WGM * nN, gid = wgid / nig, fm = gid * WGM, gsz = (nM - fm) < WGM ? (nM - fm) : WGM;
    pm = fm + ((wgid % nig) % gsz); pn = (wgid % nig) / gsz; return true;
}
struct DenseSched {
    static constexpr bool GATHER = false;
    const bf16_t* A; const bf16_t* Bt; int K, nM, nN, G, c;
    __device__ __forceinline__ bool next(int i, Unit& u) const { u.e = 0; u.r0 = 0; return static_order(i, G, c, nM, nN, u.pm, u.pn); }
    __device__ __forceinline__ const char* a_base(const Unit& u) const { return (const char*)A + (size_t)u.pm * BM * K * 2; }
    __device__ __forceinline__ const char* b_base(const Unit& u) const { return (const char*)Bt + (size_t)u.pn * BM * K * 2; }
    __device__ __forceinline__ void a_offs(const Unit& u, const int (&R)[2], const int (&C)[2], unsigned (&o)[2][2]) const {
#pragma unroll
        for (int h = 0; h < 2; ++h)
#pragma unroll
            for (int i = 0; i < 2; ++i) o[h][i] = (unsigned)((u.pm * BM + h * HALF + R[i]) * K + C[i]) * 2u;
    }
    __device__ __forceinline__ int load_id(const Unit&, int) const { return 0; }
    __device__ __forceinline__ void a_offs_lds(const LAS int*, const int (&)[2], const int (&)[2], unsigned (&)[2][2]) const {}
};
template <bool GATHER_> struct MoeSched {
    static constexpr bool GATHER = GATHER_;
    const bf16_t* A; const bf16_t* Bt; int K, nN, G, c; size_t bstride;
    const LAS int* tb; const LAS int* cnt; const int* tokList;
    __device__ __forceinline__ bool next(int i, Unit& u) const {
        const int nM = tb[NE];
        if (!static_order(i, G, c, nM, nN, u.pm, u.pn)) return false;
        int e = 0;
#pragma unroll 1
        for (int j = 1; j < NE; ++j) e += (u.pm >= tb[j]) ? 1 : 0;
        u.e = e; u.r0 = (u.pm - tb[e]) * BM; return true;
    }
    __device__ __forceinline__ const char* a_base(const Unit& u) const { return GATHER ? (const char*)A : (const char*)A + (size_t)u.pm * BM * K * 2; }
    __device__ __forceinline__ const char* b_base(const Unit& u) const { return (const char*)Bt + (size_t)u.e * bstride + (size_t)u.pn * BM * K * 2; }
    __device__ __forceinline__ int load_id(const Unit& u, int i) const { const int r = u.r0 + i; return (r < cnt[u.e]) ? tokList[(size_t)u.e * T + r] : 0; }
    __device__ __forceinline__ void a_offs(const Unit& u, const int (&R)[2], const int (&C)[2], unsigned (&o)[2][2]) const {
#pragma unroll
        for (int h = 0; h < 2; ++h)
#pragma unroll
            for (int i = 0; i < 2; ++i) o[h][i] = (unsigned)(load_id(u, h * HALF + R[i]) * K + C[i]) * 2u;
    }
    __device__ __forceinline__ void a_offs_lds(const LAS int* ids, const int (&R)[2], const int (&C)[2], unsigned (&o)[2][2]) const {
#pragma unroll
        for (int h = 0; h < 2; ++h)
#pragma unroll
            for (int i = 0; i < 2; ++i) o[h][i] = (unsigned)(ids[h * HALF + R[i]] * K + C[i]) * 2u;
    }
};


template <class Epi, class Sched, bool ALIGN_EPI>
__device__ __forceinline__ void gemm_phase(LAS unsigned char* lds, const Sched& S, const Epi& E) {
    constexpr bool GATHER = Sched::GATHER;
    const int tid = opaque_v(threadIdx.x), wid = __builtin_amdgcn_readfirstlane(tid >> 6), lane = tid & 63, wr = wid >> 2, wc = wid & 3, fr = lane & 15, fq = lane >> 4;
    const int K = S.K, nt = K / BK;
    int R[2], C[2]; unsigned voffA[2], voffB[2];
#pragma unroll
    for (int i = 0; i < 2; ++i) { stage_rc(tid * 16 + i * 8192, R[i], C[i]); const int Rb = Epi::PERM ? ((R[i] & ~31) + perm32(R[i] & 31)) : R[i];
        voffA[i] = (unsigned)(R[i] * K + C[i]) * 2u; voffB[i] = (unsigned)(Rb * K + C[i]) * 2u; }
    const size_t kstep = (size_t)(BK * 2);
    const size_t hstep = (size_t)HALF * K * 2;
    const unsigned ldsw = (unsigned)wid * 1024u;
    const int aoff = lds_byte(wr * 64 + fr, fq * 8), boff = lds_byte(wc * 32 + fr, fq * 8);
#define PG8_SA(b, h) (((b) * 2 + (h)) * HTB)
#define PG8_SB(b, h) ((4 + (b) * 2 + (h)) * HTB)
#define PG8_STAGE(bufoff, gbase, voff) do { _Pragma("unroll") for (int _i = 0; _i < 2; ++_i) \
        __builtin_amdgcn_global_load_lds((const unsigned*)((const char*)(gbase) + (voff)[_i]), (LAS unsigned*)(lds + (bufoff) + ldsw + _i * 8192), 16, 0, 0); } while (0)
#define PG8_STAGE_A(bufoff, ab, ao, h, kb) do { if constexpr (GATHER) { PG8_STAGE(bufoff, (ab) + (kb), (ao)[h]); } else { PG8_STAGE(bufoff, (ab) + (kb) + (h) * hstep, voffA); } } while (0)
#define PG8_LDA(dst, b, h) do { _Pragma("unroll") for (int m = 0; m < 4; ++m) _Pragma("unroll") for (int k = 0; k < 2; ++k) dst[m][k] = *(const LAS bf16x8*)(lds + PG8_SA(b, h) + aoff + m * 2048 + k * 1024); } while (0)
#define PG8_LDB(dst, b, h) do { _Pragma("unroll") for (int n = 0; n < 2; ++n) _Pragma("unroll") for (int k = 0; k < 2; ++k) dst[n][k] = *(const LAS bf16x8*)(lds + PG8_SB(b, h) + boff + n * 2048 + k * 1024); } while (0)
#define PG8_MMA(ai, bj, At, Bt) do { __builtin_amdgcn_s_setprio(1); _Pragma("unroll") for (int m = 0; m < 4; ++m) _Pragma("unroll") for (int n = 0; n < 2; ++n) _Pragma("unroll") for (int k = 0; k < 2; ++k) \
        acc[ai][bj][m][n] = __builtin_amdgcn_mfma_f32_16x16x32_bf16(Bt[n][k], At[m][k], acc[ai][bj][m][n], 0, 0, 0); __builtin_amdgcn_s_setprio(0); } while (0)
#define PG8_WAIT_V(n) asm volatile("s_waitcnt vmcnt(" #n ")" ::: "memory")
#define PG8_WAIT_L(n) asm volatile("s_waitcnt lgkmcnt(" #n ")" ::: "memory")
#define PG8_BAR __builtin_amdgcn_s_barrier()
#define PG8_SCHED __builtin_amdgcn_sched_barrier(0)
    Unit cur, nxt; int ui = 0;
    if (!S.next(0, cur)) return;
    f32x4 acc[2][2][4][2];
#pragma unroll
    for (int a = 0; a < 2; ++a)
#pragma unroll
        for (int b = 0; b < 2; ++b)
#pragma unroll
            for (int m = 0; m < 4; ++m)
#pragma unroll
                for (int n = 0; n < 2; ++n) acc[a][b][m][n] = (f32x4){0.f, 0.f, 0.f, 0.f};
    bf16x8 At[4][2], B0[2][2], B1[2][2];
    unsigned ca[2][2];
    LAS int* ids = (LAS int*)(lds + IDS_OFF);
    if constexpr (GATHER) { S.a_offs(cur, R, C, ca); Unit n1; if (S.next(1, n1) && tid < 256) ids[tid] = S.load_id(n1, tid); }
    const char* cA = S.a_base(cur);
    const char* cB = S.b_base(cur);
    PG8_STAGE(PG8_SB(0, 0), cB, voffB); PG8_STAGE(PG8_SB(0, 1), cB + hstep, voffB); PG8_STAGE_A(PG8_SA(0, 0), cA, ca, 0, 0); PG8_STAGE_A(PG8_SA(0, 1), cA, ca, 1, 0);
    if (wr == 1) PG8_BAR;
    PG8_WAIT_V(2); PG8_BAR;
    PG8_STAGE(PG8_SB(1, 0), cB + kstep, voffB); PG8_STAGE_A(PG8_SA(1, 0), cA, ca, 0, kstep); PG8_STAGE(PG8_SB(1, 1), cB + hstep + kstep, voffB);
    PG8_WAIT_V(6); PG8_BAR;
    for (;;) {
        const bool has_next = S.next(ui + 1, nxt);
        const char* nA = has_next ? S.a_base(nxt) : cA; const char* nB = has_next ? S.b_base(nxt) : cB;
        for (int t = 0; t < nt; t += 2) {
            const bool last = (t == nt - 2);
            const size_t k1 = (size_t)(t + 1) * kstep;
            const size_t k2 = last ? 0 : (size_t)(t + 2) * kstep, k3 = k2 + kstep;
            const char* a2 = last ? nA : cA; const char* b2 = (last ? nB : cB) + k2; const char* b3 = b2 + kstep;
            PG8_LDB(B0, 0, 0); PG8_LDB(B1, 0, 1); PG8_SCHED; PG8_LDA(At, 0, 0); PG8_STAGE_A(PG8_SA(1, 1), cA, ca, 1, k1);
            PG8_WAIT_V(8); PG8_WAIT_L(0); PG8_BAR; PG8_MMA(0, 0, At, B0); PG8_MMA(0, 1, At, B1); PG8_BAR; PG8_SCHED;
            if constexpr (GATHER) { if (last && has_next) S.a_offs_lds(ids, R, C, ca); }
            PG8_LDA(At, 0, 1); PG8_STAGE(PG8_SB(0, 0), b2, voffB); PG8_STAGE(PG8_SB(0, 1), b2 + hstep, voffB); PG8_STAGE_A(PG8_SA(0, 0), a2, ca, 0, k2);
            PG8_WAIT_V(8); PG8_WAIT_L(0); PG8_BAR; PG8_MMA(1, 0, At, B0); PG8_MMA(1, 1, At, B1); PG8_BAR; PG8_SCHED;
            PG8_LDB(B0, 1, 0); PG8_LDB(B1, 1, 1); PG8_SCHED; PG8_LDA(At, 1, 0); PG8_STAGE_A(PG8_SA(0, 1), a2, ca, 1, k2);
            PG8_WAIT_V(8); PG8_WAIT_L(0); PG8_BAR; PG8_MMA(0, 0, At, B0); PG8_MMA(0, 1, At, B1); PG8_BAR; PG8_SCHED;
            PG8_LDA(At, 1, 1); PG8_STAGE(PG8_SB(1, 0), b3, voffB); PG8_STAGE(PG8_SB(1, 1), b3 + hstep, voffB); PG8_STAGE_A(PG8_SA(1, 0), a2, ca, 0, k3);
            PG8_WAIT_V(8); PG8_WAIT_L(0); PG8_BAR; PG8_MMA(1, 0, At, B0); PG8_MMA(1, 1, At, B1); PG8_BAR; PG8_SCHED;
        }
        if constexpr (ALIGN_EPI) { if (wr == 0) PG8_BAR; }
        int idv = 0; bool fill = false;
        if constexpr (GATHER) { Unit n2; fill = S.next(ui + 2, n2) && tid < 256; if (fill) idv = S.load_id(n2, tid); }
        E(acc, cur, wr, wc, fr, fq);
        if constexpr (GATHER) { if (fill) ids[tid] = idv; }
        if (!has_next) break;
#pragma unroll
        for (int a = 0; a < 2; ++a)
#pragma unroll
            for (int b = 0; b < 2; ++b)
#pragma unroll
                for (int m = 0; m < 4; ++m)
#pragma unroll
                    for (int n = 0; n < 2; ++n) acc[a][b][m][n] = (f32x4){0.f, 0.f, 0.f, 0.f};
        cur = nxt; cA = nA; cB = nB; ++ui;
        if constexpr (ALIGN_EPI) { if (wr == 1) PG8_BAR; }
    }
    PG8_WAIT_V(0);
    if constexpr (!ALIGN_EPI) { if (wr == 0) PG8_BAR; }
    PG8_BAR;
#undef PG8_SA
#undef PG8_SB
#undef PG8_STAGE
#undef PG8_STAGE_A
#undef PG8_LDA
#undef PG8_LDB
#undef PG8_MMA
#undef PG8_WAIT_V
#undef PG8_WAIT_L
#undef PG8_BAR
#undef PG8_SCHED
}

typedef const f32x4 (&AccRef)[2][2][4][2];

struct EpiIn {
    static constexpr bool PERM = true;
    const float* bias; bf16_t *U, *V, *QKV, *GA, *GB;
    __device__ __forceinline__ void operator()(AccRef acc, const Unit& u, int wr, int wc, int fr, int fq) const {
        const int pn = u.pn; bf16_t* base; int ldc = D, colt, act;
        if (pn < 4) { base = U; colt = pn * 256; act = 1; }
        else if (pn < 8) { base = V; colt = (pn - 4) * 256; act = 1; }
        else if (pn < 26) { base = QKV; ldc = QKVW; colt = (pn - 8) * 256; act = 0; }
        else if (pn < 30) { base = GA; colt = (pn - 26) * 256; act = 2; }
        else { base = GB; colt = (pn - 30) * 256; act = 2; }
        const int row0 = u.pm * BM + wr * 64 + fr, col0 = colt + wc * 32 + 8 * fq, bcol0 = pn * BM + wc * 32 + 8 * fq;
        f32x4 bv[2][2];
#pragma unroll
        for (int bj = 0; bj < 2; ++bj)
#pragma unroll
            for (int n = 0; n < 2; ++n) bv[bj][n] = *(const f32x4*)(bias + bcol0 + bj * HALF + 4 * n);
#pragma unroll
        for (int ai = 0; ai < 2; ++ai)
#pragma unroll
            for (int m = 0; m < 4; ++m) { bf16_t* rowp = base + (size_t)(row0 + ai * HALF + m * 16) * ldc + col0;
#pragma unroll
                for (int bj = 0; bj < 2; ++bj) { f32x4 v0 = acc[ai][bj][m][0] + bv[bj][0], v1 = acc[ai][bj][m][1] + bv[bj][1];
                    if (act == 1) { f32x2 a = gelu_pk((f32x2){v0[0], v0[1]}), b = gelu_pk((f32x2){v0[2], v0[3]}), c = gelu_pk((f32x2){v1[0], v1[1]}), d = gelu_pk((f32x2){v1[2], v1[3]});
                        v0 = (f32x4){a.x, a.y, b.x, b.y}; v1 = (f32x4){c.x, c.y, d.x, d.y}; }
                    if (act == 2) {
#pragma unroll
                        for (int j = 0; j < 4; ++j) { v0[j] = sigmoidf_(v0[j]); v1[j] = sigmoidf_(v1[j]); } }
                    u32x4 w; w.x = cvt_pk_bf16(v0[0], v0[1]); w.y = cvt_pk_bf16(v0[2], v0[3]); w.z = cvt_pk_bf16(v1[0], v1[1]); w.w = cvt_pk_bf16(v1[2], v1[3]);
                    *(u32x4*)(rowp + bj * HALF) = w; } }
    }
};
struct EpiT1 {
    static constexpr bool PERM = true;
    const bf16_t* GA; float* T1;
    __device__ __forceinline__ void operator()(AccRef acc, const Unit& u, int wr, int wc, int fr, int fq) const {
        const int row0 = u.pm * BM + wr * 64 + fr, col0 = u.pn * BM + wc * 32 + 8 * fq;
#pragma unroll
        for (int ai = 0; ai < 2; ++ai)
#pragma unroll
            for (int m = 0; m < 4; ++m) { const size_t off = (size_t)(row0 + ai * HALF + m * 16) * D + col0;
#pragma unroll
                for (int bj = 0; bj < 2; ++bj) { const u32x4 g = *(const u32x4*)(GA + off + bj * HALF);
                    const f32x4 g0 = (f32x4){bflo(g.x), bfhi(g.x), bflo(g.y), bfhi(g.y)}, g1 = (f32x4){bflo(g.z), bfhi(g.z), bflo(g.w), bfhi(g.w)};
                    *(f32x4*)(T1 + off + bj * HALF) = acc[ai][bj][m][0] * g0; *(f32x4*)(T1 + off + bj * HALF + 4) = acc[ai][bj][m][1] * g1; }
                asm volatile("" ::: "memory"); }
    }
};
struct EpiMg {
    static constexpr bool PERM = true;
    const bf16_t* GB; const float* T1; bf16_t* MG;
    __device__ __forceinline__ void operator()(AccRef acc, const Unit& u, int wr, int wc, int fr, int fq) const {
        const int row0 = u.pm * BM + wr * 64 + fr, col0 = u.pn * BM + wc * 32 + 8 * fq;
#pragma unroll
        for (int ai = 0; ai < 2; ++ai)
#pragma unroll
            for (int m = 0; m < 4; ++m) { const size_t off = (size_t)(row0 + ai * HALF + m * 16) * D + col0;
#pragma unroll
                for (int bj = 0; bj < 2; ++bj) { const u32x4 g = *(const u32x4*)(GB + off + bj * HALF);
                    const f32x4 t0 = *(const f32x4*)(T1 + off + bj * HALF), t1 = *(const f32x4*)(T1 + off + bj * HALF + 4);
                    const f32x4 g0 = (f32x4){bflo(g.x), bfhi(g.x), bflo(g.y), bfhi(g.y)}, g1 = (f32x4){bflo(g.z), bfhi(g.z), bflo(g.w), bfhi(g.w)};
                    const f32x4 v0 = t0 + acc[ai][bj][m][0] * g0, v1 = t1 + acc[ai][bj][m][1] * g1;
                    u32x4 w; w.x = cvt_pk_bf16(v0[0], v0[1]); w.y = cvt_pk_bf16(v0[2], v0[3]); w.z = cvt_pk_bf16(v1[0], v1[1]); w.w = cvt_pk_bf16(v1[2], v1[3]);
                    *(u32x4*)(MG + off + bj * HALF) = w; }
                asm volatile("" ::: "memory"); }
    }
};
struct EpiWo {
    static constexpr bool PERM = false;
    const float* xa; const float* xb; float* XF;
    __device__ __forceinline__ void operator()(AccRef acc, const Unit& u, int wr, int wc, int fr, int fq) const {
        const int row0 = u.pm * BM + wr * 64 + fr, col0 = u.pn * BM + wc * 32 + 4 * fq;
        const float* xr = (u.pm * BM < TP) ? xa : xb;
#pragma unroll
        for (int ai = 0; ai < 2; ++ai)
#pragma unroll
            for (int m = 0; m < 4; ++m) { const size_t off = (size_t)(row0 + ai * HALF + m * 16) * D + col0;
#pragma unroll
                for (int bj = 0; bj < 2; ++bj)
#pragma unroll
                    for (int n = 0; n < 2; ++n) { const f32x4 x = *(const f32x4*)(xr + off + bj * HALF + n * 16); *(f32x4*)(XF + off + bj * HALF + n * 16) = x * DN_ALPHA + acc[ai][bj][m][n]; }
                asm volatile("" ::: "memory"); }
    }
};
struct EpiGU {
    static constexpr bool PERM = true;
    const float* bgu; bf16_t* H;
    __device__ __forceinline__ void operator()(AccRef acc, const Unit& u, int wr, int wc, int fr, int fq) const {
        const int row0 = u.pm * BM + wr * 64 + fr, cc = u.pn * HALF + wc * 32 + 8 * fq;
        const float* bg = bgu + (size_t)u.e * 2048 + cc;
        const f32x4 bg0 = *(const f32x4*)(bg), bg1 = *(const f32x4*)(bg + 4), bu0 = *(const f32x4*)(bg + 1024), bu1 = *(const f32x4*)(bg + 1028);
#pragma unroll
        for (int ai = 0; ai < 2; ++ai)
#pragma unroll
            for (int m = 0; m < 4; ++m) {
                f32x4 g0 = acc[ai][0][m][0] + bg0, g1 = acc[ai][0][m][1] + bg1, u0 = acc[ai][1][m][0] + bu0, u1 = acc[ai][1][m][1] + bu1, h0, h1;
#pragma unroll
                for (int j = 0; j < 4; ++j) {
                    const float ga = fminf(g0[j], 7.0f), gb = fminf(g1[j], 7.0f);
                    const float ua = fminf(fmaxf(u0[j], -7.0f), 7.0f), ub = fminf(fmaxf(u1[j], -7.0f), 7.0f);
                    h0[j] = (ua + 1.0f) * ga * sigmoidf_(1.702f * ga); h1[j] = (ub + 1.0f) * gb * sigmoidf_(1.702f * gb); }
                u32x4 w; w.x = cvt_pk_bf16(h0[0], h0[1]); w.y = cvt_pk_bf16(h0[2], h0[3]); w.z = cvt_pk_bf16(h1[0], h1[1]); w.w = cvt_pk_bf16(h1[2], h1[3]);
                *(u32x4*)(H + (size_t)(row0 + ai * HALF + m * 16) * D + cc) = w; }
    }
};
struct EpiDown {
    static constexpr bool PERM = true;
    const float* bd; bf16_t* YK;
    __device__ __forceinline__ void operator()(AccRef acc, const Unit& u, int wr, int wc, int fr, int fq) const {
        const int row0 = u.pm * BM + wr * 64 + fr, col0 = u.pn * BM + wc * 32 + 8 * fq;
        f32x4 bv[2][2];
#pragma unroll
        for (int bj = 0; bj < 2; ++bj)
#pragma unroll
            for (int n = 0; n < 2; ++n) bv[bj][n] = *(const f32x4*)(bd + (size_t)u.e * D + col0 + bj * HALF + 4 * n);
#pragma unroll
        for (int ai = 0; ai < 2; ++ai)
#pragma unroll
            for (int m = 0; m < 4; ++m) { bf16_t* rowp = YK + (size_t)(row0 + ai * HALF + m * 16) * D + col0;
#pragma unroll
                for (int bj = 0; bj < 2; ++bj) { const f32x4 v0 = acc[ai][bj][m][0] + bv[bj][0], v1 = acc[ai][bj][m][1] + bv[bj][1];
                    u32x4 w; w.x = cvt_pk_bf16(v0[0], v0[1]); w.y = cvt_pk_bf16(v0[2], v0[3]); w.z = cvt_pk_bf16(v1[0], v1[1]); w.w = cvt_pk_bf16(v1[2], v1[3]);
                    *(u32x4*)(rowp + bj * HALF) = w; } }
    }
};
}

struct Args { const float* in[21]; float* out; unsigned char* ws; int ph_lo, ph_hi; };
enum { I_XP = 0, I_XS, I_WIN, I_BIN, I_LNVG, I_LNVB, I_WS, I_BS, I_WPA, I_WPB, I_WO, I_LN1G, I_LN1B, I_WR, I_BR, I_WGU, I_BGU, I_WD, I_BD, I_LN2G, I_LN2B };

__device__ __forceinline__ void tr_item(const float* W, int K, int N, bf16_t* WT, int k0, int n0, int nd0, LAS unsigned* scr, int lane) {
    const int i = lane & 15, kp = lane >> 4;
    f32x4 a[8], b[8];
#pragma unroll
    for (int it = 0; it < 8; ++it) { const int k = it * 8 + kp * 2; a[it] = *(const f32x4*)(W + (size_t)(k0 + k) * N + n0 + 4 * i); b[it] = *(const f32x4*)(W + (size_t)(k0 + k + 1) * N + n0 + 4 * i); }
#pragma unroll
    for (int it = 0; it < 8; ++it) {
#pragma unroll
        for (int j = 0; j < 4; ++j) scr[(4 * i + j) * 33 + it * 4 + kp] = pk2(a[it][j], b[it][j]); }
    asm volatile("s_waitcnt lgkmcnt(0)" ::: "memory");
    const int nn = lane >> 3, c = lane & 7;
#pragma unroll
    for (int j = 0; j < 8; ++j) { const int n = nn + 8 * j; u32x4 o; o.x = scr[n * 33 + 4 * c]; o.y = scr[n * 33 + 4 * c + 1]; o.z = scr[n * 33 + 4 * c + 2]; o.w = scr[n * 33 + 4 * c + 3];
        *(u32x4*)(WT + (size_t)(nd0 + n) * K + k0 + 8 * c) = o; }
    asm volatile("s_waitcnt lgkmcnt(0)" ::: "memory");
}
__device__ __forceinline__ void p0_prologue(const Args& a, LAS unsigned char* lds, int G) {
    const int tid = opaque_v(threadIdx.x), lane = tid & 63, wave = tid >> 6;
    LAS unsigned* scr = (LAS unsigned*)(lds + wave * 8704);
    const int gw = blockIdx.x * 8 + wave, NGW = G * 8;
    unsigned char* ws = a.ws;
    constexpr int I_GU = DEPTH * NE * 16 * 32, I_D = DEPTH * NE * 16 * 16, I_IN = DEPTH * 16 * 136, I_PA = DEPTH * 256, I_PB = DEPTH * 8 * 16, I_O = DEPTH * 256;
    constexpr int NITEMS = I_GU + I_D + I_IN + I_PA + I_PB + I_O;
    for (int it = gw; it < NITEMS; it += NGW) {
        int r = it;
        if (r < I_GU) { const int mat = r / 512, q = r % 512, kb = q / 32, nb = q % 32, n0 = nb * 64, c = n0 & 1023, nd0 = (c >> 7) * 256 + ((n0 >= 1024) ? 128 : 0) + (c & 127);
            tr_item(a.in[I_WGU] + (size_t)mat * 1024 * 2048, 1024, 2048, (bf16_t*)(ws + WS_WGU) + (size_t)mat * 2048 * 1024, kb * 64, n0, nd0, scr, lane); continue; }
        r -= I_GU;
        if (r < I_D) { const int mat = r / 256, q = r % 256, kb = q / 16, nb = q % 16;
            tr_item(a.in[I_WD] + (size_t)mat * 1024 * 1024, 1024, 1024, (bf16_t*)(ws + WS_WD) + (size_t)mat * 1024 * 1024, kb * 64, nb * 64, nb * 64, scr, lane); continue; }
        r -= I_D;
        if (r < I_IN) { const int mat = r / (16 * 136), q = r % (16 * 136), kb = q / 136, nb = q % 136;
            tr_item(a.in[I_WIN] + (size_t)mat * 1024 * DIN, 1024, DIN, (bf16_t*)(ws + WS_WIN) + (size_t)mat * DIN * 1024, kb * 64, nb * 64, nb * 64, scr, lane); continue; }
        r -= I_IN;
        if (r < I_PA) { const int mat = r / 256, q = r % 256, kb = q / 16, nb = q % 16;
            tr_item(a.in[I_WPA] + (size_t)mat * 1024 * 1024, 1024, 1024, (bf16_t*)(ws + WS_WPA) + (size_t)mat * 1024 * 1024, kb * 64, nb * 64, nb * 64, scr, lane); continue; }
        r -= I_PA;
        if (r < I_PB) { const int mat = r / 128, q = r % 128, kb = q / 16, nb = q % 16;
            tr_item(a.in[I_WPB] + (size_t)mat * 512 * 1024, 512, 1024, (bf16_t*)(ws + WS_WPB) + (size_t)mat * 1024 * 512, kb * 64, nb * 64, nb * 64, scr, lane); continue; }
        r -= I_PB;
        { const int mat = r / 256, q = r % 256, kb = q / 16, nb = q % 16;
            tr_item(a.in[I_WO] + (size_t)mat * 1024 * 1024, 1024, 1024, (bf16_t*)(ws + WS_WO) + (size_t)mat * 1024 * 1024, kb * 64, nb * 64, nb * 64, scr, lane); }
    }
    const size_t gt = (size_t)blockIdx.x * 512 + tid, NGT = (size_t)G * 512;
    { float* prm = (float*)(ws + WS_PRM);
#define CPY(idx, off, n) for (size_t i = gt; i < (size_t)(n) / 4; i += NGT) *(f32x4*)(prm + (off) + i * 4) = *(const f32x4*)(a.in[idx] + i * 4)
      CPY(I_BIN, PR_BIN, DEPTH * DIN); CPY(I_LNVG, PR_LNVG, DEPTH * D); CPY(I_LNVB, PR_LNVB, DEPTH * D); CPY(I_BS, PR_BS, DEPTH * D); CPY(I_LN1G, PR_LN1G, DEPTH * D); CPY(I_LN1B, PR_LN1B, DEPTH * D);
      CPY(I_WR, PR_WR, DEPTH * D * NE); CPY(I_BR, PR_BR, DEPTH * NE); CPY(I_BGU, PR_BGU, DEPTH * NE * 2048); CPY(I_BD, PR_BD, DEPTH * NE * D); CPY(I_LN2G, PR_LN2G, DEPTH * D); CPY(I_LN2B, PR_LN2B, DEPTH * D);
#undef CPY
    }
    { const float* src = a.in[I_WS]; bf16_t* dst = (bf16_t*)(ws + WS_WS);
      for (size_t i = gt; i < (size_t)DEPTH * 8 * 128 * 128 / 8; i += NGT) { const f32x4 x = *(const f32x4*)(src + i * 8), y = *(const f32x4*)(src + i * 8 + 4);
          u32x4 o; o.x = pk2(x[0], x[1]); o.y = pk2(x[2], x[3]); o.z = pk2(y[0], y[1]); o.w = pk2(y[2], y[3]); *(u32x4*)(dst + i * 8) = o; } }
    { bf16_t* dst = (bf16_t*)(ws + WS_XB);
      for (size_t i = gt; i < (size_t)T * D / 8; i += NGT) { const size_t e = i * 8; const float* src = (e < (size_t)TP * D) ? a.in[I_XP] + e : a.in[I_XS] + (e - (size_t)TP * D);
          const f32x4 x = *(const f32x4*)(src), y = *(const f32x4*)(src + 4);
          u32x4 o; o.x = pk2(x[0], x[1]); o.y = pk2(x[2], x[3]); o.z = pk2(y[0], y[1]); o.w = pk2(y[2], y[3]); *(u32x4*)(dst + e) = o; } }
}

template <int BASE> __device__ __forceinline__ void tr8(unsigned addr, s16x4 (&r)[8]) {
    asm volatile("ds_read_b64_tr_b16 %0, %8 offset:%9\n\tds_read_b64_tr_b16 %1, %8 offset:%10\n\tds_read_b64_tr_b16 %2, %8 offset:%11\n\tds_read_b64_tr_b16 %3, %8 offset:%12\n\t"
                 "ds_read_b64_tr_b16 %4, %8 offset:%13\n\tds_read_b64_tr_b16 %5, %8 offset:%14\n\tds_read_b64_tr_b16 %6, %8 offset:%15\n\tds_read_b64_tr_b16 %7, %8 offset:%16\n\t"
                 : "=&v"(r[0]), "=&v"(r[1]), "=&v"(r[2]), "=&v"(r[3]), "=&v"(r[4]), "=&v"(r[5]), "=&v"(r[6]), "=&v"(r[7])
                 : "v"(addr), "n"(BASE), "n"(BASE + 32), "n"(BASE + 64), "n"(BASE + 96), "n"(BASE + 128), "n"(BASE + 160), "n"(BASE + 192), "n"(BASE + 224) : "memory");
}
__device__ __forceinline__ bf16x8 cat4(s16x4 a, s16x4 b) { return (bf16x8){a[0], a[1], a[2], a[3], b[0], b[1], b[2], b[3]}; }

constexpr int AT_KSTR = 272, AT_VSTR = 288, AT_KBYTES = 256 * AT_KSTR, AT_VOFF = AT_KBYTES, AT_VBYTES = 256 * AT_VSTR;
static_assert(AT_VOFF + AT_VBYTES <= SCR_BYTES, "attention LDS");

template <int ST> __device__ __forceinline__ void attn_pv_step(unsigned vaddr, const f32x4 (&s)[9], f32x4 (&o)[8]) {
    s16x4 r0[8], r1[8];
    tr8<ST * 32 * AT_VSTR>(vaddr, r0);
    tr8<ST * 32 * AT_VSTR + (ST < 4 ? 16 * AT_VSTR : 0)>(vaddr, r1);
    asm volatile("s_waitcnt lgkmcnt(0)" ::: "memory");
    __builtin_amdgcn_sched_barrier(0);
    u32x4 pw; pw.x = cvt_pk_bf16(s[2 * ST][0], s[2 * ST][1]); pw.y = cvt_pk_bf16(s[2 * ST][2], s[2 * ST][3]);
    if (ST < 4) { pw.z = cvt_pk_bf16(s[2 * ST + (ST < 4 ? 1 : 0)][0], s[2 * ST + (ST < 4 ? 1 : 0)][1]); pw.w = cvt_pk_bf16(s[2 * ST + (ST < 4 ? 1 : 0)][2], s[2 * ST + (ST < 4 ? 1 : 0)][3]); }
    else { pw.z = 0u; pw.w = 0u; }
    const bf16x8 pf = __builtin_bit_cast(bf16x8, pw);
#pragma unroll
    for (int db = 0; db < 8; ++db) o[db] = __builtin_amdgcn_mfma_f32_16x16x32_bf16(cat4(r0[db], r1[db]), pf, o[db], 0, 0, 0);
}

__device__ __forceinline__ void attn_unit(LAS unsigned char* lds, const bf16_t* QKV, bf16_t* OG, float* LSE, int unit) {
    const int tid = opaque_v(threadIdx.x), lane = tid & 63, w = tid >> 6, ql = lane & 15, quad = lane >> 4;
    const int wsub = unit & 31, h = (unit >> 5) & 3, bg = unit >> 7, g = bg % 3, b = bg / 3;
    const int dsh = 2 * g, dil = 1 << dsh, L = SEQ >> dsh, nblk = L >> 7, r = wsub / nblk, blk = wsub % nblk, p0 = blk * 128;
    const int qc = g * 1536 + h * 128, kc = qc + 512, vc = qc + 1024;
    const float slope = __builtin_amdgcn_exp2f(-(2.0f / 3.0f) * (float)(4 * g + h + 1));
    const float ca = slope * (float)dil * LOG2E, SC = 0.08838834764831845f * LOG2E;
    const int qrow = b * SEQ + (p0 + 16 * w + ql) * dil + r;
    bf16x8 qf[4];
#pragma unroll
    for (int ks = 0; ks < 4; ++ks) qf[ks] = *(const bf16x8*)(QKV + (size_t)qrow * QKVW + qc + 32 * ks + 8 * quad);
    {
        u32x4 kr[8], vr[8];
#pragma unroll
        for (int j = 0; j < 8; ++j) { const int id = tid + 512 * j, kk = id >> 4, ch = id & 15, pk = p0 - 64 + kk;
            if (pk >= 0 && pk < L) { const size_t ro = (size_t)(b * SEQ + pk * dil + r) * QKVW; kr[j] = *(const u32x4*)(QKV + ro + kc + ch * 8); vr[j] = *(const u32x4*)(QKV + ro + vc + ch * 8); }
            else { kr[j] = (u32x4){0u, 0u, 0u, 0u}; vr[j] = (u32x4){0u, 0u, 0u, 0u}; } }
#pragma unroll
        for (int j = 0; j < 8; ++j) { const int id = tid + 512 * j, kk = id >> 4, ch = id & 15;
            *(LAS u32x4*)(lds + kk * AT_KSTR + ch * 16) = kr[j]; *(LAS u32x4*)(lds + AT_VOFF + kk * AT_VSTR + ch * 16) = vr[j]; }
    }
    __syncthreads();
    f32x4 s[9];
#pragma unroll
    for (int j = 0; j < 9; ++j) { s[j] = (f32x4){0.f, 0.f, 0.f, 0.f};
#pragma unroll
        for (int ks = 0; ks < 4; ++ks) { const bf16x8 kf = *(const LAS bf16x8*)(lds + (16 * w + 16 * j + ql) * AT_KSTR + (32 * ks + 8 * quad) * 2);
            s[j] = __builtin_amdgcn_mfma_f32_16x16x32_bf16(kf, qf[ks], s[j], 0, 0, 0); } }
    float mx = -1e30f;
#pragma unroll
    for (int j = 0; j < 9; ++j)
#pragma unroll
        for (int i = 0; i < 4; ++i) { const int rel = 16 * j + 4 * quad + i - 64 - ql, pk = p0 + 16 * w + ql + rel, ar = rel < 0 ? -rel : rel;
            const bool ok = (ar <= 64) && (pk >= 0) && (pk < L);
            const float v = ok ? (s[j][i] * SC - ca * (float)ar) : -1e30f; s[j][i] = v; mx = fmaxf(mx, v); }
    mx = fmaxf(mx, __shfl_xor(mx, 16)); mx = fmaxf(mx, __shfl_xor(mx, 32));
    float den = 0.f;
#pragma unroll
    for (int j = 0; j < 9; ++j)
#pragma unroll
        for (int i = 0; i < 4; ++i) { const float p = __builtin_amdgcn_exp2f(s[j][i] - mx); s[j][i] = p; den += p; }
    den += __shfl_xor(den, 16); den += __shfl_xor(den, 32);
    f32x4 o[8];
#pragma unroll
    for (int db = 0; db < 8; ++db) o[db] = (f32x4){0.f, 0.f, 0.f, 0.f};
    const unsigned vaddr = (unsigned)(uintptr_t)(lds + AT_VOFF) + (unsigned)((16 * w + 4 * quad + (ql >> 2)) * AT_VSTR + (ql & 3) * 8);
    attn_pv_step<0>(vaddr, s, o); attn_pv_step<1>(vaddr, s, o); attn_pv_step<2>(vaddr, s, o); attn_pv_step<3>(vaddr, s, o); attn_pv_step<4>(vaddr, s, o);
    const float inv = 1.0f / den;
    bf16_t* orow = OG + ((size_t)g * T + qrow) * 512 + h * 128 + 4 * quad;
#pragma unroll
    for (int db = 0; db < 8; ++db) { u32x2 wv; wv.x = cvt_pk_bf16(o[db][0] * inv, o[db][1] * inv); wv.y = cvt_pk_bf16(o[db][2] * inv, o[db][3] * inv); *(u32x2*)(orow + 16 * db) = wv; }
    if (quad == 0) LSE[((size_t)g * T + qrow) * 4 + h] = (mx + __builtin_amdgcn_logf(den)) * LN2;
    __syncthreads();
}

constexpr int SG_STR = 288, SG_TILE = 128 * SG_STR, SG_STATS = 2 * SG_TILE;
template <int KS> __device__ __forceinline__ void sg_step(unsigned vaddr, const bf16x8 wf, f32x4 (&acc)[8]) {
    s16x4 r0[8], r1[8];
    tr8<KS * 32 * SG_STR>(vaddr, r0);
    tr8<KS * 32 * SG_STR + 4 * SG_STR>(vaddr, r1);
    asm volatile("s_waitcnt lgkmcnt(0)" ::: "memory");
    __builtin_amdgcn_sched_barrier(0);
#pragma unroll
    for (int cb = 0; cb < 8; ++cb) acc[cb] = __builtin_amdgcn_mfma_f32_16x16x32_bf16(cat4(r0[cb], r1[cb]), wf, acc[cb], 0, 0, 0);
}
__device__ __forceinline__ void sg_unit(LAS unsigned char* lds, const bf16_t* U, const bf16_t* V, bf16_t* AOUT, const bf16_t* WsB, const float* bs, const float* lng, const float* lnb, int unit) {
    const int tid = opaque_v(threadIdx.x), lane = tid & 63, w = tid >> 6, ql = lane & 15, quad = lane >> 4;
    const int ci = unit >> 1, hh = unit & 1, row0 = ci * 128;
    LAS float* stats = (LAS float*)(lds + SG_STATS);
#pragma unroll 4
    for (int rr = 0; rr < 16; ++rr) { const int row = row0 + 16 * w + rr;
        const u32x4 x0 = *(const u32x4*)(V + (size_t)row * D + lane * 16), x1 = *(const u32x4*)(V + (size_t)row * D + lane * 16 + 8);
        float f[16] = {bflo(x0.x), bfhi(x0.x), bflo(x0.y), bfhi(x0.y), bflo(x0.z), bfhi(x0.z), bflo(x0.w), bfhi(x0.w), bflo(x1.x), bfhi(x1.x), bflo(x1.y), bfhi(x1.y), bflo(x1.z), bfhi(x1.z), bflo(x1.w), bfhi(x1.w)};
        float sm = 0.f;
#pragma unroll
        for (int j = 0; j < 16; ++j) sm += f[j];
        const float mean = wave_sum(sm) * (1.0f / D); float s2 = 0.f;
#pragma unroll
        for (int j = 0; j < 16; ++j) { const float d = f[j] - mean; s2 += d * d; }
        const float rstd = 1.0f / sqrtf(wave_sum(s2) * (1.0f / D) + LN_EPS);
        if (lane == 0) { stats[2 * (16 * w + rr)] = mean; stats[2 * (16 * w + rr) + 1] = rstd; } }
    __syncthreads();
    const int ch = tid & 15;
#pragma unroll 1
    for (int gi = 0; gi < 4; ++gi) {
        const int g = 4 * hh + gi; LAS unsigned char* tile = lds + (gi & 1) * SG_TILE;
        const f32x4 ga0 = *(const f32x4*)(lng + g * 128 + ch * 8), ga1 = *(const f32x4*)(lng + g * 128 + ch * 8 + 4), be0 = *(const f32x4*)(lnb + g * 128 + ch * 8), be1 = *(const f32x4*)(lnb + g * 128 + ch * 8 + 4);
#pragma unroll
        for (int j = 0; j < 4; ++j) { const int sr = (tid >> 4) + 32 * j; const u32x4 x = *(const u32x4*)(V + (size_t)(row0 + sr) * D + g * 128 + ch * 8);
            const float mean = stats[2 * sr], rstd = stats[2 * sr + 1];
            const f32x4 a = ((f32x4){bflo(x.x), bfhi(x.x), bflo(x.y), bfhi(x.y)} - mean) * rstd * ga0 + be0, bq = ((f32x4){bflo(x.z), bfhi(x.z), bflo(x.w), bfhi(x.w)} - mean) * rstd * ga1 + be1;
            u32x4 o; o.x = cvt_pk_bf16(a[0], a[1]); o.y = cvt_pk_bf16(a[2], a[3]); o.z = cvt_pk_bf16(bq[0], bq[1]); o.w = cvt_pk_bf16(bq[2], bq[3]);
            *(LAS u32x4*)(tile + sr * SG_STR + ch * 16) = o; }
        const bf16_t* Wg = WsB + (size_t)g * 128 * 128 + (size_t)(16 * w + ql) * 128 + 8 * quad;
        bf16x8 wf[4];
#pragma unroll
        for (int ks = 0; ks < 4; ++ks) wf[ks] = *(const bf16x8*)(Wg + 32 * ks);
        __syncthreads();
        f32x4 acc[8];
#pragma unroll
        for (int cb = 0; cb < 8; ++cb) acc[cb] = (f32x4){0.f, 0.f, 0.f, 0.f};
        const unsigned vaddr = (unsigned)(uintptr_t)tile + (unsigned)((8 * quad + (ql >> 2)) * SG_STR + (ql & 3) * 8);
        sg_step<0>(vaddr, wf[0], acc); sg_step<1>(vaddr, wf[1], acc); sg_step<2>(vaddr, wf[2], acc); sg_step<3>(vaddr, wf[3], acc);
        const int t = 16 * w + ql; const float bst = bs[g * 128 + t];
        const size_t off = (size_t)(row0 + t) * D + g * 128 + 4 * quad;
#pragma unroll
        for (int cb = 0; cb < 8; ++cb) { const u32x2 uu = *(const u32x2*)(U + off + 16 * cb);
            u32x2 o; o.x = cvt_pk_bf16(bflo(uu.x) * (acc[cb][0] + bst), bfhi(uu.x) * (acc[cb][1] + bst)); o.y = cvt_pk_bf16(bflo(uu.y) * (acc[cb][2] + bst), bfhi(uu.y) * (acc[cb][3] + bst));
            *(u32x2*)(AOUT + off + 16 * cb) = o; }
    }
    __syncthreads();
}

__device__ __forceinline__ void merge_phase(const bf16_t* OG, const float* LSE, bf16_t* BOUT, int G) {
    const int tid = opaque_v(threadIdx.x), lane = tid & 63, gw = blockIdx.x * 8 + (tid >> 6), NGW = G * 8, hd = lane >> 4;
    for (int row = gw; row < T; row += NGW) {
        const float l0 = LSE[((size_t)0 * T + row) * 4 + hd], l1 = LSE[((size_t)1 * T + row) * 4 + hd], l2 = LSE[((size_t)2 * T + row) * 4 + hd];
        const float m = fmaxf(l0, fmaxf(l1, l2));
        float w0 = __builtin_amdgcn_exp2f((l0 - m) * LOG2E), w1 = __builtin_amdgcn_exp2f((l1 - m) * LOG2E), w2 = __builtin_amdgcn_exp2f((l2 - m) * LOG2E);
        const float inv = 1.0f / (w0 + w1 + w2); w0 *= inv; w1 *= inv; w2 *= inv;
        const u32x4 a = *(const u32x4*)(OG + ((size_t)0 * T + row) * 512 + lane * 8), b = *(const u32x4*)(OG + ((size_t)1 * T + row) * 512 + lane * 8), c = *(const u32x4*)(OG + ((size_t)2 * T + row) * 512 + lane * 8);
        u32x4 o;
        o.x = cvt_pk_bf16(w0 * bflo(a.x) + w1 * bflo(b.x) + w2 * bflo(c.x), w0 * bfhi(a.x) + w1 * bfhi(b.x) + w2 * bfhi(c.x));
        o.y = cvt_pk_bf16(w0 * bflo(a.y) + w1 * bflo(b.y) + w2 * bflo(c.y), w0 * bfhi(a.y) + w1 * bfhi(b.y) + w2 * bfhi(c.y));
        o.z = cvt_pk_bf16(w0 * bflo(a.z) + w1 * bflo(b.z) + w2 * bflo(c.z), w0 * bfhi(a.z) + w1 * bfhi(b.z) + w2 * bfhi(c.z));
        o.w = cvt_pk_bf16(w0 * bflo(a.w) + w1 * bflo(b.w) + w2 * bflo(c.w), w0 * bfhi(a.w) + w1 * bfhi(b.w) + w2 * bfhi(c.w));
        *(u32x4*)(BOUT + (size_t)row * 512 + lane * 8) = o;
    }
}

constexpr int RT_WSTR = 36, RT_WBYTES = 1024 * RT_WSTR * 4, RT_ENT = RT_WBYTES;
static_assert(RT_ENT + 64 * 4 * 8 <= SCR_BYTES, "router LDS");
__device__ __forceinline__ void ln1_router_phase(LAS unsigned char* lds, volatile LAS unsigned* MISC, float* XF, bf16_t* XB, const float* g1, const float* b1, const float* wr, const float* br,
                                                 unsigned* gcnt, int* tokList, int* tokE, int* tokPos, float* gate, int G) {
    const int tid = opaque_v(threadIdx.x), lane = tid & 63, w = tid >> 6;
    LAS float* wl = (LAS float*)lds;
    for (int i = tid; i < 1024 * 8; i += 512) { const int k = i >> 3, c4 = i & 7; const f32x4 v = *(const f32x4*)(wr + (size_t)k * 32 + c4 * 4);
        const int slot = ((k >> 8) * 4 + (k & 3)) * 64 + ((k >> 2) & 63); *(LAS f32x4*)(wl + slot * RT_WSTR + c4 * 4) = v; }
    LAS int* ent = (LAS int*)(lds + RT_ENT);
    volatile LAS unsigned* lcnt = MISC + 128; volatile LAS unsigned* gbase = MISC + 160;
    if (tid < 32) lcnt[tid] = 0u;
    f32x4 gv[4], bv[4];
#pragma unroll
    for (int j = 0; j < 4; ++j) { gv[j] = *(const f32x4*)(g1 + 256 * j + 4 * lane); bv[j] = *(const f32x4*)(b1 + 256 * j + 4 * lane); }
    const float myb = br[(lane >> 1) & 31];
    __syncthreads();
    for (int bt = blockIdx.x; bt < T / 64; bt += G) {
#pragma unroll 1
        for (int rr = 0; rr < 8; ++rr) {
            const int row = bt * 64 + w * 8 + rr;
            f32x4 v[4]; float s = 0.f;
#pragma unroll
            for (int j = 0; j < 4; ++j) { v[j] = *(const f32x4*)(XF + (size_t)row * D + 256 * j + 4 * lane); s += (v[j][0] + v[j][1]) + (v[j][2] + v[j][3]); }
            const float mean = wave_sum(s) * (1.0f / D); float s2 = 0.f;
#pragma unroll
            for (int j = 0; j < 4; ++j) { v[j] = v[j] - mean; s2 += (v[j][0] * v[j][0] + v[j][1] * v[j][1]) + (v[j][2] * v[j][2] + v[j][3] * v[j][3]); }
            const float rstd = 1.0f / sqrtf(wave_sum(s2) * (1.0f / D) + LN_EPS);
#pragma unroll
            for (int j = 0; j < 4; ++j) { v[j] = v[j] * rstd * gv[j] + bv[j];
                *(f32x4*)(XF + (size_t)row * D + 256 * j + 4 * lane) = v[j];
                u32x2 o; o.x = cvt_pk_bf16(v[j][0], v[j][1]); o.y = cvt_pk_bf16(v[j][2], v[j][3]); *(u32x2*)(XB + (size_t)row * D + 256 * j + 4 * lane) = o; }
            float acc[32];
#pragma unroll
            for (int e = 0; e < 32; ++e) acc[e] = 0.f;
#pragma unroll
            for (int j = 0; j < 4; ++j)
#pragma unroll
                for (int jj = 0; jj < 4; ++jj) { const LAS float* wp = wl + ((j * 4 + jj) * 64 + lane) * RT_WSTR; const float x = v[j][jj];
#pragma unroll
                    for (int c4 = 0; c4 < 8; ++c4) { const f32x4 wv = *(const LAS f32x4*)(wp + c4 * 4); acc[c4 * 4] += x * wv[0]; acc[c4 * 4 + 1] += x * wv[1]; acc[c4 * 4 + 2] += x * wv[2]; acc[c4 * 4 + 3] += x * wv[3]; } }
            float r16[16], r8[8], r4[4], r2[2], lg;
            { const bool hi = (lane & 32) != 0;
#pragma unroll
              for (int i = 0; i < 16; ++i) { const float mine = hi ? acc[16 + i] : acc[i], oth = hi ? acc[i] : acc[16 + i]; r16[i] = mine + __shfl_xor(oth, 32); } }
            { const bool hi = (lane & 16) != 0;
#pragma unroll
              for (int i = 0; i < 8; ++i) { const float mine = hi ? r16[8 + i] : r16[i], oth = hi ? r16[i] : r16[8 + i]; r8[i] = mine + __shfl_xor(oth, 16); } }
            { const bool hi = (lane & 8) != 0;
#pragma unroll
              for (int i = 0; i < 4; ++i) { const float mine = hi ? r8[4 + i] : r8[i], oth = hi ? r8[i] : r8[4 + i]; r4[i] = mine + __shfl_xor(oth, 8); } }
            { const bool hi = (lane & 4) != 0;
#pragma unroll
              for (int i = 0; i < 2; ++i) { const float mine = hi ? r4[2 + i] : r4[i], oth = hi ? r4[i] : r4[2 + i]; r2[i] = mine + __shfl_xor(oth, 4); } }
            { const bool hi = (lane & 2) != 0; const float mine = hi ? r2[1] : r2[0], oth = hi ? r2[0] : r2[1]; lg = mine + __shfl_xor(oth, 2); }
            lg += __shfl_xor(lg, 1);
            lg += myb;
            const int me = (lane >> 1) & 31;
            float tv[4]; int ti[4]; float cur = lg;
#pragma unroll
            for (int k = 0; k < 4; ++k) { float bvv = cur; int bi = me;
#pragma unroll
                for (int o = 1; o < 64; o <<= 1) { const float ov = __shfl_xor(bvv, o); const int oi = __shfl_xor(bi, o); if (ov > bvv || (ov == bvv && oi < bi)) { bvv = ov; bi = oi; } }
                tv[k] = bvv; ti[k] = bi; if (me == bi) cur = -3.0e38f; }
            const float e1 = __builtin_amdgcn_exp2f((tv[1] - tv[0]) * LOG2E), e2 = __builtin_amdgcn_exp2f((tv[2] - tv[0]) * LOG2E), e3 = __builtin_amdgcn_exp2f((tv[3] - tv[0]) * LOG2E);
            const float inv = 1.0f / (1.0f + e1 + e2 + e3);
            if (lane < 4) { const int e = lane == 0 ? ti[0] : lane == 1 ? ti[1] : lane == 2 ? ti[2] : ti[3]; const float gt = (lane == 0 ? 1.0f : lane == 1 ? e1 : lane == 2 ? e2 : e3) * inv;
                const unsigned lp = __hip_atomic_fetch_add((LAS unsigned*)&lcnt[e], 1u, __ATOMIC_RELAXED, __HIP_MEMORY_SCOPE_WORKGROUP);
                ent[((w * 8 + rr) * 4 + lane) * 2] = e; ent[((w * 8 + rr) * 4 + lane) * 2 + 1] = (int)lp;
                gate[(size_t)row * 4 + lane] = gt; tokE[(size_t)row * 4 + lane] = e; }
        }
        __syncthreads();
        if (tid < 32) { const unsigned n = lcnt[tid]; gbase[tid] = n ? __hip_atomic_fetch_add(gcnt + tid, n, __ATOMIC_RELAXED, __HIP_MEMORY_SCOPE_AGENT) : 0u; }
        __syncthreads();
        if (tid < 256) { const int e = ent[tid * 2], lp = ent[tid * 2 + 1], row = bt * 64 + (tid >> 2), pos = (int)gbase[e] + lp;
            tokList[(size_t)e * T + pos] = row; tokPos[(size_t)row * 4 + (tid & 3)] = pos; }
        if (tid < 32) lcnt[tid] = 0u;
        __syncthreads();
    }
}

__device__ __forceinline__ void combine_ln2_phase(volatile LAS unsigned* MISC, const float* XF, const bf16_t* YK, const int* tokE, const int* tokPos, const float* gate, const float* g2, const float* b2,
                                                  float* outF, bf16_t* XB, int G) {
    const int tid = opaque_v(threadIdx.x), lane = tid & 63, gw = blockIdx.x * 8 + (tid >> 6), NGW = G * 8;
    const volatile LAS int* tb = (const volatile LAS int*)(MISC + 16);
    f32x4 gv[4], bv[4];
#pragma unroll
    for (int j = 0; j < 4; ++j) { gv[j] = *(const f32x4*)(g2 + 256 * j + 4 * lane); bv[j] = *(const f32x4*)(b2 + 256 * j + 4 * lane); }
    for (int row = gw; row < T; row += NGW) {
        f32x4 v[4];
#pragma unroll
        for (int j = 0; j < 4; ++j) v[j] = *(const f32x4*)(XF + (size_t)row * D + 256 * j + 4 * lane) * DN_ALPHA;
#pragma unroll
        for (int k = 0; k < 4; ++k) { const int e = tokE[(size_t)row * 4 + k], pos = tokPos[(size_t)row * 4 + k]; const float gt = gate[(size_t)row * 4 + k];
            const size_t slot = (size_t)tb[e] * 256 + pos;
#pragma unroll
            for (int j = 0; j < 4; ++j) { const u32x2 y = *(const u32x2*)(YK + slot * D + 256 * j + 4 * lane); v[j] += (f32x4){bflo(y.x), bfhi(y.x), bflo(y.y), bfhi(y.y)} * gt; } }
        float s = 0.f;
#pragma unroll
        for (int j = 0; j < 4; ++j) s += (v[j][0] + v[j][1]) + (v[j][2] + v[j][3]);
        const float mean = wave_sum(s) * (1.0f / D); float s2 = 0.f;
#pragma unroll
        for (int j = 0; j < 4; ++j) { v[j] = v[j] - mean; s2 += (v[j][0] * v[j][0] + v[j][1] * v[j][1]) + (v[j][2] * v[j][2] + v[j][3] * v[j][3]); }
        const float rstd = 1.0f / sqrtf(wave_sum(s2) * (1.0f / D) + LN_EPS);
#pragma unroll
        for (int j = 0; j < 4; ++j) { v[j] = v[j] * rstd * gv[j] + bv[j];
            *(f32x4*)(outF + (size_t)row * D + 256 * j + 4 * lane) = v[j];
            u32x2 o; o.x = cvt_pk_bf16(v[j][0], v[j][1]); o.y = cvt_pk_bf16(v[j][2], v[j][3]); *(u32x2*)(XB + (size_t)row * D + 256 * j + 4 * lane) = o; }
    }
}

__device__ __forceinline__ void moe_tables(volatile LAS unsigned* MISC, const unsigned* gcnt) {
    if (threadIdx.x == 0) { int acc = 0;
        for (int e = 0; e < NE; ++e) { const int n = (int)__hip_atomic_load(gcnt + e, __ATOMIC_RELAXED, __HIP_MEMORY_SCOPE_AGENT); MISC[64 + e] = (unsigned)n; MISC[16 + e] = (unsigned)acc; acc += (n + 255) >> 8; }
        MISC[16 + NE] = (unsigned)acc; }
    __syncthreads();
}

__global__ void __launch_bounds__(512, 2) fwd_kernel(Args args) {
    extern __shared__ __attribute__((aligned(16))) unsigned char lds_raw[];
    LAS unsigned char* lds = (LAS unsigned char*)lds_raw;
    volatile LAS unsigned* MISC = (volatile LAS unsigned*)(lds + MISC_OFF);
    const int tid = threadIdx.x, G = gridDim.x;
    unsigned char* const ws0 = args.ws;
    unsigned* ctl = (unsigned*)(ws0 + WS_CTL);
    for (int u = tid; u < 256; u += 512) MISC[u] = 0u;
    __syncthreads();
    const int lo = args.ph_lo, hi = args.ph_hi;
    XcdBarrier bar; bar.bar = ctl + CW_BAR; bar.x = 0; bar.st = MISC;
    if (hi - lo > 1) bar = xcd_barrier_post(ctl + CW_BAR, MISC);
#ifndef PH_MASK
#define PH_MASK 0x3ff
#endif
#define IN(k) (lo <= (k) && (k) < hi)
#define PON(p) (((PH_MASK) >> (p)) & 1)
#define SEAM(k) do { if (IN((k) + 1)) xcd_barrier(bar); } while (0)
#define WSP(T_, off) ((T_*)(ws + (off)))
#define PRM(off) ((const float*)(ws + WS_PRM) + (off))

    if (PON(9) && IN(0)) { p0_prologue(args, lds, G); SEAM(0); }

#pragma unroll 1
    for (int l = 0; l < DEPTH; ++l) {
        const int pb = 1 + l * NPH;
        if (PON(0) && IN(pb + 0)) { unsigned char* ws = opaque_p(ws0); unsigned* ctl = (unsigned*)(ws + WS_CTL); (void)ctl;
            pg8::DenseSched S{WSP(const bf16_t, WS_XB), WSP(const bf16_t, WS_WIN) + (size_t)l * DIN * D, D, T / 256, DIN / 256, G, (int)blockIdx.x};
            pg8::EpiIn E{PRM(PR_BIN) + (size_t)l * DIN, WSP(bf16_t, WS_U), WSP(bf16_t, WS_V), WSP(bf16_t, WS_QKV), WSP(bf16_t, WS_GA), WSP(bf16_t, WS_GB)};
            pg8::gemm_phase<pg8::EpiIn, pg8::DenseSched, true>(lds, S, E);
            SEAM(pb + 0);
        }
        if (PON(1) && IN(pb + 1)) { unsigned char* ws = opaque_p(ws0); unsigned* ctl = (unsigned*)(ws + WS_CTL); (void)ctl;
            for (int u = blockIdx.x; u < 12 * 3 * 4 * 32; u += G) attn_unit(lds, WSP(const bf16_t, WS_QKV), WSP(bf16_t, WS_OG), WSP(float, WS_LSE), u);
            for (int u = blockIdx.x; u < 768; u += G)
                sg_unit(lds, WSP(const bf16_t, WS_U), WSP(const bf16_t, WS_V), WSP(bf16_t, WS_AOUT), WSP(const bf16_t, WS_WS) + (size_t)l * 8 * 128 * 128, PRM(PR_BS) + (size_t)l * 1024, PRM(PR_LNVG) + (size_t)l * 1024, PRM(PR_LNVB) + (size_t)l * 1024, u);
            SEAM(pb + 1);
        }
        if (PON(2) && IN(pb + 2)) { unsigned char* ws = opaque_p(ws0); unsigned* ctl = (unsigned*)(ws + WS_CTL); (void)ctl; merge_phase(WSP(const bf16_t, WS_OG), WSP(const float, WS_LSE), WSP(bf16_t, WS_BOUT), G); SEAM(pb + 2); }
        if (PON(3) && IN(pb + 3)) { unsigned char* ws = opaque_p(ws0); unsigned* ctl = (unsigned*)(ws + WS_CTL); (void)ctl;
            pg8::DenseSched S{WSP(const bf16_t, WS_AOUT), WSP(const bf16_t, WS_WPA) + (size_t)l * D * D, D, T / 256, D / 256, G, (int)blockIdx.x};
            pg8::EpiT1 E{WSP(const bf16_t, WS_GA), WSP(float, WS_T1)};
            pg8::gemm_phase<pg8::EpiT1, pg8::DenseSched, true>(lds, S, E);
        }
        if (PON(3) && IN(pb + 3)) { unsigned char* ws = opaque_p(ws0); unsigned* ctl = (unsigned*)(ws + WS_CTL); (void)ctl;
            pg8::DenseSched S{WSP(const bf16_t, WS_BOUT), WSP(const bf16_t, WS_WPB) + (size_t)l * D * 512, 512, T / 256, D / 256, G, (int)blockIdx.x};
            pg8::EpiMg E{WSP(const bf16_t, WS_GB), WSP(const float, WS_T1), WSP(bf16_t, WS_MG)};
            pg8::gemm_phase<pg8::EpiMg, pg8::DenseSched, true>(lds, S, E);
            SEAM(pb + 3);
        }
        if (PON(4) && IN(pb + 4)) { unsigned char* ws = opaque_p(ws0); unsigned* ctl = (unsigned*)(ws + WS_CTL); (void)ctl;
            pg8::DenseSched S{WSP(const bf16_t, WS_MG), WSP(const bf16_t, WS_WO) + (size_t)l * D * D, D, T / 256, D / 256, G, (int)blockIdx.x};
            pg8::EpiWo E{l == 0 ? args.in[I_XP] : WSP(const float, WS_XF), l == 0 ? args.in[I_XS] - (size_t)TP * D : WSP(const float, WS_XF), WSP(float, WS_XF)};
            pg8::gemm_phase<pg8::EpiWo, pg8::DenseSched, true>(lds, S, E);
            SEAM(pb + 4);
        }
        if (PON(5) && IN(pb + 5)) { unsigned char* ws = opaque_p(ws0); unsigned* ctl = (unsigned*)(ws + WS_CTL); (void)ctl;
            ln1_router_phase(lds, MISC, WSP(float, WS_XF), WSP(bf16_t, WS_XB), PRM(PR_LN1G) + (size_t)l * D, PRM(PR_LN1B) + (size_t)l * D, PRM(PR_WR) + (size_t)l * D * NE, PRM(PR_BR) + (size_t)l * NE,
                             ctl + CW_CNT + l * 64, WSP(int, WS_TOKLIST), WSP(int, WS_TOKE), WSP(int, WS_TOKPOS), WSP(float, WS_GATE), G);
            SEAM(pb + 5);
        }
        if (PON(6) && IN(pb + 6)) { unsigned char* ws = opaque_p(ws0); unsigned* ctl = (unsigned*)(ws + WS_CTL); (void)ctl;
            moe_tables(MISC, ctl + CW_CNT + l * 64);
            pg8::MoeSched<true> S{WSP(const bf16_t, WS_XB), WSP(const bf16_t, WS_WGU) + (size_t)l * NE * 2048 * D, D, 8, G, (int)blockIdx.x, (size_t)2048 * D * 2, (const LAS int*)(lds + MISC_OFF + 64), (const LAS int*)(lds + MISC_OFF + 256), WSP(const int, WS_TOKLIST)};
            pg8::EpiGU E{PRM(PR_BGU) + (size_t)l * NE * 2048, WSP(bf16_t, WS_H)};
            pg8::gemm_phase<pg8::EpiGU, pg8::MoeSched<true>, true>(lds, S, E);
            SEAM(pb + 6);
        }
        if (PON(7) && IN(pb + 7)) { unsigned char* ws = opaque_p(ws0); unsigned* ctl = (unsigned*)(ws + WS_CTL); (void)ctl;
            moe_tables(MISC, ctl + CW_CNT + l * 64);
            pg8::MoeSched<false> S{WSP(const bf16_t, WS_H), WSP(const bf16_t, WS_WD) + (size_t)l * NE * D * D, D, 4, G, (int)blockIdx.x, (size_t)D * D * 2, (const LAS int*)(lds + MISC_OFF + 64), (const LAS int*)(lds + MISC_OFF + 256), nullptr};
            pg8::EpiDown E{PRM(PR_BD) + (size_t)l * NE * D, WSP(bf16_t, WS_YK)};
            pg8::gemm_phase<pg8::EpiDown, pg8::MoeSched<false>, true>(lds, S, E);
            SEAM(pb + 7);
        }
        if (PON(8) && IN(pb + 8)) { unsigned char* ws = opaque_p(ws0); unsigned* ctl = (unsigned*)(ws + WS_CTL); (void)ctl;
            moe_tables(MISC, ctl + CW_CNT + l * 64);
            combine_ln2_phase(MISC, WSP(const float, WS_XF), WSP(const bf16_t, WS_YK), WSP(const int, WS_TOKE), WSP(const int, WS_TOKPOS), WSP(const float, WS_GATE), PRM(PR_LN2G) + (size_t)l * D, PRM(PR_LN2B) + (size_t)l * D,
                              l == DEPTH - 1 ? args.out : WSP(float, WS_XF), WSP(bf16_t, WS_XB), G);
            SEAM(pb + 8);
        }
    }
#undef IN
#undef SEAM
}

extern "C" void kernel_launch(void* const* d_in, const int* in_sizes, int n_in, void* d_out, int out_size, void* d_ws, size_t ws_size, hipStream_t stream) {
    static int grid = 0;
    if (grid == 0) {
        if (n_in != 21 || out_size != T * D || ws_size < WS_END) { fprintf(stderr, "kernel_launch: unexpected shapes (n_in %d, out %d, ws %zu < %zu)\n", n_in, out_size, ws_size, (size_t)WS_END); grid = -1; return; }
        int dev = 0, cus = 0, per_cu = 0;
        if (hipGetDevice(&dev) != hipSuccess || hipDeviceGetAttribute(&cus, hipDeviceAttributeMultiprocessorCount, dev) != hipSuccess) { grid = -1; return; }
        if (hipFuncSetAttribute((const void*)fwd_kernel, hipFuncAttributeMaxDynamicSharedMemorySize, LDS_BYTES) != hipSuccess) { fprintf(stderr, "kernel_launch: hipFuncSetAttribute failed\n"); grid = -1; return; }
        if (hipOccupancyMaxActiveBlocksPerMultiprocessor(&per_cu, (const void*)fwd_kernel, 512, LDS_BYTES) != hipSuccess || per_cu < 1) fprintf(stderr, "kernel_launch: occupancy query says %d\n", per_cu);
        (void)hipGetLastError();
        grid = cus;
    }
    if (grid < 0) return;
    (void)hipMemsetAsync((char*)d_ws + WS_CTL, 0, CTL_BYTES, stream);
    Args a{};
    for (int i = 0; i < 21; ++i) a.in[i] = (const float*)d_in[i];
    a.out = (float*)d_out; a.ws = (unsigned char*)d_ws;
#if MK_SPLIT
    for (int p = 0; p < NPHASE; ++p) { a.ph_lo = p; a.ph_hi = p + 1; hipLaunchKernelGGL(fwd_kernel, dim3(grid), dim3(512), LDS_BYTES, stream, a); }
#else
    a.ph_lo = 0; a.ph_hi = NPHASE;
    hipLaunchKernelGGL(fwd_kernel, dim3(grid), dim3(512), LDS_BYTES, stream, a);
#endif
}
```

```cpp
#include <hip/hip_runtime.h>
#include <cstdio>
#include <cstdint>

#ifndef Y1_BF16
#define Y1_BF16 1
#endif
#ifndef MK_SPLIT
#define MK_SPLIT 0
#endif

#define LAS __attribute__((address_space(3)))
#define GAS __attribute__((address_space(1)))
typedef unsigned short bf16_t;
typedef short bf16x8 __attribute__((ext_vector_type(8)));
typedef short s16x4 __attribute__((ext_vector_type(4)));
typedef float f32x4 __attribute__((ext_vector_type(4)));
typedef float f32x2 __attribute__((ext_vector_type(2)));
typedef unsigned u32x4 __attribute__((ext_vector_type(4)));
typedef unsigned u32x2 __attribute__((ext_vector_type(2)));

constexpr int D = 1024, T = 49152, TP = 32768, SEQ = 4096, DEPTH = 4, DIN = 8704, NE = 32, TOPK = 4, QKVW = 4608;
constexpr int NSLOT = T * TOPK + NE * 256;
constexpr float DN_ALPHA = 1.6817928305074290f;
constexpr float LN_EPS = 1e-5f;
constexpr float LOG2E = 1.4426950408889634f, LN2 = 0.6931471805599453f;
constexpr int NPH = 9, NPHASE = 1 + DEPTH * NPH;

constexpr size_t MiB = 1u << 20;
constexpr size_t WS_CTL = 0, CTL_BYTES = 128 * 1024;
constexpr size_t WS_PRM = 1 * MiB;
constexpr int PR_BIN = 0, PR_LNVG = PR_BIN + DEPTH * DIN, PR_LNVB = PR_LNVG + DEPTH * D, PR_BS = PR_LNVB + DEPTH * D, PR_LN1G = PR_BS + DEPTH * D, PR_LN1B = PR_LN1G + DEPTH * D,
              PR_WR = PR_LN1B + DEPTH * D, PR_BR = PR_WR + DEPTH * D * NE, PR_BGU = PR_BR + DEPTH * NE, PR_BD = PR_BGU + DEPTH * NE * 2048, PR_LN2G = PR_BD + DEPTH * NE * D, PR_LN2B = PR_LN2G + DEPTH * D,
              PR_END = PR_LN2B + DEPTH * D;
static_assert((size_t)PR_END * 4 <= 4 * MiB, "params region");
constexpr size_t WS_WIN = 5 * MiB;
constexpr size_t WS_WPA = WS_WIN + (size_t)DEPTH * DIN * D * 2;
constexpr size_t WS_WPB = WS_WPA + (size_t)DEPTH * D * D * 2;
constexpr size_t WS_WO = WS_WPB + (size_t)DEPTH * D * 512 * 2;
constexpr size_t WS_WS = WS_WO + (size_t)DEPTH * D * D * 2;
constexpr size_t WS_WGU = WS_WS + (size_t)DEPTH * 8 * 128 * 128 * 2;
constexpr size_t WS_WD = WS_WGU + (size_t)DEPTH * NE * 2048 * D * 2;
constexpr size_t WS_XF = WS_WD + (size_t)DEPTH * NE * D * D * 2;
constexpr size_t WS_WRI = WS_XF + (size_t)T * D * 2;
constexpr size_t WS_XB = WS_XF + (size_t)T * D * 4;
constexpr size_t WS_TOKLIST = WS_XB + (size_t)T * D * 2;
constexpr size_t WS_TOKE = WS_TOKLIST + (size_t)NE * T * 4;
constexpr size_t WS_TOKPOS = WS_TOKE + (size_t)T * 4 * 4;
constexpr size_t WS_GATE = WS_TOKPOS + (size_t)T * 4 * 4;
constexpr size_t WS_PS = WS_GATE + (size_t)T * 4 * 4;
constexpr size_t WS_RS = WS_PS + (size_t)T * 16 * 8;
constexpr size_t WS_R = WS_RS + (size_t)T * 8;
constexpr size_t WS_U = WS_R;
constexpr size_t WS_V = WS_U + (size_t)T * D * 2;
constexpr size_t WS_QKV = WS_V + (size_t)T * D * 2;
constexpr size_t WS_GA = WS_QKV + (size_t)T * QKVW * 2;
constexpr size_t WS_GB = WS_GA + (size_t)T * D * 2;
constexpr size_t WS_AOUT = WS_GB + (size_t)T * D * 2;
constexpr size_t WS_OG = WS_AOUT + (size_t)T * D * 2;
constexpr size_t WS_LSE = WS_OG + (size_t)3 * T * 512 * 2;
constexpr size_t WS_BOUT = WS_LSE + (size_t)3 * T * 4 * 4;
constexpr size_t WS_T1 = WS_BOUT + (size_t)T * 512 * 2;
constexpr size_t WS_MG = WS_T1 + (size_t)T * D * 4;
constexpr size_t WS_END_A = WS_MG + (size_t)T * D * 2;
constexpr size_t WS_H = WS_R;
constexpr size_t WS_YK = WS_H + (size_t)NSLOT * D * 2;
constexpr size_t WS_END_B = WS_YK + (size_t)NSLOT * D * 2;
constexpr size_t WS_END = WS_END_A > WS_END_B ? WS_END_A : WS_END_B;
constexpr int CW_BAR = 4096;
constexpr int CW_CNT = 16384;

constexpr int LDS_BYTES = 160 * 1024;
constexpr int MISC_OFF = LDS_BYTES - 2048, IDS_OFF = MISC_OFF + 1024;
constexpr int MISC_DOC = 0;
constexpr int SCR_BYTES = MISC_OFF;

#if Y1_BF16
typedef unsigned short y1_t;
#define Y1_LD4(p) ({ const u32x2 q_ = *(const u32x2*)(p); (f32x4){__builtin_bit_cast(float, q_.x << 16), __builtin_bit_cast(float, q_.x & 0xffff0000u), __builtin_bit_cast(float, q_.y << 16), __builtin_bit_cast(float, q_.y & 0xffff0000u)}; })
#else
typedef float y1_t;
#define Y1_LD4(p) (*(const f32x4*)(p))
#endif
__device__ __forceinline__ int opaque_v(int x) { asm volatile("" : "+v"(x)); return x; }
__device__ __forceinline__ int opaque_s(int x) { asm volatile("" : "+s"(x)); return x; }
template <class P> __device__ __forceinline__ P* opaque_p(P* p) { unsigned long long z = 0; asm volatile("" : "+s"(z)); return (P*)((char*)p + z); }
__device__ __forceinline__ unsigned f2bf(float f) { unsigned u = __builtin_bit_cast(unsigned, f); return (u + 0x7fffu + ((u >> 16) & 1u)) >> 16; }
__device__ __forceinline__ unsigned pk2(float lo, float hi) { return f2bf(lo) | (f2bf(hi) << 16); }
__device__ __forceinline__ unsigned cvt_pk_bf16(float lo, float hi) { unsigned r; asm volatile("v_cvt_pk_bf16_f32 %0, %1, %2" : "=v"(r) : "v"(lo), "v"(hi)); return r; }
__device__ __forceinline__ float bflo(unsigned w) { return __builtin_bit_cast(float, w << 16); }
__device__ __forceinline__ float bfhi(unsigned w) { return __builtin_bit_cast(float, w & 0xffff0000u); }
__device__ __forceinline__ float wave_sum(float v) {
#pragma unroll
    for (int o = 1; o < 64; o <<= 1) v += __shfl_xor(v, o);
    return v;
}
__device__ __forceinline__ float sigmoidf_(float x) { return __builtin_amdgcn_rcpf(1.0f + __builtin_amdgcn_exp2f(-x * LOG2E)); }
__device__ __forceinline__ f32x2 gelu_pk(f32x2 v) {
    f32x2 t = v * v; t.x = fminf(t.x, 16.0f); t.y = fminf(t.y, 16.0f);
    f32x2 p = t * 9.567564795975869e-11f + (-8.026423969909047e-09f);
    p = p * t + 3.002628830017784e-07f; p = p * t + (-6.72069427309907e-06f); p = p * t + 0.00010251090134261176f; p = p * t + (-0.0011512201745063066f);
    p = p * t + 0.009921522811055183f; p = p * t + (-0.06646095216274261f); p = p * t + 0.3989395201206207f;
    f32x2 vc; vc.x = fminf(fmaxf(v.x, -4.0f), 4.0f); vc.y = fminf(fmaxf(v.y, -4.0f), 4.0f);
    return v * (vc * p + 0.5f);
}

#define XB_TMO      128
#define XB_XCNT(j)  (256  + 64 * (j))
#define XB_XSUB(j)  (1280 + 64 * (j))
#define XB_XGEN(j)  (2304 + 64 * (j))
#define XB_TOP      3328
#define XB_TOPGEN   3392
#define XCD_BAR_WORDS 3456
#define XB_SPIN_CAP (1u << 18)
__device__ __forceinline__ unsigned xb_ld(unsigned* p)              { return __hip_atomic_load(p, __ATOMIC_RELAXED, __HIP_MEMORY_SCOPE_AGENT); }
__device__ __forceinline__ unsigned xb_add(unsigned* p, unsigned v) { return __hip_atomic_fetch_add(p, v, __ATOMIC_RELAXED, __HIP_MEMORY_SCOPE_AGENT); }
__device__ __forceinline__ unsigned xb_xcc_id() { return (unsigned)__builtin_amdgcn_s_getreg((3 << 11) | 20) & 0xFu; }
#define XB_SPIN(cond, bar) do { unsigned _sp = 0; while (cond) { __builtin_amdgcn_s_sleep(1); \
    if ((++_sp & 255u) == 0u) { if (xb_ld(&(bar)[XB_TMO])) break; if (_sp > XB_SPIN_CAP) { atomicAdd(&(bar)[XB_TMO], 1u); break; } } } } while (0)
struct XcdBarrier { unsigned* bar; unsigned x; volatile LAS unsigned* st; };
__device__ __forceinline__ XcdBarrier xcd_barrier_post(unsigned* bar, volatile LAS unsigned* st) {
    XcdBarrier b; b.bar = bar; b.x = xb_xcc_id(); b.st = st;
    if (threadIdx.x == 0) (void)xb_add(&bar[XB_XCNT(b.x)], 1u);
    return b;
}
__device__ __forceinline__ void xcd_barrier_complete(unsigned* bar, unsigned x, unsigned& nloc, unsigned& nx) {
    const unsigned G = gridDim.x * gridDim.y * gridDim.z;
    unsigned sum, cnt, mine, sp = 0u;
    for (;;) {
        sum = 0u; cnt = 0u; mine = 0u;
#pragma unroll
        for (unsigned j = 0; j < 16; ++j) { const unsigned c = xb_ld(&bar[XB_XCNT(j)]); sum += c; cnt += (c > 0u) ? 1u : 0u; mine = (j == x) ? c : mine; }
        if (sum == G) break;
        __builtin_amdgcn_s_sleep(1);
        if ((++sp & 255u) == 0u) { if (xb_ld(&bar[XB_TMO])) break; if (sp > XB_SPIN_CAP) { atomicAdd(&bar[XB_TMO], 1u); break; } }
    }
    nloc = mine > 0u ? mine : 1u; nx = cnt > 0u ? cnt : 1u;
}
__device__ __forceinline__ void xcd_barrier(const XcdBarrier& b) {
    asm volatile("s_waitcnt vmcnt(0)" ::: "memory");
    __syncthreads();
    if (threadIdx.x == 0) {
        unsigned* bar = b.bar;
        __builtin_amdgcn_s_waitcnt(0);
        unsigned nloc = b.st[0], nx = b.st[1];
        if (nloc == 0u) { xcd_barrier_complete(bar, b.x, nloc, nx); b.st[0] = nloc; b.st[1] = nx; }
        const unsigned old = xb_add(&bar[XB_XSUB(b.x)], 1u);
        const unsigned gen = old / nloc;
        if (old + 1u == (gen + 1u) * nloc) {
            __builtin_amdgcn_fence(__ATOMIC_RELEASE, "agent");
            asm volatile("s_waitcnt vmcnt(0)" ::: "memory");
            const unsigned og = xb_add(&bar[XB_TOP], 1u);
            const unsigned tg = og / nx;
            if (og + 1u == (tg + 1u) * nx) xb_add(&bar[XB_TOPGEN], 1u);
            else XB_SPIN(xb_ld(&bar[XB_TOPGEN]) == tg, bar);
            __builtin_amdgcn_fence(__ATOMIC_ACQUIRE, "agent");
            xb_add(&bar[XB_XGEN(b.x)], 1u);
            asm volatile("s_waitcnt vmcnt(0)" ::: "memory");
        } else {
            XB_SPIN(xb_ld(&bar[XB_XGEN(b.x)]) == gen, bar);
            __builtin_amdgcn_fence(__ATOMIC_ACQUIRE, "agent");
            asm volatile("s_waitcnt vmcnt(0)" ::: "memory");
        }
    }
    __syncthreads();
}

#ifndef EPI_NT
#define EPI_NT 1
#endif
#if EPI_NT
#define EPI_ST(T_, p, v) __builtin_nontemporal_store((T_)(v), (T_*)(p))
#else
#define EPI_ST(T_, p, v) (*(T_*)(p) = (v))
#endif
namespace pg8 {
constexpr int BM = 256, BK = 64, HALF = 128, HTB = HALF * BK * 2, STAGE_BYTES = 8 * HTB, NXCD = 8, WGM = 4;
__host__ __device__ __forceinline__ int lds_byte(int r, int c) { const int st = (r >> 4) * 2 + (c >> 5), rr = r & 15, cc = c & 31, ob = rr * 64 + cc * 2; return st * 1024 + (ob ^ (((ob >> 9) & 1) << 5)); }
__host__ __device__ __forceinline__ void stage_rc(int b, int& R, int& C) { const int st = b / 1024, sb = b % 1024, swz = sb ^ (((sb >> 9) & 1) << 5); R = (st >> 1) * 16 + swz / 64; C = (st & 1) * 32 + (swz % 64) / 2; }
__host__ __device__ __forceinline__ int perm32(int rho) { const int n = rho >> 4, i = rho & 15; return 8 * (i >> 2) + 4 * n + (i & 3); }

struct Unit { int pm, pn, e, r0; };

__device__ __forceinline__ bool static_order(int i, int G, int c, int nM, int nN, int& pm, int& pn) {
    const int nwg = nM * nN; const long L = (long)i * G + c; if (L >= nwg) return false;
    int wgid = (int)L; { const int q = nwg / NXCD, r = nwg % NXCD, xcd = wgid % NXCD, off = wgid / NXCD; wgid = (xcd < r ? xcd * (q + 1) : r * (q + 1) + (xcd - r) * q) + off; }
    const int nig = WGM * nN, gid = wgid / nig, fm = gid * WGM, gsz = (nM - fm) < WGM ? (nM - fm) : WGM;
    pm = fm + ((wgid % nig) % gsz); pn = (wgid % nig) / gsz; return true;
}
struct DenseSched {
    static constexpr bool GATHER = false;
    const bf16_t* A; const bf16_t* Bt; int K, nM, nN, G, c;
    __device__ __forceinline__ bool next(int i, Unit& u) const { u.e = 0; u.r0 = 0; return static_order(i, G, c, nM, nN, u.pm, u.pn); }
    __device__ __forceinline__ const char* a_base(const Unit& u) const { return (const char*)A + (size_t)u.pm * BM * K * 2; }
    __device__ __forceinline__ const char* b_base(const Unit& u) const { return (const char*)Bt + (size_t)u.pn * BM * K * 2; }
    __device__ __forceinline__ void a_offs(const Unit& u, const int (&R)[2], const int (&C)[2], unsigned (&o)[2][2]) const {
#pragma unroll
        for (int h = 0; h < 2; ++h)
#pragma unroll
            for (int i = 0; i < 2; ++i) o[h][i] = (unsigned)((u.pm * BM + h * HALF + R[i]) * K + C[i]) * 2u;
    }
    __device__ __forceinline__ int load_id(const Unit&, int) const { return 0; }
    __device__ __forceinline__ void a_offs_lds(const LAS int*, const int (&)[2], const int (&)[2], unsigned (&)[2][2]) const {}
};
template <bool GATHER_> struct MoeSched {
    static constexpr bool GATHER = GATHER_;
    const bf16_t* A; const bf16_t* Bt; int K, nN, G, c; size_t bstride;
    const LAS int* tb; const LAS int* cnt; const int* tokList;
    __device__ __forceinline__ bool next(int i, Unit& u) const {
        const int nM = tb[NE];
        if (!static_order(i, G, c, nM, nN, u.pm, u.pn)) return false;
        int e = 0;
#pragma unroll 1
        for (int j = 1; j < NE; ++j) e += (u.pm >= tb[j]) ? 1 : 0;
        u.e = e; u.r0 = (u.pm - tb[e]) * BM; return true;
    }
    __device__ __forceinline__ const char* a_base(const Unit& u) const { return GATHER ? (const char*)A : (const char*)A + (size_t)u.pm * BM * K * 2; }
    __device__ __forceinline__ const char* b_base(const Unit& u) const { return (const char*)Bt + (size_t)u.e * bstride + (size_t)u.pn * BM * K * 2; }
    __device__ __forceinline__ int load_id(const Unit& u, int i) const { const int r = u.r0 + i; return (r < cnt[u.e]) ? tokList[(size_t)u.e * T + r] : 0; }
    __device__ __forceinline__ void a_offs(const Unit& u, const int (&R)[2], const int (&C)[2], unsigned (&o)[2][2]) const {
#pragma unroll
        for (int h = 0; h < 2; ++h)
#pragma unroll
            for (int i = 0; i < 2; ++i) o[h][i] = (unsigned)(load_id(u, h * HALF + R[i]) * K + C[i]) * 2u;
    }
    __device__ __forceinline__ void a_offs_lds(const LAS int* ids, const int (&R)[2], const int (&C)[2], unsigned (&o)[2][2]) const {
#pragma unroll
        for (int h = 0; h < 2; ++h)
#pragma unroll
            for (int i = 0; i < 2; ++i) o[h][i] = (unsigned)(ids[h * HALF + R[i]] * K + C[i]) * 2u;
    }
};


template <class Epi, class Sched, bool ALIGN_EPI>
__device__ __forceinline__ void gemm_phase(LAS unsigned char* lds, const Sched& S, const Epi& E) {
    constexpr bool GATHER = Sched::GATHER;
    const int tid = opaque_v(threadIdx.x), wid = __builtin_amdgcn_readfirstlane(tid >> 6), lane = tid & 63, wr = wid >> 2, wc = wid & 3, fr = lane & 15, fq = lane >> 4;
    const int K = S.K, nt = K / BK;
    int R[2], C[2]; unsigned voffA[2], voffB[2];
#pragma unroll
    for (int i = 0; i < 2; ++i) { stage_rc(tid * 16 + i * 8192, R[i], C[i]); const int Rb = 64 * (R[i] >> 5) + (Epi::PERM ? perm32(R[i] & 31) : (R[i] & 31));
        voffA[i] = (unsigned)(R[i] * K + C[i]) * 2u; voffB[i] = (unsigned)(Rb * K + C[i]) * 2u; }
    const size_t kstep = (size_t)(BK * 2);
    const size_t hstep = (size_t)HALF * K * 2;
    const size_t bhstep = (size_t)32 * K * 2;
    const unsigned ldsw = (unsigned)wid * 1024u;
    const int aoff = lds_byte(wr * 64 + fr, fq * 8), boff = lds_byte(wc * 32 + fr, fq * 8);
#define PG8_SA(b, h) (((b) * 2 + (h)) * HTB)
#define PG8_SB(b, h) ((4 + (b) * 2 + (h)) * HTB)
#define PG8_STAGE(bufoff, gbase, voff) do { _Pragma("unroll") for (int _i = 0; _i < 2; ++_i) \
        __builtin_amdgcn_global_load_lds((const unsigned*)((const char*)(gbase) + (voff)[_i]), (LAS unsigned*)(lds + (bufoff) + ldsw + _i * 8192), 16, 0, 0); } while (0)
#define PG8_STAGE_A(bufoff, ab, ao, h, kb) do { if constexpr (GATHER) { PG8_STAGE(bufoff, (ab) + (kb), (ao)[h]); } else { PG8_STAGE(bufoff, (ab) + (kb) + (h) * hstep, voffA); } } while (0)
#define PG8_LDA(dst, b, h) do { _Pragma("unroll") for (int m = 0; m < 4; ++m) _Pragma("unroll") for (int k = 0; k < 2; ++k) dst[m][k] = *(const LAS bf16x8*)(lds + PG8_SA(b, h) + aoff + m * 2048 + k * 1024); } while (0)
#define PG8_LDB(dst, b, h) do { _Pragma("unroll") for (int n = 0; n < 2; ++n) _Pragma("unroll") for (int k = 0; k < 2; ++k) dst[n][k] = *(const LAS bf16x8*)(lds + PG8_SB(b, h) + boff + n * 2048 + k * 1024); } while (0)
#define PG8_MMA(ai, bj, At, Bt) do { __builtin_amdgcn_s_setprio(1); _Pragma("unroll") for (int m = 0; m < 4; ++m) _Pragma("unroll") for (int n = 0; n < 2; ++n) _Pragma("unroll") for (int k = 0; k < 2; ++k) \
        acc[ai][bj][m][n] = __builtin_amdgcn_mfma_f32_16x16x32_bf16(Bt[n][k], At[m][k], acc[ai][bj][m][n], 0, 0, 0); __builtin_amdgcn_s_setprio(0); } while (0)
#define PG8_WAIT_V(n) asm volatile("s_waitcnt vmcnt(" #n ")" ::: "memory")
#define PG8_WAIT_L(n) asm volatile("s_waitcnt lgkmcnt(" #n ")" ::: "memory")
#define PG8_BAR __builtin_amdgcn_s_barrier()
#define PG8_SCHED __builtin_amdgcn_sched_barrier(0)
    Unit cur, nxt; int ui = 0;
    if (!S.next(0, cur)) return;
    f32x4 acc[2][2][4][2];
    { f32x4 bv[2][2]; E.binit(cur, wc, fq, bv);
#pragma unroll
    for (int a = 0; a < 2; ++a)
#pragma unroll
        for (int b = 0; b < 2; ++b)
#pragma unroll
            for (int m = 0; m < 4; ++m)
#pragma unroll
                for (int n = 0; n < 2; ++n) { acc[a][b][m][n] = bv[b][n]; asm volatile("" : "+v"(acc[a][b][m][n])); } }
    bf16x8 At[4][2], B0[2][2], B1[2][2];
    unsigned ca[2][2];
    LAS int* ids = (LAS int*)(lds + IDS_OFF);
    if constexpr (GATHER) { S.a_offs(cur, R, C, ca); Unit n1; if (S.next(1, n1) && tid < 256) ids[tid] = S.load_id(n1, tid); }
    const char* cA = S.a_base(cur);
    const char* cB = S.b_base(cur);
    PG8_STAGE(PG8_SB(0, 0), cB, voffB); PG8_STAGE(PG8_SB(0, 1), cB + bhstep, voffB); PG8_STAGE_A(PG8_SA(0, 0), cA, ca, 0, 0); PG8_STAGE_A(PG8_SA(0, 1), cA, ca, 1, 0);
    if (wr == 1) PG8_BAR;
    PG8_WAIT_V(2); PG8_BAR;
    PG8_STAGE(PG8_SB(1, 0), cB + kstep, voffB); PG8_STAGE_A(PG8_SA(1, 0), cA, ca, 0, kstep); PG8_STAGE(PG8_SB(1, 1), cB + bhstep + kstep, voffB);
    PG8_WAIT_V(6); PG8_BAR;
    for (;;) {
        const bool has_next = S.next(ui + 1, nxt);
        const char* nA = has_next ? S.a_base(nxt) : cA; const char* nB = has_next ? S.b_base(nxt) : cB;
#define PG8_TRIP(RELAX) do { \
            const bool last = (t == nt - 2); \
            const size_t k1 = (size_t)(t + 1) * kstep; \
            const size_t k2 = last ? 0 : (size_t)(t + 2) * kstep, k3 = k2 + kstep; \
            const char* a2 = last ? nA : cA; const char* b2 = (last ? nB : cB) + k2; const char* b3 = b2 + kstep; \
            PG8_LDB(B0, 0, 0); PG8_LDB(B1, 0, 1); PG8_SCHED; PG8_LDA(At, 0, 0); PG8_STAGE_A(PG8_SA(1, 1), cA, ca, 1, k1); \
            if (!(RELAX)) PG8_WAIT_V(8); PG8_WAIT_L(0); PG8_BAR; PG8_MMA(0, 0, At, B0); PG8_MMA(0, 1, At, B1); PG8_BAR; PG8_SCHED; \
            if constexpr (GATHER) { if (last && has_next) { int R2[2], C2[2]; const int t2 = opaque_v(tid); stage_rc(t2 * 16, R2[0], C2[0]); stage_rc(t2 * 16 + 8192, R2[1], C2[1]); S.a_offs_lds(ids, R2, C2, ca); } } \
            PG8_LDA(At, 0, 1); PG8_STAGE(PG8_SB(0, 0), b2, voffB); PG8_STAGE(PG8_SB(0, 1), b2 + bhstep, voffB); PG8_STAGE_A(PG8_SA(0, 0), a2, ca, 0, k2); \
            if (!(RELAX)) PG8_WAIT_V(8); PG8_WAIT_L(0); PG8_BAR; PG8_MMA(1, 0, At, B0); PG8_MMA(1, 1, At, B1); PG8_BAR; PG8_SCHED; \
            PG8_LDB(B0, 1, 0); PG8_LDB(B1, 1, 1); PG8_SCHED; PG8_LDA(At, 1, 0); PG8_STAGE_A(PG8_SA(0, 1), a2, ca, 1, k2); \
            PG8_WAIT_V(8); PG8_WAIT_L(0); PG8_BAR; PG8_MMA(0, 0, At, B0); PG8_MMA(0, 1, At, B1); PG8_BAR; PG8_SCHED; \
            PG8_LDA(At, 1, 1); PG8_STAGE(PG8_SB(1, 0), b3, voffB); PG8_STAGE(PG8_SB(1, 1), b3 + bhstep, voffB); PG8_STAGE_A(PG8_SA(1, 0), a2, ca, 0, k3); \
            PG8_WAIT_V(8); PG8_WAIT_L(0); PG8_BAR; PG8_MMA(1, 0, At, B0); PG8_MMA(1, 1, At, B1); PG8_BAR; PG8_SCHED; \
        } while (0)
        int t = 0;
#ifndef NO_RELAX
        if (ui > 0) { PG8_TRIP(true); t = 2; }
#endif
        for (; t < nt; t += 2) PG8_TRIP(false);
#undef PG8_TRIP
        if constexpr (ALIGN_EPI) { if (wr == 0) PG8_BAR; }
        int idv = 0; bool fill = false;
        if constexpr (GATHER) { Unit n2; fill = S.next(ui + 2, n2) && tid < 256; if (fill) idv = S.load_id(n2, tid); }
        f32x4 bvn[2][2];
        if (has_next) E.binit(nxt, wc, fq, bvn);
        E(lds, acc, cur, wr, wc, fr, fq);
        if constexpr (GATHER) { if (fill) ids[tid] = idv; }
        if (!has_next) break;
#pragma unroll
        for (int a = 0; a < 2; ++a)
#pragma unroll
            for (int b = 0; b < 2; ++b)
#pragma unroll
                for (int m = 0; m < 4; ++m)
#pragma unroll
                    for (int n = 0; n < 2; ++n) { acc[a][b][m][n] = bvn[b][n]; asm volatile("" : "+v"(acc[a][b][m][n])); }
        cur = nxt; cA = nA; cB = nB; ++ui;
        if constexpr (ALIGN_EPI) { if (wr == 1) PG8_BAR; }
    }
    PG8_WAIT_V(0);
    if constexpr (!ALIGN_EPI) { if (wr == 0) PG8_BAR; }
    PG8_BAR;
#undef PG8_SA
#undef PG8_SB
#undef PG8_STAGE
#undef PG8_STAGE_A
#undef PG8_LDA
#undef PG8_LDB
#undef PG8_MMA
#undef PG8_WAIT_V
#undef PG8_WAIT_L
#undef PG8_BAR
#undef PG8_SCHED
}

struct Dense2Sched {
    const bf16_t* A1; const bf16_t* B1; int K1; const bf16_t* A2; const bf16_t* B2; int K2; int nM, nN, G, c;
    __device__ __forceinline__ bool next(int i, Unit& u) const { u.e = 0; u.r0 = 0; return static_order(i, G, c, nM, nN, u.pm, u.pn); }
};
template <class Epi>
__device__ __forceinline__ void gemm_phase2(LAS unsigned char* lds, const Dense2Sched& S, const Epi& E) {
    const int tid = opaque_v(threadIdx.x), wid = __builtin_amdgcn_readfirstlane(tid >> 6), lane = tid & 63, wr = wid >> 2, wc = wid & 3, fr = lane & 15, fq = lane >> 4;
    const int K1 = S.K1, K2 = S.K2, nt1 = K1 / BK, nt = nt1 + K2 / BK;
    unsigned vRA[2], vRB[2], vC[2];
#pragma unroll
    for (int i = 0; i < 2; ++i) { int R, C; stage_rc(tid * 16 + i * 8192, R, C); const int Rb = 64 * (R >> 5) + (Epi::PERM ? perm32(R & 31) : (R & 31)); vRA[i] = (unsigned)R * 2u; vRB[i] = (unsigned)Rb * 2u; vC[i] = (unsigned)C * 2u; }
#define PG8_VOFF(dst, vR, Kx) unsigned dst[2]; _Pragma("unroll") for (int i_ = 0; i_ < 2; ++i_) dst[i_] = (vR)[i_] * (unsigned)(Kx) + (unsigned)opaque_v((int)vC[i_])
    const size_t kstep = (size_t)(BK * 2);
    const size_t hstep1 = (size_t)HALF * K1 * 2, bhstep1 = (size_t)32 * K1 * 2, hstep2 = (size_t)HALF * K2 * 2, bhstep2 = (size_t)32 * K2 * 2;
    const unsigned ldsw = (unsigned)wid * 1024u;
    const int aoff = lds_byte(wr * 64 + fr, fq * 8), boff = lds_byte(wc * 32 + fr, fq * 8);
#define PG8_SA(b, h) (((b) * 2 + (h)) * HTB)
#define PG8_SB(b, h) ((4 + (b) * 2 + (h)) * HTB)
#define PG8_STAGE(bufoff, gbase, voff) do { _Pragma("unroll") for (int _i = 0; _i < 2; ++_i) \
        __builtin_amdgcn_global_load_lds((const unsigned*)((const char*)(gbase) + (voff)[_i]), (LAS unsigned*)(lds + (bufoff) + ldsw + _i * 8192), 16, 0, 0); } while (0)
#define PG8_LDA(dst, b, h) do { _Pragma("unroll") for (int m = 0; m < 4; ++m) _Pragma("unroll") for (int k = 0; k < 2; ++k) dst[m][k] = *(const LAS bf16x8*)(lds + PG8_SA(b, h) + aoff + m * 2048 + k * 1024); } while (0)
#define PG8_LDB(dst, b, h) do { _Pragma("unroll") for (int n = 0; n < 2; ++n) _Pragma("unroll") for (int k = 0; k < 2; ++k) dst[n][k] = *(const LAS bf16x8*)(lds + PG8_SB(b, h) + boff + n * 2048 + k * 1024); } while (0)
#define PG8_MMA(ai, bj, At, Bt) do { __builtin_amdgcn_s_setprio(1); _Pragma("unroll") for (int m = 0; m < 4; ++m) _Pragma("unroll") for (int n = 0; n < 2; ++n) _Pragma("unroll") for (int k = 0; k < 2; ++k) \
        acc[ai][bj][m][n] = __builtin_amdgcn_mfma_f32_16x16x32_bf16(Bt[n][k], At[m][k], acc[ai][bj][m][n], 0, 0, 0); __builtin_amdgcn_s_setprio(0); } while (0)
#define PG8_WAIT_V(n) asm volatile("s_waitcnt vmcnt(" #n ")" ::: "memory")
#define PG8_WAIT_L(n) asm volatile("s_waitcnt lgkmcnt(" #n ")" ::: "memory")
#define PG8_BAR __builtin_amdgcn_s_barrier()
#define PG8_SCHED __builtin_amdgcn_sched_barrier(0)
    Unit cur, nxt; int ui = 0;
    if (!S.next(0, cur)) return;
    f32x4 acc[2][2][4][2];
#pragma unroll
    for (int a = 0; a < 2; ++a)
#pragma unroll
        for (int b = 0; b < 2; ++b)
#pragma unroll
            for (int m = 0; m < 4; ++m)
#pragma unroll
                for (int n = 0; n < 2; ++n) acc[a][b][m][n] = (f32x4){0.f, 0.f, 0.f, 0.f};
    bf16x8 At[4][2], B0[2][2], B1[2][2];
    const char* cA1 = (const char*)S.A1 + (size_t)cur.pm * BM * K1 * 2; const char* cB1 = (const char*)S.B1 + (size_t)cur.pn * BM * K1 * 2;
    const char* cA2 = (const char*)S.A2 + (size_t)cur.pm * BM * K2 * 2; const char* cB2 = (const char*)S.B2 + (size_t)cur.pn * BM * K2 * 2;
    { PG8_VOFF(voffA1, vRA, K1); PG8_VOFF(voffB1, vRB, K1);
    PG8_STAGE(PG8_SB(0, 0), cB1, voffB1); PG8_STAGE(PG8_SB(0, 1), cB1 + bhstep1, voffB1); PG8_STAGE(PG8_SA(0, 0), cA1, voffA1); PG8_STAGE(PG8_SA(0, 1), cA1 + hstep1, voffA1);
    if (wr == 1) PG8_BAR;
    PG8_WAIT_V(2); PG8_BAR;
    PG8_STAGE(PG8_SB(1, 0), cB1 + kstep, voffB1); PG8_STAGE(PG8_SA(1, 0), cA1 + kstep, voffA1); PG8_STAGE(PG8_SB(1, 1), cB1 + bhstep1 + kstep, voffB1);
    PG8_WAIT_V(6); PG8_BAR; }
    for (;;) {
        const bool has_next = S.next(ui + 1, nxt);
        const char* nA1 = has_next ? (const char*)S.A1 + (size_t)nxt.pm * BM * K1 * 2 : cA1; const char* nB1 = has_next ? (const char*)S.B1 + (size_t)nxt.pn * BM * K1 * 2 : cB1;
#define PG8_TRIP2(RELAX) do { \
            const bool last = (t == nt - 2), s1c = (t < nt1), s1n = last || (t + 2 < nt1); \
            const char* ac = s1c ? cA1 + (size_t)(t + 1) * kstep + hstep1 : cA2 + (size_t)(t + 1 - nt1) * kstep + hstep2; \
            const char* an = last ? nA1 : (s1n ? cA1 + (size_t)(t + 2) * kstep : cA2 + (size_t)(t + 2 - nt1) * kstep); \
            const char* bn = last ? nB1 : (s1n ? cB1 + (size_t)(t + 2) * kstep : cB2 + (size_t)(t + 2 - nt1) * kstep); \
            const size_t hsn = s1n ? hstep1 : hstep2, bhn = s1n ? bhstep1 : bhstep2; \
            const int Kc = s1c ? K1 : K2, Kn = s1n ? K1 : K2; \
            PG8_LDB(B0, 0, 0); PG8_LDB(B1, 0, 1); PG8_SCHED; PG8_LDA(At, 0, 0); { PG8_VOFF(vac, vRA, Kc); PG8_STAGE(PG8_SA(1, 1), ac, vac); } \
            if (!(RELAX)) PG8_WAIT_V(8); PG8_WAIT_L(0); PG8_BAR; PG8_MMA(0, 0, At, B0); PG8_MMA(0, 1, At, B1); PG8_BAR; PG8_SCHED; \
            PG8_LDA(At, 0, 1); { PG8_VOFF(vbn, vRB, Kn); PG8_VOFF(van, vRA, Kn); PG8_STAGE(PG8_SB(0, 0), bn, vbn); PG8_STAGE(PG8_SB(0, 1), bn + bhn, vbn); PG8_STAGE(PG8_SA(0, 0), an, van); } \
            if (!(RELAX)) PG8_WAIT_V(8); PG8_WAIT_L(0); PG8_BAR; PG8_MMA(1, 0, At, B0); PG8_MMA(1, 1, At, B1); PG8_BAR; PG8_SCHED; \
            PG8_LDB(B0, 1, 0); PG8_LDB(B1, 1, 1); PG8_SCHED; PG8_LDA(At, 1, 0); { PG8_VOFF(van, vRA, Kn); PG8_STAGE(PG8_SA(0, 1), an + hsn, van); } \
            PG8_WAIT_V(8); PG8_WAIT_L(0); PG8_BAR; PG8_MMA(0, 0, At, B0); PG8_MMA(0, 1, At, B1); PG8_BAR; PG8_SCHED; \
            PG8_LDA(At, 1, 1); { PG8_VOFF(vbn, vRB, Kn); PG8_VOFF(van, vRA, Kn); PG8_STAGE(PG8_SB(1, 0), bn + kstep, vbn); PG8_STAGE(PG8_SB(1, 1), bn + kstep + bhn, vbn); PG8_STAGE(PG8_SA(1, 0), an + kstep, van); } \
            PG8_WAIT_V(8); PG8_WAIT_L(0); PG8_BAR; PG8_MMA(1, 0, At, B0); PG8_MMA(1, 1, At, B1); PG8_BAR; PG8_SCHED; \
        } while (0)
        int t = 0;
        if (ui > 0) { PG8_TRIP2(true); t = 2; }
        for (; t < nt1; t += 2) PG8_TRIP2(false);
        E.mid(lds, acc, cur, wr, wc, fr, fq);
        for (; t < nt; t += 2) PG8_TRIP2(false);
#undef PG8_TRIP2
        if (wr == 0) PG8_BAR;
        E(lds, acc, cur, wr, wc, fr, fq);
        if (!has_next) break;
#pragma unroll
        for (int a = 0; a < 2; ++a)
#pragma unroll
            for (int b = 0; b < 2; ++b)
#pragma unroll
                for (int m = 0; m < 4; ++m)
#pragma unroll
                    for (int n = 0; n < 2; ++n) acc[a][b][m][n] = (f32x4){0.f, 0.f, 0.f, 0.f};
        cur = nxt; cA1 = nA1; cB1 = nB1; cA2 = (const char*)S.A2 + (size_t)cur.pm * BM * K2 * 2; cB2 = (const char*)S.B2 + (size_t)cur.pn * BM * K2 * 2; ++ui;
        if (wr == 1) PG8_BAR;
    }
    PG8_WAIT_V(0);
    PG8_BAR;
#undef PG8_VOFF
#undef PG8_SA
#undef PG8_SB
#undef PG8_STAGE
#undef PG8_LDA
#undef PG8_LDB
#undef PG8_MMA
#undef PG8_WAIT_V
#undef PG8_WAIT_L
#undef PG8_BAR
#undef PG8_SCHED
}

typedef const f32x4 (&AccRef)[2][2][4][2];
constexpr int EPI_OFF = STAGE_BYTES, EPI_WSTR = 144, EPI_WBYTES = 16 * EPI_WSTR;
__device__ __forceinline__ void epi_xpose(LAS unsigned char* st, int fr, int fq, int lane, u32x4 in0, u32x4 in1, u32x4& out0, u32x4& out1) {
    *(LAS u32x4*)(st + fr * EPI_WSTR + fq * 16) = in0; *(LAS u32x4*)(st + fr * EPI_WSTR + 64 + fq * 16) = in1;
    out0 = *(const LAS u32x4*)(st + (lane >> 3) * EPI_WSTR + (lane & 7) * 16); out1 = *(const LAS u32x4*)(st + (8 + (lane >> 3)) * EPI_WSTR + (lane & 7) * 16);
}
__device__ __forceinline__ void epi_xpose1(LAS unsigned char* st, int fr, int fq, int lane, u32x4 in0, u32x4& out0) {
    *(LAS u32x4*)(st + fr * 80 + fq * 16) = in0;
    out0 = *(const LAS u32x4*)(st + (lane >> 2) * 80 + (lane & 3) * 16);
}
#define EPI_DRAIN() asm volatile("s_waitcnt vmcnt(0)" ::: "memory")
#define EPI_LOCALS() const int lane = opaque_v(fq * 16 + fr), lr = lane >> 3, lc = lane & 7;        LAS unsigned char* st = lds + EPI_OFF + (wr * 4 + wc) * EPI_WBYTES; (void)lr; (void)lc

struct EpiIn {
    static constexpr bool PERM = true;
    const float* bias; bf16_t *U, *V, *QKV, *GA, *GB; f32x2* PS;
    __device__ __forceinline__ void binit(const Unit& u, int wc, int fq, f32x4 (&bv)[2][2]) const {
#pragma unroll
        for (int bj = 0; bj < 2; ++bj)
#pragma unroll
            for (int n = 0; n < 2; ++n) bv[bj][n] = *(const f32x4*)(bias + u.pn * BM + wc * 64 + bj * 32 + 8 * fq + 4 * n);
    }
    __device__ __forceinline__ void operator()(LAS unsigned char* lds, AccRef acc, const Unit& u, int wr, int wc, int fr, int fq) const {
        EPI_LOCALS();
        const int pn = u.pn; bf16_t* base; int ldc = D, colt, act;
        if (pn < 4) { base = U; colt = pn * 256; act = 1; }
        else if (pn < 8) { base = V; colt = (pn - 4) * 256; act = 1; }
        else if (pn < 26) { base = QKV; ldc = QKVW; colt = (pn - 8) * 256; act = 0; }
        else if (pn < 30) { base = GA; colt = (pn - 26) * 256; act = 2; }
        else { base = GB; colt = (pn - 30) * 256; act = 2; }
        bf16_t* p0 = base + (size_t)(u.pm * BM + wr * 64 + lr) * ldc + colt + wc * 64 + lc * 8;
        const bool vstats = (pn >= 4 && pn < 8);
        f32x2* ps0 = PS + (size_t)(u.pm * BM + wr * 64 + lr) * 16 + (pn - 4) * 4 + wc;
#pragma unroll
        for (int ai = 0; ai < 2; ++ai)
#pragma unroll
            for (int m = 0; m < 4; ++m) { u32x4 w[2];
#pragma unroll
                for (int bj = 0; bj < 2; ++bj) { f32x4 v0 = acc[ai][bj][m][0], v1 = acc[ai][bj][m][1];
                    if (act == 1) { f32x2 a = gelu_pk((f32x2){v0[0], v0[1]}), b = gelu_pk((f32x2){v0[2], v0[3]}), c = gelu_pk((f32x2){v1[0], v1[1]}), d = gelu_pk((f32x2){v1[2], v1[3]});
                        v0 = (f32x4){a.x, a.y, b.x, b.y}; v1 = (f32x4){c.x, c.y, d.x, d.y}; }
                    if (act == 2) {
#pragma unroll
                        for (int j = 0; j < 4; ++j) { v0[j] = sigmoidf_(v0[j]); v1[j] = sigmoidf_(v1[j]); } }
                    w[bj].x = cvt_pk_bf16(v0[0], v0[1]); w[bj].y = cvt_pk_bf16(v0[2], v0[3]); w[bj].z = cvt_pk_bf16(v1[0], v1[1]); w[bj].w = cvt_pk_bf16(v1[2], v1[3]); }
                u32x4 o0, o1; epi_xpose(st, fr, fq, lane, w[0], w[1], o0, o1);
                if (ai == 0 && m == 0) EPI_DRAIN();
                bf16_t* rp = p0 + (size_t)(ai * HALF + m * 16) * ldc;
                EPI_ST(u32x4, rp, o0); EPI_ST(u32x4, rp + (size_t)8 * ldc, o1);
                if (vstats) {
                    float s0 = 0.f, q0 = 0.f, s1 = 0.f, q1 = 0.f;
#pragma unroll
                    for (int c = 0; c < 4; ++c) { const float a = bflo(o0[c]), b = bfhi(o0[c]), d = bflo(o1[c]), e = bfhi(o1[c]); s0 += a + b; q0 += a * a + b * b; s1 += d + e; q1 += d * d + e * e; }
#pragma unroll
                    for (int o = 1; o < 8; o <<= 1) { s0 += __shfl_xor(s0, o); q0 += __shfl_xor(q0, o); s1 += __shfl_xor(s1, o); q1 += __shfl_xor(q1, o); }
                    if (lc == 0) { ps0[(size_t)(ai * HALF + m * 16) * 16] = (f32x2){s0, q0}; ps0[(size_t)(ai * HALF + m * 16 + 8) * 16] = (f32x2){s1, q1}; } }
                asm volatile("" ::: "memory"); }
    }
};
struct EpiT1 {
    static constexpr bool PERM = false;
    const bf16_t* GA; bf16_t* T1;
    __device__ __forceinline__ void binit(const Unit&, int, int, f32x4 (&bv)[2][2]) const { bv[0][0] = bv[0][1] = bv[1][0] = bv[1][1] = (f32x4){0.f, 0.f, 0.f, 0.f}; }
    __device__ __forceinline__ void operator()(LAS unsigned char* lds, AccRef acc, const Unit& u, int wr, int wc, int fr, int fq) const {
        EPI_LOCALS();
        const size_t o00 = (size_t)(u.pm * BM + wr * 64 + lr) * D + u.pn * BM + wc * 64 + lc * 4;
#pragma unroll
        for (int ai = 0; ai < 2; ++ai) {
            u32x2 g[4][2][2];
#pragma unroll
            for (int m = 0; m < 4; ++m)
#pragma unroll
                for (int bj = 0; bj < 2; ++bj)
#pragma unroll
                    for (int s = 0; s < 2; ++s) g[m][bj][s] = *(const u32x2*)(GA + o00 + (size_t)(ai * HALF + m * 16 + 8 * s) * D + bj * 32);
            asm volatile("" ::: "memory");
#pragma unroll
            for (int m = 0; m < 4; ++m)
#pragma unroll
                for (int bj = 0; bj < 2; ++bj) { u32x4 o[2]; epi_xpose(st, fr, fq, lane, __builtin_bit_cast(u32x4, acc[ai][bj][m][0]), __builtin_bit_cast(u32x4, acc[ai][bj][m][1]), o[0], o[1]);
#pragma unroll
                    for (int s = 0; s < 2; ++s) { const size_t off = o00 + (size_t)(ai * HALF + m * 16 + 8 * s) * D + bj * 32; const u32x2 gq = g[m][bj][s];
                        const f32x4 gv = (f32x4){bflo(gq.x), bfhi(gq.x), bflo(gq.y), bfhi(gq.y)}; const f32x4 tv = __builtin_bit_cast(f32x4, o[s]) * gv;
                        u32x2 tw; tw.x = cvt_pk_bf16(tv[0], tv[1]); tw.y = cvt_pk_bf16(tv[2], tv[3]); EPI_ST(u32x2, T1 + off, tw); } }
        }
    }
};
struct EpiMg {
    static constexpr bool PERM = false;
    const bf16_t* GB; const bf16_t* T1; bf16_t* MG;
    __device__ __forceinline__ void binit(const Unit&, int, int, f32x4 (&bv)[2][2]) const { bv[0][0] = bv[0][1] = bv[1][0] = bv[1][1] = (f32x4){0.f, 0.f, 0.f, 0.f}; }
    __device__ __forceinline__ void operator()(LAS unsigned char* lds, AccRef acc, const Unit& u, int wr, int wc, int fr, int fq) const {
        EPI_LOCALS();
        const size_t o00 = (size_t)(u.pm * BM + wr * 64 + lr) * D + u.pn * BM + wc * 64 + lc * 4;
#pragma unroll
        for (int ai = 0; ai < 2; ++ai) {
            u32x2 g[4][2][2], tq[4][2][2];
#pragma unroll
            for (int m = 0; m < 4; ++m)
#pragma unroll
                for (int bj = 0; bj < 2; ++bj)
#pragma unroll
                    for (int s = 0; s < 2; ++s) { const size_t off = o00 + (size_t)(ai * HALF + m * 16 + 8 * s) * D + bj * 32; g[m][bj][s] = *(const u32x2*)(GB + off); tq[m][bj][s] = *(const u32x2*)(T1 + off); }
            asm volatile("" ::: "memory");
#pragma unroll
            for (int m = 0; m < 4; ++m)
#pragma unroll
                for (int bj = 0; bj < 2; ++bj) { u32x4 o[2]; epi_xpose(st, fr, fq, lane, __builtin_bit_cast(u32x4, acc[ai][bj][m][0]), __builtin_bit_cast(u32x4, acc[ai][bj][m][1]), o[0], o[1]);
#pragma unroll
                    for (int s = 0; s < 2; ++s) { const size_t off = o00 + (size_t)(ai * HALF + m * 16 + 8 * s) * D + bj * 32; const u32x2 gq = g[m][bj][s], t2 = tq[m][bj][s];
                        const f32x4 t = (f32x4){bflo(t2.x), bfhi(t2.x), bflo(t2.y), bfhi(t2.y)};
                        const f32x4 v = t + __builtin_bit_cast(f32x4, o[s]) * (f32x4){bflo(gq.x), bfhi(gq.x), bflo(gq.y), bfhi(gq.y)};
                        u32x2 w; w.x = cvt_pk_bf16(v[0], v[1]); w.y = cvt_pk_bf16(v[2], v[3]); EPI_ST(u32x2, MG + off, w); } }
        }
    }
};
struct EpiMg2 {
    static constexpr bool PERM = false;
    const bf16_t* GA; const bf16_t* GB; bf16_t* MG;
    __device__ __forceinline__ void mid(LAS unsigned char* lds, f32x4 (&acc)[2][2][4][2], const Unit& u, int wr, int wc, int fr, int fq) const {
        EPI_LOCALS();
        const size_t o00 = (size_t)(u.pm * BM + wr * 64 + lr) * D + u.pn * BM + wc * 64 + lc * 4;
#pragma unroll
        for (int q = 0; q < 4; ++q) { const int ai = q >> 1, m0 = 2 * (q & 1);
            u32x2 ga[2][2][2], gb[2][2][2];
#pragma unroll
            for (int mm = 0; mm < 2; ++mm)
#pragma unroll
                for (int bj = 0; bj < 2; ++bj)
#pragma unroll
                    for (int s = 0; s < 2; ++s) { const size_t off = o00 + (size_t)(ai * HALF + (m0 + mm) * 16 + 8 * s) * D + bj * 32; ga[mm][bj][s] = *(const u32x2*)(GA + off); gb[mm][bj][s] = *(const u32x2*)(GB + off); }
            asm volatile("" ::: "memory");
#pragma unroll
            for (int mm = 0; mm < 2; ++mm)
#pragma unroll
                for (int bj = 0; bj < 2; ++bj) { const int m = m0 + mm;
#pragma unroll
                    for (int s = 0; s < 2; ++s) { const u32x2 a2 = ga[mm][bj][s], b2 = gb[mm][bj][s]; f32x4 r;
                        r[0] = bflo(a2.x) * __builtin_amdgcn_rcpf(fmaxf(bflo(b2.x), 1e-30f)); r[1] = bfhi(a2.x) * __builtin_amdgcn_rcpf(fmaxf(bfhi(b2.x), 1e-30f));
                        r[2] = bflo(a2.y) * __builtin_amdgcn_rcpf(fmaxf(bflo(b2.y), 1e-30f)); r[3] = bfhi(a2.y) * __builtin_amdgcn_rcpf(fmaxf(bfhi(b2.y), 1e-30f));
                        *(LAS f32x4*)(st + (8 * s + lr) * EPI_WSTR + lc * 16) = r; }
                    const f32x4 r0 = *(const LAS f32x4*)(st + fr * EPI_WSTR + fq * 16), r1 = *(const LAS f32x4*)(st + fr * EPI_WSTR + 64 + fq * 16);
                    acc[ai][bj][m][0] *= r0; acc[ai][bj][m][1] *= r1; }
        }
    }
    __device__ __forceinline__ void operator()(LAS unsigned char* lds, AccRef acc, const Unit& u, int wr, int wc, int fr, int fq) const {
        EPI_LOCALS();
        const size_t o00 = (size_t)(u.pm * BM + wr * 64 + lr) * D + u.pn * BM + wc * 64 + lc * 4;
#pragma unroll
        for (int ai = 0; ai < 2; ++ai) {
            u32x2 g[4][2][2];
#pragma unroll
            for (int m = 0; m < 4; ++m)
#pragma unroll
                for (int bj = 0; bj < 2; ++bj)
#pragma unroll
                    for (int s = 0; s < 2; ++s) g[m][bj][s] = *(const u32x2*)(GB + o00 + (size_t)(ai * HALF + m * 16 + 8 * s) * D + bj * 32);
            asm volatile("" ::: "memory");
#pragma unroll
            for (int m = 0; m < 4; ++m)
#pragma unroll
                for (int bj = 0; bj < 2; ++bj) { u32x4 o[2]; epi_xpose(st, fr, fq, lane, __builtin_bit_cast(u32x4, acc[ai][bj][m][0]), __builtin_bit_cast(u32x4, acc[ai][bj][m][1]), o[0], o[1]);
#pragma unroll
                    for (int s = 0; s < 2; ++s) { const size_t off = o00 + (size_t)(ai * HALF + m * 16 + 8 * s) * D + bj * 32; const u32x2 gq = g[m][bj][s];
                        const f32x4 v = __builtin_bit_cast(f32x4, o[s]) * (f32x4){bflo(gq.x), bfhi(gq.x), bflo(gq.y), bfhi(gq.y)};
                        u32x2 w; w.x = cvt_pk_bf16(v[0], v[1]); w.y = cvt_pk_bf16(v[2], v[3]); EPI_ST(u32x2, MG + off, w); } }
        }
    }
};
struct EpiWo {
    static constexpr bool PERM = false;
    const float* xa; const float* xb; const bf16_t* XBres; y1_t* XF;
    __device__ __forceinline__ void binit(const Unit&, int, int, f32x4 (&bv)[2][2]) const { bv[0][0] = bv[0][1] = bv[1][0] = bv[1][1] = (f32x4){0.f, 0.f, 0.f, 0.f}; }
    __device__ __forceinline__ void operator()(LAS unsigned char* lds, AccRef acc, const Unit& u, int wr, int wc, int fr, int fq) const {
        EPI_LOCALS();
        const size_t o00 = (size_t)(u.pm * BM + wr * 64 + lr) * D + u.pn * BM + wc * 64 + lc * 4;
        const float* xr = (u.pm * BM < TP) ? xa : xb;
#pragma unroll
        for (int ai = 0; ai < 2; ++ai) {
            f32x4 xv[4][2][2];
            if (XBres) {
                u32x2 xq[4][2][2];
#pragma unroll
                for (int m = 0; m < 4; ++m)
#pragma unroll
                    for (int bj = 0; bj < 2; ++bj)
#pragma unroll
                        for (int s = 0; s < 2; ++s) xq[m][bj][s] = *(const u32x2*)(XBres + o00 + (size_t)(ai * HALF + m * 16 + 8 * s) * D + bj * 32);
#pragma unroll
                for (int m = 0; m < 4; ++m)
#pragma unroll
                    for (int bj = 0; bj < 2; ++bj)
#pragma unroll
                        for (int s = 0; s < 2; ++s) xv[m][bj][s] = (f32x4){bflo(xq[m][bj][s].x), bfhi(xq[m][bj][s].x), bflo(xq[m][bj][s].y), bfhi(xq[m][bj][s].y)};
            } else {
#pragma unroll
                for (int m = 0; m < 4; ++m)
#pragma unroll
                    for (int bj = 0; bj < 2; ++bj)
#pragma unroll
                        for (int s = 0; s < 2; ++s) xv[m][bj][s] = *(const f32x4*)(xr + o00 + (size_t)(ai * HALF + m * 16 + 8 * s) * D + bj * 32);
            }
            asm volatile("" ::: "memory");
#pragma unroll
            for (int m = 0; m < 4; ++m)
#pragma unroll
                for (int bj = 0; bj < 2; ++bj) { u32x4 o[2]; epi_xpose(st, fr, fq, lane, __builtin_bit_cast(u32x4, acc[ai][bj][m][0]), __builtin_bit_cast(u32x4, acc[ai][bj][m][1]), o[0], o[1]);
#pragma unroll
                    for (int s = 0; s < 2; ++s) { const size_t off = o00 + (size_t)(ai * HALF + m * 16 + 8 * s) * D + bj * 32;
                        const f32x4 yv = xv[m][bj][s] * DN_ALPHA + __builtin_bit_cast(f32x4, o[s]);
#if Y1_BF16
                        { u32x2 yw; yw.x = cvt_pk_bf16(yv[0], yv[1]); yw.y = cvt_pk_bf16(yv[2], yv[3]); EPI_ST(u32x2, XF + off, yw); }
#else
                        EPI_ST(f32x4, XF + off, yv);
#endif
                    } }
        }
    }
};
struct EpiGU {
    static constexpr bool PERM = true;
    const float* bgu; bf16_t* H;
    __device__ __forceinline__ void binit(const Unit& u, int wc, int fq, f32x4 (&bv)[2][2]) const {
        const float* bg = bgu + (size_t)u.e * 2048 + u.pn * HALF + wc * 32 + 8 * fq;
        bv[0][0] = *(const f32x4*)(bg); bv[0][1] = *(const f32x4*)(bg + 4); bv[1][0] = *(const f32x4*)(bg + 1024); bv[1][1] = *(const f32x4*)(bg + 1028);
    }
    __device__ __forceinline__ void operator()(LAS unsigned char* lds, AccRef acc, const Unit& u, int wr, int wc, int fr, int fq) const {
        EPI_LOCALS();
        bf16_t* p0 = H + (size_t)(u.pm * BM + wr * 64 + (lane >> 2)) * D + u.pn * HALF + wc * 32 + (lane & 3) * 8;
#pragma unroll
        for (int ai = 0; ai < 2; ++ai)
#pragma unroll
            for (int m = 0; m < 4; ++m) {
                f32x4 g0 = acc[ai][0][m][0], g1 = acc[ai][0][m][1], u0 = acc[ai][1][m][0], u1 = acc[ai][1][m][1], h0, h1;
#pragma unroll
                for (int j = 0; j < 4; ++j) {
                    const float ga = fminf(g0[j], 7.0f), gb = fminf(g1[j], 7.0f);
                    const float ua = fminf(fmaxf(u0[j], -7.0f), 7.0f), ub = fminf(fmaxf(u1[j], -7.0f), 7.0f);
                    h0[j] = (ua + 1.0f) * ga * sigmoidf_(1.702f * ga); h1[j] = (ub + 1.0f) * gb * sigmoidf_(1.702f * gb); }
                u32x4 w; w.x = cvt_pk_bf16(h0[0], h0[1]); w.y = cvt_pk_bf16(h0[2], h0[3]); w.z = cvt_pk_bf16(h1[0], h1[1]); w.w = cvt_pk_bf16(h1[2], h1[3]);
                u32x4 o; epi_xpose1(st, fr, fq, lane, w, o);
                if (ai == 0 && m == 0) EPI_DRAIN();
                EPI_ST(u32x4, p0 + (size_t)(ai * HALF + m * 16) * D, o); asm volatile("" ::: "memory"); }
    }
};
struct EpiDown {
    static constexpr bool PERM = true;
    const float* bd; bf16_t* YK;
    __device__ __forceinline__ void binit(const Unit& u, int wc, int fq, f32x4 (&bv)[2][2]) const {
#pragma unroll
        for (int bj = 0; bj < 2; ++bj)
#pragma unroll
            for (int n = 0; n < 2; ++n) bv[bj][n] = *(const f32x4*)(bd + (size_t)u.e * D + u.pn * BM + wc * 64 + bj * 32 + 8 * fq + 4 * n);
    }
    __device__ __forceinline__ void operator()(LAS unsigned char* lds, AccRef acc, const Unit& u, int wr, int wc, int fr, int fq) const {
        EPI_LOCALS();
        bf16_t* p0 = YK + (size_t)(u.pm * BM + wr * 64 + lr) * D + u.pn * BM + wc * 64 + lc * 8;
#pragma unroll
        for (int ai = 0; ai < 2; ++ai)
#pragma unroll
            for (int m = 0; m < 4; ++m) { u32x4 w[2];
#pragma unroll
                for (int bj = 0; bj < 2; ++bj) { const f32x4 v0 = acc[ai][bj][m][0], v1 = acc[ai][bj][m][1];
                    w[bj].x = cvt_pk_bf16(v0[0], v0[1]); w[bj].y = cvt_pk_bf16(v0[2], v0[3]); w[bj].z = cvt_pk_bf16(v1[0], v1[1]); w[bj].w = cvt_pk_bf16(v1[2], v1[3]); }
                u32x4 o0, o1; epi_xpose(st, fr, fq, lane, w[0], w[1], o0, o1);
                if (ai == 0 && m == 0) EPI_DRAIN();
                bf16_t* rp = p0 + (size_t)(ai * HALF + m * 16) * D;
                EPI_ST(u32x4, rp, o0); EPI_ST(u32x4, rp + (size_t)8 * D, o1); asm volatile("" ::: "memory"); }
    }
};
}

struct Args { const float* in[21]; float* out; unsigned char* ws; int ph_lo, ph_hi, sub, pad; };
enum { I_XP = 0, I_XS, I_WIN, I_BIN, I_LNVG, I_LNVB, I_WS, I_BS, I_WPA, I_WPB, I_WO, I_LN1G, I_LN1B, I_WR, I_BR, I_WGU, I_BGU, I_WD, I_BD, I_LN2G, I_LN2B };

__device__ __forceinline__ void tr_item(const float* W, int K, int N, bf16_t* WT, int k0, int n0, int nd0, LAS unsigned* scr, int lane, int ndhi = 32) {
    const int i = lane & 15, kp = lane >> 4;
    f32x4 a[8], b[8];
#pragma unroll
    for (int it = 0; it < 8; ++it) { const int k = it * 8 + kp * 2; a[it] = *(const f32x4*)(W + (size_t)(k0 + k) * N + n0 + 4 * i); b[it] = *(const f32x4*)(W + (size_t)(k0 + k + 1) * N + n0 + 4 * i); }
#pragma unroll
    for (int it = 0; it < 8; ++it) {
#pragma unroll
        for (int j = 0; j < 4; ++j) scr[(4 * i + j) * 33 + it * 4 + kp] = pk2(a[it][j], b[it][j]); }
    asm volatile("s_waitcnt lgkmcnt(0)" ::: "memory");
    const int nn = lane >> 3, c = lane & 7;
#pragma unroll
    for (int j = 0; j < 8; ++j) { const int n = nn + 8 * j; u32x4 o; o.x = scr[n * 33 + 4 * c]; o.y = scr[n * 33 + 4 * c + 1]; o.z = scr[n * 33 + 4 * c + 2]; o.w = scr[n * 33 + 4 * c + 3];
        *(u32x4*)(WT + (size_t)(nd0 + (n & 31) + (n >> 5) * ndhi) * K + k0 + 8 * c) = o; }
    asm volatile("s_waitcnt lgkmcnt(0)" ::: "memory");
}
__device__ __forceinline__ void p0_prologue(const Args& a, LAS unsigned char* lds, int G) {
    const int tid = opaque_v(threadIdx.x), lane = tid & 63, wave = tid >> 6;
    LAS unsigned* scr = (LAS unsigned*)(lds + wave * 8704);
    const int gw = blockIdx.x * 8 + wave, NGW = G * 8;
    unsigned char* ws = a.ws;
    constexpr int I_GU = DEPTH * NE * 16 * 32, I_D = DEPTH * NE * 16 * 16, I_IN = DEPTH * 16 * 136, I_PA = DEPTH * 256, I_PB = DEPTH * 8 * 16, I_O = DEPTH * 256;
    constexpr int NITEMS = I_GU + I_D + I_IN + I_PA + I_PB + I_O;
    for (int it = gw; it < NITEMS; it += NGW) {
        int r = it;
        if (r < I_GU) { const int mat = r / 512, q = r % 512, kb = q / 32, nb = q % 32, n0 = nb * 64, c = n0 & 1023, nd0 = (c >> 7) * 256 + ((c & 127) >> 5) * 64 + ((n0 >= 1024) ? 32 : 0);
            tr_item(a.in[I_WGU] + (size_t)mat * 1024 * 2048, 1024, 2048, (bf16_t*)(ws + WS_WGU) + (size_t)mat * 2048 * 1024, kb * 64, n0, nd0, scr, lane, 64); continue; }
        r -= I_GU;
        if (r < I_D) { const int mat = r / 256, q = r % 256, kb = q / 16, nb = q % 16;
            tr_item(a.in[I_WD] + (size_t)mat * 1024 * 1024, 1024, 1024, (bf16_t*)(ws + WS_WD) + (size_t)mat * 1024 * 1024, kb * 64, nb * 64, nb * 64, scr, lane); continue; }
        r -= I_D;
        if (r < I_IN) { const int mat = r / (16 * 136), q = r % (16 * 136), kb = q / 136, nb = q % 136;
            tr_item(a.in[I_WIN] + (size_t)mat * 1024 * DIN, 1024, DIN, (bf16_t*)(ws + WS_WIN) + (size_t)mat * DIN * 1024, kb * 64, nb * 64, nb * 64, scr, lane); continue; }
        r -= I_IN;
        if (r < I_PA) { const int mat = r / 256, q = r % 256, kb = q / 16, nb = q % 16;
            tr_item(a.in[I_WPA] + (size_t)mat * 1024 * 1024, 1024, 1024, (bf16_t*)(ws + WS_WPA) + (size_t)mat * 1024 * 1024, kb * 64, nb * 64, nb * 64, scr, lane); continue; }
        r -= I_PA;
        if (r < I_PB) { const int mat = r / 128, q = r % 128, kb = q / 16, nb = q % 16;
            tr_item(a.in[I_WPB] + (size_t)mat * 512 * 1024, 512, 1024, (bf16_t*)(ws + WS_WPB) + (size_t)mat * 1024 * 512, kb * 64, nb * 64, nb * 64, scr, lane); continue; }
        r -= I_PB;
        { const int mat = r / 256, q = r % 256, kb = q / 16, nb = q % 16;
            tr_item(a.in[I_WO] + (size_t)mat * 1024 * 1024, 1024, 1024, (bf16_t*)(ws + WS_WO) + (size_t)mat * 1024 * 1024, kb * 64, nb * 64, nb * 64, scr, lane); }
    }
    const size_t gt = (size_t)blockIdx.x * 512 + tid, NGT = (size_t)G * 512;
    { float* prm = (float*)(ws + WS_PRM);
#define CPY(idx, off, n) for (size_t i = gt; i < (size_t)(n) / 4; i += NGT) *(f32x4*)(prm + (off) + i * 4) = *(const f32x4*)(a.in[idx] + i * 4)
      CPY(I_BIN, PR_BIN, DEPTH * DIN); CPY(I_LNVG, PR_LNVG, DEPTH * D); CPY(I_LNVB, PR_LNVB, DEPTH * D); CPY(I_BS, PR_BS, DEPTH * D); CPY(I_LN1G, PR_LN1G, DEPTH * D); CPY(I_LN1B, PR_LN1B, DEPTH * D);
      CPY(I_WR, PR_WR, DEPTH * D * NE); CPY(I_BR, PR_BR, DEPTH * NE); CPY(I_BGU, PR_BGU, DEPTH * NE * 2048); CPY(I_BD, PR_BD, DEPTH * NE * D); CPY(I_LN2G, PR_LN2G, DEPTH * D); CPY(I_LN2B, PR_LN2B, DEPTH * D);
#undef CPY
    }
    { const float* src = a.in[I_WR]; bf16_t* img = (bf16_t*)(ws + WS_WRI);
      for (size_t i = gt; i < (size_t)DEPTH * D * NE; i += NGT) { const int l = (int)(i >> 15), k = (int)(i >> 5) & 1023, e = (int)i & 31; const float v = src[i]; const unsigned h = f2bf(v), lo = f2bf(v - __builtin_bit_cast(float, h << 16));
          img[(size_t)l * 65536 + e * 1024 + k] = (bf16_t)h; img[(size_t)l * 65536 + 32768 + e * 1024 + k] = (bf16_t)lo; } }
    { const float* src = a.in[I_WS]; bf16_t* dst = (bf16_t*)(ws + WS_WS);
      for (size_t i = gt; i < (size_t)DEPTH * 8 * 128 * 128 / 8; i += NGT) { const f32x4 x = *(const f32x4*)(src + i * 8), y = *(const f32x4*)(src + i * 8 + 4);
          u32x4 o; o.x = pk2(x[0], x[1]); o.y = pk2(x[2], x[3]); o.z = pk2(y[0], y[1]); o.w = pk2(y[2], y[3]); *(u32x4*)(dst + i * 8) = o; } }
    { bf16_t* dst = (bf16_t*)(ws + WS_XB);
      for (size_t i = gt; i < (size_t)T * D / 8; i += NGT) { const size_t e = i * 8; const float* src = (e < (size_t)TP * D) ? a.in[I_XP] + e : a.in[I_XS] + (e - (size_t)TP * D);
          const f32x4 x = *(const f32x4*)(src), y = *(const f32x4*)(src + 4);
          u32x4 o; o.x = pk2(x[0], x[1]); o.y = pk2(x[2], x[3]); o.z = pk2(y[0], y[1]); o.w = pk2(y[2], y[3]); *(u32x4*)(dst + e) = o; } }
}

template <int BASE> __device__ __forceinline__ void tr8(unsigned addr, s16x4 (&r)[8]) {
    asm volatile("ds_read_b64_tr_b16 %0, %8 offset:%9\n\tds_read_b64_tr_b16 %1, %8 offset:%10\n\tds_read_b64_tr_b16 %2, %8 offset:%11\n\tds_read_b64_tr_b16 %3, %8 offset:%12\n\t"
                 "ds_read_b64_tr_b16 %4, %8 offset:%13\n\tds_read_b64_tr_b16 %5, %8 offset:%14\n\tds_read_b64_tr_b16 %6, %8 offset:%15\n\tds_read_b64_tr_b16 %7, %8 offset:%16\n\t"
                 : "=&v"(r[0]), "=&v"(r[1]), "=&v"(r[2]), "=&v"(r[3]), "=&v"(r[4]), "=&v"(r[5]), "=&v"(r[6]), "=&v"(r[7])
                 : "v"(addr), "n"(BASE), "n"(BASE + 32), "n"(BASE + 64), "n"(BASE + 96), "n"(BASE + 128), "n"(BASE + 160), "n"(BASE + 192), "n"(BASE + 224) : "memory");
}
__device__ __forceinline__ bf16x8 cat4(s16x4 a, s16x4 b) { return (bf16x8){a[0], a[1], a[2], a[3], b[0], b[1], b[2], b[3]}; }

constexpr int AT_KSTR = 272, AT_VSTR = 288, AT_KBYTES = 256 * AT_KSTR, AT_VOFF = AT_KBYTES, AT_VBYTES = 256 * AT_VSTR;
constexpr int AT_EPI_OFF = AT_VOFF + AT_VBYTES;
static_assert(AT_EPI_OFF + 8 * 2304 <= SCR_BYTES, "attention LDS");

template <int ST> __device__ __forceinline__ void attn_pv_step(unsigned vaddr, const f32x4 (&s)[9], f32x4 (&o)[8]) {
    s16x4 r0[8], r1[8];
    tr8<ST * 32 * AT_VSTR>(vaddr, r0);
    tr8<ST * 32 * AT_VSTR + (ST < 4 ? 16 * AT_VSTR : 0)>(vaddr, r1);
    asm volatile("s_waitcnt lgkmcnt(0)" ::: "memory");
    __builtin_amdgcn_sched_barrier(0);
    u32x4 pw; pw.x = cvt_pk_bf16(s[2 * ST][0], s[2 * ST][1]); pw.y = cvt_pk_bf16(s[2 * ST][2], s[2 * ST][3]);
    if (ST < 4) { pw.z = cvt_pk_bf16(s[2 * ST + (ST < 4 ? 1 : 0)][0], s[2 * ST + (ST < 4 ? 1 : 0)][1]); pw.w = cvt_pk_bf16(s[2 * ST + (ST < 4 ? 1 : 0)][2], s[2 * ST + (ST < 4 ? 1 : 0)][3]); }
    else { pw.z = 0u; pw.w = 0u; }
    const bf16x8 pf = __builtin_bit_cast(bf16x8, pw);
#pragma unroll
    for (int db = 0; db < 8; ++db) o[db] = __builtin_amdgcn_mfma_f32_16x16x32_bf16(cat4(r0[db], r1[db]), pf, o[db], 0, 0, 0);
}

__device__ __forceinline__ void attn_load(const bf16_t* QKV, int unit, int tid, u32x4 (&kr)[8], u32x4 (&vr)[8]) {
    const int wsub = unit & 31, h = (unit >> 5) & 3, bg = unit >> 7, g = bg % 3, b = bg / 3;
    const int dsh = 2 * g, dil = 1 << dsh, L = SEQ >> dsh, nblk = L >> 7, r = wsub / nblk, blk = wsub % nblk, p0 = blk * 128;
    const int kc = g * 1536 + h * 128 + 512, vc = kc + 512;
#pragma unroll
    for (int j = 0; j < 8; ++j) { const int id = tid + 512 * j, kk = id >> 4, ch = id & 15, pk = p0 - 64 + kk; const bool ok = pk >= 0 && pk < L;
        const size_t ro = (size_t)(b * SEQ + (ok ? pk : 0) * dil + r) * QKVW; const u32x4 kx = *(const u32x4*)(QKV + ro + kc + ch * 8), vx = *(const u32x4*)(QKV + ro + vc + ch * 8);
        kr[j] = ok ? kx : (u32x4){0u, 0u, 0u, 0u}; vr[j] = ok ? vx : (u32x4){0u, 0u, 0u, 0u}; }
}
__device__ __forceinline__ void attn_unit(LAS unsigned char* lds, const bf16_t* QKV, bf16_t* OG, float* LSE, int unit, int unit_next, u32x4 (&kr)[8], u32x4 (&vr)[8]) {
    const int tid = opaque_v(threadIdx.x), lane = tid & 63, w = tid >> 6, ql = lane & 15, quad = lane >> 4;
    const int wsub = unit & 31, h = (unit >> 5) & 3, bg = unit >> 7, g = bg % 3, b = bg / 3;
    const int dsh = 2 * g, dil = 1 << dsh, L = SEQ >> dsh, nblk = L >> 7, r = wsub / nblk, blk = wsub % nblk, p0 = blk * 128;
    const int qc = g * 1536 + h * 128;
    const float slope = __builtin_amdgcn_exp2f(-(2.0f / 3.0f) * (float)(4 * g + h + 1));
    const float ca = slope * (float)dil * LOG2E, SC = 0.08838834764831845f * LOG2E;
#pragma unroll
    for (int j = 0; j < 8; ++j) { const int id = tid + 512 * j, kk = id >> 4, ch = id & 15;
        *(LAS u32x4*)(lds + kk * AT_KSTR + ch * 16) = kr[j]; *(LAS u32x4*)(lds + AT_VOFF + kk * AT_VSTR + ch * 16) = vr[j]; }
    const int qrow = b * SEQ + (p0 + 16 * w + ql) * dil + r;
    bf16x8 qf[4];
#pragma unroll
    for (int ks = 0; ks < 4; ++ks) qf[ks] = *(const bf16x8*)(QKV + (size_t)qrow * QKVW + qc + 32 * ks + 8 * quad);
    __syncthreads();
    asm volatile("" : "+v"(qf[0]), "+v"(qf[1]), "+v"(qf[2]), "+v"(qf[3]));
    attn_load(QKV, unit_next >= 0 ? unit_next : unit, tid, kr, vr);
    f32x4 s[9];
#pragma unroll
    for (int j = 0; j < 9; ++j) { s[j] = (f32x4){0.f, 0.f, 0.f, 0.f};
#pragma unroll
        for (int ks = 0; ks < 4; ++ks) { const bf16x8 kf = *(const LAS bf16x8*)(lds + (16 * w + 16 * j + ql) * AT_KSTR + (32 * ks + 8 * quad) * 2);
            s[j] = __builtin_amdgcn_mfma_f32_16x16x32_bf16(kf, qf[ks], s[j], 0, 0, 0); } }
    float mx = -1e30f;
#pragma unroll
    for (int j = 0; j < 9; ++j)
#pragma unroll
        for (int i = 0; i < 4; ++i) { const int rel = 16 * j + 4 * quad + i - 64 - ql, pk = p0 + 16 * w + ql + rel, ar = rel < 0 ? -rel : rel;
            const bool ok = (ar <= 64) && (pk >= 0) && (pk < L);
            const float v = ok ? (s[j][i] * SC - ca * (float)ar) : -1e30f; s[j][i] = v; mx = fmaxf(mx, v); }
    mx = fmaxf(mx, __shfl_xor(mx, 16)); mx = fmaxf(mx, __shfl_xor(mx, 32));
    float den = 0.f;
#pragma unroll
    for (int j = 0; j < 9; ++j)
#pragma unroll
        for (int i = 0; i < 4; ++i) { const float p = __builtin_amdgcn_exp2f(s[j][i] - mx); s[j][i] = p; den += p; }
    den += __shfl_xor(den, 16); den += __shfl_xor(den, 32);
    f32x4 o[8];
#pragma unroll
    for (int db = 0; db < 8; ++db) o[db] = (f32x4){0.f, 0.f, 0.f, 0.f};
    const unsigned vaddr = (unsigned)(uintptr_t)(lds + AT_VOFF) + (unsigned)((16 * w + 4 * quad + (ql >> 2)) * AT_VSTR + (ql & 3) * 8);
    attn_pv_step<0>(vaddr, s, o); attn_pv_step<1>(vaddr, s, o); attn_pv_step<2>(vaddr, s, o); attn_pv_step<3>(vaddr, s, o); attn_pv_step<4>(vaddr, s, o);
    const float inv = 1.0f / den;
    {
        LAS unsigned char* st = lds + AT_EPI_OFF + w * 2304;
        const int lr = lane >> 3, lc = lane & 7;
        bf16_t* od0 = OG + ((size_t)g * T + (size_t)(b * SEQ + (p0 + 16 * w + lr) * dil + r)) * 512 + h * 128 + lc * 8;
        bf16_t* od1 = OG + ((size_t)g * T + (size_t)(b * SEQ + (p0 + 16 * w + 8 + lr) * dil + r)) * 512 + h * 128 + lc * 8;
#pragma unroll
        for (int hh = 0; hh < 2; ++hh) {
#pragma unroll
            for (int d4 = 0; d4 < 4; ++d4) { const int db = 4 * hh + d4; u32x2 wv; wv.x = cvt_pk_bf16(o[db][0] * inv, o[db][1] * inv); wv.y = cvt_pk_bf16(o[db][2] * inv, o[db][3] * inv);
                *(LAS u32x2*)(st + ql * 144 + d4 * 32 + quad * 8) = wv; }
            const u32x4 r0 = *(const LAS u32x4*)(st + lr * 144 + lc * 16), r1 = *(const LAS u32x4*)(st + (8 + lr) * 144 + lc * 16);
            __builtin_nontemporal_store(r0, (u32x4*)(od0 + hh * 64)); __builtin_nontemporal_store(r1, (u32x4*)(od1 + hh * 64));
        }
    }
    if (quad == 0) LSE[((size_t)g * T + qrow) * 4 + h] = (mx + __builtin_amdgcn_logf(den)) * LN2;
    __syncthreads();
}

constexpr int SG_STR = 288, SG_TILE = 128 * SG_STR, SG_STATS = 2 * SG_TILE, SG_EPI_OFF = SG_STATS + 1024, SG_EPI_WBYTES = 16 * 528;
static_assert(SG_EPI_OFF + 8 * SG_EPI_WBYTES <= SCR_BYTES, "spatial gating LDS");
template <int KS> __device__ __forceinline__ void sg_step(unsigned vaddr, const bf16x8 wf, f32x4 (&acc)[8]) {
    s16x4 r0[8], r1[8];
    tr8<KS * 32 * SG_STR>(vaddr, r0);
    tr8<KS * 32 * SG_STR + 4 * SG_STR>(vaddr, r1);
    asm volatile("s_waitcnt lgkmcnt(0)" ::: "memory");
    __builtin_amdgcn_sched_barrier(0);
#pragma unroll
    for (int cb = 0; cb < 8; ++cb) acc[cb] = __builtin_amdgcn_mfma_f32_16x16x32_bf16(cat4(r0[cb], r1[cb]), wf, acc[cb], 0, 0, 0);
}
#define SG_LOADG_(ROW0, G_) do { const int g_ = (G_); \
        _Pragma("unroll") for (int j = 0; j < 4; ++j) vt[j] = *(const u32x4*)(V + (size_t)((ROW0) + (tid >> 4) + 32 * j) * D + g_ * 128 + ch * 8); \
        gab[0] = *(const f32x4*)(lng + g_ * 128 + ch * 8); gab[1] = *(const f32x4*)(lng + g_ * 128 + ch * 8 + 4); gab[2] = *(const f32x4*)(lnb + g_ * 128 + ch * 8); gab[3] = *(const f32x4*)(lnb + g_ * 128 + ch * 8 + 4); \
        const bf16_t* Wg_ = WsB + (size_t)g_ * 128 * 128 + (size_t)(16 * w + ql) * 128 + 8 * quad; \
        _Pragma("unroll") for (int ks = 0; ks < 4; ++ks) wf[ks] = *(const bf16x8*)(Wg_ + 32 * ks); } while (0)
__device__ __forceinline__ void sg_prefetch(const bf16_t* V, const bf16_t* WsB, const float* lng, const float* lnb, const f32x2* PS, int unit, u32x4 (&vt)[4], bf16x8 (&wf)[4], f32x4 (&gab)[4], f32x4 (&pp)[2]) {
    const int tid = opaque_v(threadIdx.x), lane = tid & 63, w = tid >> 6, ql = lane & 15, quad = lane >> 4, ch = tid & 15;
    const int row0 = (unit >> 1) * 128, hh = unit & 1;
    { const int row = tid >> 2, part = tid & 3; pp[0] = *(const f32x4*)(PS + (size_t)(row0 + row) * 16 + part * 4); pp[1] = *(const f32x4*)(PS + (size_t)(row0 + row) * 16 + part * 4 + 2); }
    SG_LOADG_(row0, 4 * hh);
}
__device__ __forceinline__ void sg_unit(LAS unsigned char* lds, const bf16_t* U, const bf16_t* V, bf16_t* AOUT, const bf16_t* WsB, const float* bs, const float* lng, const float* lnb, const f32x2* PS, int unit, int unit_next,
                                        u32x4 (&vt)[4], bf16x8 (&wf)[4], f32x4 (&gab)[4], f32x4 (&pp)[2]) {
    const int tid = opaque_v(threadIdx.x), lane = tid & 63, w = tid >> 6, ql = lane & 15, quad = lane >> 4;
    const int ci = unit >> 1, hh = unit & 1, row0 = ci * 128;
    LAS float* stats = (LAS float*)(lds + SG_STATS);
    { const int row = tid >> 2, part = tid & 3; const f32x4 pa = pp[0], pb = pp[1];
      float sm = (pa[0] + pa[2]) + (pb[0] + pb[2]), sq = (pa[1] + pa[3]) + (pb[1] + pb[3]);
      sm += __shfl_xor(sm, 1); sq += __shfl_xor(sq, 1); sm += __shfl_xor(sm, 2); sq += __shfl_xor(sq, 2);
      const float mean = sm * (1.0f / D), rstd = 1.0f / sqrtf(fmaxf(sq * (1.0f / D) - mean * mean, 0.f) + LN_EPS);
      if (part == 0) { stats[2 * row] = mean; stats[2 * row + 1] = rstd; } }
    __syncthreads();
    const int ch = tid & 15;
    const int row0n = (unit_next >> 1) * 128, hhn = unit_next & 1;
#pragma unroll 1
    for (int gi = 0; gi < 4; ++gi) {
        const int g = 4 * hh + gi; LAS unsigned char* tile = lds + (gi & 1) * SG_TILE;
#pragma unroll
        for (int j = 0; j < 4; ++j) { const int sr = (tid >> 4) + 32 * j; const u32x4 x = vt[j];
            const float mean = stats[2 * sr], rstd = stats[2 * sr + 1];
            const f32x4 a = ((f32x4){bflo(x.x), bfhi(x.x), bflo(x.y), bfhi(x.y)} - mean) * rstd * gab[0] + gab[2], bq = ((f32x4){bflo(x.z), bfhi(x.z), bflo(x.w), bfhi(x.w)} - mean) * rstd * gab[1] + gab[3];
            u32x4 o; o.x = cvt_pk_bf16(a[0], a[1]); o.y = cvt_pk_bf16(a[2], a[3]); o.z = cvt_pk_bf16(bq[0], bq[1]); o.w = cvt_pk_bf16(bq[2], bq[3]);
            *(LAS u32x4*)(tile + sr * SG_STR + ch * 16) = o; }
        bf16x8 wfc[4];
#pragma unroll
        for (int ks = 0; ks < 4; ++ks) { wfc[ks] = wf[ks]; asm volatile("" : "+v"(wfc[ks])); }
        __syncthreads();
        const size_t off = (size_t)(row0 + 16 * w + (lane >> 5)) * D + g * 128 + 4 * (lane & 31);
        u32x2 uu[8];
#pragma unroll
        for (int it = 0; it < 8; ++it) uu[it] = *(const u32x2*)(U + off + (size_t)(2 * it) * D);
        if (gi < 3) SG_LOADG_(row0, 4 * hh + gi + 1);
        else { SG_LOADG_(row0n, 4 * hhn); const int row = tid >> 2, part = tid & 3; pp[0] = *(const f32x4*)(PS + (size_t)(row0n + row) * 16 + part * 4); pp[1] = *(const f32x4*)(PS + (size_t)(row0n + row) * 16 + part * 4 + 2); }
        f32x4 acc[8];
#pragma unroll
        for (int cb = 0; cb < 8; ++cb) acc[cb] = (f32x4){0.f, 0.f, 0.f, 0.f};
        const unsigned vaddr = (unsigned)(uintptr_t)tile + (unsigned)((8 * quad + (ql >> 2)) * SG_STR + (ql & 3) * 8);
        sg_step<0>(vaddr, wfc[0], acc); sg_step<1>(vaddr, wfc[1], acc); sg_step<2>(vaddr, wfc[2], acc); sg_step<3>(vaddr, wfc[3], acc);
        const int t = 16 * w + ql; const float bst = bs[g * 128 + t];
        LAS unsigned char* st = lds + SG_EPI_OFF + w * SG_EPI_WBYTES;
#pragma unroll
        for (int cb = 0; cb < 8; ++cb) *(LAS f32x4*)(st + ql * 528 + 64 * cb + 16 * quad) = acc[cb] + bst;
#pragma unroll
        for (int it = 0; it < 8; ++it) { const f32x4 mv = *(const LAS f32x4*)(st + (2 * it + (lane >> 5)) * 528 + (lane & 31) * 16);
            u32x2 o; o.x = cvt_pk_bf16(bflo(uu[it].x) * mv[0], bfhi(uu[it].x) * mv[1]); o.y = cvt_pk_bf16(bflo(uu[it].y) * mv[2], bfhi(uu[it].y) * mv[3]);
            __builtin_nontemporal_store(o, (u32x2*)(AOUT + off + (size_t)(2 * it) * D)); }
    }
    __syncthreads();
}

__device__ __forceinline__ void merge_phase(const bf16_t* OG, const float* LSE, bf16_t* BOUT, int G) {
    const int tid = opaque_v(threadIdx.x), lane = tid & 63, gw = blockIdx.x * 8 + (tid >> 6), NGW = G * 8, hd = lane >> 4;
    for (int row = gw; row < T; row += NGW) {
        const float l0 = LSE[((size_t)0 * T + row) * 4 + hd], l1 = LSE[((size_t)1 * T + row) * 4 + hd], l2 = LSE[((size_t)2 * T + row) * 4 + hd];
        const float m = fmaxf(l0, fmaxf(l1, l2));
        float w0 = __builtin_amdgcn_exp2f((l0 - m) * LOG2E), w1 = __builtin_amdgcn_exp2f((l1 - m) * LOG2E), w2 = __builtin_amdgcn_exp2f((l2 - m) * LOG2E);
        const float inv = 1.0f / (w0 + w1 + w2); w0 *= inv; w1 *= inv; w2 *= inv;
        const u32x4 a = *(const u32x4*)(OG + ((size_t)0 * T + row) * 512 + lane * 8), b = *(const u32x4*)(OG + ((size_t)1 * T + row) * 512 + lane * 8), c = *(const u32x4*)(OG + ((size_t)2 * T + row) * 512 + lane * 8);
        u32x4 o;
        o.x = cvt_pk_bf16(w0 * bflo(a.x) + w1 * bflo(b.x) + w2 * bflo(c.x), w0 * bfhi(a.x) + w1 * bfhi(b.x) + w2 * bfhi(c.x));
        o.y = cvt_pk_bf16(w0 * bflo(a.y) + w1 * bflo(b.y) + w2 * bflo(c.y), w0 * bfhi(a.y) + w1 * bfhi(b.y) + w2 * bfhi(c.y));
        o.z = cvt_pk_bf16(w0 * bflo(a.z) + w1 * bflo(b.z) + w2 * bflo(c.z), w0 * bfhi(a.z) + w1 * bfhi(b.z) + w2 * bfhi(c.z));
        o.w = cvt_pk_bf16(w0 * bflo(a.w) + w1 * bflo(b.w) + w2 * bflo(c.w), w0 * bfhi(a.w) + w1 * bfhi(b.w) + w2 * bfhi(c.w));
        __builtin_nontemporal_store(o, (u32x4*)(BOUT + (size_t)row * 512 + lane * 8));
    }
}

constexpr int RT_WSTR = 2064, RT_WL = 32 * RT_WSTR, RT_GB = 2 * RT_WL, RT_ST = RT_GB + 8192, RT_STW = 2560;
static_assert(RT_ST + 8 * RT_STW <= SCR_BYTES, "router LDS");
#if !Y1_BF16
#error "P5 keeps a wave's rows in registers: it needs the bf16 y1"
#endif
#define P5_UNPK(q) ((f32x4){bflo((q).x), bfhi((q).x), bflo((q).y), bfhi((q).y)})
template <bool HASB> __device__ __forceinline__ void p5_tile(LAS unsigned char* lds, u32x2 (&ra)[32], u32x2 (&rb)[32], bool liveA, bool liveB, int rowA, int rowB, f32x2* RS, bf16_t* XB,
                                                             int lane_, int w, const float (&bre)[8], float (&lg)[8]) {
    const int lane = opaque_v(lane_), r = lane & 15, quad = lane >> 4, lr = lane >> 3, lc = lane & 7;
    float smA = 0.f, sqA = 0.f, smB = 0.f, sqB = 0.f;
#pragma unroll
    for (int s = 0; s < 32; ++s) { const f32x4 a = P5_UNPK(ra[s]);
        smA += (a[0] + a[1]) + (a[2] + a[3]); sqA += (a[0] * a[0] + a[1] * a[1]) + (a[2] * a[2] + a[3] * a[3]);
        if (HASB) { const f32x4 b = P5_UNPK(rb[s]); smB += (b[0] + b[1]) + (b[2] + b[3]); sqB += (b[0] * b[0] + b[1] * b[1]) + (b[2] * b[2] + b[3] * b[3]); } }
#pragma unroll
    for (int o = 1; o < 8; o <<= 1) { smA += __shfl_xor(smA, o); sqA += __shfl_xor(sqA, o); if (HASB) { smB += __shfl_xor(smB, o); sqB += __shfl_xor(sqB, o); } }
    const float meanA = smA * (1.0f / D), rstdA = 1.0f / sqrtf(fmaxf(sqA * (1.0f / D) - meanA * meanA, 0.f) + LN_EPS);
    const float meanB = smB * (1.0f / D), rstdB = 1.0f / sqrtf(fmaxf(sqB * (1.0f / D) - meanB * meanB, 0.f) + LN_EPS);
    if (lc == 0) { if (liveA) RS[rowA] = (f32x2){meanA, rstdA}; if (HASB && liveB) RS[rowB] = (f32x2){meanB, rstdB}; }
#pragma unroll
    for (int s = 0; s < 32; ++s) { asm volatile("" : "+v"(ra[s])); if (HASB) asm volatile("" : "+v"(rb[s])); }
    f32x4 acc[2] = {(f32x4){0.f, 0.f, 0.f, 0.f}, (f32x4){0.f, 0.f, 0.f, 0.f}};
    const LAS unsigned char* wp = lds + r * RT_WSTR + 16 * quad;
    LAS unsigned char* stw = lds + RT_ST + w * RT_STW;
    const LAS float* gl = (const LAS float*)(lds + RT_GB) + 4 * lc; const LAS float* bl = gl + 1024;
    bf16_t* xoA = XB + (size_t)rowA * D + 4 * lc; bf16_t* xoB = XB + (size_t)rowB * D + 4 * lc;
#pragma unroll
    for (int s = 0; s < 32; ++s) {
        const f32x4 a = P5_UNPK(ra[s]);
        const f32x4 gv = *(const LAS f32x4*)(gl + 32 * s), bv = *(const LAS f32x4*)(bl + 32 * s);
        const f32x4 xa = (a - meanA) * rstdA * gv + bv;
        u32x2 ha, la;
        ha.x = cvt_pk_bf16(xa[0], xa[1]); ha.y = cvt_pk_bf16(xa[2], xa[3]);
        la.x = cvt_pk_bf16(xa[0] - bflo(ha.x), xa[1] - bfhi(ha.x)); la.y = cvt_pk_bf16(xa[2] - bflo(ha.y), xa[3] - bfhi(ha.y));
        if (liveA) *(u32x2*)(xoA + 32 * s) = ha;
        *(LAS u32x2*)(stw + lr * 80 + lc * 8) = ha; *(LAS u32x2*)(stw + 1280 + lr * 80 + lc * 8) = la;
        if (HASB) { const f32x4 b = P5_UNPK(rb[s]); const f32x4 xb = (b - meanB) * rstdB * gv + bv; u32x2 hb, lb;
            hb.x = cvt_pk_bf16(xb[0], xb[1]); hb.y = cvt_pk_bf16(xb[2], xb[3]); lb.x = cvt_pk_bf16(xb[0] - bflo(hb.x), xb[1] - bfhi(hb.x)); lb.y = cvt_pk_bf16(xb[2] - bflo(hb.y), xb[3] - bfhi(hb.y));
            if (liveB) *(u32x2*)(xoB + 32 * s) = hb;
            *(LAS u32x2*)(stw + (8 + lr) * 80 + lc * 8) = hb; *(LAS u32x2*)(stw + 1280 + (8 + lr) * 80 + lc * 8) = lb; }
        const bf16x8 xh = *(const LAS bf16x8*)(stw + r * 80 + quad * 16), xl = *(const LAS bf16x8*)(stw + 1280 + r * 80 + quad * 16);
#pragma unroll
        for (int eb = 0; eb < 2; ++eb) { const bf16x8 wh = *(const LAS bf16x8*)(wp + eb * 16 * RT_WSTR + 64 * s), wl = *(const LAS bf16x8*)(wp + RT_WL + eb * 16 * RT_WSTR + 64 * s);
            acc[eb] = __builtin_amdgcn_mfma_f32_16x16x32_bf16(wh, xh, acc[eb], 0, 0, 0); acc[eb] = __builtin_amdgcn_mfma_f32_16x16x32_bf16(wh, xl, acc[eb], 0, 0, 0); acc[eb] = __builtin_amdgcn_mfma_f32_16x16x32_bf16(wl, xh, acc[eb], 0, 0, 0); }
    }
#pragma unroll
    for (int eb = 0; eb < 2; ++eb)
#pragma unroll
        for (int i = 0; i < 4; ++i) lg[eb * 4 + i] = acc[eb][i] + bre[eb * 4 + i];
}
__device__ __forceinline__ void p5_route(float (&lg)[8], bool live, int row, int lane_, int tid_, volatile LAS unsigned* lcnt, volatile LAS unsigned* gbase, unsigned* gcnt, int* tokList, int* tokE, int* tokPos, float* gate) {
    const int lane = opaque_v(lane_), tid = opaque_v(tid_), quad = lane >> 4;
    float tv[4]; int ti[4];
#pragma unroll
    for (int k = 0; k < 4; ++k) { float bvv = lg[0]; int bi = 4 * quad;
#pragma unroll
        for (int j = 1; j < 8; ++j) { const int ej = 16 * (j >> 2) + 4 * quad + (j & 3); if (lg[j] > bvv) { bvv = lg[j]; bi = ej; } }
#pragma unroll
        for (int o = 16; o < 64; o <<= 1) { const float ov = __shfl_xor(bvv, o); const int oi = __shfl_xor(bi, o); if (ov > bvv || (ov == bvv && oi < bi)) { bvv = ov; bi = oi; } }
        tv[k] = bvv; ti[k] = bi;
#pragma unroll
        for (int j = 0; j < 8; ++j) { const int ej = 16 * (j >> 2) + 4 * quad + (j & 3); if (ej == bi) lg[j] = -3.0e38f; } }
    const float e1 = __builtin_amdgcn_exp2f((tv[1] - tv[0]) * LOG2E), e2 = __builtin_amdgcn_exp2f((tv[2] - tv[0]) * LOG2E), e3 = __builtin_amdgcn_exp2f((tv[3] - tv[0]) * LOG2E);
    const float inv = 1.0f / (1.0f + e1 + e2 + e3);
    const int ek = quad == 0 ? ti[0] : quad == 1 ? ti[1] : quad == 2 ? ti[2] : ti[3]; const float gk = (quad == 0 ? 1.0f : quad == 1 ? e1 : quad == 2 ? e2 : e3) * inv;
    int lp = -1;
    if (live) { lp = (int)__hip_atomic_fetch_add((LAS unsigned*)&lcnt[ek], 1u, __ATOMIC_RELAXED, __HIP_MEMORY_SCOPE_WORKGROUP);
        gate[(size_t)row * 4 + quad] = gk; tokE[(size_t)row * 4 + quad] = ek; }
    __syncthreads();
    if (tid < 32) { const unsigned n = lcnt[tid]; gbase[tid] = n ? __hip_atomic_fetch_add(gcnt + tid, n, __ATOMIC_RELAXED, __HIP_MEMORY_SCOPE_AGENT) : 0u; }
    __syncthreads();
    if (lp >= 0) { const int pos = (int)gbase[ek] + lp; tokList[(size_t)ek * T + pos] = row; tokPos[(size_t)row * 4 + quad] = pos; }
    if (tid < 32) lcnt[tid] = 0u;
    __syncthreads();
}
__device__ __forceinline__ void ln1_router_phase(LAS unsigned char* lds, volatile LAS unsigned* MISC, f32x2* RS, const y1_t* XFin, y1_t* XF, bf16_t* XB, const float* g1, const float* b1, const bf16_t* wri, const float* br,
                                                 unsigned* gcnt, int* tokList, int* tokE, int* tokPos, float* gate, int G) {
    const int tid = opaque_v(threadIdx.x), lane = tid & 63, w = tid >> 6, r = lane & 15, quad = lane >> 4, lr = lane >> 3, lc = lane & 7;
    volatile LAS unsigned* lcnt = MISC + 128; volatile LAS unsigned* gbase = MISC + 160;
    float bre[8];
#pragma unroll
    for (int eb = 0; eb < 2; ++eb)
#pragma unroll
        for (int i = 0; i < 4; ++i) bre[eb * 4 + i] = br[16 * eb + 4 * quad + i];
    constexpr int NCHUNK = T / 24;
    const int iters = (NCHUNK + 8 * G - 1) / (8 * G);
    for (int it = 0; it < iters; ++it) {
        const int chunk = (it * G + blockIdx.x) * 8 + w;
        const bool live_chunk = chunk < NCHUNK;
        const int row0 = opaque_v(live_chunk ? chunk * 24 : 0);
        u32x2 ra[32], rb[32];
        { const y1_t* xa_ = XFin + (size_t)(row0 + lr) * D + 4 * lc;
#pragma unroll
          for (int s = 0; s < 32; ++s) { ra[s] = *(const u32x2*)(xa_ + 32 * s); rb[s] = *(const u32x2*)(xa_ + (size_t)8 * D + 32 * s); } }
        if (it == 0) {
_Pragma("unroll 4")
            for (int j = 0; j < 16; ++j) { const int u = tid + 512 * j; const u32x4 v = ((const u32x4*)wri)[u]; *(LAS u32x4*)(lds + (u >> 12) * RT_WL + ((u >> 7) & 31) * RT_WSTR + (u & 127) * 16) = v; }
            for (int i = tid; i < 1024; i += 512) { ((LAS float*)(lds + RT_GB))[i] = g1[i]; ((LAS float*)(lds + RT_GB))[1024 + i] = b1[i]; }
            if (tid < 32) lcnt[tid] = 0u;
            __syncthreads();
        }
        float lg[8];
        p5_tile<true>(lds, ra, rb, live_chunk, live_chunk, row0 + lr, row0 + 8 + lr, RS, XB, lane, w, bre, lg);
        asm volatile("" ::: "memory");
        u32x2 rc[32];
        { const y1_t* xc_ = XFin + (size_t)(row0 + 16 + lr) * D + 4 * lc;
#pragma unroll
          for (int s = 0; s < 32; ++s) rc[s] = *(const u32x2*)(xc_ + 32 * s); }
        p5_route(lg, live_chunk, row0 + r, lane, tid, lcnt, gbase, gcnt, tokList, tokE, tokPos, gate);
        p5_tile<false>(lds, rc, rc, live_chunk, false, row0 + 16 + lr, row0 + 16 + lr, RS, XB, lane, w, bre, lg);
        p5_route(lg, live_chunk && (r < 8), row0 + 16 + (r & 7), lane, tid, lcnt, gbase, gcnt, tokList, tokE, tokPos, gate);
    }
}

__device__ __forceinline__ void combine_ln2_phase(volatile LAS unsigned* MISC, const f32x2* RS, const float* g1, const float* b1, const y1_t* XF, const bf16_t* YK, const int* tokE, const int* tokPos, const float* gate, const float* g2, const float* b2,
                                                  float* outF, bf16_t* XB, int G) {
    const int tid = opaque_v(threadIdx.x), lane = tid & 63, gw = blockIdx.x * 8 + (tid >> 6), NGW = G * 8;
    const volatile LAS int* tb = (const volatile LAS int*)(MISC + 16);
    f32x4 gv[4], bv[4];
#pragma unroll
    for (int j = 0; j < 4; ++j) { gv[j] = *(const f32x4*)(g2 + 256 * j + 4 * lane); bv[j] = *(const f32x4*)(b2 + 256 * j + 4 * lane); }
    f32x4 gv1[4], bv1[4];
#pragma unroll
    for (int j = 0; j < 4; ++j) { gv1[j] = *(const f32x4*)(g1 + 256 * j + 4 * lane); bv1[j] = *(const f32x4*)(b1 + 256 * j + 4 * lane); }
    typedef int i32x4 __attribute__((ext_vector_type(4)));
    i32x4 ne = *(const i32x4*)(tokE + (size_t)(gw < T ? gw : 0) * 4), np = *(const i32x4*)(tokPos + (size_t)(gw < T ? gw : 0) * 4); f32x4 ng = *(const f32x4*)(gate + (size_t)(gw < T ? gw : 0) * 4);
    for (int row = gw; row < T; row += NGW) {
        const i32x4 ce = ne, cpz = np; const f32x4 cg = ng;
        f32x4 v[4]; u32x2 y[4][4];
#pragma unroll
        for (int j = 0; j < 4; ++j) v[j] = Y1_LD4(XF + (size_t)row * D + 256 * j + 4 * lane);
        const f32x2 rs = RS[row];
#pragma unroll
        for (int k = 0; k < 4; ++k) { const size_t slot = (size_t)tb[ce[k]] * 256 + cpz[k];
#pragma unroll
            for (int j = 0; j < 4; ++j) y[k][j] = __builtin_nontemporal_load((const u32x2*)(YK + slot * D + 256 * j + 4 * lane)); }
        { const int rn = (row + NGW < T) ? row + NGW : row; ne = *(const i32x4*)(tokE + (size_t)rn * 4); np = *(const i32x4*)(tokPos + (size_t)rn * 4); ng = *(const f32x4*)(gate + (size_t)rn * 4); }
#pragma unroll
        for (int j = 0; j < 4; ++j) { v[j] = ((v[j] - rs[0]) * rs[1] * gv1[j] + bv1[j]) * DN_ALPHA;
#pragma unroll
            for (int k = 0; k < 4; ++k) v[j] += (f32x4){bflo(y[k][j].x), bfhi(y[k][j].x), bflo(y[k][j].y), bfhi(y[k][j].y)} * cg[k]; }
        float s = 0.f;
#pragma unroll
        for (int j = 0; j < 4; ++j) s += (v[j][0] + v[j][1]) + (v[j][2] + v[j][3]);
        const float mean = wave_sum(s) * (1.0f / D); float s2 = 0.f;
#pragma unroll
        for (int j = 0; j < 4; ++j) { v[j] = v[j] - mean; s2 += (v[j][0] * v[j][0] + v[j][1] * v[j][1]) + (v[j][2] * v[j][2] + v[j][3] * v[j][3]); }
        const float rstd = 1.0f / sqrtf(wave_sum(s2) * (1.0f / D) + LN_EPS);
#pragma unroll
        for (int j = 0; j < 4; ++j) { v[j] = v[j] * rstd * gv[j] + bv[j];
            if (outF) __builtin_nontemporal_store(v[j], (f32x4*)(outF + (size_t)row * D + 256 * j + 4 * lane));
            if (!outF) { u32x2 o; o.x = cvt_pk_bf16(v[j][0], v[j][1]); o.y = cvt_pk_bf16(v[j][2], v[j][3]); *(u32x2*)(XB + (size_t)row * D + 256 * j + 4 * lane) = o; } }
    }
}

__device__ __forceinline__ void moe_tables(volatile LAS unsigned* MISC, const unsigned* gcnt) {
    const int tid_ = opaque_v(threadIdx.x);
    if (tid_ < 64) {
        const int lane = tid_;
        const int n = lane < NE ? (int)__hip_atomic_load(gcnt + lane, __ATOMIC_RELAXED, __HIP_MEMORY_SCOPE_AGENT) : 0;
        const int nt = (n + 255) >> 8; int incl = nt;
#pragma unroll
        for (int o = 1; o < 32; o <<= 1) { const int v = __shfl_up(incl, o); if (lane >= o) incl += v; }
        if (lane < NE) { MISC[64 + lane] = (unsigned)n; MISC[16 + lane] = (unsigned)(incl - nt); }
        if (lane == NE - 1) MISC[16 + NE] = (unsigned)incl;
    }
    __syncthreads();
}

__device__ __forceinline__ void stagger(int span_ticks) {
    const unsigned long long t0 = __builtin_amdgcn_s_memrealtime(); const unsigned long long d = (unsigned long long)((((int)blockIdx.x >> 3) & 31) * span_ticks) >> 5;
    while (__builtin_amdgcn_s_memrealtime() - t0 < d) __builtin_amdgcn_s_sleep(8);
}
__global__ void __launch_bounds__(512, 2) fwd_kernel(Args args) {
    extern __shared__ __attribute__((aligned(16))) unsigned char lds_raw[];
    LAS unsigned char* lds = (LAS unsigned char*)lds_raw;
    volatile LAS unsigned* MISC = (volatile LAS unsigned*)(lds + MISC_OFF);
    const int tid = threadIdx.x, G = gridDim.x;
    unsigned char* const ws0 = args.ws;
    unsigned* ctl = (unsigned*)(ws0 + WS_CTL);
    for (int u = tid; u < 256; u += 512) MISC[u] = 0u;
    __syncthreads();
    const int lo = args.ph_lo, hi = args.ph_hi;
    XcdBarrier bar; bar.bar = ctl + CW_BAR; bar.x = 0; bar.st = MISC;
    if (hi - lo > 1) bar = xcd_barrier_post(ctl + CW_BAR, MISC);
#ifndef PH_MASK
#define PH_MASK 0x3ff
#endif
#define IN(k) (lo <= (k) && (k) < hi)
#define PON(p) (((PH_MASK) >> (p)) & 1)
#define SEAM(k) do { if (IN((k) + 1)) { XcdBarrier b2_ = bar; b2_.bar = opaque_p(bar.bar); { unsigned x_ = bar.x; asm volatile("" : "+s"(x_)); b2_.x = x_; } xcd_barrier(b2_); } } while (0)
#ifndef DUP_MASK
#define DUP_MASK 0
#endif
#define REP(p) _Pragma("unroll 1") for (int rep_ = 0; rep_ < ((((DUP_MASK) >> (p)) & 1) ? opaque_v(2) : 1); ++rep_)
#define WSP(T_, off) ((T_*)(ws + (off)))
#define PRM(off) ((const float*)(ws + WS_PRM) + (off))

    if (PON(9) && IN(0)) { REP(9) p0_prologue(args, lds, G); SEAM(0); }

#pragma unroll 1
    for (int l = 0; l < DEPTH; ++l) {
        const int pb = 1 + l * NPH;
        if (PON(0) && IN(pb + 0)) { unsigned char* ws = opaque_p(ws0); unsigned* ctl = (unsigned*)(ws + WS_CTL); (void)ctl; const int Gp = opaque_s(G), cp = opaque_s((int)blockIdx.x); (void)Gp; (void)cp;
            pg8::DenseSched S{WSP(const bf16_t, WS_XB), WSP(const bf16_t, WS_WIN) + (size_t)l * DIN * D, D, T / 256, DIN / 256, Gp, cp};
            pg8::EpiIn E{PRM(PR_BIN) + (size_t)l * DIN, WSP(bf16_t, WS_U), WSP(bf16_t, WS_V), WSP(bf16_t, WS_QKV), WSP(bf16_t, WS_GA), WSP(bf16_t, WS_GB), WSP(f32x2, WS_PS)};
#ifdef STAG_P1
            stagger(STAG_P1);
#endif
            REP(0) pg8::gemm_phase<pg8::EpiIn, pg8::DenseSched, true>(lds, S, E);
            SEAM(pb + 0);
        }
        if (PON(1) && IN(pb + 1)) { unsigned char* ws = opaque_p(ws0); unsigned* ctl = (unsigned*)(ws + WS_CTL); (void)ctl; const int Gp = opaque_s(G), cp = opaque_s((int)blockIdx.x); (void)Gp; (void)cp;
            const int vcu = (Gp % 8 == 0) ? (cp % 8) * (Gp / 8) + cp / 8 : cp;
            { constexpr int NU = 12 * 3 * 4 * 32, NS = 768;
                const int na = (NU - vcu + Gp - 1) / Gp;
                const int ka = (na * ((vcu >> 3) % 7)) / 6;
                const int usplit = vcu + (ka < na ? ka : na) * Gp;
                { u32x4 kr[8], vr[8];
                  _Pragma("unroll") for (int j = 0; j < 8; ++j) { kr[j] = (u32x4){0u, 0u, 0u, 0u}; vr[j] = (u32x4){0u, 0u, 0u, 0u}; }
                  if (vcu < usplit) attn_load(WSP(const bf16_t, WS_QKV), vcu, opaque_v(threadIdx.x), kr, vr);
                  for (int u = vcu; u < usplit; u += Gp) attn_unit(lds, WSP(const bf16_t, WS_QKV), WSP(bf16_t, WS_OG), WSP(float, WS_LSE), u, (u + Gp < usplit) ? u + Gp : -1, kr, vr); }
                { u32x4 vt[4]; bf16x8 wf[4]; f32x4 gab[4], pp[2];
                  _Pragma("unroll") for (int j = 0; j < 4; ++j) { vt[j] = (u32x4){0u, 0u, 0u, 0u}; wf[j] = (bf16x8){0, 0, 0, 0, 0, 0, 0, 0}; gab[j] = (f32x4){0.f, 0.f, 0.f, 0.f}; }
                  pp[0] = (f32x4){0.f, 0.f, 0.f, 0.f}; pp[1] = pp[0];
                  if (vcu < NS) sg_prefetch(WSP(const bf16_t, WS_V), WSP(const bf16_t, WS_WS) + (size_t)l * 8 * 128 * 128, PRM(PR_LNVG) + (size_t)l * 1024, PRM(PR_LNVB) + (size_t)l * 1024, WSP(const f32x2, WS_PS), vcu, vt, wf, gab, pp);
                  for (int u = vcu; u < NS; u += Gp)
                    sg_unit(lds, WSP(const bf16_t, WS_U), WSP(const bf16_t, WS_V), WSP(bf16_t, WS_AOUT), WSP(const bf16_t, WS_WS) + (size_t)l * 8 * 128 * 128, PRM(PR_BS) + (size_t)l * 1024, PRM(PR_LNVG) + (size_t)l * 1024, PRM(PR_LNVB) + (size_t)l * 1024, WSP(const f32x2, WS_PS), u, (u + Gp < NS) ? u + Gp : u, vt, wf, gab, pp); }
                { u32x4 kr[8], vr[8];
                  _Pragma("unroll") for (int j = 0; j < 8; ++j) { kr[j] = (u32x4){0u, 0u, 0u, 0u}; vr[j] = (u32x4){0u, 0u, 0u, 0u}; }
                  if (usplit < NU) attn_load(WSP(const bf16_t, WS_QKV), usplit, opaque_v(threadIdx.x), kr, vr);
                  for (int u = usplit; u < NU; u += Gp) attn_unit(lds, WSP(const bf16_t, WS_QKV), WSP(bf16_t, WS_OG), WSP(float, WS_LSE), u, (u + Gp < NU) ? u + Gp : -1, kr, vr); }
            }
            SEAM(pb + 1);
        }
        if (PON(2) && IN(pb + 2)) { unsigned char* ws = opaque_p(ws0); unsigned* ctl = (unsigned*)(ws + WS_CTL); (void)ctl; const int Gp = opaque_s(G), cp = opaque_s((int)blockIdx.x); (void)Gp; (void)cp; REP(2) merge_phase(WSP(const bf16_t, WS_OG), WSP(const float, WS_LSE), WSP(bf16_t, WS_BOUT), Gp); SEAM(pb + 2); }
        if (PON(3) && IN(pb + 3)) { unsigned char* ws = opaque_p(ws0); unsigned* ctl = (unsigned*)(ws + WS_CTL); (void)ctl; const int Gp = opaque_s(G), cp = opaque_s((int)blockIdx.x); (void)Gp; (void)cp;
            pg8::Dense2Sched S{WSP(const bf16_t, WS_AOUT), WSP(const bf16_t, WS_WPA) + (size_t)l * D * D, D, WSP(const bf16_t, WS_BOUT), WSP(const bf16_t, WS_WPB) + (size_t)l * D * 512, 512, T / 256, D / 256, Gp, cp};
            pg8::EpiMg2 E{WSP(const bf16_t, WS_GA), WSP(const bf16_t, WS_GB), WSP(bf16_t, WS_MG)};
            REP(3) pg8::gemm_phase2<pg8::EpiMg2>(lds, S, E);
            SEAM(pb + 3);
        }
        if (PON(4) && IN(pb + 4)) { unsigned char* ws = opaque_p(ws0); unsigned* ctl = (unsigned*)(ws + WS_CTL); (void)ctl; const int Gp = opaque_s(G), cp = opaque_s((int)blockIdx.x); (void)Gp; (void)cp;
            pg8::DenseSched S{WSP(const bf16_t, WS_MG), WSP(const bf16_t, WS_WO) + (size_t)l * D * D, D, T / 256, D / 256, Gp, cp};
            pg8::EpiWo E{args.in[I_XP], args.in[I_XS] - (size_t)TP * D, l == 0 ? (const bf16_t*)nullptr : WSP(const bf16_t, WS_XB), WSP(y1_t, WS_XF)};
            pg8::gemm_phase<pg8::EpiWo, pg8::DenseSched, true>(lds, S, E);
            SEAM(pb + 4);
        }
        if (PON(5) && IN(pb + 5)) { unsigned char* ws = opaque_p(ws0); unsigned* ctl = (unsigned*)(ws + WS_CTL); (void)ctl; const int Gp = opaque_s(G), cp = opaque_s((int)blockIdx.x); (void)Gp; (void)cp;
            if (((DUP_MASK) >> 5) & 1) ln1_router_phase(lds, MISC, WSP(f32x2, WS_RS), WSP(const y1_t, WS_XF), WSP(y1_t, WS_T1), WSP(bf16_t, WS_U), PRM(PR_LN1G) + (size_t)l * D, PRM(PR_LN1B) + (size_t)l * D, WSP(const bf16_t, WS_WRI) + (size_t)l * 65536, PRM(PR_BR) + (size_t)l * NE,
                             ctl + CW_CNT + 1024 + l * 64, WSP(int, WS_OG), WSP(int, WS_LSE), WSP(int, WS_BOUT), WSP(float, WS_AOUT), Gp);
            ln1_router_phase(lds, MISC, WSP(f32x2, WS_RS), WSP(const y1_t, WS_XF), WSP(y1_t, WS_XF), WSP(bf16_t, WS_XB), PRM(PR_LN1G) + (size_t)l * D, PRM(PR_LN1B) + (size_t)l * D, WSP(const bf16_t, WS_WRI) + (size_t)l * 65536, PRM(PR_BR) + (size_t)l * NE,
                             ctl + CW_CNT + l * 64, WSP(int, WS_TOKLIST), WSP(int, WS_TOKE), WSP(int, WS_TOKPOS), WSP(float, WS_GATE), Gp);
            SEAM(pb + 5);
        }
        if (PON(6) && IN(pb + 6)) { unsigned char* ws = opaque_p(ws0); unsigned* ctl = (unsigned*)(ws + WS_CTL); (void)ctl; const int Gp = opaque_s(G), cp = opaque_s((int)blockIdx.x); (void)Gp; (void)cp;
            moe_tables(MISC, ctl + CW_CNT + l * 64);
            pg8::MoeSched<true> S{WSP(const bf16_t, WS_XB), WSP(const bf16_t, WS_WGU) + (size_t)l * NE * 2048 * D, D, 8, Gp, cp, (size_t)2048 * D * 2, (const LAS int*)(lds + MISC_OFF + 64), (const LAS int*)(lds + MISC_OFF + 256), WSP(const int, WS_TOKLIST)};
            pg8::EpiGU E{PRM(PR_BGU) + (size_t)l * NE * 2048, WSP(bf16_t, WS_H)};
            REP(6) pg8::gemm_phase<pg8::EpiGU, pg8::MoeSched<true>, true>(lds, S, E);
            SEAM(pb + 6);
        }
        if (PON(7) && IN(pb + 7)) { unsigned char* ws = opaque_p(ws0); unsigned* ctl = (unsigned*)(ws + WS_CTL); (void)ctl; const int Gp = opaque_s(G), cp = opaque_s((int)blockIdx.x); (void)Gp; (void)cp;
            moe_tables(MISC, ctl + CW_CNT + l * 64);
            pg8::MoeSched<false> S{WSP(const bf16_t, WS_H), WSP(const bf16_t, WS_WD) + (size_t)l * NE * D * D, D, 4, Gp, cp, (size_t)D * D * 2, (const LAS int*)(lds + MISC_OFF + 64), (const LAS int*)(lds + MISC_OFF + 256), nullptr};
            pg8::EpiDown E{PRM(PR_BD) + (size_t)l * NE * D, WSP(bf16_t, WS_YK)};
            REP(7) pg8::gemm_phase<pg8::EpiDown, pg8::MoeSched<false>, true>(lds, S, E);
            SEAM(pb + 7);
        }
        if (PON(8) && IN(pb + 8)) { unsigned char* ws = opaque_p(ws0); unsigned* ctl = (unsigned*)(ws + WS_CTL); (void)ctl; const int Gp = opaque_s(G), cp = opaque_s((int)blockIdx.x); (void)Gp; (void)cp;
            moe_tables(MISC, ctl + CW_CNT + l * 64);
            combine_ln2_phase(MISC, WSP(const f32x2, WS_RS), PRM(PR_LN1G) + (size_t)l * D, PRM(PR_LN1B) + (size_t)l * D, WSP(const y1_t, WS_XF), WSP(const bf16_t, WS_YK), WSP(const int, WS_TOKE), WSP(const int, WS_TOKPOS), WSP(const float, WS_GATE), PRM(PR_LN2G) + (size_t)l * D, PRM(PR_LN2B) + (size_t)l * D,
                              l == DEPTH - 1 ? args.out : (float*)nullptr, WSP(bf16_t, WS_XB), Gp);
            SEAM(pb + 8);
        }
    }
#undef IN
#undef SEAM
}

extern "C" void kernel_launch(void* const* d_in, const int* in_sizes, int n_in, void* d_out, int out_size, void* d_ws, size_t ws_size, hipStream_t stream) {
    static int grid = 0;
    if (grid == 0) {
        if (n_in != 21 || out_size != T * D || ws_size < WS_END) { fprintf(stderr, "kernel_launch: unexpected shapes (n_in %d, out %d, ws %zu < %zu)\n", n_in, out_size, ws_size, (size_t)WS_END); grid = -1; return; }
        int dev = 0, cus = 0, per_cu = 0;
        if (hipGetDevice(&dev) != hipSuccess || hipDeviceGetAttribute(&cus, hipDeviceAttributeMultiprocessorCount, dev) != hipSuccess) { grid = -1; return; }
        if (hipFuncSetAttribute((const void*)fwd_kernel, hipFuncAttributeMaxDynamicSharedMemorySize, LDS_BYTES) != hipSuccess) { fprintf(stderr, "kernel_launch: hipFuncSetAttribute failed\n"); grid = -1; return; }
        if (hipOccupancyMaxActiveBlocksPerMultiprocessor(&per_cu, (const void*)fwd_kernel, 512, LDS_BYTES) != hipSuccess || per_cu < 1) fprintf(stderr, "kernel_launch: occupancy query says %d\n", per_cu);
        (void)hipGetLastError();
        grid = cus;
    }
    if (grid < 0) return;
    (void)hipMemsetAsync((char*)d_ws + WS_CTL, 0, CTL_BYTES, stream);
    Args a{};
    for (int i = 0; i < 21; ++i) a.in[i] = (const float*)d_in[i];
    a.out = (float*)d_out; a.ws = (unsigned char*)d_ws;
#if MK_SPLIT
    for (int p = 0; p < NPHASE; ++p) { a.ph_lo = p; a.ph_hi = p + 1; hipLaunchKernelGGL(fwd_kernel, dim3(grid), dim3(512), LDS_BYTES, stream, a); }
#else
    a.ph_lo = 0; a.ph_hi = NPHASE;
    hipLaunchKernelGGL(fwd_kernel, dim3(grid), dim3(512), LDS_BYTES, stream, a);
#ifdef PROBE_PHASE
    for (int r = 0; r < PROBE_REPS; ++r) { a.ph_lo = 1 + 2 * NPH + PROBE_PHASE; a.ph_hi = a.ph_lo + 1;
#ifdef PROBE_SUB
        a.sub = PROBE_SUB;
#endif
 hipLaunchKernelGGL(fwd_kernel, dim3(grid), dim3(512), LDS_BYTES, stream, a); }
#endif
#endif
}
```

```cpp
#include <hip/hip_runtime.h>
#include <cstdio>
#include <cstdint>

#ifndef Y1_BF16
#define Y1_BF16 1
#endif
#ifndef MK_SPLIT
#define MK_SPLIT 0
#endif

#define LAS __attribute__((address_space(3)))
#define GAS __attribute__((address_space(1)))
typedef unsigned short bf16_t;
typedef short bf16x8 __attribute__((ext_vector_type(8)));
typedef short s16x4 __attribute__((ext_vector_type(4)));
typedef float f32x4 __attribute__((ext_vector_type(4)));
typedef float f32x2 __attribute__((ext_vector_type(2)));
typedef unsigned u32x4 __attribute__((ext_vector_type(4)));
typedef unsigned u32x2 __attribute__((ext_vector_type(2)));

constexpr int D = 1024, T = 49152, TP = 32768, SEQ = 4096, DEPTH = 4, DIN = 8704, NE = 32, TOPK = 4, QKVW = 4608;
constexpr int NSLOT = T * TOPK + NE * 256;
constexpr float DN_ALPHA = 1.6817928305074290f;
constexpr float LN_EPS = 1e-5f;
constexpr float LOG2E = 1.4426950408889634f, LN2 = 0.6931471805599453f;
constexpr int NPH = 9, NPHASE = 1 + DEPTH * NPH;

constexpr size_t MiB = 1u << 20;
constexpr size_t WS_CTL = 0, CTL_BYTES = 128 * 1024;
constexpr size_t WS_PRM = 1 * MiB;
constexpr int PR_BIN = 0, PR_LNVG = PR_BIN + DEPTH * DIN, PR_LNVB = PR_LNVG + DEPTH * D, PR_BS = PR_LNVB + DEPTH * D, PR_LN1G = PR_BS + DEPTH * D, PR_LN1B = PR_LN1G + DEPTH * D,
              PR_WR = PR_LN1B + DEPTH * D, PR_BR = PR_WR + DEPTH * D * NE, PR_BGU = PR_BR + DEPTH * NE, PR_BD = PR_BGU + DEPTH * NE * 2048, PR_LN2G = PR_BD + DEPTH * NE * D, PR_LN2B = PR_LN2G + DEPTH * D,
              PR_END = PR_LN2B + DEPTH * D;
static_assert((size_t)PR_END * 4 <= 4 * MiB, "params region");
constexpr size_t WS_WIN = 5 * MiB;
constexpr size_t WS_WPA = WS_WIN + (size_t)DEPTH * DIN * D * 2;
constexpr size_t WS_WPB = WS_WPA + (size_t)DEPTH * D * D * 2;
constexpr size_t WS_WO = WS_WPB + (size_t)DEPTH * D * 512 * 2;
constexpr size_t WS_WS = WS_WO + (size_t)DEPTH * D * D * 2;
constexpr size_t WS_WGU = WS_WS + (size_t)DEPTH * 8 * 128 * 128 * 2;
constexpr size_t WS_WD = WS_WGU + (size_t)DEPTH * NE * 2048 * D * 2;
constexpr size_t WS_XF = WS_WD + (size_t)DEPTH * NE * D * D * 2;
constexpr size_t WS_WRI = WS_XF + (size_t)T * D * 2;
constexpr size_t WS_XB = WS_XF + (size_t)T * D * 4;
constexpr size_t WS_TOKLIST = WS_XB + (size_t)T * D * 2;
constexpr size_t WS_TOKE = WS_TOKLIST + (size_t)NE * T * 4;
constexpr size_t WS_TOKPOS = WS_TOKE + (size_t)T * 4 * 4;
constexpr size_t WS_GATE = WS_TOKPOS + (size_t)T * 4 * 4;
constexpr size_t WS_PS = WS_GATE + (size_t)T * 4 * 4;
constexpr size_t WS_RS = WS_PS + (size_t)T * 16 * 8;
constexpr size_t WS_R = WS_RS + (size_t)T * 8;
constexpr size_t WS_U = WS_R;
constexpr size_t WS_V = WS_U + (size_t)T * D * 2;
constexpr size_t WS_QKV = WS_V + (size_t)T * D * 2;
constexpr size_t WS_GA = WS_QKV + (size_t)T * QKVW * 2;
constexpr size_t WS_GB = WS_GA + (size_t)T * D * 2;
constexpr size_t WS_AOUT = WS_GB + (size_t)T * D * 2;
constexpr size_t WS_OG = WS_AOUT + (size_t)T * D * 2;
constexpr size_t WS_LSE = WS_OG + (size_t)3 * T * 512 * 2;
constexpr size_t WS_BOUT = WS_LSE + (size_t)3 * T * 4 * 4;
constexpr size_t WS_T1 = WS_BOUT + (size_t)T * 512 * 2;
constexpr size_t WS_MG = WS_T1 + (size_t)T * D * 4;
constexpr size_t WS_END_A = WS_MG + (size_t)T * D * 2;
constexpr size_t WS_H = WS_R;
constexpr size_t WS_YK = WS_H + (size_t)NSLOT * D * 2;
constexpr size_t WS_END_B = WS_YK + (size_t)NSLOT * D * 2;
constexpr size_t WS_END = WS_END_A > WS_END_B ? WS_END_A : WS_END_B;
constexpr int CW_BAR = 4096;
constexpr int CW_CNT = 16384;

constexpr int LDS_BYTES = 160 * 1024;
constexpr int MISC_OFF = LDS_BYTES - 2048, IDS_OFF = MISC_OFF + 1024;
constexpr int MISC_DOC = 0;
constexpr int SCR_BYTES = MISC_OFF;

#if Y1_BF16
typedef unsigned short y1_t;
#define Y1_LD4(p) ({ const u32x2 q_ = *(const u32x2*)(p); (f32x4){__builtin_bit_cast(float, q_.x << 16), __builtin_bit_cast(float, q_.x & 0xffff0000u), __builtin_bit_cast(float, q_.y << 16), __builtin_bit_cast(float, q_.y & 0xffff0000u)}; })
#else
typedef float y1_t;
#define Y1_LD4(p) (*(const f32x4*)(p))
#endif
__device__ __forceinline__ int opaque_v(int x) { asm volatile("" : "+v"(x)); return x; }
__device__ __forceinline__ int opaque_s(int x) { asm volatile("" : "+s"(x)); return x; }
template <class P> __device__ __forceinline__ P* opaque_p(P* p) { unsigned long long z = 0; asm volatile("" : "+s"(z)); return (P*)((char*)p + z); }
__device__ __forceinline__ unsigned f2bf(float f) { unsigned u = __builtin_bit_cast(unsigned, f); return (u + 0x7fffu + ((u >> 16) & 1u)) >> 16; }
__device__ __forceinline__ unsigned pk2(float lo, float hi) { return f2bf(lo) | (f2bf(hi) << 16); }
__device__ __forceinline__ unsigned cvt_pk_bf16(float lo, float hi) { unsigned r; asm volatile("v_cvt_pk_bf16_f32 %0, %1, %2" : "=v"(r) : "v"(lo), "v"(hi)); return r; }
__device__ __forceinline__ float bflo(unsigned w) { return __builtin_bit_cast(float, w << 16); }
__device__ __forceinline__ float bfhi(unsigned w) { return __builtin_bit_cast(float, w & 0xffff0000u); }
__device__ __forceinline__ float wave_sum(float v) {
#pragma unroll
    for (int o = 1; o < 64; o <<= 1) v += __shfl_xor(v, o);
    return v;
}
__device__ __forceinline__ float sigmoidf_(float x) { return __builtin_amdgcn_rcpf(1.0f + __builtin_amdgcn_exp2f(-x * LOG2E)); }
__device__ __forceinline__ f32x2 gelu_pk(f32x2 v) {
    f32x2 t = v * v; t.x = fminf(t.x, 16.0f); t.y = fminf(t.y, 16.0f);
    f32x2 p = t * 9.567564795975869e-11f + (-8.026423969909047e-09f);
    p = p * t + 3.002628830017784e-07f; p = p * t + (-6.72069427309907e-06f); p = p * t + 0.00010251090134261176f; p = p * t + (-0.0011512201745063066f);
    p = p * t + 0.009921522811055183f; p = p * t + (-0.06646095216274261f); p = p * t + 0.3989395201206207f;
    f32x2 vc; vc.x = fminf(fmaxf(v.x, -4.0f), 4.0f); vc.y = fminf(fmaxf(v.y, -4.0f), 4.0f);
    return v * (vc * p + 0.5f);
}

#define XB_TMO      128
#define XB_XCNT(j)  (256  + 64 * (j))
#define XB_XSUB(j)  (1280 + 64 * (j))
#define XB_XGEN(j)  (2304 + 64 * (j))
#define XB_TOP      3328
#define XB_TOPGEN   3392
#define XCD_BAR_WORDS 3456
#define XB_SPIN_CAP (1u << 18)
__device__ __forceinline__ unsigned xb_ld(unsigned* p)              { return __hip_atomic_load(p, __ATOMIC_RELAXED, __HIP_MEMORY_SCOPE_AGENT); }
__device__ __forceinline__ unsigned xb_add(unsigned* p, unsigned v) { return __hip_atomic_fetch_add(p, v, __ATOMIC_RELAXED, __HIP_MEMORY_SCOPE_AGENT); }
__device__ __forceinline__ unsigned xb_xcc_id() { return (unsigned)__builtin_amdgcn_s_getreg((3 << 11) | 20) & 0xFu; }
#define XB_SPIN(cond, bar) do { unsigned _sp = 0; while (cond) { __builtin_amdgcn_s_sleep(1); \
    if ((++_sp & 255u) == 0u) { if (xb_ld(&(bar)[XB_TMO])) break; if (_sp > XB_SPIN_CAP) { atomicAdd(&(bar)[XB_TMO], 1u); break; } } } } while (0)
struct XcdBarrier { unsigned* bar; unsigned x; volatile LAS unsigned* st; };
__device__ __forceinline__ XcdBarrier xcd_barrier_post(unsigned* bar, volatile LAS unsigned* st) {
    XcdBarrier b; b.bar = bar; b.x = xb_xcc_id(); b.st = st;
    if (threadIdx.x == 0) (void)xb_add(&bar[XB_XCNT(b.x)], 1u);
    return b;
}
__device__ __forceinline__ void xcd_barrier_complete(unsigned* bar, unsigned x, unsigned& nloc, unsigned& nx) {
    const unsigned G = gridDim.x * gridDim.y * gridDim.z;
    unsigned sum, cnt, mine, sp = 0u;
    for (;;) {
        sum = 0u; cnt = 0u; mine = 0u;
#pragma unroll
        for (unsigned j = 0; j < 16; ++j) { const unsigned c = xb_ld(&bar[XB_XCNT(j)]); sum += c; cnt += (c > 0u) ? 1u : 0u; mine = (j == x) ? c : mine; }
        if (sum == G) break;
        __builtin_amdgcn_s_sleep(1);
        if ((++sp & 255u) == 0u) { if (xb_ld(&bar[XB_TMO])) break; if (sp > XB_SPIN_CAP) { atomicAdd(&bar[XB_TMO], 1u); break; } }
    }
    nloc = mine > 0u ? mine : 1u; nx = cnt > 0u ? cnt : 1u;
}
__device__ __forceinline__ void xcd_barrier(const XcdBarrier& b) {
    asm volatile("s_waitcnt vmcnt(0)" ::: "memory");
    __syncthreads();
    if (threadIdx.x == 0) {
        unsigned* bar = b.bar;
        __builtin_amdgcn_s_waitcnt(0);
        unsigned nloc = b.st[0], nx = b.st[1];
        if (nloc == 0u) { xcd_barrier_complete(bar, b.x, nloc, nx); b.st[0] = nloc; b.st[1] = nx; }
        const unsigned old = xb_add(&bar[XB_XSUB(b.x)], 1u);
        const unsigned gen = old / nloc;
        if (old + 1u == (gen + 1u) * nloc) {
            __builtin_amdgcn_fence(__ATOMIC_RELEASE, "agent");
            asm volatile("s_waitcnt vmcnt(0)" ::: "memory");
            const unsigned og = xb_add(&bar[XB_TOP], 1u);
            const unsigned tg = og / nx;
            if (og + 1u == (tg + 1u) * nx) xb_add(&bar[XB_TOPGEN], 1u);
            else XB_SPIN(xb_ld(&bar[XB_TOPGEN]) == tg, bar);
            __builtin_amdgcn_fence(__ATOMIC_ACQUIRE, "agent");
            xb_add(&bar[XB_XGEN(b.x)], 1u);
            asm volatile("s_waitcnt vmcnt(0)" ::: "memory");
        } else {
            XB_SPIN(xb_ld(&bar[XB_XGEN(b.x)]) == gen, bar);
            __builtin_amdgcn_fence(__ATOMIC_ACQUIRE, "agent");
            asm volatile("s_waitcnt vmcnt(0)" ::: "memory");
        }
    }
    __syncthreads();
}

#ifndef EPI_NT
#define EPI_NT 1
#endif
#if EPI_NT
#define EPI_ST(T_, p, v) __builtin_nontemporal_store((T_)(v), (T_*)(p))
#else
#define EPI_ST(T_, p, v) (*(T_*)(p) = (v))
#endif
namespace pg8 {
constexpr int BM = 256, BK = 64, HALF = 128, HTB = HALF * BK * 2, STAGE_BYTES = 8 * HTB, NXCD = 8, WGM = 4;
__host__ __device__ __forceinline__ int lds_byte(int r, int c) { const int st = (r >> 4) * 2 + (c >> 5), rr = r & 15, cc = c & 31, ob = rr * 64 + cc * 2; return st * 1024 + (ob ^ (((ob >> 9) & 1) << 5)); }
__host__ __device__ __forceinline__ void stage_rc(int b, int& R, int& C) { const int st = b / 1024, sb = b % 1024, swz = sb ^ (((sb >> 9) & 1) << 5); R = (st >> 1) * 16 + swz / 64; C = (st & 1) * 32 + (swz % 64) / 2; }
__host__ __device__ __forceinline__ int perm32(int rho) { const int n = rho >> 4, i = rho & 15; return 8 * (i >> 2) + 4 * n + (i & 3); }

struct Unit { int pm, pn, e, r0; };

__device__ __forceinline__ bool static_order(int i, int G, int c, int nM, int nN, int& pm, int& pn) {
    const int nwg = nM * nN; const long L = (long)i * G + c; if (L >= nwg) return false;
    int wgid = (int)L; { const int q = nwg / NXCD, r = nwg % NXCD, xcd = wgid % NXCD, off = wgid / NXCD; wgid = (xcd < r ? xcd * (q + 1) : r * (q + 1) + (xcd - r) * q) + off; }
    const int nig = WGM * nN, gid = wgid / nig, fm = gid * WGM, gsz = (nM - fm) < WGM ? (nM - fm) : WGM;
    pm = fm + ((wgid % nig) % gsz); pn = (wgid % nig) / gsz; return true;
}
struct DenseSched {
    static constexpr bool GATHER = false;
    const bf16_t* A; const bf16_t* Bt; int K, nM, nN, G, c;
    __device__ __forceinline__ bool next(int i, Unit& u) const { u.e = 0; u.r0 = 0; return static_order(i, G, c, nM, nN, u.pm, u.pn); }
    __device__ __forceinline__ const char* a_base(const Unit& u) const { return (const char*)A + (size_t)u.pm * BM * K * 2; }
    __device__ __forceinline__ const char* b_base(const Unit& u) const { return (const char*)Bt + (size_t)u.pn * BM * K * 2; }
    __device__ __forceinline__ void a_offs(const Unit& u, const int (&R)[2], const int (&C)[2], unsigned (&o)[2][2]) const {
#pragma unroll
        for (int h = 0; h < 2; ++h)
#pragma unroll
            for (int i = 0; i < 2; ++i) o[h][i] = (unsigned)((u.pm * BM + h * HALF + R[i]) * K + C[i]) * 2u;
    }
    __device__ __forceinline__ int load_id(const Unit&, int) const { return 0; }
    __device__ __forceinline__ void a_offs_lds(const LAS int*, const int (&)[2], const int (&)[2], unsigned (&)[2][2]) const {}
};
template <bool GATHER_> struct MoeSched {
    static constexpr bool GATHER = GATHER_;
    const bf16_t* A; const bf16_t* Bt; int K, nN, G, c; size_t bstride;
    const LAS int* tb; const LAS int* cnt; const int* tokList;
    __device__ __forceinline__ bool next(int i, Unit& u) const {
        const int nM = tb[NE];
        if (!static_order(i, G, c, nM, nN, u.pm, u.pn)) return false;
        int e = 0;
#pragma unroll 1
        for (int j = 1; j < NE; ++j) e += (u.pm >= tb[j]) ? 1 : 0;
        u.e = e; u.r0 = (u.pm - tb[e]) * BM; return true;
    }
    __device__ __forceinline__ const char* a_base(const Unit& u) const { return GATHER ? (const char*)A : (const char*)A + (size_t)u.pm * BM * K * 2; }
    __device__ __forceinline__ const char* b_base(const Unit& u) const { return (const char*)Bt + (size_t)u.e * bstride + (size_t)u.pn * BM * K * 2; }
    __device__ __forceinline__ int load_id(const Unit& u, int i) const { const int r = u.r0 + i; return (r < cnt[u.e]) ? tokList[(size_t)u.e * T + r] : 0; }
    __device__ __forceinline__ void a_offs(const Unit& u, const int (&R)[2], const int (&C)[2], unsigned (&o)[2][2]) const {
#pragma unroll
        for (int h = 0; h < 2; ++h)
#pragma unroll
            for (int i = 0; i < 2; ++i) o[h][i] = (unsigned)(load_id(u, h * HALF + R[i]) * K + C[i]) * 2u;
    }
    __device__ __forceinline__ void a_offs_lds(const LAS int* ids, const int (&R)[2], const int (&C)[2], unsigned (&o)[2][2]) const {
#pragma unroll
        for (int h = 0; h < 2; ++h)
#pragma unroll
            for (int i = 0; i < 2; ++i) o[h][i] = (unsigned)(ids[h * HALF + R[i]] * K + C[i]) * 2u;
    }
};


template <class Epi, class Sched, bool ALIGN_EPI>
__device__ __forceinline__ void gemm_phase(LAS unsigned char* lds, const Sched& S, const Epi& E) {
    constexpr bool GATHER = Sched::GATHER;
    const int tid = opaque_v(threadIdx.x), wid = __builtin_amdgcn_readfirstlane(tid >> 6), lane = tid & 63, wr = wid >> 2, wc = wid & 3, fr = lane & 15, fq = lane >> 4;
    const int K = S.K, nt = K / BK;
    int R[2], C[2]; unsigned voffA[2], voffB[2];
#pragma unroll
    for (int i = 0; i < 2; ++i) { stage_rc(tid * 16 + i * 8192, R[i], C[i]); const int Rb = 64 * (R[i] >> 5) + (Epi::PERM ? perm32(R[i] & 31) : (R[i] & 31));
        voffA[i] = (unsigned)(R[i] * K + C[i]) * 2u; voffB[i] = (unsigned)(Rb * K + C[i]) * 2u; }
    const size_t kstep = (size_t)(BK * 2);
    const size_t hstep = (size_t)HALF * K * 2;
    const size_t bhstep = (size_t)32 * K * 2;
    const unsigned ldsw = (unsigned)wid * 1024u;
    const int aoff = lds_byte(wr * 64 + fr, fq * 8), boff = lds_byte(wc * 32 + fr, fq * 8);
#define PG8_SA(b, h) (((b) * 2 + (h)) * HTB)
#define PG8_SB(b, h) ((4 + (b) * 2 + (h)) * HTB)
#define PG8_STAGE(bufoff, gbase, voff) do { _Pragma("unroll") for (int _i = 0; _i < 2; ++_i) \
        __builtin_amdgcn_global_load_lds((const unsigned*)((const char*)(gbase) + (voff)[_i]), (LAS unsigned*)(lds + (bufoff) + ldsw + _i * 8192), 16, 0, 0); } while (0)
#define PG8_STAGE_A(bufoff, ab, ao, h, kb) do { if constexpr (GATHER) { PG8_STAGE(bufoff, (ab) + (kb), (ao)[h]); } else { PG8_STAGE(bufoff, (ab) + (kb) + (h) * hstep, voffA); } } while (0)
#define PG8_LDA(dst, b, h) do { _Pragma("unroll") for (int m = 0; m < 4; ++m) _Pragma("unroll") for (int k = 0; k < 2; ++k) dst[m][k] = *(const LAS bf16x8*)(lds + PG8_SA(b, h) + aoff + m * 2048 + k * 1024); } while (0)
#define PG8_LDB(dst, b, h) do { _Pragma("unroll") for (int n = 0; n < 2; ++n) _Pragma("unroll") for (int k = 0; k < 2; ++k) dst[n][k] = *(const LAS bf16x8*)(lds + PG8_SB(b, h) + boff + n * 2048 + k * 1024); } while (0)
#define PG8_MMA(ai, bj, At, Bt) do { __builtin_amdgcn_s_setprio(1); _Pragma("unroll") for (int m = 0; m < 4; ++m) _Pragma("unroll") for (int n = 0; n < 2; ++n) _Pragma("unroll") for (int k = 0; k < 2; ++k) \
        acc[ai][bj][m][n] = __builtin_amdgcn_mfma_f32_16x16x32_bf16(Bt[n][k], At[m][k], acc[ai][bj][m][n], 0, 0, 0); __builtin_amdgcn_s_setprio(0); } while (0)
#define PG8_WAIT_V(n) asm volatile("s_waitcnt vmcnt(" #n ")" ::: "memory")
#define PG8_WAIT_L(n) asm volatile("s_waitcnt lgkmcnt(" #n ")" ::: "memory")
#define PG8_BAR __builtin_amdgcn_s_barrier()
#define PG8_SCHED __builtin_amdgcn_sched_barrier(0)
    Unit cur, nxt; int ui = 0;
    if (!S.next(0, cur)) return;
    f32x4 acc[2][2][4][2];
    { f32x4 bv[2][2]; E.binit(cur, wc, fq, bv);
#pragma unroll
    for (int a = 0; a < 2; ++a)
#pragma unroll
        for (int b = 0; b < 2; ++b)
#pragma unroll
            for (int m = 0; m < 4; ++m)
#pragma unroll
                for (int n = 0; n < 2; ++n) { acc[a][b][m][n] = bv[b][n]; asm volatile("" : "+v"(acc[a][b][m][n])); } }
    bf16x8 At[4][2], B0[2][2], B1[2][2];
    unsigned ca[2][2];
    LAS int* ids = (LAS int*)(lds + IDS_OFF);
    if constexpr (GATHER) { S.a_offs(cur, R, C, ca); Unit n1; if (S.next(1, n1) && tid < 256) ids[tid] = S.load_id(n1, tid); }
    const char* cA = S.a_base(cur);
    const char* cB = S.b_base(cur);
    PG8_STAGE(PG8_SB(0, 0), cB, voffB); PG8_STAGE(PG8_SB(0, 1), cB + bhstep, voffB); PG8_STAGE_A(PG8_SA(0, 0), cA, ca, 0, 0); PG8_STAGE_A(PG8_SA(0, 1), cA, ca, 1, 0);
    if (wr == 1) PG8_BAR;
    PG8_WAIT_V(2); PG8_BAR;
    PG8_STAGE(PG8_SB(1, 0), cB + kstep, voffB); PG8_STAGE_A(PG8_SA(1, 0), cA, ca, 0, kstep); PG8_STAGE(PG8_SB(1, 1), cB + bhstep + kstep, voffB);
    PG8_WAIT_V(6); PG8_BAR;
    for (;;) {
        const bool has_next = S.next(ui + 1, nxt);
        const char* nA = has_next ? S.a_base(nxt) : cA; const char* nB = has_next ? S.b_base(nxt) : cB;
#define PG8_TRIP(RELAX) do { \
            const bool last = (t == nt - 2); \
            const size_t k1 = (size_t)(t + 1) * kstep; \
            const size_t k2 = last ? 0 : (size_t)(t + 2) * kstep, k3 = k2 + kstep; \
            const char* a2 = last ? nA : cA; const char* b2 = (last ? nB : cB) + k2; const char* b3 = b2 + kstep; \
            PG8_LDB(B0, 0, 0); PG8_LDB(B1, 0, 1); PG8_SCHED; PG8_LDA(At, 0, 0); PG8_STAGE_A(PG8_SA(1, 1), cA, ca, 1, k1); \
            if (!(RELAX)) PG8_WAIT_V(8); PG8_WAIT_L(0); PG8_BAR; PG8_MMA(0, 0, At, B0); PG8_MMA(0, 1, At, B1); PG8_BAR; PG8_SCHED; \
            if constexpr (GATHER) { if (last && has_next) { int R2[2], C2[2]; const int t2 = opaque_v(tid); stage_rc(t2 * 16, R2[0], C2[0]); stage_rc(t2 * 16 + 8192, R2[1], C2[1]); S.a_offs_lds(ids, R2, C2, ca); } } \
            PG8_LDA(At, 0, 1); PG8_STAGE(PG8_SB(0, 0), b2, voffB); PG8_STAGE(PG8_SB(0, 1), b2 + bhstep, voffB); PG8_STAGE_A(PG8_SA(0, 0), a2, ca, 0, k2); \
            if (!(RELAX)) PG8_WAIT_V(8); PG8_WAIT_L(0); PG8_BAR; PG8_MMA(1, 0, At, B0); PG8_MMA(1, 1, At, B1); PG8_BAR; PG8_SCHED; \
            PG8_LDB(B0, 1, 0); PG8_LDB(B1, 1, 1); PG8_SCHED; PG8_LDA(At, 1, 0); PG8_STAGE_A(PG8_SA(0, 1), a2, ca, 1, k2); \
            PG8_WAIT_V(8); PG8_WAIT_L(0); PG8_BAR; PG8_MMA(0, 0, At, B0); PG8_MMA(0, 1, At, B1); PG8_BAR; PG8_SCHED; \
            PG8_LDA(At, 1, 1); PG8_STAGE(PG8_SB(1, 0), b3, voffB); PG8_STAGE(PG8_SB(1, 1), b3 + bhstep, voffB); PG8_STAGE_A(PG8_SA(1, 0), a2, ca, 0, k3); \
            PG8_WAIT_V(8); PG8_WAIT_L(0); PG8_BAR; PG8_MMA(1, 0, At, B0); PG8_MMA(1, 1, At, B1); PG8_BAR; PG8_SCHED; \
        } while (0)
        int t = 0;
#ifndef NO_RELAX
        if (ui > 0) { PG8_TRIP(true); t = 2; }
#endif
        for (; t < nt; t += 2) PG8_TRIP(false);
#undef PG8_TRIP
        if constexpr (ALIGN_EPI) { if (wr == 0) PG8_BAR; }
        int idv = 0; bool fill = false;
        if constexpr (GATHER) { Unit n2; fill = S.next(ui + 2, n2) && tid < 256; if (fill) idv = S.load_id(n2, tid); }
        f32x4 bvn[2][2];
        if (has_next) E.binit(nxt, wc, fq, bvn);
        E(lds, acc, cur, wr, wc, fr, fq);
        if constexpr (GATHER) { if (fill) ids[tid] = idv; }
        if (!has_next) break;
#pragma unroll
        for (int a = 0; a < 2; ++a)
#pragma unroll
            for (int b = 0; b < 2; ++b)
#pragma unroll
                for (int m = 0; m < 4; ++m)
#pragma unroll
                    for (int n = 0; n < 2; ++n) { acc[a][b][m][n] = bvn[b][n]; asm volatile("" : "+v"(acc[a][b][m][n])); }
        cur = nxt; cA = nA; cB = nB; ++ui;
        if constexpr (ALIGN_EPI) { if (wr == 1) PG8_BAR; }
    }
    PG8_WAIT_V(0);
    if constexpr (!ALIGN_EPI) { if (wr == 0) PG8_BAR; }
    PG8_BAR;
#undef PG8_SA
#undef PG8_SB
#undef PG8_STAGE
#undef PG8_STAGE_A
#undef PG8_LDA
#undef PG8_LDB
#undef PG8_MMA
#undef PG8_WAIT_V
#undef PG8_WAIT_L
#undef PG8_BAR
#undef PG8_SCHED
}

struct Dense2Sched {
    const bf16_t* A1; const bf16_t* B1; int K1; const bf16_t* A2; const bf16_t* B2; int K2; int nM, nN, G, c;
    __device__ __forceinline__ bool next(int i, Unit& u) const { u.e = 0; u.r0 = 0; return static_order(i, G, c, nM, nN, u.pm, u.pn); }
};
template <class Epi>
__device__ __forceinline__ void gemm_phase2(LAS unsigned char* lds, const Dense2Sched& S, const Epi& E) {
    const int tid = opaque_v(threadIdx.x), wid = __builtin_amdgcn_readfirstlane(tid >> 6), lane = tid & 63, wr = wid >> 2, wc = wid & 3, fr = lane & 15, fq = lane >> 4;
    const int K1 = S.K1, K2 = S.K2, nt1 = K1 / BK, nt = nt1 + K2 / BK;
    unsigned vRA[2], vRB[2], vC[2];
#pragma unroll
    for (int i = 0; i < 2; ++i) { int R, C; stage_rc(tid * 16 + i * 8192, R, C); const int Rb = 64 * (R >> 5) + (Epi::PERM ? perm32(R & 31) : (R & 31)); vRA[i] = (unsigned)R * 2u; vRB[i] = (unsigned)Rb * 2u; vC[i] = (unsigned)C * 2u; }
#define PG8_VOFF(dst, vR, Kx) unsigned dst[2]; _Pragma("unroll") for (int i_ = 0; i_ < 2; ++i_) dst[i_] = (vR)[i_] * (unsigned)(Kx) + (unsigned)opaque_v((int)vC[i_])
    const size_t kstep = (size_t)(BK * 2);
    const size_t hstep1 = (size_t)HALF * K1 * 2, bhstep1 = (size_t)32 * K1 * 2, hstep2 = (size_t)HALF * K2 * 2, bhstep2 = (size_t)32 * K2 * 2;
    const unsigned ldsw = (unsigned)wid * 1024u;
    const int aoff = lds_byte(wr * 64 + fr, fq * 8), boff = lds_byte(wc * 32 + fr, fq * 8);
#define PG8_SA(b, h) (((b) * 2 + (h)) * HTB)
#define PG8_SB(b, h) ((4 + (b) * 2 + (h)) * HTB)
#define PG8_STAGE(bufoff, gbase, voff) do { _Pragma("unroll") for (int _i = 0; _i < 2; ++_i) \
        __builtin_amdgcn_global_load_lds((const unsigned*)((const char*)(gbase) + (voff)[_i]), (LAS unsigned*)(lds + (bufoff) + ldsw + _i * 8192), 16, 0, 0); } while (0)
#define PG8_LDA(dst, b, h) do { _Pragma("unroll") for (int m = 0; m < 4; ++m) _Pragma("unroll") for (int k = 0; k < 2; ++k) dst[m][k] = *(const LAS bf16x8*)(lds + PG8_SA(b, h) + aoff + m * 2048 + k * 1024); } while (0)
#define PG8_LDB(dst, b, h) do { _Pragma("unroll") for (int n = 0; n < 2; ++n) _Pragma("unroll") for (int k = 0; k < 2; ++k) dst[n][k] = *(const LAS bf16x8*)(lds + PG8_SB(b, h) + boff + n * 2048 + k * 1024); } while (0)
#define PG8_MMA(ai, bj, At, Bt) do { __builtin_amdgcn_s_setprio(1); _Pragma("unroll") for (int m = 0; m < 4; ++m) _Pragma("unroll") for (int n = 0; n < 2; ++n) _Pragma("unroll") for (int k = 0; k < 2; ++k) \
        acc[ai][bj][m][n] = __builtin_amdgcn_mfma_f32_16x16x32_bf16(Bt[n][k], At[m][k], acc[ai][bj][m][n], 0, 0, 0); __builtin_amdgcn_s_setprio(0); } while (0)
#define PG8_WAIT_V(n) asm volatile("s_waitcnt vmcnt(" #n ")" ::: "memory")
#define PG8_WAIT_L(n) asm volatile("s_waitcnt lgkmcnt(" #n ")" ::: "memory")
#define PG8_BAR __builtin_amdgcn_s_barrier()
#define PG8_SCHED __builtin_amdgcn_sched_barrier(0)
    Unit cur, nxt; int ui = 0;
    if (!S.next(0, cur)) return;
    f32x4 acc[2][2][4][2];
#pragma unroll
    for (int a = 0; a < 2; ++a)
#pragma unroll
        for (int b = 0; b < 2; ++b)
#pragma unroll
            for (int m = 0; m < 4; ++m)
#pragma unroll
                for (int n = 0; n < 2; ++n) acc[a][b][m][n] = (f32x4){0.f, 0.f, 0.f, 0.f};
    bf16x8 At[4][2], B0[2][2], B1[2][2];
    const char* cA1 = (const char*)S.A1 + (size_t)cur.pm * BM * K1 * 2; const char* cB1 = (const char*)S.B1 + (size_t)cur.pn * BM * K1 * 2;
    const char* cA2 = (const char*)S.A2 + (size_t)cur.pm * BM * K2 * 2; const char* cB2 = (const char*)S.B2 + (size_t)cur.pn * BM * K2 * 2;
    { PG8_VOFF(voffA1, vRA, K1); PG8_VOFF(voffB1, vRB, K1);
    PG8_STAGE(PG8_SB(0, 0), cB1, voffB1); PG8_STAGE(PG8_SB(0, 1), cB1 + bhstep1, voffB1); PG8_STAGE(PG8_SA(0, 0), cA1, voffA1); PG8_STAGE(PG8_SA(0, 1), cA1 + hstep1, voffA1);
    if (wr == 1) PG8_BAR;
    PG8_WAIT_V(2); PG8_BAR;
    PG8_STAGE(PG8_SB(1, 0), cB1 + kstep, voffB1); PG8_STAGE(PG8_SA(1, 0), cA1 + kstep, voffA1); PG8_STAGE(PG8_SB(1, 1), cB1 + bhstep1 + kstep, voffB1);
    PG8_WAIT_V(6); PG8_BAR; }
    for (;;) {
        const bool has_next = S.next(ui + 1, nxt);
        const char* nA1 = has_next ? (const char*)S.A1 + (size_t)nxt.pm * BM * K1 * 2 : cA1; const char* nB1 = has_next ? (const char*)S.B1 + (size_t)nxt.pn * BM * K1 * 2 : cB1;
#define PG8_TRIP2(RELAX) do { \
            const bool last = (t == nt - 2), s1c = (t < nt1), s1n = last || (t + 2 < nt1); \
            const char* ac = s1c ? cA1 + (size_t)(t + 1) * kstep + hstep1 : cA2 + (size_t)(t + 1 - nt1) * kstep + hstep2; \
            const char* an = last ? nA1 : (s1n ? cA1 + (size_t)(t + 2) * kstep : cA2 + (size_t)(t + 2 - nt1) * kstep); \
            const char* bn = last ? nB1 : (s1n ? cB1 + (size_t)(t + 2) * kstep : cB2 + (size_t)(t + 2 - nt1) * kstep); \
            const size_t hsn = s1n ? hstep1 : hstep2, bhn = s1n ? bhstep1 : bhstep2; \
            const int Kc = s1c ? K1 : K2, Kn = s1n ? K1 : K2; \
            PG8_LDB(B0, 0, 0); PG8_LDB(B1, 0, 1); PG8_SCHED; PG8_LDA(At, 0, 0); { PG8_VOFF(vac, vRA, Kc); PG8_STAGE(PG8_SA(1, 1), ac, vac); } \
            if (!(RELAX)) PG8_WAIT_V(8); PG8_WAIT_L(0); PG8_BAR; PG8_MMA(0, 0, At, B0); PG8_MMA(0, 1, At, B1); PG8_BAR; PG8_SCHED; \
            PG8_LDA(At, 0, 1); { PG8_VOFF(vbn, vRB, Kn); PG8_VOFF(van, vRA, Kn); PG8_STAGE(PG8_SB(0, 0), bn, vbn); PG8_STAGE(PG8_SB(0, 1), bn + bhn, vbn); PG8_STAGE(PG8_SA(0, 0), an, van); } \
            if (!(RELAX)) PG8_WAIT_V(8); PG8_WAIT_L(0); PG8_BAR; PG8_MMA(1, 0, At, B0); PG8_MMA(1, 1, At, B1); PG8_BAR; PG8_SCHED; \
            PG8_LDB(B0, 1, 0); PG8_LDB(B1, 1, 1); PG8_SCHED; PG8_LDA(At, 1, 0); { PG8_VOFF(van, vRA, Kn); PG8_STAGE(PG8_SA(0, 1), an + hsn, van); } \
            PG8_WAIT_V(8); PG8_WAIT_L(0); PG8_BAR; PG8_MMA(0, 0, At, B0); PG8_MMA(0, 1, At, B1); PG8_BAR; PG8_SCHED; \
            PG8_LDA(At, 1, 1); { PG8_VOFF(vbn, vRB, Kn); PG8_VOFF(van, vRA, Kn); PG8_STAGE(PG8_SB(1, 0), bn + kstep, vbn); PG8_STAGE(PG8_SB(1, 1), bn + kstep + bhn, vbn); PG8_STAGE(PG8_SA(1, 0), an + kstep, van); } \
            PG8_WAIT_V(8); PG8_WAIT_L(0); PG8_BAR; PG8_MMA(1, 0, At, B0); PG8_MMA(1, 1, At, B1); PG8_BAR; PG8_SCHED; \
        } while (0)
        int t = 0;
        if (ui > 0) { PG8_TRIP2(true); t = 2; }
        for (; t < nt1; t += 2) PG8_TRIP2(false);
        E.mid(lds, acc, cur, wr, wc, fr, fq);
        for (; t < nt; t += 2) PG8_TRIP2(false);
#undef PG8_TRIP2
        if (wr == 0) PG8_BAR;
        E(lds, acc, cur, wr, wc, fr, fq);
        if (!has_next) break;
#pragma unroll
        for (int a = 0; a < 2; ++a)
#pragma unroll
            for (int b = 0; b < 2; ++b)
#pragma unroll
                for (int m = 0; m < 4; ++m)
#pragma unroll
                    for (int n = 0; n < 2; ++n) acc[a][b][m][n] = (f32x4){0.f, 0.f, 0.f, 0.f};
        cur = nxt; cA1 = nA1; cB1 = nB1; cA2 = (const char*)S.A2 + (size_t)cur.pm * BM * K2 * 2; cB2 = (const char*)S.B2 + (size_t)cur.pn * BM * K2 * 2; ++ui;
        if (wr == 1) PG8_BAR;
    }
    PG8_WAIT_V(0);
    PG8_BAR;
#undef PG8_VOFF
#undef PG8_SA
#undef PG8_SB
#undef PG8_STAGE
#undef PG8_LDA
#undef PG8_LDB
#undef PG8_MMA
#undef PG8_WAIT_V
#undef PG8_WAIT_L
#undef PG8_BAR
#undef PG8_SCHED
}

typedef const f32x4 (&AccRef)[2][2][4][2];
constexpr int EPI_OFF = STAGE_BYTES, EPI_WSTR = 144, EPI_WBYTES = 16 * EPI_WSTR;
__device__ __forceinline__ void epi_xpose(LAS unsigned char* st, int fr, int fq, int lane, u32x4 in0, u32x4 in1, u32x4& out0, u32x4& out1) {
    *(LAS u32x4*)(st + fr * EPI_WSTR + fq * 16) = in0; *(LAS u32x4*)(st + fr * EPI_WSTR + 64 + fq * 16) = in1;
    out0 = *(const LAS u32x4*)(st + (lane >> 3) * EPI_WSTR + (lane & 7) * 16); out1 = *(const LAS u32x4*)(st + (8 + (lane >> 3)) * EPI_WSTR + (lane & 7) * 16);
}
__device__ __forceinline__ void epi_xpose1(LAS unsigned char* st, int fr, int fq, int lane, u32x4 in0, u32x4& out0) {
    *(LAS u32x4*)(st + fr * 80 + fq * 16) = in0;
    out0 = *(const LAS u32x4*)(st + (lane >> 2) * 80 + (lane & 3) * 16);
}
#define EPI_DRAIN() asm volatile("s_waitcnt vmcnt(0)" ::: "memory")
#define EPI_LOCALS() const int lane = opaque_v(fq * 16 + fr), lr = lane >> 3, lc = lane & 7;        LAS unsigned char* st = lds + EPI_OFF + (wr * 4 + wc) * EPI_WBYTES; (void)lr; (void)lc

struct EpiIn {
    static constexpr bool PERM = true;
    const float* bias; bf16_t *U, *V, *QKV, *GA, *GB; f32x2* PS;
    __device__ __forceinline__ void binit(const Unit& u, int wc, int fq, f32x4 (&bv)[2][2]) const {
#pragma unroll
        for (int bj = 0; bj < 2; ++bj)
#pragma unroll
            for (int n = 0; n < 2; ++n) bv[bj][n] = *(const f32x4*)(bias + u.pn * BM + wc * 64 + bj * 32 + 8 * fq + 4 * n);
    }
    __device__ __forceinline__ void operator()(LAS unsigned char* lds, AccRef acc, const Unit& u, int wr, int wc, int fr, int fq) const {
        EPI_LOCALS();
        const int pn = u.pn; bf16_t* base; int ldc = D, colt, act, dsh = 0;
        if (pn < 4) { base = U; colt = pn * 256; act = 1; }
        else if (pn < 8) { base = V; colt = (pn - 4) * 256; act = 1; }
        else if (pn < 26) {
            const int c0 = (pn - 8) * 256 + wc * 64; base = QKV + (size_t)(c0 >> 7) * T * 128; ldc = 128; colt = (c0 & 127) - wc * 64; act = 0; dsh = c0 >= 3072 ? 4 : c0 >= 1536 ? 2 : 0; }
        else if (pn < 30) { base = GA; colt = (pn - 26) * 256; act = 2; }
        else { base = GB; colt = (pn - 30) * 256; act = 2; }
        const int trow = u.pm * BM + wr * 64 + lr;
        bf16_t* p0 = base + colt + wc * 64 + lc * 8;
#define EPIIN_ROW(t_) ((size_t)((((t_) & ~(SEQ - 1)) | ((((t_) & ((1 << dsh) - 1)) << (12 - dsh)) + (((t_) & (SEQ - 1)) >> dsh)))) * ldc)
        const bool vstats = (pn >= 4 && pn < 8);
        f32x2* ps0 = PS + (size_t)(u.pm * BM + wr * 64 + lr) * 16 + (pn - 4) * 4 + wc;
#pragma unroll
        for (int ai = 0; ai < 2; ++ai)
#pragma unroll
            for (int m = 0; m < 4; ++m) { u32x4 w[2];
#pragma unroll
                for (int bj = 0; bj < 2; ++bj) { f32x4 v0 = acc[ai][bj][m][0], v1 = acc[ai][bj][m][1];
                    if (act == 1) { f32x2 a = gelu_pk((f32x2){v0[0], v0[1]}), b = gelu_pk((f32x2){v0[2], v0[3]}), c = gelu_pk((f32x2){v1[0], v1[1]}), d = gelu_pk((f32x2){v1[2], v1[3]});
                        v0 = (f32x4){a.x, a.y, b.x, b.y}; v1 = (f32x4){c.x, c.y, d.x, d.y}; }
                    if (act == 2) {
#pragma unroll
                        for (int j = 0; j < 4; ++j) { v0[j] = sigmoidf_(v0[j]); v1[j] = sigmoidf_(v1[j]); } }
                    w[bj].x = cvt_pk_bf16(v0[0], v0[1]); w[bj].y = cvt_pk_bf16(v0[2], v0[3]); w[bj].z = cvt_pk_bf16(v1[0], v1[1]); w[bj].w = cvt_pk_bf16(v1[2], v1[3]); }
                u32x4 o0, o1; epi_xpose(st, fr, fq, lane, w[0], w[1], o0, o1);
                if (ai == 0 && m == 0) EPI_DRAIN();
                { const int t0 = trow + ai * HALF + m * 16; bf16_t* rpa = p0 + EPIIN_ROW(t0); bf16_t* rpb = p0 + EPIIN_ROW(t0 + 8);
                  EPI_ST(u32x4, rpa, o0); EPI_ST(u32x4, rpb, o1); }
                if (vstats) {
                    float s0 = 0.f, q0 = 0.f, s1 = 0.f, q1 = 0.f;
#pragma unroll
                    for (int c = 0; c < 4; ++c) { const float a = bflo(o0[c]), b = bfhi(o0[c]), d = bflo(o1[c]), e = bfhi(o1[c]); s0 += a + b; q0 += a * a + b * b; s1 += d + e; q1 += d * d + e * e; }
#pragma unroll
                    for (int o = 1; o < 8; o <<= 1) { s0 += __shfl_xor(s0, o); q0 += __shfl_xor(q0, o); s1 += __shfl_xor(s1, o); q1 += __shfl_xor(q1, o); }
                    if (lc == 0) { ps0[(size_t)(ai * HALF + m * 16) * 16] = (f32x2){s0, q0}; ps0[(size_t)(ai * HALF + m * 16 + 8) * 16] = (f32x2){s1, q1}; } }
                asm volatile("" ::: "memory"); }
#undef EPIIN_ROW
    }
};
struct EpiT1 {
    static constexpr bool PERM = false;
    const bf16_t* GA; bf16_t* T1;
    __device__ __forceinline__ void binit(const Unit&, int, int, f32x4 (&bv)[2][2]) const { bv[0][0] = bv[0][1] = bv[1][0] = bv[1][1] = (f32x4){0.f, 0.f, 0.f, 0.f}; }
    __device__ __forceinline__ void operator()(LAS unsigned char* lds, AccRef acc, const Unit& u, int wr, int wc, int fr, int fq) const {
        EPI_LOCALS();
        const size_t o00 = (size_t)(u.pm * BM + wr * 64 + lr) * D + u.pn * BM + wc * 64 + lc * 4;
#pragma unroll
        for (int ai = 0; ai < 2; ++ai) {
            u32x2 g[4][2][2];
#pragma unroll
            for (int m = 0; m < 4; ++m)
#pragma unroll
                for (int bj = 0; bj < 2; ++bj)
#pragma unroll
                    for (int s = 0; s < 2; ++s) g[m][bj][s] = *(const u32x2*)(GA + o00 + (size_t)(ai * HALF + m * 16 + 8 * s) * D + bj * 32);
            asm volatile("" ::: "memory");
#pragma unroll
            for (int m = 0; m < 4; ++m)
#pragma unroll
                for (int bj = 0; bj < 2; ++bj) { u32x4 o[2]; epi_xpose(st, fr, fq, lane, __builtin_bit_cast(u32x4, acc[ai][bj][m][0]), __builtin_bit_cast(u32x4, acc[ai][bj][m][1]), o[0], o[1]);
#pragma unroll
                    for (int s = 0; s < 2; ++s) { const size_t off = o00 + (size_t)(ai * HALF + m * 16 + 8 * s) * D + bj * 32; const u32x2 gq = g[m][bj][s];
                        const f32x4 gv = (f32x4){bflo(gq.x), bfhi(gq.x), bflo(gq.y), bfhi(gq.y)}; const f32x4 tv = __builtin_bit_cast(f32x4, o[s]) * gv;
                        u32x2 tw; tw.x = cvt_pk_bf16(tv[0], tv[1]); tw.y = cvt_pk_bf16(tv[2], tv[3]); EPI_ST(u32x2, T1 + off, tw); } }
        }
    }
};
struct EpiMg {
    static constexpr bool PERM = false;
    const bf16_t* GB; const bf16_t* T1; bf16_t* MG;
    __device__ __forceinline__ void binit(const Unit&, int, int, f32x4 (&bv)[2][2]) const { bv[0][0] = bv[0][1] = bv[1][0] = bv[1][1] = (f32x4){0.f, 0.f, 0.f, 0.f}; }
    __device__ __forceinline__ void operator()(LAS unsigned char* lds, AccRef acc, const Unit& u, int wr, int wc, int fr, int fq) const {
        EPI_LOCALS();
        const size_t o00 = (size_t)(u.pm * BM + wr * 64 + lr) * D + u.pn * BM + wc * 64 + lc * 4;
#pragma unroll
        for (int ai = 0; ai < 2; ++ai) {
            u32x2 g[4][2][2], tq[4][2][2];
#pragma unroll
            for (int m = 0; m < 4; ++m)
#pragma unroll
                for (int bj = 0; bj < 2; ++bj)
#pragma unroll
                    for (int s = 0; s < 2; ++s) { const size_t off = o00 + (size_t)(ai * HALF + m * 16 + 8 * s) * D + bj * 32; g[m][bj][s] = *(const u32x2*)(GB + off); tq[m][bj][s] = *(const u32x2*)(T1 + off); }
            asm volatile("" ::: "memory");
#pragma unroll
            for (int m = 0; m < 4; ++m)
#pragma unroll
                for (int bj = 0; bj < 2; ++bj) { u32x4 o[2]; epi_xpose(st, fr, fq, lane, __builtin_bit_cast(u32x4, acc[ai][bj][m][0]), __builtin_bit_cast(u32x4, acc[ai][bj][m][1]), o[0], o[1]);
#pragma unroll
                    for (int s = 0; s < 2; ++s) { const size_t off = o00 + (size_t)(ai * HALF + m * 16 + 8 * s) * D + bj * 32; const u32x2 gq = g[m][bj][s], t2 = tq[m][bj][s];
                        const f32x4 t = (f32x4){bflo(t2.x), bfhi(t2.x), bflo(t2.y), bfhi(t2.y)};
                        const f32x4 v = t + __builtin_bit_cast(f32x4, o[s]) * (f32x4){bflo(gq.x), bfhi(gq.x), bflo(gq.y), bfhi(gq.y)};
                        u32x2 w; w.x = cvt_pk_bf16(v[0], v[1]); w.y = cvt_pk_bf16(v[2], v[3]); EPI_ST(u32x2, MG + off, w); } }
        }
    }
};
struct EpiMg2 {
    static constexpr bool PERM = false;
    const bf16_t* GA; const bf16_t* GB; bf16_t* MG;
    __device__ __forceinline__ void mid(LAS unsigned char* lds, f32x4 (&acc)[2][2][4][2], const Unit& u, int wr, int wc, int fr, int fq) const {
        EPI_LOCALS();
        const size_t o00 = (size_t)(u.pm * BM + wr * 64 + lr) * D + u.pn * BM + wc * 64 + lc * 4;
#pragma unroll
        for (int q = 0; q < 4; ++q) { const int ai = q >> 1, m0 = 2 * (q & 1);
            u32x2 ga[2][2][2], gb[2][2][2];
#pragma unroll
            for (int mm = 0; mm < 2; ++mm)
#pragma unroll
                for (int bj = 0; bj < 2; ++bj)
#pragma unroll
                    for (int s = 0; s < 2; ++s) { const size_t off = o00 + (size_t)(ai * HALF + (m0 + mm) * 16 + 8 * s) * D + bj * 32; ga[mm][bj][s] = *(const u32x2*)(GA + off); gb[mm][bj][s] = *(const u32x2*)(GB + off); }
            asm volatile("" ::: "memory");
#pragma unroll
            for (int mm = 0; mm < 2; ++mm)
#pragma unroll
                for (int bj = 0; bj < 2; ++bj) { const int m = m0 + mm;
#pragma unroll
                    for (int s = 0; s < 2; ++s) { const u32x2 a2 = ga[mm][bj][s], b2 = gb[mm][bj][s]; f32x4 r;
                        r[0] = bflo(a2.x) * __builtin_amdgcn_rcpf(fmaxf(bflo(b2.x), 1e-30f)); r[1] = bfhi(a2.x) * __builtin_amdgcn_rcpf(fmaxf(bfhi(b2.x), 1e-30f));
                        r[2] = bflo(a2.y) * __builtin_amdgcn_rcpf(fmaxf(bflo(b2.y), 1e-30f)); r[3] = bfhi(a2.y) * __builtin_amdgcn_rcpf(fmaxf(bfhi(b2.y), 1e-30f));
                        *(LAS f32x4*)(st + (8 * s + lr) * EPI_WSTR + lc * 16) = r; }
                    const f32x4 r0 = *(const LAS f32x4*)(st + fr * EPI_WSTR + fq * 16), r1 = *(const LAS f32x4*)(st + fr * EPI_WSTR + 64 + fq * 16);
                    acc[ai][bj][m][0] *= r0; acc[ai][bj][m][1] *= r1; }
        }
    }
    __device__ __forceinline__ void operator()(LAS unsigned char* lds, AccRef acc, const Unit& u, int wr, int wc, int fr, int fq) const {
        EPI_LOCALS();
        const size_t o00 = (size_t)(u.pm * BM + wr * 64 + lr) * D + u.pn * BM + wc * 64 + lc * 4;
#pragma unroll
        for (int ai = 0; ai < 2; ++ai) {
            u32x2 g[4][2][2];
#pragma unroll
            for (int m = 0; m < 4; ++m)
#pragma unroll
                for (int bj = 0; bj < 2; ++bj)
#pragma unroll
                    for (int s = 0; s < 2; ++s) g[m][bj][s] = *(const u32x2*)(GB + o00 + (size_t)(ai * HALF + m * 16 + 8 * s) * D + bj * 32);
            asm volatile("" ::: "memory");
#pragma unroll
            for (int m = 0; m < 4; ++m)
#pragma unroll
                for (int bj = 0; bj < 2; ++bj) { u32x4 o[2]; epi_xpose(st, fr, fq, lane, __builtin_bit_cast(u32x4, acc[ai][bj][m][0]), __builtin_bit_cast(u32x4, acc[ai][bj][m][1]), o[0], o[1]);
#pragma unroll
                    for (int s = 0; s < 2; ++s) { const size_t off = o00 + (size_t)(ai * HALF + m * 16 + 8 * s) * D + bj * 32; const u32x2 gq = g[m][bj][s];
                        const f32x4 v = __builtin_bit_cast(f32x4, o[s]) * (f32x4){bflo(gq.x), bfhi(gq.x), bflo(gq.y), bfhi(gq.y)};
                        u32x2 w; w.x = cvt_pk_bf16(v[0], v[1]); w.y = cvt_pk_bf16(v[2], v[3]); EPI_ST(u32x2, MG + off, w); } }
        }
    }
};
struct EpiWo {
    static constexpr bool PERM = false;
    const float* xa; const float* xb; const bf16_t* XBres; y1_t* XF;
    __device__ __forceinline__ void binit(const Unit&, int, int, f32x4 (&bv)[2][2]) const { bv[0][0] = bv[0][1] = bv[1][0] = bv[1][1] = (f32x4){0.f, 0.f, 0.f, 0.f}; }
    __device__ __forceinline__ void operator()(LAS unsigned char* lds, AccRef acc, const Unit& u, int wr, int wc, int fr, int fq) const {
        EPI_LOCALS();
        const size_t o00 = (size_t)(u.pm * BM + wr * 64 + lr) * D + u.pn * BM + wc * 64 + lc * 4;
        const float* xr = (u.pm * BM < TP) ? xa : xb;
#pragma unroll
        for (int ai = 0; ai < 2; ++ai) {
            f32x4 xv[4][2][2];
            if (XBres) {
                u32x2 xq[4][2][2];
#pragma unroll
                for (int m = 0; m < 4; ++m)
#pragma unroll
                    for (int bj = 0; bj < 2; ++bj)
#pragma unroll
                        for (int s = 0; s < 2; ++s) xq[m][bj][s] = *(const u32x2*)(XBres + o00 + (size_t)(ai * HALF + m * 16 + 8 * s) * D + bj * 32);
#pragma unroll
                for (int m = 0; m < 4; ++m)
#pragma unroll
                    for (int bj = 0; bj < 2; ++bj)
#pragma unroll
                        for (int s = 0; s < 2; ++s) xv[m][bj][s] = (f32x4){bflo(xq[m][bj][s].x), bfhi(xq[m][bj][s].x), bflo(xq[m][bj][s].y), bfhi(xq[m][bj][s].y)};
            } else {
#pragma unroll
                for (int m = 0; m < 4; ++m)
#pragma unroll
                    for (int bj = 0; bj < 2; ++bj)
#pragma unroll
                        for (int s = 0; s < 2; ++s) xv[m][bj][s] = *(const f32x4*)(xr + o00 + (size_t)(ai * HALF + m * 16 + 8 * s) * D + bj * 32);
            }
            asm volatile("" ::: "memory");
#pragma unroll
            for (int m = 0; m < 4; ++m)
#pragma unroll
                for (int bj = 0; bj < 2; ++bj) { u32x4 o[2]; epi_xpose(st, fr, fq, lane, __builtin_bit_cast(u32x4, acc[ai][bj][m][0]), __builtin_bit_cast(u32x4, acc[ai][bj][m][1]), o[0], o[1]);
#pragma unroll
                    for (int s = 0; s < 2; ++s) { const size_t off = o00 + (size_t)(ai * HALF + m * 16 + 8 * s) * D + bj * 32;
                        const f32x4 yv = xv[m][bj][s] * DN_ALPHA + __builtin_bit_cast(f32x4, o[s]);
#if Y1_BF16
                        { u32x2 yw; yw.x = cvt_pk_bf16(yv[0], yv[1]); yw.y = cvt_pk_bf16(yv[2], yv[3]); EPI_ST(u32x2, XF + off, yw); }
#else
                        EPI_ST(f32x4, XF + off, yv);
#endif
                    } }
        }
    }
};
struct EpiGU {
    static constexpr bool PERM = true;
    const float* bgu; bf16_t* H;
    __device__ __forceinline__ void binit(const Unit& u, int wc, int fq, f32x4 (&bv)[2][2]) const {
        const float* bg = bgu + (size_t)u.e * 2048 + u.pn * HALF + wc * 32 + 8 * fq;
        bv[0][0] = *(const f32x4*)(bg); bv[0][1] = *(const f32x4*)(bg + 4); bv[1][0] = *(const f32x4*)(bg + 1024); bv[1][1] = *(const f32x4*)(bg + 1028);
    }
    __device__ __forceinline__ void operator()(LAS unsigned char* lds, AccRef acc, const Unit& u, int wr, int wc, int fr, int fq) const {
        EPI_LOCALS();
        bf16_t* p0 = H + (size_t)(u.pm * BM + wr * 64 + (lane >> 2)) * D + u.pn * HALF + wc * 32 + (lane & 3) * 8;
#pragma unroll
        for (int ai = 0; ai < 2; ++ai)
#pragma unroll
            for (int m = 0; m < 4; ++m) {
                f32x4 g0 = acc[ai][0][m][0], g1 = acc[ai][0][m][1], u0 = acc[ai][1][m][0], u1 = acc[ai][1][m][1], h0, h1;
#pragma unroll
                for (int j = 0; j < 4; ++j) {
                    const float ga = fminf(g0[j], 7.0f), gb = fminf(g1[j], 7.0f);
                    const float ua = fminf(fmaxf(u0[j], -7.0f), 7.0f), ub = fminf(fmaxf(u1[j], -7.0f), 7.0f);
                    h0[j] = (ua + 1.0f) * ga * sigmoidf_(1.702f * ga); h1[j] = (ub + 1.0f) * gb * sigmoidf_(1.702f * gb); }
                u32x4 w; w.x = cvt_pk_bf16(h0[0], h0[1]); w.y = cvt_pk_bf16(h0[2], h0[3]); w.z = cvt_pk_bf16(h1[0], h1[1]); w.w = cvt_pk_bf16(h1[2], h1[3]);
                u32x4 o; epi_xpose1(st, fr, fq, lane, w, o);
                if (ai == 0 && m == 0) EPI_DRAIN();
                EPI_ST(u32x4, p0 + (size_t)(ai * HALF + m * 16) * D, o); asm volatile("" ::: "memory"); }
    }
};
struct EpiDown {
    static constexpr bool PERM = true;
    const float* bd; bf16_t* YK;
    __device__ __forceinline__ void binit(const Unit& u, int wc, int fq, f32x4 (&bv)[2][2]) const {
#pragma unroll
        for (int bj = 0; bj < 2; ++bj)
#pragma unroll
            for (int n = 0; n < 2; ++n) bv[bj][n] = *(const f32x4*)(bd + (size_t)u.e * D + u.pn * BM + wc * 64 + bj * 32 + 8 * fq + 4 * n);
    }
    __device__ __forceinline__ void operator()(LAS unsigned char* lds, AccRef acc, const Unit& u, int wr, int wc, int fr, int fq) const {
        EPI_LOCALS();
        bf16_t* p0 = YK + (size_t)(u.pm * BM + wr * 64 + lr) * D + u.pn * BM + wc * 64 + lc * 8;
#pragma unroll
        for (int ai = 0; ai < 2; ++ai)
#pragma unroll
            for (int m = 0; m < 4; ++m) { u32x4 w[2];
#pragma unroll
                for (int bj = 0; bj < 2; ++bj) { const f32x4 v0 = acc[ai][bj][m][0], v1 = acc[ai][bj][m][1];
                    w[bj].x = cvt_pk_bf16(v0[0], v0[1]); w[bj].y = cvt_pk_bf16(v0[2], v0[3]); w[bj].z = cvt_pk_bf16(v1[0], v1[1]); w[bj].w = cvt_pk_bf16(v1[2], v1[3]); }
                u32x4 o0, o1; epi_xpose(st, fr, fq, lane, w[0], w[1], o0, o1);
                if (ai == 0 && m == 0) EPI_DRAIN();
                bf16_t* rp = p0 + (size_t)(ai * HALF + m * 16) * D;
                EPI_ST(u32x4, rp, o0); EPI_ST(u32x4, rp + (size_t)8 * D, o1); asm volatile("" ::: "memory"); }
    }
};
}

struct Args { const float* in[21]; float* out; unsigned char* ws; int ph_lo, ph_hi, sub, pad; };
enum { I_XP = 0, I_XS, I_WIN, I_BIN, I_LNVG, I_LNVB, I_WS, I_BS, I_WPA, I_WPB, I_WO, I_LN1G, I_LN1B, I_WR, I_BR, I_WGU, I_BGU, I_WD, I_BD, I_LN2G, I_LN2B };

__device__ __forceinline__ void tr_item(const float* W, int K, int N, bf16_t* WT, int k0, int n0, int nd0, LAS unsigned* scr, int lane, int ndhi = 32) {
    const int i = lane & 15, kp = lane >> 4;
    f32x4 a[8], b[8];
#pragma unroll
    for (int it = 0; it < 8; ++it) { const int k = it * 8 + kp * 2; a[it] = *(const f32x4*)(W + (size_t)(k0 + k) * N + n0 + 4 * i); b[it] = *(const f32x4*)(W + (size_t)(k0 + k + 1) * N + n0 + 4 * i); }
#pragma unroll
    for (int it = 0; it < 8; ++it) {
#pragma unroll
        for (int j = 0; j < 4; ++j) scr[(4 * i + j) * 33 + it * 4 + kp] = pk2(a[it][j], b[it][j]); }
    asm volatile("s_waitcnt lgkmcnt(0)" ::: "memory");
    const int nn = lane >> 3, c = lane & 7;
#pragma unroll
    for (int j = 0; j < 8; ++j) { const int n = nn + 8 * j; u32x4 o; o.x = scr[n * 33 + 4 * c]; o.y = scr[n * 33 + 4 * c + 1]; o.z = scr[n * 33 + 4 * c + 2]; o.w = scr[n * 33 + 4 * c + 3];
        *(u32x4*)(WT + (size_t)(nd0 + (n & 31) + (n >> 5) * ndhi) * K + k0 + 8 * c) = o; }
    asm volatile("s_waitcnt lgkmcnt(0)" ::: "memory");
}
__device__ __forceinline__ void p0_prologue(const Args& a, LAS unsigned char* lds, int G) {
    const int tid = opaque_v(threadIdx.x), lane = tid & 63, wave = tid >> 6;
    LAS unsigned* scr = (LAS unsigned*)(lds + wave * 8704);
    const int gw = blockIdx.x * 8 + wave, NGW = G * 8;
    unsigned char* ws = a.ws;
    constexpr int I_GU = DEPTH * NE * 16 * 32, I_D = DEPTH * NE * 16 * 16, I_IN = DEPTH * 16 * 136, I_PA = DEPTH * 256, I_PB = DEPTH * 8 * 16, I_O = DEPTH * 256;
    constexpr int NITEMS = I_GU + I_D + I_IN + I_PA + I_PB + I_O;
    for (int it = gw; it < NITEMS; it += NGW) {
        int r = it;
        if (r < I_GU) { const int mat = r / 512, q = r % 512, kb = q / 32, nb = q % 32, n0 = nb * 64, c = n0 & 1023, nd0 = (c >> 7) * 256 + ((c & 127) >> 5) * 64 + ((n0 >= 1024) ? 32 : 0);
            tr_item(a.in[I_WGU] + (size_t)mat * 1024 * 2048, 1024, 2048, (bf16_t*)(ws + WS_WGU) + (size_t)mat * 2048 * 1024, kb * 64, n0, nd0, scr, lane, 64); continue; }
        r -= I_GU;
        if (r < I_D) { const int mat = r / 256, q = r % 256, kb = q / 16, nb = q % 16;
            tr_item(a.in[I_WD] + (size_t)mat * 1024 * 1024, 1024, 1024, (bf16_t*)(ws + WS_WD) + (size_t)mat * 1024 * 1024, kb * 64, nb * 64, nb * 64, scr, lane); continue; }
        r -= I_D;
        if (r < I_IN) { const int mat = r / (16 * 136), q = r % (16 * 136), kb = q / 136, nb = q % 136;
            tr_item(a.in[I_WIN] + (size_t)mat * 1024 * DIN, 1024, DIN, (bf16_t*)(ws + WS_WIN) + (size_t)mat * DIN * 1024, kb * 64, nb * 64, nb * 64, scr, lane); continue; }
        r -= I_IN;
        if (r < I_PA) { const int mat = r / 256, q = r % 256, kb = q / 16, nb = q % 16;
            tr_item(a.in[I_WPA] + (size_t)mat * 1024 * 1024, 1024, 1024, (bf16_t*)(ws + WS_WPA) + (size_t)mat * 1024 * 1024, kb * 64, nb * 64, nb * 64, scr, lane); continue; }
        r -= I_PA;
        if (r < I_PB) { const int mat = r / 128, q = r % 128, kb = q / 16, nb = q % 16;
            tr_item(a.in[I_WPB] + (size_t)mat * 512 * 1024, 512, 1024, (bf16_t*)(ws + WS_WPB) + (size_t)mat * 1024 * 512, kb * 64, nb * 64, nb * 64, scr, lane); continue; }
        r -= I_PB;
        { const int mat = r / 256, q = r % 256, kb = q / 16, nb = q % 16;
            tr_item(a.in[I_WO] + (size_t)mat * 1024 * 1024, 1024, 1024, (bf16_t*)(ws + WS_WO) + (size_t)mat * 1024 * 1024, kb * 64, nb * 64, nb * 64, scr, lane); }
    }
    const size_t gt = (size_t)blockIdx.x * 512 + tid, NGT = (size_t)G * 512;
    { float* prm = (float*)(ws + WS_PRM);
#define CPY(idx, off, n) for (size_t i = gt; i < (size_t)(n) / 4; i += NGT) *(f32x4*)(prm + (off) + i * 4) = *(const f32x4*)(a.in[idx] + i * 4)
      CPY(I_BIN, PR_BIN, DEPTH * DIN); CPY(I_LNVG, PR_LNVG, DEPTH * D); CPY(I_LNVB, PR_LNVB, DEPTH * D); CPY(I_BS, PR_BS, DEPTH * D); CPY(I_LN1G, PR_LN1G, DEPTH * D); CPY(I_LN1B, PR_LN1B, DEPTH * D);
      CPY(I_WR, PR_WR, DEPTH * D * NE); CPY(I_BR, PR_BR, DEPTH * NE); CPY(I_BGU, PR_BGU, DEPTH * NE * 2048); CPY(I_BD, PR_BD, DEPTH * NE * D); CPY(I_LN2G, PR_LN2G, DEPTH * D); CPY(I_LN2B, PR_LN2B, DEPTH * D);
#undef CPY
    }
    { const float* src = a.in[I_WR]; bf16_t* img = (bf16_t*)(ws + WS_WRI);
      for (size_t i = gt; i < (size_t)DEPTH * D * NE; i += NGT) { const int l = (int)(i >> 15), k = (int)(i >> 5) & 1023, e = (int)i & 31; const float v = src[i]; const unsigned h = f2bf(v), lo = f2bf(v - __builtin_bit_cast(float, h << 16));
          img[(size_t)l * 65536 + e * 1024 + k] = (bf16_t)h; img[(size_t)l * 65536 + 32768 + e * 1024 + k] = (bf16_t)lo; } }
    { const float* src = a.in[I_WS]; bf16_t* dst = (bf16_t*)(ws + WS_WS);
      for (size_t i = gt; i < (size_t)DEPTH * 8 * 128 * 128 / 8; i += NGT) { const f32x4 x = *(const f32x4*)(src + i * 8), y = *(const f32x4*)(src + i * 8 + 4);
          u32x4 o; o.x = pk2(x[0], x[1]); o.y = pk2(x[2], x[3]); o.z = pk2(y[0], y[1]); o.w = pk2(y[2], y[3]); *(u32x4*)(dst + i * 8) = o; } }
    { bf16_t* dst = (bf16_t*)(ws + WS_XB);
      for (size_t i = gt; i < (size_t)T * D / 8; i += NGT) { const size_t e = i * 8; const float* src = (e < (size_t)TP * D) ? a.in[I_XP] + e : a.in[I_XS] + (e - (size_t)TP * D);
          const f32x4 x = *(const f32x4*)(src), y = *(const f32x4*)(src + 4);
          u32x4 o; o.x = pk2(x[0], x[1]); o.y = pk2(x[2], x[3]); o.z = pk2(y[0], y[1]); o.w = pk2(y[2], y[3]); *(u32x4*)(dst + e) = o; } }
}

template <int BASE> __device__ __forceinline__ void tr8(unsigned addr, s16x4 (&r)[8]) {
    asm volatile("ds_read_b64_tr_b16 %0, %8 offset:%9\n\tds_read_b64_tr_b16 %1, %8 offset:%10\n\tds_read_b64_tr_b16 %2, %8 offset:%11\n\tds_read_b64_tr_b16 %3, %8 offset:%12\n\t"
                 "ds_read_b64_tr_b16 %4, %8 offset:%13\n\tds_read_b64_tr_b16 %5, %8 offset:%14\n\tds_read_b64_tr_b16 %6, %8 offset:%15\n\tds_read_b64_tr_b16 %7, %8 offset:%16\n\t"
                 : "=&v"(r[0]), "=&v"(r[1]), "=&v"(r[2]), "=&v"(r[3]), "=&v"(r[4]), "=&v"(r[5]), "=&v"(r[6]), "=&v"(r[7])
                 : "v"(addr), "n"(BASE), "n"(BASE + 32), "n"(BASE + 64), "n"(BASE + 96), "n"(BASE + 128), "n"(BASE + 160), "n"(BASE + 192), "n"(BASE + 224) : "memory");
}
__device__ __forceinline__ bf16x8 cat4(s16x4 a, s16x4 b) { return (bf16x8){a[0], a[1], a[2], a[3], b[0], b[1], b[2], b[3]}; }

constexpr int AT_KSTR = 272, AT_VSTR = 288, AT_KBYTES = 256 * AT_KSTR, AT_VOFF = AT_KBYTES, AT_VBYTES = 256 * AT_VSTR;
constexpr int AT_EPI_OFF = AT_VOFF + AT_VBYTES;
static_assert(AT_EPI_OFF + 8 * 2304 <= SCR_BYTES, "attention LDS");

template <int ST> __device__ __forceinline__ void attn_pv_step(unsigned vaddr, const f32x4 (&s)[9], f32x4 (&o)[8]) {
    s16x4 r0[8], r1[8];
    tr8<ST * 32 * AT_VSTR>(vaddr, r0);
    tr8<ST * 32 * AT_VSTR + (ST < 4 ? 16 * AT_VSTR : 0)>(vaddr, r1);
    asm volatile("s_waitcnt lgkmcnt(0)" ::: "memory");
    __builtin_amdgcn_sched_barrier(0);
    u32x4 pw; pw.x = cvt_pk_bf16(s[2 * ST][0], s[2 * ST][1]); pw.y = cvt_pk_bf16(s[2 * ST][2], s[2 * ST][3]);
    if (ST < 4) { pw.z = cvt_pk_bf16(s[2 * ST + (ST < 4 ? 1 : 0)][0], s[2 * ST + (ST < 4 ? 1 : 0)][1]); pw.w = cvt_pk_bf16(s[2 * ST + (ST < 4 ? 1 : 0)][2], s[2 * ST + (ST < 4 ? 1 : 0)][3]); }
    else { pw.z = 0u; pw.w = 0u; }
    const bf16x8 pf = __builtin_bit_cast(bf16x8, pw);
#pragma unroll
    for (int db = 0; db < 8; ++db) o[db] = __builtin_amdgcn_mfma_f32_16x16x32_bf16(cat4(r0[db], r1[db]), pf, o[db], 0, 0, 0);
}

__device__ __forceinline__ void attn_load(const bf16_t* QKV, int unit, int tid, u32x4 (&kr)[8], u32x4 (&vr)[8]) {
    const int wsub = unit & 31, h = (unit >> 5) & 3, bg = unit >> 7, g = bg % 3, b = bg / 3;
    const int dsh = 2 * g, dil = 1 << dsh, L = SEQ >> dsh, nblk = L >> 7, r = wsub / nblk, blk = wsub % nblk, p0 = blk * 128;
    const bf16_t* Kp = QKV + ((size_t)(g * 12 + 4 + h) * T + (size_t)(b * SEQ + r * L)) * 128; const bf16_t* Vp = Kp + (size_t)4 * T * 128;
    (void)dil;
#pragma unroll
    for (int j = 0; j < 8; ++j) { const int id = tid + 512 * j, kk = id >> 4, ch = id & 15, pk = p0 - 64 + kk; const bool ok = pk >= 0 && pk < L;
        const size_t ro = (size_t)(ok ? pk : 0) * 128 + ch * 8; const u32x4 kx = *(const u32x4*)(Kp + ro), vx = *(const u32x4*)(Vp + ro);
        kr[j] = ok ? kx : (u32x4){0u, 0u, 0u, 0u}; vr[j] = ok ? vx : (u32x4){0u, 0u, 0u, 0u}; }
}
__device__ __forceinline__ void attn_unit(LAS unsigned char* lds, const bf16_t* QKV, bf16_t* OG, float* LSE, int unit, int unit_next, u32x4 (&kr)[8], u32x4 (&vr)[8]) {
    const int tid = opaque_v(threadIdx.x), lane = tid & 63, w = tid >> 6, ql = lane & 15, quad = lane >> 4;
    const int wsub = unit & 31, h = (unit >> 5) & 3, bg = unit >> 7, g = bg % 3, b = bg / 3;
    const int dsh = 2 * g, dil = 1 << dsh, L = SEQ >> dsh, nblk = L >> 7, r = wsub / nblk, blk = wsub % nblk, p0 = blk * 128;
    const float slope = __builtin_amdgcn_exp2f(-(2.0f / 3.0f) * (float)(4 * g + h + 1));
    const float ca = slope * (float)dil * LOG2E, SC = 0.08838834764831845f * LOG2E;
#pragma unroll
    for (int j = 0; j < 8; ++j) { const int id = tid + 512 * j, kk = id >> 4, ch = id & 15;
        *(LAS u32x4*)(lds + kk * AT_KSTR + ch * 16) = kr[j]; *(LAS u32x4*)(lds + AT_VOFF + kk * AT_VSTR + ch * 16) = vr[j]; }
    const int qrow = b * SEQ + (p0 + 16 * w + ql) * dil + r;
    bf16x8 qf[4];
#pragma unroll
    for (int ks = 0; ks < 4; ++ks) qf[ks] = *(const bf16x8*)(QKV + ((size_t)(g * 12 + h) * T + (size_t)(b * SEQ + r * L + p0 + 16 * w + ql)) * 128 + 32 * ks + 8 * quad);
    __syncthreads();
    asm volatile("" : "+v"(qf[0]), "+v"(qf[1]), "+v"(qf[2]), "+v"(qf[3]));
    attn_load(QKV, unit_next >= 0 ? unit_next : unit, tid, kr, vr);
    f32x4 s[9];
#pragma unroll
    for (int j = 0; j < 9; ++j) { s[j] = (f32x4){0.f, 0.f, 0.f, 0.f};
#pragma unroll
        for (int ks = 0; ks < 4; ++ks) { const bf16x8 kf = *(const LAS bf16x8*)(lds + (16 * w + 16 * j + ql) * AT_KSTR + (32 * ks + 8 * quad) * 2);
            s[j] = __builtin_amdgcn_mfma_f32_16x16x32_bf16(kf, qf[ks], s[j], 0, 0, 0); } }
    float mx = -1e30f;
#pragma unroll
    for (int j = 0; j < 9; ++j)
#pragma unroll
        for (int i = 0; i < 4; ++i) { const int rel = 16 * j + 4 * quad + i - 64 - ql, pk = p0 + 16 * w + ql + rel, ar = rel < 0 ? -rel : rel;
            const bool ok = (ar <= 64) && (pk >= 0) && (pk < L);
            const float v = ok ? (s[j][i] * SC - ca * (float)ar) : -1e30f; s[j][i] = v; mx = fmaxf(mx, v); }
    mx = fmaxf(mx, __shfl_xor(mx, 16)); mx = fmaxf(mx, __shfl_xor(mx, 32));
    float den = 0.f;
#pragma unroll
    for (int j = 0; j < 9; ++j)
#pragma unroll
        for (int i = 0; i < 4; ++i) { const float p = __builtin_amdgcn_exp2f(s[j][i] - mx); s[j][i] = p; den += p; }
    den += __shfl_xor(den, 16); den += __shfl_xor(den, 32);
    f32x4 o[8];
#pragma unroll
    for (int db = 0; db < 8; ++db) o[db] = (f32x4){0.f, 0.f, 0.f, 0.f};
    const unsigned vaddr = (unsigned)(uintptr_t)(lds + AT_VOFF) + (unsigned)((16 * w + 4 * quad + (ql >> 2)) * AT_VSTR + (ql & 3) * 8);
    attn_pv_step<0>(vaddr, s, o); attn_pv_step<1>(vaddr, s, o); attn_pv_step<2>(vaddr, s, o); attn_pv_step<3>(vaddr, s, o); attn_pv_step<4>(vaddr, s, o);
    const float inv = 1.0f / den;
    {
        LAS unsigned char* st = lds + AT_EPI_OFF + w * 2304;
        const int lr = lane >> 3, lc = lane & 7;
        bf16_t* od0 = OG + ((size_t)g * T + (size_t)(b * SEQ + (p0 + 16 * w + lr) * dil + r)) * 512 + h * 128 + lc * 8;
        bf16_t* od1 = OG + ((size_t)g * T + (size_t)(b * SEQ + (p0 + 16 * w + 8 + lr) * dil + r)) * 512 + h * 128 + lc * 8;
#pragma unroll
        for (int hh = 0; hh < 2; ++hh) {
#pragma unroll
            for (int d4 = 0; d4 < 4; ++d4) { const int db = 4 * hh + d4; u32x2 wv; wv.x = cvt_pk_bf16(o[db][0] * inv, o[db][1] * inv); wv.y = cvt_pk_bf16(o[db][2] * inv, o[db][3] * inv);
                *(LAS u32x2*)(st + ql * 144 + d4 * 32 + quad * 8) = wv; }
            const u32x4 r0 = *(const LAS u32x4*)(st + lr * 144 + lc * 16), r1 = *(const LAS u32x4*)(st + (8 + lr) * 144 + lc * 16);
            __builtin_nontemporal_store(r0, (u32x4*)(od0 + hh * 64)); __builtin_nontemporal_store(r1, (u32x4*)(od1 + hh * 64));
        }
    }
    if (quad == 0) LSE[((size_t)g * T + qrow) * 4 + h] = (mx + __builtin_amdgcn_logf(den)) * LN2;
    __syncthreads();
}

constexpr int SG_STR = 288, SG_TILE = 128 * SG_STR, SG_STATS = 2 * SG_TILE, SG_EPI_OFF = SG_STATS + 1024, SG_EPI_WBYTES = 16 * 528;
static_assert(SG_EPI_OFF + 8 * SG_EPI_WBYTES <= SCR_BYTES, "spatial gating LDS");
template <int KS> __device__ __forceinline__ void sg_step(unsigned vaddr, const bf16x8 wf, f32x4 (&acc)[8]) {
    s16x4 r0[8], r1[8];
    tr8<KS * 32 * SG_STR>(vaddr, r0);
    tr8<KS * 32 * SG_STR + 4 * SG_STR>(vaddr, r1);
    asm volatile("s_waitcnt lgkmcnt(0)" ::: "memory");
    __builtin_amdgcn_sched_barrier(0);
#pragma unroll
    for (int cb = 0; cb < 8; ++cb) acc[cb] = __builtin_amdgcn_mfma_f32_16x16x32_bf16(cat4(r0[cb], r1[cb]), wf, acc[cb], 0, 0, 0);
}
__device__ __forceinline__ void sg_unit(LAS unsigned char* lds, const bf16_t* U, const bf16_t* V, bf16_t* AOUT, const bf16_t* WsB, const float* bs, const float* lng, const float* lnb, const f32x2* PS, int unit) {
    const int tid = opaque_v(threadIdx.x), lane = tid & 63, w = tid >> 6, ql = lane & 15, quad = lane >> 4;
    const int ci = unit >> 1, hh = unit & 1, row0 = ci * 128;
    LAS float* stats = (LAS float*)(lds + SG_STATS);
    { const int row = tid >> 2, part = tid & 3; const f32x4 pa = *(const f32x4*)(PS + (size_t)(row0 + row) * 16 + part * 4), pb = *(const f32x4*)(PS + (size_t)(row0 + row) * 16 + part * 4 + 2);
      float sm = (pa[0] + pa[2]) + (pb[0] + pb[2]), sq = (pa[1] + pa[3]) + (pb[1] + pb[3]);
      sm += __shfl_xor(sm, 1); sq += __shfl_xor(sq, 1); sm += __shfl_xor(sm, 2); sq += __shfl_xor(sq, 2);
      const float mean = sm * (1.0f / D), rstd = 1.0f / sqrtf(fmaxf(sq * (1.0f / D) - mean * mean, 0.f) + LN_EPS);
      if (part == 0) { stats[2 * row] = mean; stats[2 * row + 1] = rstd; } }
    __syncthreads();
    const int ch = tid & 15;
    u32x4 vt[4]; bf16x8 wf[4]; f32x4 gab[4];
#define SG_LOADG(GI) do { const int g_ = 4 * hh + (GI); \
        _Pragma("unroll") for (int j = 0; j < 4; ++j) vt[j] = *(const u32x4*)(V + (size_t)(row0 + (tid >> 4) + 32 * j) * D + g_ * 128 + ch * 8); \
        gab[0] = *(const f32x4*)(lng + g_ * 128 + ch * 8); gab[1] = *(const f32x4*)(lng + g_ * 128 + ch * 8 + 4); gab[2] = *(const f32x4*)(lnb + g_ * 128 + ch * 8); gab[3] = *(const f32x4*)(lnb + g_ * 128 + ch * 8 + 4); \
        const bf16_t* Wg_ = WsB + (size_t)g_ * 128 * 128 + (size_t)(16 * w + ql) * 128 + 8 * quad; \
        _Pragma("unroll") for (int ks = 0; ks < 4; ++ks) wf[ks] = *(const bf16x8*)(Wg_ + 32 * ks); } while (0)
    SG_LOADG(0);
#pragma unroll 1
    for (int gi = 0; gi < 4; ++gi) {
        const int g = 4 * hh + gi; LAS unsigned char* tile = lds + (gi & 1) * SG_TILE;
#pragma unroll
        for (int j = 0; j < 4; ++j) { const int sr = (tid >> 4) + 32 * j; const u32x4 x = vt[j];
            const float mean = stats[2 * sr], rstd = stats[2 * sr + 1];
            const f32x4 a = ((f32x4){bflo(x.x), bfhi(x.x), bflo(x.y), bfhi(x.y)} - mean) * rstd * gab[0] + gab[2], bq = ((f32x4){bflo(x.z), bfhi(x.z), bflo(x.w), bfhi(x.w)} - mean) * rstd * gab[1] + gab[3];
            u32x4 o; o.x = cvt_pk_bf16(a[0], a[1]); o.y = cvt_pk_bf16(a[2], a[3]); o.z = cvt_pk_bf16(bq[0], bq[1]); o.w = cvt_pk_bf16(bq[2], bq[3]);
            *(LAS u32x4*)(tile + sr * SG_STR + ch * 16) = o; }
        bf16x8 wfc[4];
#pragma unroll
        for (int ks = 0; ks < 4; ++ks) { wfc[ks] = wf[ks]; asm volatile("" : "+v"(wfc[ks])); }
        __syncthreads();
        const size_t off = (size_t)(row0 + 16 * w + (lane >> 5)) * D + g * 128 + 4 * (lane & 31);
        u32x2 uu[8];
#pragma unroll
        for (int it = 0; it < 8; ++it) uu[it] = *(const u32x2*)(U + off + (size_t)(2 * it) * D);
        SG_LOADG(gi < 3 ? gi + 1 : 3);
        f32x4 acc[8];
#pragma unroll
        for (int cb = 0; cb < 8; ++cb) acc[cb] = (f32x4){0.f, 0.f, 0.f, 0.f};
        const unsigned vaddr = (unsigned)(uintptr_t)tile + (unsigned)((8 * quad + (ql >> 2)) * SG_STR + (ql & 3) * 8);
        sg_step<0>(vaddr, wfc[0], acc); sg_step<1>(vaddr, wfc[1], acc); sg_step<2>(vaddr, wfc[2], acc); sg_step<3>(vaddr, wfc[3], acc);
        const int t = 16 * w + ql; const float bst = bs[g * 128 + t];
        LAS unsigned char* st = lds + SG_EPI_OFF + w * SG_EPI_WBYTES;
#pragma unroll
        for (int cb = 0; cb < 8; ++cb) *(LAS f32x4*)(st + ql * 528 + 64 * cb + 16 * quad) = acc[cb] + bst;
#pragma unroll
        for (int it = 0; it < 8; ++it) { const f32x4 mv = *(const LAS f32x4*)(st + (2 * it + (lane >> 5)) * 528 + (lane & 31) * 16);
            u32x2 o; o.x = cvt_pk_bf16(bflo(uu[it].x) * mv[0], bfhi(uu[it].x) * mv[1]); o.y = cvt_pk_bf16(bflo(uu[it].y) * mv[2], bfhi(uu[it].y) * mv[3]);
            __builtin_nontemporal_store(o, (u32x2*)(AOUT + off + (size_t)(2 * it) * D)); }
    }
#undef SG_LOADG
    __syncthreads();
}

__device__ __forceinline__ void merge_phase(const bf16_t* OG, const float* LSE, bf16_t* BOUT, int G) {
    const int tid = opaque_v(threadIdx.x), lane = tid & 63, gw = blockIdx.x * 8 + (tid >> 6), NGW = G * 8, hd = lane >> 4;
    for (int row = gw; row < T; row += NGW) {
        const float l0 = LSE[((size_t)0 * T + row) * 4 + hd], l1 = LSE[((size_t)1 * T + row) * 4 + hd], l2 = LSE[((size_t)2 * T + row) * 4 + hd];
        const float m = fmaxf(l0, fmaxf(l1, l2));
        float w0 = __builtin_amdgcn_exp2f((l0 - m) * LOG2E), w1 = __builtin_amdgcn_exp2f((l1 - m) * LOG2E), w2 = __builtin_amdgcn_exp2f((l2 - m) * LOG2E);
        const float inv = 1.0f / (w0 + w1 + w2); w0 *= inv; w1 *= inv; w2 *= inv;
        const u32x4 a = *(const u32x4*)(OG + ((size_t)0 * T + row) * 512 + lane * 8), b = *(const u32x4*)(OG + ((size_t)1 * T + row) * 512 + lane * 8), c = *(const u32x4*)(OG + ((size_t)2 * T + row) * 512 + lane * 8);
        u32x4 o;
        o.x = cvt_pk_bf16(w0 * bflo(a.x) + w1 * bflo(b.x) + w2 * bflo(c.x), w0 * bfhi(a.x) + w1 * bfhi(b.x) + w2 * bfhi(c.x));
        o.y = cvt_pk_bf16(w0 * bflo(a.y) + w1 * bflo(b.y) + w2 * bflo(c.y), w0 * bfhi(a.y) + w1 * bfhi(b.y) + w2 * bfhi(c.y));
        o.z = cvt_pk_bf16(w0 * bflo(a.z) + w1 * bflo(b.z) + w2 * bflo(c.z), w0 * bfhi(a.z) + w1 * bfhi(b.z) + w2 * bfhi(c.z));
        o.w = cvt_pk_bf16(w0 * bflo(a.w) + w1 * bflo(b.w) + w2 * bflo(c.w), w0 * bfhi(a.w) + w1 * bfhi(b.w) + w2 * bfhi(c.w));
        __builtin_nontemporal_store(o, (u32x4*)(BOUT + (size_t)row * 512 + lane * 8));
    }
}

constexpr int RT_WSTR = 2064, RT_WL = 32 * RT_WSTR, RT_GB = 2 * RT_WL, RT_ST = RT_GB + 8192, RT_STW = 2560;
static_assert(RT_ST + 8 * RT_STW <= SCR_BYTES, "router LDS");
#if !Y1_BF16
#error "P5 keeps a wave's rows in registers: it needs the bf16 y1"
#endif
#define P5_UNPK(q) ((f32x4){bflo((q).x), bfhi((q).x), bflo((q).y), bfhi((q).y)})
template <bool HASB> __device__ __forceinline__ void p5_tile(LAS unsigned char* lds, u32x2 (&ra)[32], u32x2 (&rb)[32], bool liveA, bool liveB, int rowA, int rowB, f32x2* RS, bf16_t* XB,
                                                             int lane_, int w, const float (&bre)[8], float (&lg)[8]) {
    const int lane = opaque_v(lane_), r = lane & 15, quad = lane >> 4, lr = lane >> 3, lc = lane & 7;
    float smA = 0.f, sqA = 0.f, smB = 0.f, sqB = 0.f;
#pragma unroll
    for (int s = 0; s < 32; ++s) { const f32x4 a = P5_UNPK(ra[s]);
        smA += (a[0] + a[1]) + (a[2] + a[3]); sqA += (a[0] * a[0] + a[1] * a[1]) + (a[2] * a[2] + a[3] * a[3]);
        if (HASB) { const f32x4 b = P5_UNPK(rb[s]); smB += (b[0] + b[1]) + (b[2] + b[3]); sqB += (b[0] * b[0] + b[1] * b[1]) + (b[2] * b[2] + b[3] * b[3]); } }
#pragma unroll
    for (int o = 1; o < 8; o <<= 1) { smA += __shfl_xor(smA, o); sqA += __shfl_xor(sqA, o); if (HASB) { smB += __shfl_xor(smB, o); sqB += __shfl_xor(sqB, o); } }
    const float meanA = smA * (1.0f / D), rstdA = 1.0f / sqrtf(fmaxf(sqA * (1.0f / D) - meanA * meanA, 0.f) + LN_EPS);
    const float meanB = smB * (1.0f / D), rstdB = 1.0f / sqrtf(fmaxf(sqB * (1.0f / D) - meanB * meanB, 0.f) + LN_EPS);
    if (lc == 0) { if (liveA) RS[rowA] = (f32x2){meanA, rstdA}; if (HASB && liveB) RS[rowB] = (f32x2){meanB, rstdB}; }
#pragma unroll
    for (int s = 0; s < 32; ++s) { asm volatile("" : "+v"(ra[s])); if (HASB) asm volatile("" : "+v"(rb[s])); }
    f32x4 acc[2] = {(f32x4){0.f, 0.f, 0.f, 0.f}, (f32x4){0.f, 0.f, 0.f, 0.f}};
    const LAS unsigned char* wp = lds + r * RT_WSTR + 16 * quad;
    LAS unsigned char* stw = lds + RT_ST + w * RT_STW;
    const LAS float* gl = (const LAS float*)(lds + RT_GB) + 4 * lc; const LAS float* bl = gl + 1024;
    bf16_t* xoA = XB + (size_t)rowA * D + 4 * lc; bf16_t* xoB = XB + (size_t)rowB * D + 4 * lc;
#pragma unroll
    for (int s = 0; s < 32; ++s) {
        const f32x4 a = P5_UNPK(ra[s]);
        const f32x4 gv = *(const LAS f32x4*)(gl + 32 * s), bv = *(const LAS f32x4*)(bl + 32 * s);
        const f32x4 xa = (a - meanA) * rstdA * gv + bv;
        u32x2 ha, la;
        ha.x = cvt_pk_bf16(xa[0], xa[1]); ha.y = cvt_pk_bf16(xa[2], xa[3]);
        la.x = cvt_pk_bf16(xa[0] - bflo(ha.x), xa[1] - bfhi(ha.x)); la.y = cvt_pk_bf16(xa[2] - bflo(ha.y), xa[3] - bfhi(ha.y));
        if (liveA) *(u32x2*)(xoA + 32 * s) = ha;
        *(LAS u32x2*)(stw + lr * 80 + lc * 8) = ha; *(LAS u32x2*)(stw + 1280 + lr * 80 + lc * 8) = la;
        if (HASB) { const f32x4 b = P5_UNPK(rb[s]); const f32x4 xb = (b - meanB) * rstdB * gv + bv; u32x2 hb, lb;
            hb.x = cvt_pk_bf16(xb[0], xb[1]); hb.y = cvt_pk_bf16(xb[2], xb[3]); lb.x = cvt_pk_bf16(xb[0] - bflo(hb.x), xb[1] - bfhi(hb.x)); lb.y = cvt_pk_bf16(xb[2] - bflo(hb.y), xb[3] - bfhi(hb.y));
            if (liveB) *(u32x2*)(xoB + 32 * s) = hb;
            *(LAS u32x2*)(stw + (8 + lr) * 80 + lc * 8) = hb; *(LAS u32x2*)(stw + 1280 + (8 + lr) * 80 + lc * 8) = lb; }
        const bf16x8 xh = *(const LAS bf16x8*)(stw + r * 80 + quad * 16), xl = *(const LAS bf16x8*)(stw + 1280 + r * 80 + quad * 16);
#pragma unroll
        for (int eb = 0; eb < 2; ++eb) { const bf16x8 wh = *(const LAS bf16x8*)(wp + eb * 16 * RT_WSTR + 64 * s), wl = *(const LAS bf16x8*)(wp + RT_WL + eb * 16 * RT_WSTR + 64 * s);
            acc[eb] = __builtin_amdgcn_mfma_f32_16x16x32_bf16(wh, xh, acc[eb], 0, 0, 0); acc[eb] = __builtin_amdgcn_mfma_f32_16x16x32_bf16(wh, xl, acc[eb], 0, 0, 0); acc[eb] = __builtin_amdgcn_mfma_f32_16x16x32_bf16(wl, xh, acc[eb], 0, 0, 0); }
    }
#pragma unroll
    for (int eb = 0; eb < 2; ++eb)
#pragma unroll
        for (int i = 0; i < 4; ++i) lg[eb * 4 + i] = acc[eb][i] + bre[eb * 4 + i];
}
__device__ __forceinline__ void p5_route(float (&lg)[8], bool live, int row, int lane_, int tid_, volatile LAS unsigned* lcnt, volatile LAS unsigned* gbase, unsigned* gcnt, int* tokList, int* tokE, int* tokPos, float* gate) {
    const int lane = opaque_v(lane_), tid = opaque_v(tid_), quad = lane >> 4;
    float tv[4]; int ti[4];
#pragma unroll
    for (int k = 0; k < 4; ++k) { float bvv = lg[0]; int bi = 4 * quad;
#pragma unroll
        for (int j = 1; j < 8; ++j) { const int ej = 16 * (j >> 2) + 4 * quad + (j & 3); if (lg[j] > bvv) { bvv = lg[j]; bi = ej; } }
#pragma unroll
        for (int o = 16; o < 64; o <<= 1) { const float ov = __shfl_xor(bvv, o); const int oi = __shfl_xor(bi, o); if (ov > bvv || (ov == bvv && oi < bi)) { bvv = ov; bi = oi; } }
        tv[k] = bvv; ti[k] = bi;
#pragma unroll
        for (int j = 0; j < 8; ++j) { const int ej = 16 * (j >> 2) + 4 * quad + (j & 3); if (ej == bi) lg[j] = -3.0e38f; } }
    const float e1 = __builtin_amdgcn_exp2f((tv[1] - tv[0]) * LOG2E), e2 = __builtin_amdgcn_exp2f((tv[2] - tv[0]) * LOG2E), e3 = __builtin_amdgcn_exp2f((tv[3] - tv[0]) * LOG2E);
    const float inv = 1.0f / (1.0f + e1 + e2 + e3);
    const int ek = quad == 0 ? ti[0] : quad == 1 ? ti[1] : quad == 2 ? ti[2] : ti[3]; const float gk = (quad == 0 ? 1.0f : quad == 1 ? e1 : quad == 2 ? e2 : e3) * inv;
    int lp = -1;
    if (live) { lp = (int)__hip_atomic_fetch_add((LAS unsigned*)&lcnt[ek], 1u, __ATOMIC_RELAXED, __HIP_MEMORY_SCOPE_WORKGROUP);
        gate[(size_t)row * 4 + quad] = gk; tokE[(size_t)row * 4 + quad] = ek; }
    __syncthreads();
    if (tid < 32) { const unsigned n = lcnt[tid]; gbase[tid] = n ? __hip_atomic_fetch_add(gcnt + tid, n, __ATOMIC_RELAXED, __HIP_MEMORY_SCOPE_AGENT) : 0u; }
    __syncthreads();
    if (lp >= 0) { const int pos = (int)gbase[ek] + lp; tokList[(size_t)ek * T + pos] = row; tokPos[(size_t)row * 4 + quad] = pos; }
    if (tid < 32) lcnt[tid] = 0u;
    __syncthreads();
}
__device__ __forceinline__ void ln1_router_phase(LAS unsigned char* lds, volatile LAS unsigned* MISC, f32x2* RS, const y1_t* XFin, y1_t* XF, bf16_t* XB, const float* g1, const float* b1, const bf16_t* wri, const float* br,
                                                 unsigned* gcnt, int* tokList, int* tokE, int* tokPos, float* gate, int G) {
    const int tid = opaque_v(threadIdx.x), lane = tid & 63, w = tid >> 6, r = lane & 15, quad = lane >> 4, lr = lane >> 3, lc = lane & 7;
    volatile LAS unsigned* lcnt = MISC + 128; volatile LAS unsigned* gbase = MISC + 160;
    float bre[8];
#pragma unroll
    for (int eb = 0; eb < 2; ++eb)
#pragma unroll
        for (int i = 0; i < 4; ++i) bre[eb * 4 + i] = br[16 * eb + 4 * quad + i];
    constexpr int NCHUNK = T / 24;
    const int iters = (NCHUNK + 8 * G - 1) / (8 * G);
    for (int it = 0; it < iters; ++it) {
        const int chunk = (it * G + blockIdx.x) * 8 + w;
        const bool live_chunk = chunk < NCHUNK;
        const int row0 = opaque_v(live_chunk ? chunk * 24 : 0);
        u32x2 ra[32], rb[32];
        { const y1_t* xa_ = XFin + (size_t)(row0 + lr) * D + 4 * lc;
#pragma unroll
          for (int s = 0; s < 32; ++s) { ra[s] = *(const u32x2*)(xa_ + 32 * s); rb[s] = *(const u32x2*)(xa_ + (size_t)8 * D + 32 * s); } }
        if (it == 0) {
_Pragma("unroll 4")
            for (int j = 0; j < 16; ++j) { const int u = tid + 512 * j; const u32x4 v = ((const u32x4*)wri)[u]; *(LAS u32x4*)(lds + (u >> 12) * RT_WL + ((u >> 7) & 31) * RT_WSTR + (u & 127) * 16) = v; }
            for (int i = tid; i < 1024; i += 512) { ((LAS float*)(lds + RT_GB))[i] = g1[i]; ((LAS float*)(lds + RT_GB))[1024 + i] = b1[i]; }
            if (tid < 32) lcnt[tid] = 0u;
            __syncthreads();
        }
        float lg[8];
        p5_tile<true>(lds, ra, rb, live_chunk, live_chunk, row0 + lr, row0 + 8 + lr, RS, XB, lane, w, bre, lg);
        asm volatile("" ::: "memory");
        u32x2 rc[32];
        { const y1_t* xc_ = XFin + (size_t)(row0 + 16 + lr) * D + 4 * lc;
#pragma unroll
          for (int s = 0; s < 32; ++s) rc[s] = *(const u32x2*)(xc_ + 32 * s); }
        p5_route(lg, live_chunk, row0 + r, lane, tid, lcnt, gbase, gcnt, tokList, tokE, tokPos, gate);
        p5_tile<false>(lds, rc, rc, live_chunk, false, row0 + 16 + lr, row0 + 16 + lr, RS, XB, lane, w, bre, lg);
        p5_route(lg, live_chunk && (r < 8), row0 + 16 + (r & 7), lane, tid, lcnt, gbase, gcnt, tokList, tokE, tokPos, gate);
    }
}

__device__ __forceinline__ void combine_ln2_phase(volatile LAS unsigned* MISC, const f32x2* RS, const float* g1, const float* b1, const y1_t* XF, const bf16_t* YK, const int* tokE, const int* tokPos, const float* gate, const float* g2, const float* b2,
                                                  float* outF, bf16_t* XB, int G) {
    const int tid = opaque_v(threadIdx.x), lane = tid & 63, gw = blockIdx.x * 8 + (tid >> 6), NGW = G * 8;
    const volatile LAS int* tb = (const volatile LAS int*)(MISC + 16);
    f32x4 gv[4], bv[4];
#pragma unroll
    for (int j = 0; j < 4; ++j) { gv[j] = *(const f32x4*)(g2 + 256 * j + 4 * lane); bv[j] = *(const f32x4*)(b2 + 256 * j + 4 * lane); }
    f32x4 gv1[4], bv1[4];
#pragma unroll
    for (int j = 0; j < 4; ++j) { gv1[j] = *(const f32x4*)(g1 + 256 * j + 4 * lane); bv1[j] = *(const f32x4*)(b1 + 256 * j + 4 * lane); }
    typedef int i32x4 __attribute__((ext_vector_type(4)));
    i32x4 ne = *(const i32x4*)(tokE + (size_t)(gw < T ? gw : 0) * 4), np = *(const i32x4*)(tokPos + (size_t)(gw < T ? gw : 0) * 4); f32x4 ng = *(const f32x4*)(gate + (size_t)(gw < T ? gw : 0) * 4);
    for (int row = gw; row < T; row += NGW) {
        const i32x4 ce = ne, cpz = np; const f32x4 cg = ng;
        f32x4 v[4]; u32x2 y[4][4];
#pragma unroll
        for (int j = 0; j < 4; ++j) v[j] = Y1_LD4(XF + (size_t)row * D + 256 * j + 4 * lane);
        const f32x2 rs = RS[row];
#pragma unroll
        for (int k = 0; k < 4; ++k) { const size_t slot = (size_t)tb[ce[k]] * 256 + cpz[k];
#pragma unroll
            for (int j = 0; j < 4; ++j) y[k][j] = __builtin_nontemporal_load((const u32x2*)(YK + slot * D + 256 * j + 4 * lane)); }
        { const int rn = (row + NGW < T) ? row + NGW : row; ne = *(const i32x4*)(tokE + (size_t)rn * 4); np = *(const i32x4*)(tokPos + (size_t)rn * 4); ng = *(const f32x4*)(gate + (size_t)rn * 4); }
#pragma unroll
        for (int j = 0; j < 4; ++j) { v[j] = ((v[j] - rs[0]) * rs[1] * gv1[j] + bv1[j]) * DN_ALPHA;
#pragma unroll
            for (int k = 0; k < 4; ++k) v[j] += (f32x4){bflo(y[k][j].x), bfhi(y[k][j].x), bflo(y[k][j].y), bfhi(y[k][j].y)} * cg[k]; }
        float s = 0.f;
#pragma unroll
        for (int j = 0; j < 4; ++j) s += (v[j][0] + v[j][1]) + (v[j][2] + v[j][3]);
        const float mean = wave_sum(s) * (1.0f / D); float s2 = 0.f;
#pragma unroll
        for (int j = 0; j < 4; ++j) { v[j] = v[j] - mean; s2 += (v[j][0] * v[j][0] + v[j][1] * v[j][1]) + (v[j][2] * v[j][2] + v[j][3] * v[j][3]); }
        const float rstd = 1.0f / sqrtf(wave_sum(s2) * (1.0f / D) + LN_EPS);
#pragma unroll
        for (int j = 0; j < 4; ++j) { v[j] = v[j] * rstd * gv[j] + bv[j];
            if (outF) __builtin_nontemporal_store(v[j], (f32x4*)(outF + (size_t)row * D + 256 * j + 4 * lane));
            if (!outF) { u32x2 o; o.x = cvt_pk_bf16(v[j][0], v[j][1]); o.y = cvt_pk_bf16(v[j][2], v[j][3]); *(u32x2*)(XB + (size_t)row * D + 256 * j + 4 * lane) = o; } }
    }
}

__device__ __forceinline__ void moe_tables(volatile LAS unsigned* MISC, const unsigned* gcnt) {
    const int tid_ = opaque_v(threadIdx.x);
    if (tid_ < 64) {
        const int lane = tid_;
        const int n = lane < NE ? (int)__hip_atomic_load(gcnt + lane, __ATOMIC_RELAXED, __HIP_MEMORY_SCOPE_AGENT) : 0;
        const int nt = (n + 255) >> 8; int incl = nt;
#pragma unroll
        for (int o = 1; o < 32; o <<= 1) { const int v = __shfl_up(incl, o); if (lane >= o) incl += v; }
        if (lane < NE) { MISC[64 + lane] = (unsigned)n; MISC[16 + lane] = (unsigned)(incl - nt); }
        if (lane == NE - 1) MISC[16 + NE] = (unsigned)incl;
    }
    __syncthreads();
}

__device__ __forceinline__ void stagger(int span_ticks) {
    const unsigned long long t0 = __builtin_amdgcn_s_memrealtime(); const unsigned long long d = (unsigned long long)((((int)blockIdx.x >> 3) & 31) * span_ticks) >> 5;
    while (__builtin_amdgcn_s_memrealtime() - t0 < d) __builtin_amdgcn_s_sleep(8);
}
__global__ void __launch_bounds__(512, 2) fwd_kernel(Args args) {
    extern __shared__ __attribute__((aligned(16))) unsigned char lds_raw[];
    LAS unsigned char* lds = (LAS unsigned char*)lds_raw;
    volatile LAS unsigned* MISC = (volatile LAS unsigned*)(lds + MISC_OFF);
    const int tid = threadIdx.x, G = gridDim.x;
    unsigned char* const ws0 = args.ws;
    unsigned* ctl = (unsigned*)(ws0 + WS_CTL);
    for (int u = tid; u < 256; u += 512) MISC[u] = 0u;
    __syncthreads();
    const int lo = args.ph_lo, hi = args.ph_hi;
    XcdBarrier bar; bar.bar = ctl + CW_BAR; bar.x = 0; bar.st = MISC;
    if (hi - lo > 1) bar = xcd_barrier_post(ctl + CW_BAR, MISC);
#ifndef PH_MASK
#define PH_MASK 0x3ff
#endif
#define IN(k) (lo <= (k) && (k) < hi)
#define PON(p) (((PH_MASK) >> (p)) & 1)
#define SEAM(k) do { if (IN((k) + 1)) { XcdBarrier b2_ = bar; b2_.bar = opaque_p(bar.bar); { unsigned x_ = bar.x; asm volatile("" : "+s"(x_)); b2_.x = x_; } xcd_barrier(b2_); } } while (0)
#ifndef DUP_MASK
#define DUP_MASK 0
#endif
#define REP(p) _Pragma("unroll 1") for (int rep_ = 0; rep_ < ((((DUP_MASK) >> (p)) & 1) ? opaque_v(2) : 1); ++rep_)
#define WSP(T_, off) ((T_*)(ws + (off)))
#define PRM(off) ((const float*)(ws + WS_PRM) + (off))

    if (PON(9) && IN(0)) { REP(9) p0_prologue(args, lds, G); SEAM(0); }

#pragma unroll 1
    for (int l = 0; l < DEPTH; ++l) {
        const int pb = 1 + l * NPH;
        if (PON(0) && IN(pb + 0)) { unsigned char* ws = opaque_p(ws0); unsigned* ctl = (unsigned*)(ws + WS_CTL); (void)ctl; const int Gp = opaque_s(G), cp = opaque_s((int)blockIdx.x); (void)Gp; (void)cp;
            pg8::DenseSched S{WSP(const bf16_t, WS_XB), WSP(const bf16_t, WS_WIN) + (size_t)l * DIN * D, D, T / 256, DIN / 256, Gp, cp};
            pg8::EpiIn E{PRM(PR_BIN) + (size_t)l * DIN, WSP(bf16_t, WS_U), WSP(bf16_t, WS_V), WSP(bf16_t, WS_QKV), WSP(bf16_t, WS_GA), WSP(bf16_t, WS_GB), WSP(f32x2, WS_PS)};
#ifdef STAG_P1
            stagger(STAG_P1);
#endif
            REP(0) pg8::gemm_phase<pg8::EpiIn, pg8::DenseSched, true>(lds, S, E);
            SEAM(pb + 0);
        }
        if (PON(1) && IN(pb + 1)) { unsigned char* ws = opaque_p(ws0); unsigned* ctl = (unsigned*)(ws + WS_CTL); (void)ctl; const int Gp = opaque_s(G), cp = opaque_s((int)blockIdx.x); (void)Gp; (void)cp;
            const int vcu = (Gp % 8 == 0) ? (cp % 8) * (Gp / 8) + cp / 8 : cp;
            { constexpr int NU = 12 * 3 * 4 * 32, NS = 768;
                const int na = (NU - vcu + Gp - 1) / Gp;
                const int ka = (na * ((vcu >> 3) % 7)) / 6;
                const int usplit = vcu + (ka < na ? ka : na) * Gp;
                { u32x4 kr[8], vr[8];
                  _Pragma("unroll") for (int j = 0; j < 8; ++j) { kr[j] = (u32x4){0u, 0u, 0u, 0u}; vr[j] = (u32x4){0u, 0u, 0u, 0u}; }
                  if (vcu < usplit) attn_load(WSP(const bf16_t, WS_QKV), vcu, opaque_v(threadIdx.x), kr, vr);
                  for (int u = vcu; u < usplit; u += Gp) attn_unit(lds, WSP(const bf16_t, WS_QKV), WSP(bf16_t, WS_OG), WSP(float, WS_LSE), u, (u + Gp < usplit) ? u + Gp : -1, kr, vr); }
                for (int u = vcu; u < NS; u += Gp)
                    sg_unit(lds, WSP(const bf16_t, WS_U), WSP(const bf16_t, WS_V), WSP(bf16_t, WS_AOUT), WSP(const bf16_t, WS_WS) + (size_t)l * 8 * 128 * 128, PRM(PR_BS) + (size_t)l * 1024, PRM(PR_LNVG) + (size_t)l * 1024, PRM(PR_LNVB) + (size_t)l * 1024, WSP(const f32x2, WS_PS), u);
                { u32x4 kr[8], vr[8];
                  _Pragma("unroll") for (int j = 0; j < 8; ++j) { kr[j] = (u32x4){0u, 0u, 0u, 0u}; vr[j] = (u32x4){0u, 0u, 0u, 0u}; }
                  if (usplit < NU) attn_load(WSP(const bf16_t, WS_QKV), usplit, opaque_v(threadIdx.x), kr, vr);
                  for (int u = usplit; u < NU; u += Gp) attn_unit(lds, WSP(const bf16_t, WS_QKV), WSP(bf16_t, WS_OG), WSP(float, WS_LSE), u, (u + Gp < NU) ? u + Gp : -1, kr, vr); }
            }
            SEAM(pb + 1);
        }
        if (PON(2) && IN(pb + 2)) { unsigned char* ws = opaque_p(ws0); unsigned* ctl = (unsigned*)(ws + WS_CTL); (void)ctl; const int Gp = opaque_s(G), cp = opaque_s((int)blockIdx.x); (void)Gp; (void)cp; REP(2) merge_phase(WSP(const bf16_t, WS_OG), WSP(const float, WS_LSE), WSP(bf16_t, WS_BOUT), Gp); SEAM(pb + 2); }
        if (PON(3) && IN(pb + 3)) { unsigned char* ws = opaque_p(ws0); unsigned* ctl = (unsigned*)(ws + WS_CTL); (void)ctl; const int Gp = opaque_s(G), cp = opaque_s((int)blockIdx.x); (void)Gp; (void)cp;
            pg8::Dense2Sched S{WSP(const bf16_t, WS_AOUT), WSP(const bf16_t, WS_WPA) + (size_t)l * D * D, D, WSP(const bf16_t, WS_BOUT), WSP(const bf16_t, WS_WPB) + (size_t)l * D * 512, 512, T / 256, D / 256, Gp, cp};
            pg8::EpiMg2 E{WSP(const bf16_t, WS_GA), WSP(const bf16_t, WS_GB), WSP(bf16_t, WS_MG)};
            REP(3) pg8::gemm_phase2<pg8::EpiMg2>(lds, S, E);
            SEAM(pb + 3);
        }
        if (PON(4) && IN(pb + 4)) { unsigned char* ws = opaque_p(ws0); unsigned* ctl = (unsigned*)(ws + WS_CTL); (void)ctl; const int Gp = opaque_s(G), cp = opaque_s((int)blockIdx.x); (void)Gp; (void)cp;
            pg8::DenseSched S{WSP(const bf16_t, WS_MG), WSP(const bf16_t, WS_WO) + (size_t)l * D * D, D, T / 256, D / 256, Gp, cp};
            pg8::EpiWo E{args.in[I_XP], args.in[I_XS] - (size_t)TP * D, l == 0 ? (const bf16_t*)nullptr : WSP(const bf16_t, WS_XB), WSP(y1_t, WS_XF)};
            pg8::gemm_phase<pg8::EpiWo, pg8::DenseSched, true>(lds, S, E);
            SEAM(pb + 4);
        }
        if (PON(5) && IN(pb + 5)) { unsigned char* ws = opaque_p(ws0); unsigned* ctl = (unsigned*)(ws + WS_CTL); (void)ctl; const int Gp = opaque_s(G), cp = opaque_s((int)blockIdx.x); (void)Gp; (void)cp;
            if (((DUP_MASK) >> 5) & 1) ln1_router_phase(lds, MISC, WSP(f32x2, WS_RS), WSP(const y1_t, WS_XF), WSP(y1_t, WS_T1), WSP(bf16_t, WS_U), PRM(PR_LN1G) + (size_t)l * D, PRM(PR_LN1B) + (size_t)l * D, WSP(const bf16_t, WS_WRI) + (size_t)l * 65536, PRM(PR_BR) + (size_t)l * NE,
                             ctl + CW_CNT + 1024 + l * 64, WSP(int, WS_OG), WSP(int, WS_LSE), WSP(int, WS_BOUT), WSP(float, WS_AOUT), Gp);
            ln1_router_phase(lds, MISC, WSP(f32x2, WS_RS), WSP(const y1_t, WS_XF), WSP(y1_t, WS_XF), WSP(bf16_t, WS_XB), PRM(PR_LN1G) + (size_t)l * D, PRM(PR_LN1B) + (size_t)l * D, WSP(const bf16_t, WS_WRI) + (size_t)l * 65536, PRM(PR_BR) + (size_t)l * NE,
                             ctl + CW_CNT + l * 64, WSP(int, WS_TOKLIST), WSP(int, WS_TOKE), WSP(int, WS_TOKPOS), WSP(float, WS_GATE), Gp);
            SEAM(pb + 5);
        }
        if (PON(6) && IN(pb + 6)) { unsigned char* ws = opaque_p(ws0); unsigned* ctl = (unsigned*)(ws + WS_CTL); (void)ctl; const int Gp = opaque_s(G), cp = opaque_s((int)blockIdx.x); (void)Gp; (void)cp;
            moe_tables(MISC, ctl + CW_CNT + l * 64);
            pg8::MoeSched<true> S{WSP(const bf16_t, WS_XB), WSP(const bf16_t, WS_WGU) + (size_t)l * NE * 2048 * D, D, 8, Gp, cp, (size_t)2048 * D * 2, (const LAS int*)(lds + MISC_OFF + 64), (const LAS int*)(lds + MISC_OFF + 256), WSP(const int, WS_TOKLIST)};
            pg8::EpiGU E{PRM(PR_BGU) + (size_t)l * NE * 2048, WSP(bf16_t, WS_H)};
            REP(6) pg8::gemm_phase<pg8::EpiGU, pg8::MoeSched<true>, true>(lds, S, E);
            SEAM(pb + 6);
        }
        if (PON(7) && IN(pb + 7)) { unsigned char* ws = opaque_p(ws0); unsigned* ctl = (unsigned*)(ws + WS_CTL); (void)ctl; const int Gp = opaque_s(G), cp = opaque_s((int)blockIdx.x); (void)Gp; (void)cp;
            moe_tables(MISC, ctl + CW_CNT + l * 64);
            pg8::MoeSched<false> S{WSP(const bf16_t, WS_H), WSP(const bf16_t, WS_WD) + (size_t)l * NE * D * D, D, 4, Gp, cp, (size_t)D * D * 2, (const LAS int*)(lds + MISC_OFF + 64), (const LAS int*)(lds + MISC_OFF + 256), nullptr};
            pg8::EpiDown E{PRM(PR_BD) + (size_t)l * NE * D, WSP(bf16_t, WS_YK)};
            REP(7) pg8::gemm_phase<pg8::EpiDown, pg8::MoeSched<false>, true>(lds, S, E);
            SEAM(pb + 7);
        }
        if (PON(8) && IN(pb + 8)) { unsigned char* ws = opaque_p(ws0); unsigned* ctl = (unsigned*)(ws + WS_CTL); (void)ctl; const int Gp = opaque_s(G), cp = opaque_s((int)blockIdx.x); (void)Gp; (void)cp;
            moe_tables(MISC, ctl + CW_CNT + l * 64);
            combine_ln2_phase(MISC, WSP(const f32x2, WS_RS), PRM(PR_LN1G) + (size_t)l * D, PRM(PR_LN1B) + (size_t)l * D, WSP(const y1_t, WS_XF), WSP(const bf16_t, WS_YK), WSP(const int, WS_TOKE), WSP(const int, WS_TOKPOS), WSP(const float, WS_GATE), PRM(PR_LN2G) + (size_t)l * D, PRM(PR_LN2B) + (size_t)l * D,
                              l == DEPTH - 1 ? args.out : (float*)nullptr, WSP(bf16_t, WS_XB), Gp);
            SEAM(pb + 8);
        }
    }
#undef IN
#undef SEAM
}

extern "C" void kernel_launch(void* const* d_in, const int* in_sizes, int n_in, void* d_out, int out_size, void* d_ws, size_t ws_size, hipStream_t stream) {
    static int grid = 0;
    if (grid == 0) {
        if (n_in != 21 || out_size != T * D || ws_size < WS_END) { fprintf(stderr, "kernel_launch: unexpected shapes (n_in %d, out %d, ws %zu < %zu)\n", n_in, out_size, ws_size, (size_t)WS_END); grid = -1; return; }
        int dev = 0, cus = 0, per_cu = 0;
        if (hipGetDevice(&dev) != hipSuccess || hipDeviceGetAttribute(&cus, hipDeviceAttributeMultiprocessorCount, dev) != hipSuccess) { grid = -1; return; }
        if (hipFuncSetAttribute((const void*)fwd_kernel, hipFuncAttributeMaxDynamicSharedMemorySize, LDS_BYTES) != hipSuccess) { fprintf(stderr, "kernel_launch: hipFuncSetAttribute failed\n"); grid = -1; return; }
        if (hipOccupancyMaxActiveBlocksPerMultiprocessor(&per_cu, (const void*)fwd_kernel, 512, LDS_BYTES) != hipSuccess || per_cu < 1) fprintf(stderr, "kernel_launch: occupancy query says %d\n", per_cu);
        (void)hipGetLastError();
        grid = cus;
    }
    if (grid < 0) return;
    (void)hipMemsetAsync((char*)d_ws + WS_CTL, 0, CTL_BYTES, stream);
    Args a{};
    for (int i = 0; i < 21; ++i) a.in[i] = (const float*)d_in[i];
    a.out = (float*)d_out; a.ws = (unsigned char*)d_ws;
#if MK_SPLIT
    for (int p = 0; p < NPHASE; ++p) { a.ph_lo = p; a.ph_hi = p + 1; hipLaunchKernelGGL(fwd_kernel, dim3(grid), dim3(512), LDS_BYTES, stream, a); }
#else
    a.ph_lo = 0; a.ph_hi = NPHASE;
    hipLaunchKernelGGL(fwd_kernel, dim3(grid), dim3(512), LDS_BYTES, stream, a);
#ifdef PROBE_PHASE
    for (int r = 0; r < PROBE_REPS; ++r) { a.ph_lo = 1 + 2 * NPH + PROBE_PHASE; a.ph_hi = a.ph_lo + 1;
#ifdef PROBE_SUB
        a.sub = PROBE_SUB;
#endif
 hipLaunchKernelGGL(fwd_kernel, dim3(grid), dim3(512), LDS_BYTES, stream, a); }
#endif
#endif
}
```

```cpp
#include <hip/hip_runtime.h>
#include <cstdio>
#include <cstdint>

#ifndef Y1_BF16
#define Y1_BF16 1
#endif
#ifndef MK_SPLIT
#define MK_SPLIT 0
#endif

#define LAS __attribute__((address_space(3)))
#define GAS __attribute__((address_space(1)))
typedef unsigned short bf16_t;
typedef short bf16x8 __attribute__((ext_vector_type(8)));
typedef short s16x4 __attribute__((ext_vector_type(4)));
typedef float f32x4 __attribute__((ext_vector_type(4)));
typedef float f32x2 __attribute__((ext_vector_type(2)));
typedef unsigned u32x4 __attribute__((ext_vector_type(4)));
typedef unsigned u32x2 __attribute__((ext_vector_type(2)));

constexpr int D = 1024, T = 49152, TP = 32768, SEQ = 4096, DEPTH = 4, DIN = 8704, NE = 32, TOPK = 4, QKVW = 4608;
constexpr int NSLOT = T * TOPK + NE * 256;
constexpr float DN_ALPHA = 1.6817928305074290f;
constexpr float LN_EPS = 1e-5f;
constexpr float LOG2E = 1.4426950408889634f, LN2 = 0.6931471805599453f;
constexpr int NPH = 9, NPHASE = 1 + DEPTH * NPH;

constexpr size_t MiB = 1u << 20;
constexpr size_t WS_CTL = 0, CTL_BYTES = 128 * 1024;
constexpr size_t WS_PRM = 1 * MiB;
constexpr int PR_BIN = 0, PR_LNVG = PR_BIN + DEPTH * DIN, PR_LNVB = PR_LNVG + DEPTH * D, PR_BS = PR_LNVB + DEPTH * D, PR_LN1G = PR_BS + DEPTH * D, PR_LN1B = PR_LN1G + DEPTH * D,
              PR_WR = PR_LN1B + DEPTH * D, PR_BR = PR_WR + DEPTH * D * NE, PR_BGU = PR_BR + DEPTH * NE, PR_BD = PR_BGU + DEPTH * NE * 2048, PR_LN2G = PR_BD + DEPTH * NE * D, PR_LN2B = PR_LN2G + DEPTH * D,
              PR_END = PR_LN2B + DEPTH * D;
static_assert((size_t)PR_END * 4 <= 4 * MiB, "params region");
constexpr size_t WS_WIN = 5 * MiB;
constexpr size_t WS_WPA = WS_WIN + (size_t)DEPTH * DIN * D * 2;
constexpr size_t WS_WPB = WS_WPA + (size_t)DEPTH * D * D * 2;
constexpr size_t WS_WO = WS_WPB + (size_t)DEPTH * D * 512 * 2;
constexpr size_t WS_WS = WS_WO + (size_t)DEPTH * D * D * 2;
constexpr size_t WS_WGU = WS_WS + (size_t)DEPTH * 8 * 128 * 128 * 2;
constexpr size_t WS_WD = WS_WGU + (size_t)DEPTH * NE * 2048 * D * 2;
constexpr size_t WS_XF = WS_WD + (size_t)DEPTH * NE * D * D * 2;
constexpr size_t WS_WRI = WS_XF + (size_t)T * D * 2;
constexpr size_t WS_XB = WS_XF + (size_t)T * D * 4;
constexpr size_t WS_TOKLIST = WS_XB + (size_t)T * D * 2;
constexpr size_t WS_TOKE = WS_TOKLIST + (size_t)NE * T * 4;
constexpr size_t WS_TOKPOS = WS_TOKE + (size_t)T * 4 * 4;
constexpr size_t WS_GATE = WS_TOKPOS + (size_t)T * 4 * 4;
constexpr size_t WS_PS = WS_GATE + (size_t)T * 4 * 4;
constexpr size_t WS_RS = WS_PS + (size_t)T * 16 * 8;
constexpr size_t WS_R = WS_RS + (size_t)T * 8;
constexpr size_t WS_U = WS_R;
constexpr size_t WS_V = WS_U + (size_t)T * D * 2;
constexpr size_t WS_QKV = WS_V + (size_t)T * D * 2;
constexpr size_t WS_GA = WS_QKV + (size_t)T * QKVW * 2;
constexpr size_t WS_GB = WS_GA + (size_t)T * D * 2;
constexpr size_t WS_AOUT = WS_GB + (size_t)T * D * 2;
constexpr size_t WS_OG = WS_AOUT + (size_t)T * D * 2;
constexpr size_t WS_LSE = WS_OG + (size_t)3 * T * 512 * 2;
constexpr size_t WS_BOUT = WS_LSE + (size_t)3 * T * 4 * 4;
constexpr size_t WS_T1 = WS_BOUT + (size_t)T * 512 * 2;
constexpr size_t WS_MG = WS_T1 + (size_t)T * D * 4;
constexpr size_t WS_END_A = WS_MG + (size_t)T * D * 2;
constexpr size_t WS_H = WS_R;
constexpr size_t WS_YK = WS_H + (size_t)NSLOT * D * 2;
constexpr size_t WS_END_B = WS_YK + (size_t)NSLOT * D * 2;
constexpr size_t WS_END = WS_END_A > WS_END_B ? WS_END_A : WS_END_B;
constexpr int CW_BAR = 4096;
constexpr int CW_CNT = 16384;

constexpr int LDS_BYTES = 160 * 1024;
constexpr int MISC_OFF = LDS_BYTES - 2048, IDS_OFF = MISC_OFF + 1024;
constexpr int MISC_DOC = 0;
constexpr int TMAP_OFF = MISC_OFF - 1024;
constexpr int SCR_BYTES = MISC_OFF;

#if Y1_BF16
typedef unsigned short y1_t;
#define Y1_LD4(p) ({ const u32x2 q_ = *(const u32x2*)(p); (f32x4){__builtin_bit_cast(float, q_.x << 16), __builtin_bit_cast(float, q_.x & 0xffff0000u), __builtin_bit_cast(float, q_.y << 16), __builtin_bit_cast(float, q_.y & 0xffff0000u)}; })
#else
typedef float y1_t;
#define Y1_LD4(p) (*(const f32x4*)(p))
#endif
__device__ __forceinline__ int opaque_v(int x) { asm volatile("" : "+v"(x)); return x; }
__device__ __forceinline__ int opaque_s(int x) { asm volatile("" : "+s"(x)); return x; }
template <class P> __device__ __forceinline__ P* opaque_p(P* p) { unsigned long long z = 0; asm volatile("" : "+s"(z)); return (P*)((char*)p + z); }
__device__ __forceinline__ unsigned f2bf(float f) { unsigned u = __builtin_bit_cast(unsigned, f); return (u + 0x7fffu + ((u >> 16) & 1u)) >> 16; }
__device__ __forceinline__ unsigned pk2(float lo, float hi) { return f2bf(lo) | (f2bf(hi) << 16); }
__device__ __forceinline__ unsigned cvt_pk_bf16(float lo, float hi) { unsigned r; asm volatile("v_cvt_pk_bf16_f32 %0, %1, %2" : "=v"(r) : "v"(lo), "v"(hi)); return r; }
__device__ __forceinline__ float bflo(unsigned w) { return __builtin_bit_cast(float, w << 16); }
__device__ __forceinline__ float bfhi(unsigned w) { return __builtin_bit_cast(float, w & 0xffff0000u); }
__device__ __forceinline__ float wave_sum(float v) {
#pragma unroll
    for (int o = 1; o < 64; o <<= 1) v += __shfl_xor(v, o);
    return v;
}
__device__ __forceinline__ float sigmoidf_(float x) { return __builtin_amdgcn_rcpf(1.0f + __builtin_amdgcn_exp2f(-x * LOG2E)); }
__device__ __forceinline__ f32x2 gelu_pk(f32x2 v) {
    f32x2 t = v * v; t.x = fminf(t.x, 16.0f); t.y = fminf(t.y, 16.0f);
    f32x2 p = t * 9.567564795975869e-11f + (-8.026423969909047e-09f);
    p = p * t + 3.002628830017784e-07f; p = p * t + (-6.72069427309907e-06f); p = p * t + 0.00010251090134261176f; p = p * t + (-0.0011512201745063066f);
    p = p * t + 0.009921522811055183f; p = p * t + (-0.06646095216274261f); p = p * t + 0.3989395201206207f;
    f32x2 vc; vc.x = fminf(fmaxf(v.x, -4.0f), 4.0f); vc.y = fminf(fmaxf(v.y, -4.0f), 4.0f);
    return v * (vc * p + 0.5f);
}

#define XB_TMO      128
#define XB_XCNT(j)  (256  + 64 * (j))
#define XB_XSUB(j)  (1280 + 64 * (j))
#define XB_XGEN(j)  (2304 + 64 * (j))
#define XB_TOP      3328
#define XB_TOPGEN   3392
#define XCD_BAR_WORDS 3456
#define XB_SPIN_CAP (1u << 18)
__device__ __forceinline__ unsigned xb_ld(unsigned* p)              { return __hip_atomic_load(p, __ATOMIC_RELAXED, __HIP_MEMORY_SCOPE_AGENT); }
__device__ __forceinline__ unsigned xb_add(unsigned* p, unsigned v) { return __hip_atomic_fetch_add(p, v, __ATOMIC_RELAXED, __HIP_MEMORY_SCOPE_AGENT); }
__device__ __forceinline__ unsigned xb_xcc_id() { return (unsigned)__builtin_amdgcn_s_getreg((3 << 11) | 20) & 0xFu; }
#define XB_SPIN(cond, bar) do { unsigned _sp = 0; while (cond) { __builtin_amdgcn_s_sleep(1); \
    if ((++_sp & 255u) == 0u) { if (xb_ld(&(bar)[XB_TMO])) break; if (_sp > XB_SPIN_CAP) { atomicAdd(&(bar)[XB_TMO], 1u); break; } } } } while (0)
struct XcdBarrier { unsigned* bar; unsigned x; volatile LAS unsigned* st; };
__device__ __forceinline__ XcdBarrier xcd_barrier_post(unsigned* bar, volatile LAS unsigned* st) {
    XcdBarrier b; b.bar = bar; b.x = xb_xcc_id(); b.st = st;
    if (threadIdx.x == 0) (void)xb_add(&bar[XB_XCNT(b.x)], 1u);
    return b;
}
__device__ __forceinline__ void xcd_barrier_complete(unsigned* bar, unsigned x, unsigned& nloc, unsigned& nx) {
    const unsigned G = gridDim.x * gridDim.y * gridDim.z;
    unsigned sum, cnt, mine, sp = 0u;
    for (;;) {
        sum = 0u; cnt = 0u; mine = 0u;
#pragma unroll
        for (unsigned j = 0; j < 16; ++j) { const unsigned c = xb_ld(&bar[XB_XCNT(j)]); sum += c; cnt += (c > 0u) ? 1u : 0u; mine = (j == x) ? c : mine; }
        if (sum == G) break;
        __builtin_amdgcn_s_sleep(1);
        if ((++sp & 255u) == 0u) { if (xb_ld(&bar[XB_TMO])) break; if (sp > XB_SPIN_CAP) { atomicAdd(&bar[XB_TMO], 1u); break; } }
    }
    nloc = mine > 0u ? mine : 1u; nx = cnt > 0u ? cnt : 1u;
}
__device__ __forceinline__ void xcd_barrier(const XcdBarrier& b) {
    asm volatile("s_waitcnt vmcnt(0)" ::: "memory");
    __syncthreads();
    if (threadIdx.x == 0) {
        unsigned* bar = b.bar;
        __builtin_amdgcn_s_waitcnt(0);
        unsigned nloc = b.st[0], nx = b.st[1];
        if (nloc == 0u) { xcd_barrier_complete(bar, b.x, nloc, nx); b.st[0] = nloc; b.st[1] = nx; }
        const unsigned old = xb_add(&bar[XB_XSUB(b.x)], 1u);
        const unsigned gen = old / nloc;
        if (old + 1u == (gen + 1u) * nloc) {
            __builtin_amdgcn_fence(__ATOMIC_RELEASE, "agent");
            asm volatile("s_waitcnt vmcnt(0)" ::: "memory");
            const unsigned og = xb_add(&bar[XB_TOP], 1u);
            const unsigned tg = og / nx;
            if (og + 1u == (tg + 1u) * nx) xb_add(&bar[XB_TOPGEN], 1u);
            else XB_SPIN(xb_ld(&bar[XB_TOPGEN]) == tg, bar);
            __builtin_amdgcn_fence(__ATOMIC_ACQUIRE, "agent");
            xb_add(&bar[XB_XGEN(b.x)], 1u);
            asm volatile("s_waitcnt vmcnt(0)" ::: "memory");
        } else {
            XB_SPIN(xb_ld(&bar[XB_XGEN(b.x)]) == gen, bar);
            __builtin_amdgcn_fence(__ATOMIC_ACQUIRE, "agent");
            asm volatile("s_waitcnt vmcnt(0)" ::: "memory");
        }
    }
    __syncthreads();
}

#ifndef EPI_NT
#define EPI_NT 1
#endif
#if EPI_NT
#define EPI_ST(T_, p, v) __builtin_nontemporal_store((T_)(v), (T_*)(p))
#else
#define EPI_ST(T_, p, v) (*(T_*)(p) = (v))
#endif
namespace pg8 {
constexpr int BM = 256, BK = 64, HALF = 128, HTB = HALF * BK * 2, STAGE_BYTES = 8 * HTB, NXCD = 8, WGM = 4;
__host__ __device__ __forceinline__ int lds_byte(int r, int c) { const int st = (r >> 4) * 2 + (c >> 5), rr = r & 15, cc = c & 31, ob = rr * 64 + cc * 2; return st * 1024 + (ob ^ (((ob >> 9) & 1) << 5)); }
__host__ __device__ __forceinline__ void stage_rc(int b, int& R, int& C) { const int st = b / 1024, sb = b % 1024, swz = sb ^ (((sb >> 9) & 1) << 5); R = (st >> 1) * 16 + swz / 64; C = (st & 1) * 32 + (swz % 64) / 2; }
__host__ __device__ __forceinline__ int perm32(int rho) { const int n = rho >> 4, i = rho & 15; return 8 * (i >> 2) + 4 * n + (i & 3); }

struct Unit { int pm, pn, e, r0; };

__device__ __forceinline__ bool static_order(int i, int G, int c, int nM, int nN, int& pm, int& pn) {
    const int nwg = nM * nN; const long L = (long)i * G + c; if (L >= nwg) return false;
    int wgid = (int)L; { const int q = nwg / NXCD, r = nwg % NXCD, xcd = wgid % NXCD, off = wgid / NXCD; wgid = (xcd < r ? xcd * (q + 1) : r * (q + 1) + (xcd - r) * q) + off; }
    const int nig = WGM * nN, gid = wgid / nig, fm = gid * WGM, gsz = (nM - fm) < WGM ? (nM - fm) : WGM;
    const int wi = wgid % nig;
    if (gsz == WGM) { pm = fm + (wi % WGM); pn = wi / WGM; } else { pm = fm + (wi % gsz); pn = wi / gsz; }
    return true;
}
struct DenseSched {
    static constexpr bool GATHER = false;
    const bf16_t* A; const bf16_t* Bt; int K, nM, nN, G, c;
    __device__ __forceinline__ bool next(int i, Unit& u) const { u.e = 0; u.r0 = 0; return static_order(i, G, c, nM, nN, u.pm, u.pn); }
    __device__ __forceinline__ const char* a_base(const Unit& u) const { return (const char*)A + (size_t)u.pm * BM * K * 2; }
    __device__ __forceinline__ const char* b_base(const Unit& u) const { return (const char*)Bt + (size_t)u.pn * BM * K * 2; }
    __device__ __forceinline__ void a_offs(const Unit& u, const int (&R)[2], const int (&C)[2], unsigned (&o)[2][2]) const {
#pragma unroll
        for (int h = 0; h < 2; ++h)
#pragma unroll
            for (int i = 0; i < 2; ++i) o[h][i] = (unsigned)((u.pm * BM + h * HALF + R[i]) * K + C[i]) * 2u;
    }
    __device__ __forceinline__ int load_id(const Unit&, int) const { return 0; }
    __device__ __forceinline__ void a_offs_lds(const LAS int*, const int (&)[2], const int (&)[2], unsigned (&)[2][2]) const {}
};
template <bool GATHER_> struct MoeSched {
    static constexpr bool GATHER = GATHER_;
    const bf16_t* A; const bf16_t* Bt; int K, nN, G, c; size_t bstride;
    const LAS int* tb; const LAS int* cnt; const int* tokList;
    __device__ __forceinline__ bool next(int i, Unit& u) const {
        const int nM = tb[NE];
        if (!static_order(i, G, c, nM, nN, u.pm, u.pn)) return false;
        const int e = ((const LAS unsigned char*)tb)[TMAP_OFF - (MISC_OFF + 64) + u.pm];
        u.e = e; u.r0 = (u.pm - tb[e]) * BM; return true;
    }
    __device__ __forceinline__ const char* a_base(const Unit& u) const { return GATHER ? (const char*)A : (const char*)A + (size_t)u.pm * BM * K * 2; }
    __device__ __forceinline__ const char* b_base(const Unit& u) const { return (const char*)Bt + (size_t)u.e * bstride + (size_t)u.pn * BM * K * 2; }
    __device__ __forceinline__ int load_id(const Unit& u, int i) const { const int r = u.r0 + i; return (r < cnt[u.e]) ? tokList[(size_t)u.e * T + r] : 0; }
    __device__ __forceinline__ void a_offs(const Unit& u, const int (&R)[2], const int (&C)[2], unsigned (&o)[2][2]) const {
#pragma unroll
        for (int h = 0; h < 2; ++h)
#pragma unroll
            for (int i = 0; i < 2; ++i) o[h][i] = (unsigned)(load_id(u, h * HALF + R[i]) * K + C[i]) * 2u;
    }
    __device__ __forceinline__ void a_offs_lds(const LAS int* ids, const int (&R)[2], const int (&C)[2], unsigned (&o)[2][2]) const {
#pragma unroll
        for (int h = 0; h < 2; ++h)
#pragma unroll
            for (int i = 0; i < 2; ++i) o[h][i] = (unsigned)(ids[h * HALF + R[i]] * K + C[i]) * 2u;
    }
};


template <class Epi, class Sched, bool ALIGN_EPI>
__device__ __forceinline__ void gemm_phase(LAS unsigned char* lds, const Sched& S, const Epi& E) {
    constexpr bool GATHER = Sched::GATHER;
    const int tid = opaque_v(threadIdx.x), wid = __builtin_amdgcn_readfirstlane(tid >> 6), lane = tid & 63, wr = wid >> 2, wc = wid & 3, fr = lane & 15, fq = lane >> 4;
    const int K = S.K, nt = K / BK;
    int R[2], C[2]; unsigned voffA[2], voffB[2];
#pragma unroll
    for (int i = 0; i < 2; ++i) { stage_rc(tid * 16 + i * 8192, R[i], C[i]); const int Rb = 64 * (R[i] >> 5) + (Epi::PERM ? perm32(R[i] & 31) : (R[i] & 31));
        voffA[i] = (unsigned)(R[i] * K + C[i]) * 2u; voffB[i] = (unsigned)(Rb * K + C[i]) * 2u; }
    const size_t kstep = (size_t)(BK * 2);
    const size_t hstep = (size_t)HALF * K * 2;
    const size_t bhstep = (size_t)32 * K * 2;
    const unsigned ldsw = (unsigned)wid * 1024u;
    const int aoff = lds_byte(wr * 64 + fr, fq * 8), boff = lds_byte(wc * 32 + fr, fq * 8);
#define PG8_SA(b, h) (((b) * 2 + (h)) * HTB)
#define PG8_SB(b, h) ((4 + (b) * 2 + (h)) * HTB)
#define PG8_STAGE(bufoff, gbase, voff) do { _Pragma("unroll") for (int _i = 0; _i < 2; ++_i) \
        __builtin_amdgcn_global_load_lds((const unsigned*)((const char*)(gbase) + (voff)[_i]), (LAS unsigned*)(lds + (bufoff) + ldsw + _i * 8192), 16, 0, 0); } while (0)
#define PG8_STAGE_A(bufoff, ab, ao, h, kb) do { if constexpr (GATHER) { PG8_STAGE(bufoff, (ab) + (kb), (ao)[h]); } else { PG8_STAGE(bufoff, (ab) + (kb) + (h) * hstep, voffA); } } while (0)
#define PG8_LDA(dst, b, h) do { _Pragma("unroll") for (int m = 0; m < 4; ++m) _Pragma("unroll") for (int k = 0; k < 2; ++k) dst[m][k] = *(const LAS bf16x8*)(lds + PG8_SA(b, h) + aoff + m * 2048 + k * 1024); } while (0)
#define PG8_LDB(dst, b, h) do { _Pragma("unroll") for (int n = 0; n < 2; ++n) _Pragma("unroll") for (int k = 0; k < 2; ++k) dst[n][k] = *(const LAS bf16x8*)(lds + PG8_SB(b, h) + boff + n * 2048 + k * 1024); } while (0)
#define PG8_MMA(ai, bj, At, Bt) do { __builtin_amdgcn_s_setprio(1); _Pragma("unroll") for (int m = 0; m < 4; ++m) _Pragma("unroll") for (int n = 0; n < 2; ++n) _Pragma("unroll") for (int k = 0; k < 2; ++k) \
        acc[ai][bj][m][n] = __builtin_amdgcn_mfma_f32_16x16x32_bf16(Bt[n][k], At[m][k], acc[ai][bj][m][n], 0, 0, 0); __builtin_amdgcn_s_setprio(0); } while (0)
#define PG8_WAIT_V(n) asm volatile("s_waitcnt vmcnt(" #n ")" ::: "memory")
#define PG8_WAIT_L(n) asm volatile("s_waitcnt lgkmcnt(" #n ")" ::: "memory")
#define PG8_BAR __builtin_amdgcn_s_barrier()
#define PG8_SCHED __builtin_amdgcn_sched_barrier(0)
    Unit cur, nxt; int ui = 0;
    if (!S.next(0, cur)) return;
    f32x4 acc[2][2][4][2];
    { f32x4 bv[2][2]; E.binit(cur, wc, fq, bv);
#pragma unroll
    for (int a = 0; a < 2; ++a)
#pragma unroll
        for (int b = 0; b < 2; ++b)
#pragma unroll
            for (int m = 0; m < 4; ++m)
#pragma unroll
                for (int n = 0; n < 2; ++n) { acc[a][b][m][n] = bv[b][n]; asm volatile("" : "+v"(acc[a][b][m][n])); } }
    bf16x8 At[4][2], B0[2][2], B1[2][2];
    unsigned ca[2][2];
    LAS int* ids = (LAS int*)(lds + IDS_OFF);
    if constexpr (GATHER) { S.a_offs(cur, R, C, ca); Unit n1; if (S.next(1, n1) && tid < 256) ids[tid] = S.load_id(n1, tid); }
    const char* cA = S.a_base(cur);
    const char* cB = S.b_base(cur);
    PG8_STAGE(PG8_SB(0, 0), cB, voffB); PG8_STAGE(PG8_SB(0, 1), cB + bhstep, voffB); PG8_STAGE_A(PG8_SA(0, 0), cA, ca, 0, 0); PG8_STAGE_A(PG8_SA(0, 1), cA, ca, 1, 0);
    if (wr == 1) PG8_BAR;
    PG8_WAIT_V(2); PG8_BAR;
    PG8_STAGE(PG8_SB(1, 0), cB + kstep, voffB); PG8_STAGE_A(PG8_SA(1, 0), cA, ca, 0, kstep); PG8_STAGE(PG8_SB(1, 1), cB + bhstep + kstep, voffB);
    PG8_WAIT_V(6); PG8_BAR;
    for (;;) {
        const bool has_next = S.next(ui + 1, nxt);
        const char* nA = has_next ? S.a_base(nxt) : cA; const char* nB = has_next ? S.b_base(nxt) : cB;
#define PG8_TRIP(RELAX) do { \
            const bool last = (t == nt - 2); \
            const size_t k1 = (size_t)(t + 1) * kstep; \
            const size_t k2 = last ? 0 : (size_t)(t + 2) * kstep, k3 = k2 + kstep; \
            const char* a2 = last ? nA : cA; const char* b2 = (last ? nB : cB) + k2; const char* b3 = b2 + kstep; \
            PG8_LDB(B0, 0, 0); PG8_LDB(B1, 0, 1); PG8_SCHED; PG8_LDA(At, 0, 0); PG8_STAGE_A(PG8_SA(1, 1), cA, ca, 1, k1); \
            if (!(RELAX)) PG8_WAIT_V(8); PG8_WAIT_L(0); PG8_BAR; PG8_MMA(0, 0, At, B0); PG8_MMA(0, 1, At, B1); PG8_BAR; PG8_SCHED; \
            if constexpr (GATHER) { if (last && has_next) { int R2[2], C2[2]; const int t2 = opaque_v(tid); stage_rc(t2 * 16, R2[0], C2[0]); stage_rc(t2 * 16 + 8192, R2[1], C2[1]); S.a_offs_lds(ids, R2, C2, ca); } } \
            PG8_LDA(At, 0, 1); PG8_STAGE(PG8_SB(0, 0), b2, voffB); PG8_STAGE(PG8_SB(0, 1), b2 + bhstep, voffB); PG8_STAGE_A(PG8_SA(0, 0), a2, ca, 0, k2); \
            if (!(RELAX)) PG8_WAIT_V(8); PG8_WAIT_L(0); PG8_BAR; PG8_MMA(1, 0, At, B0); PG8_MMA(1, 1, At, B1); PG8_BAR; PG8_SCHED; \
            PG8_LDB(B0, 1, 0); PG8_LDB(B1, 1, 1); PG8_SCHED; PG8_LDA(At, 1, 0); PG8_STAGE_A(PG8_SA(0, 1), a2, ca, 1, k2); \
            PG8_WAIT_V(8); PG8_WAIT_L(0); PG8_BAR; PG8_MMA(0, 0, At, B0); PG8_MMA(0, 1, At, B1); PG8_BAR; PG8_SCHED; \
            PG8_LDA(At, 1, 1); PG8_STAGE(PG8_SB(1, 0), b3, voffB); PG8_STAGE(PG8_SB(1, 1), b3 + bhstep, voffB); PG8_STAGE_A(PG8_SA(1, 0), a2, ca, 0, k3); \
            PG8_WAIT_V(8); PG8_WAIT_L(0); PG8_BAR; PG8_MMA(1, 0, At, B0); PG8_MMA(1, 1, At, B1); PG8_BAR; PG8_SCHED; \
        } while (0)
        int t = 0;
#ifndef NO_RELAX
        if (ui > 0) { PG8_TRIP(true); t = 2; }
#endif
        for (; t < nt; t += 2) PG8_TRIP(false);
#undef PG8_TRIP
        if constexpr (ALIGN_EPI) { if (wr == 0) PG8_BAR; }
        int idv = 0; bool fill = false;
        if constexpr (GATHER) { Unit n2; fill = S.next(ui + 2, n2) && tid < 256; if (fill) idv = S.load_id(n2, tid); }
        f32x4 bvn[2][2];
        if (has_next) E.binit(nxt, wc, fq, bvn);
        E(lds, acc, cur, wr, wc, fr, fq);
        if constexpr (GATHER) { if (fill) ids[tid] = idv; }
        if (!has_next) break;
#pragma unroll
        for (int a = 0; a < 2; ++a)
#pragma unroll
            for (int b = 0; b < 2; ++b)
#pragma unroll
                for (int m = 0; m < 4; ++m)
#pragma unroll
                    for (int n = 0; n < 2; ++n) { acc[a][b][m][n] = bvn[b][n]; asm volatile("" : "+v"(acc[a][b][m][n])); }
        cur = nxt; cA = nA; cB = nB; ++ui;
        if constexpr (ALIGN_EPI) { if (wr == 1) PG8_BAR; }
    }
    PG8_WAIT_V(0);
    if constexpr (!ALIGN_EPI) { if (wr == 0) PG8_BAR; }
    PG8_BAR;
#undef PG8_SA
#undef PG8_SB
#undef PG8_STAGE
#undef PG8_STAGE_A
#undef PG8_LDA
#undef PG8_LDB
#undef PG8_MMA
#undef PG8_WAIT_V
#undef PG8_WAIT_L
#undef PG8_BAR
#undef PG8_SCHED
}

struct Dense2Sched {
    const bf16_t* A1; const bf16_t* B1; int K1; const bf16_t* A2; const bf16_t* B2; int K2; int nM, nN, G, c;
    __device__ __forceinline__ bool next(int i, Unit& u) const { u.e = 0; u.r0 = 0; return static_order(i, G, c, nM, nN, u.pm, u.pn); }
};
template <class Epi>
__device__ __forceinline__ void gemm_phase2(LAS unsigned char* lds, const Dense2Sched& S, const Epi& E) {
    const int tid = opaque_v(threadIdx.x), wid = __builtin_amdgcn_readfirstlane(tid >> 6), lane = tid & 63, wr = wid >> 2, wc = wid & 3, fr = lane & 15, fq = lane >> 4;
    const int K1 = S.K1, K2 = S.K2, nt1 = K1 / BK, nt = nt1 + K2 / BK;
    unsigned vRA[2], vRB[2], vC[2];
#pragma unroll
    for (int i = 0; i < 2; ++i) { int R, C; stage_rc(tid * 16 + i * 8192, R, C); const int Rb = 64 * (R >> 5) + (Epi::PERM ? perm32(R & 31) : (R & 31)); vRA[i] = (unsigned)R * 2u; vRB[i] = (unsigned)Rb * 2u; vC[i] = (unsigned)C * 2u; }
#define PG8_VOFF(dst, vR, Kx) unsigned dst[2]; _Pragma("unroll") for (int i_ = 0; i_ < 2; ++i_) dst[i_] = (vR)[i_] * (unsigned)(Kx) + (unsigned)opaque_v((int)vC[i_])
    const size_t kstep = (size_t)(BK * 2);
    const size_t hstep1 = (size_t)HALF * K1 * 2, bhstep1 = (size_t)32 * K1 * 2, hstep2 = (size_t)HALF * K2 * 2, bhstep2 = (size_t)32 * K2 * 2;
    const unsigned ldsw = (unsigned)wid * 1024u;
    const int aoff = lds_byte(wr * 64 + fr, fq * 8), boff = lds_byte(wc * 32 + fr, fq * 8);
#define PG8_SA(b, h) (((b) * 2 + (h)) * HTB)
#define PG8_SB(b, h) ((4 + (b) * 2 + (h)) * HTB)
#define PG8_STAGE(bufoff, gbase, voff) do { _Pragma("unroll") for (int _i = 0; _i < 2; ++_i) \
        __builtin_amdgcn_global_load_lds((const unsigned*)((const char*)(gbase) + (voff)[_i]), (LAS unsigned*)(lds + (bufoff) + ldsw + _i * 8192), 16, 0, 0); } while (0)
#define PG8_LDA(dst, b, h) do { _Pragma("unroll") for (int m = 0; m < 4; ++m) _Pragma("unroll") for (int k = 0; k < 2; ++k) dst[m][k] = *(const LAS bf16x8*)(lds + PG8_SA(b, h) + aoff + m * 2048 + k * 1024); } while (0)
#define PG8_LDB(dst, b, h) do { _Pragma("unroll") for (int n = 0; n < 2; ++n) _Pragma("unroll") for (int k = 0; k < 2; ++k) dst[n][k] = *(const LAS bf16x8*)(lds + PG8_SB(b, h) + boff + n * 2048 + k * 1024); } while (0)
#define PG8_MMA(ai, bj, At, Bt) do { __builtin_amdgcn_s_setprio(1); _Pragma("unroll") for (int m = 0; m < 4; ++m) _Pragma("unroll") for (int n = 0; n < 2; ++n) _Pragma("unroll") for (int k = 0; k < 2; ++k) \
        acc[ai][bj][m][n] = __builtin_amdgcn_mfma_f32_16x16x32_bf16(Bt[n][k], At[m][k], acc[ai][bj][m][n], 0, 0, 0); __builtin_amdgcn_s_setprio(0); } while (0)
#define PG8_WAIT_V(n) asm volatile("s_waitcnt vmcnt(" #n ")" ::: "memory")
#define PG8_WAIT_L(n) asm volatile("s_waitcnt lgkmcnt(" #n ")" ::: "memory")
#define PG8_BAR __builtin_amdgcn_s_barrier()
#define PG8_SCHED __builtin_amdgcn_sched_barrier(0)
    Unit cur, nxt; int ui = 0;
    if (!S.next(0, cur)) return;
    f32x4 acc[2][2][4][2];
#pragma unroll
    for (int a = 0; a < 2; ++a)
#pragma unroll
        for (int b = 0; b < 2; ++b)
#pragma unroll
            for (int m = 0; m < 4; ++m)
#pragma unroll
                for (int n = 0; n < 2; ++n) acc[a][b][m][n] = (f32x4){0.f, 0.f, 0.f, 0.f};
    bf16x8 At[4][2], B0[2][2], B1[2][2];
    const char* cA1 = (const char*)S.A1 + (size_t)cur.pm * BM * K1 * 2; const char* cB1 = (const char*)S.B1 + (size_t)cur.pn * BM * K1 * 2;
    const char* cA2 = (const char*)S.A2 + (size_t)cur.pm * BM * K2 * 2; const char* cB2 = (const char*)S.B2 + (size_t)cur.pn * BM * K2 * 2;
    { PG8_VOFF(voffA1, vRA, K1); PG8_VOFF(voffB1, vRB, K1);
    PG8_STAGE(PG8_SB(0, 0), cB1, voffB1); PG8_STAGE(PG8_SB(0, 1), cB1 + bhstep1, voffB1); PG8_STAGE(PG8_SA(0, 0), cA1, voffA1); PG8_STAGE(PG8_SA(0, 1), cA1 + hstep1, voffA1);
    if (wr == 1) PG8_BAR;
    PG8_WAIT_V(2); PG8_BAR;
    PG8_STAGE(PG8_SB(1, 0), cB1 + kstep, voffB1); PG8_STAGE(PG8_SA(1, 0), cA1 + kstep, voffA1); PG8_STAGE(PG8_SB(1, 1), cB1 + bhstep1 + kstep, voffB1);
    PG8_WAIT_V(6); PG8_BAR; }
    for (;;) {
        const bool has_next = S.next(ui + 1, nxt);
        const char* nA1 = has_next ? (const char*)S.A1 + (size_t)nxt.pm * BM * K1 * 2 : cA1; const char* nB1 = has_next ? (const char*)S.B1 + (size_t)nxt.pn * BM * K1 * 2 : cB1;
#define PG8_TRIP2(RELAX) do { \
            const bool last = (t == nt - 2), s1c = (t < nt1), s1n = last || (t + 2 < nt1); \
            const char* ac = s1c ? cA1 + (size_t)(t + 1) * kstep + hstep1 : cA2 + (size_t)(t + 1 - nt1) * kstep + hstep2; \
            const char* an = last ? nA1 : (s1n ? cA1 + (size_t)(t + 2) * kstep : cA2 + (size_t)(t + 2 - nt1) * kstep); \
            const char* bn = last ? nB1 : (s1n ? cB1 + (size_t)(t + 2) * kstep : cB2 + (size_t)(t + 2 - nt1) * kstep); \
            const size_t hsn = s1n ? hstep1 : hstep2, bhn = s1n ? bhstep1 : bhstep2; \
            const int Kc = s1c ? K1 : K2, Kn = s1n ? K1 : K2; \
            PG8_LDB(B0, 0, 0); PG8_LDB(B1, 0, 1); PG8_SCHED; PG8_LDA(At, 0, 0); { PG8_VOFF(vac, vRA, Kc); PG8_STAGE(PG8_SA(1, 1), ac, vac); } \
            if (!(RELAX)) PG8_WAIT_V(8); PG8_WAIT_L(0); PG8_BAR; PG8_MMA(0, 0, At, B0); PG8_MMA(0, 1, At, B1); PG8_BAR; PG8_SCHED; \
            PG8_LDA(At, 0, 1); { PG8_VOFF(vbn, vRB, Kn); PG8_VOFF(van, vRA, Kn); PG8_STAGE(PG8_SB(0, 0), bn, vbn); PG8_STAGE(PG8_SB(0, 1), bn + bhn, vbn); PG8_STAGE(PG8_SA(0, 0), an, van); } \
            if (!(RELAX)) PG8_WAIT_V(8); PG8_WAIT_L(0); PG8_BAR; PG8_MMA(1, 0, At, B0); PG8_MMA(1, 1, At, B1); PG8_BAR; PG8_SCHED; \
            PG8_LDB(B0, 1, 0); PG8_LDB(B1, 1, 1); PG8_SCHED; PG8_LDA(At, 1, 0); { PG8_VOFF(van, vRA, Kn); PG8_STAGE(PG8_SA(0, 1), an + hsn, van); } \
            PG8_WAIT_V(8); PG8_WAIT_L(0); PG8_BAR; PG8_MMA(0, 0, At, B0); PG8_MMA(0, 1, At, B1); PG8_BAR; PG8_SCHED; \
            PG8_LDA(At, 1, 1); { PG8_VOFF(vbn, vRB, Kn); PG8_VOFF(van, vRA, Kn); PG8_STAGE(PG8_SB(1, 0), bn + kstep, vbn); PG8_STAGE(PG8_SB(1, 1), bn + kstep + bhn, vbn); PG8_STAGE(PG8_SA(1, 0), an + kstep, van); } \
            PG8_WAIT_V(8); PG8_WAIT_L(0); PG8_BAR; PG8_MMA(1, 0, At, B0); PG8_MMA(1, 1, At, B1); PG8_BAR; PG8_SCHED; \
        } while (0)
        int t = 0;
        if (ui > 0) { PG8_TRIP2(true); t = 2; }
        for (; t < nt1; t += 2) PG8_TRIP2(false);
        E.mid(lds, acc, cur, wr, wc, fr, fq);
        for (; t < nt; t += 2) PG8_TRIP2(false);
#undef PG8_TRIP2
        if (wr == 0) PG8_BAR;
        E(lds, acc, cur, wr, wc, fr, fq);
        if (!has_next) break;
#pragma unroll
        for (int a = 0; a < 2; ++a)
#pragma unroll
            for (int b = 0; b < 2; ++b)
#pragma unroll
                for (int m = 0; m < 4; ++m)
#pragma unroll
                    for (int n = 0; n < 2; ++n) acc[a][b][m][n] = (f32x4){0.f, 0.f, 0.f, 0.f};
        cur = nxt; cA1 = nA1; cB1 = nB1; cA2 = (const char*)S.A2 + (size_t)cur.pm * BM * K2 * 2; cB2 = (const char*)S.B2 + (size_t)cur.pn * BM * K2 * 2; ++ui;
        if (wr == 1) PG8_BAR;
    }
    PG8_WAIT_V(0);
    PG8_BAR;
#undef PG8_VOFF
#undef PG8_SA
#undef PG8_SB
#undef PG8_STAGE
#undef PG8_LDA
#undef PG8_LDB
#undef PG8_MMA
#undef PG8_WAIT_V
#undef PG8_WAIT_L
#undef PG8_BAR
#undef PG8_SCHED
}

typedef const f32x4 (&AccRef)[2][2][4][2];
constexpr int EPI_OFF = STAGE_BYTES, EPI_WSTR = 144, EPI_WBYTES = 16 * EPI_WSTR;
__device__ __forceinline__ void epi_xpose(LAS unsigned char* st, int fr, int fq, int lane, u32x4 in0, u32x4 in1, u32x4& out0, u32x4& out1) {
    *(LAS u32x4*)(st + fr * EPI_WSTR + fq * 16) = in0; *(LAS u32x4*)(st + fr * EPI_WSTR + 64 + fq * 16) = in1;
    out0 = *(const LAS u32x4*)(st + (lane >> 3) * EPI_WSTR + (lane & 7) * 16); out1 = *(const LAS u32x4*)(st + (8 + (lane >> 3)) * EPI_WSTR + (lane & 7) * 16);
}
__device__ __forceinline__ void epi_xpose1(LAS unsigned char* st, int fr, int fq, int lane, u32x4 in0, u32x4& out0) {
    *(LAS u32x4*)(st + fr * 80 + fq * 16) = in0;
    out0 = *(const LAS u32x4*)(st + (lane >> 2) * 80 + (lane & 3) * 16);
}
#define EPI_DRAIN() asm volatile("s_waitcnt vmcnt(0)" ::: "memory")
#define EPI_LOCALS() const int lane = opaque_v(fq * 16 + fr), lr = lane >> 3, lc = lane & 7;        LAS unsigned char* st = lds + EPI_OFF + (wr * 4 + wc) * EPI_WBYTES; (void)lr; (void)lc

struct EpiIn {
    static constexpr bool PERM = true;
    const float* bias; bf16_t *U, *V, *QKV, *GA, *GB; f32x2* PS;
    __device__ __forceinline__ void binit(const Unit& u, int wc, int fq, f32x4 (&bv)[2][2]) const {
#pragma unroll
        for (int bj = 0; bj < 2; ++bj)
#pragma unroll
            for (int n = 0; n < 2; ++n) bv[bj][n] = *(const f32x4*)(bias + u.pn * BM + wc * 64 + bj * 32 + 8 * fq + 4 * n);
    }
    __device__ __forceinline__ void operator()(LAS unsigned char* lds, AccRef acc, const Unit& u, int wr, int wc, int fr, int fq) const {
        EPI_LOCALS();
        const int pn = u.pn; bf16_t* base; int ldc = D, colt, act;
        if (pn < 4) { base = U; colt = pn * 256; act = 1; }
        else if (pn < 8) { base = V; colt = (pn - 4) * 256; act = 1; }
        else if (pn < 26) { base = QKV; ldc = QKVW; colt = (pn - 8) * 256; act = 0; }
        else if (pn < 30) { base = GA; colt = (pn - 26) * 256; act = 2; }
        else { base = GB; colt = (pn - 30) * 256; act = 2; }
        bf16_t* p0 = base + (size_t)(u.pm * BM + wr * 64 + lr) * ldc + colt + wc * 64 + lc * 8;
        const bool vstats = (pn >= 4 && pn < 8);
        f32x2* ps0 = PS + (size_t)(u.pm * BM + wr * 64 + lr) * 16 + (pn - 4) * 4 + wc;
#pragma unroll
        for (int ai = 0; ai < 2; ++ai)
#pragma unroll
            for (int m = 0; m < 4; ++m) { u32x4 w[2];
#pragma unroll
                for (int bj = 0; bj < 2; ++bj) { f32x4 v0 = acc[ai][bj][m][0], v1 = acc[ai][bj][m][1];
                    if (act == 1) { f32x2 a = gelu_pk((f32x2){v0[0], v0[1]}), b = gelu_pk((f32x2){v0[2], v0[3]}), c = gelu_pk((f32x2){v1[0], v1[1]}), d = gelu_pk((f32x2){v1[2], v1[3]});
                        v0 = (f32x4){a.x, a.y, b.x, b.y}; v1 = (f32x4){c.x, c.y, d.x, d.y}; }
                    if (act == 2) {
#pragma unroll
                        for (int j = 0; j < 4; ++j) { v0[j] = sigmoidf_(v0[j]); v1[j] = sigmoidf_(v1[j]); } }
                    w[bj].x = cvt_pk_bf16(v0[0], v0[1]); w[bj].y = cvt_pk_bf16(v0[2], v0[3]); w[bj].z = cvt_pk_bf16(v1[0], v1[1]); w[bj].w = cvt_pk_bf16(v1[2], v1[3]); }
                u32x4 o0, o1; epi_xpose(st, fr, fq, lane, w[0], w[1], o0, o1);
                if (ai == 0 && m == 0) EPI_DRAIN();
                bf16_t* rp = p0 + (size_t)(ai * HALF + m * 16) * ldc;
                EPI_ST(u32x4, rp, o0); EPI_ST(u32x4, rp + (size_t)8 * ldc, o1);
                if (vstats) {
                    float s0 = 0.f, q0 = 0.f, s1 = 0.f, q1 = 0.f;
#pragma unroll
                    for (int c = 0; c < 4; ++c) { const float a = bflo(o0[c]), b = bfhi(o0[c]), d = bflo(o1[c]), e = bfhi(o1[c]); s0 += a + b; q0 += a * a + b * b; s1 += d + e; q1 += d * d + e * e; }
#pragma unroll
                    for (int o = 1; o < 8; o <<= 1) { s0 += __shfl_xor(s0, o); q0 += __shfl_xor(q0, o); s1 += __shfl_xor(s1, o); q1 += __shfl_xor(q1, o); }
                    if (lc == 0) { ps0[(size_t)(ai * HALF + m * 16) * 16] = (f32x2){s0, q0}; ps0[(size_t)(ai * HALF + m * 16 + 8) * 16] = (f32x2){s1, q1}; } }
                asm volatile("" ::: "memory"); }
    }
};
struct EpiT1 {
    static constexpr bool PERM = false;
    const bf16_t* GA; bf16_t* T1;
    __device__ __forceinline__ void binit(const Unit&, int, int, f32x4 (&bv)[2][2]) const { bv[0][0] = bv[0][1] = bv[1][0] = bv[1][1] = (f32x4){0.f, 0.f, 0.f, 0.f}; }
    __device__ __forceinline__ void operator()(LAS unsigned char* lds, AccRef acc, const Unit& u, int wr, int wc, int fr, int fq) const {
        EPI_LOCALS();
        const size_t o00 = (size_t)(u.pm * BM + wr * 64 + lr) * D + u.pn * BM + wc * 64 + lc * 4;
#pragma unroll
        for (int ai = 0; ai < 2; ++ai) {
            u32x2 g[4][2][2];
#pragma unroll
            for (int m = 0; m < 4; ++m)
#pragma unroll
                for (int bj = 0; bj < 2; ++bj)
#pragma unroll
                    for (int s = 0; s < 2; ++s) g[m][bj][s] = *(const u32x2*)(GA + o00 + (size_t)(ai * HALF + m * 16 + 8 * s) * D + bj * 32);
            asm volatile("" ::: "memory");
#pragma unroll
            for (int m = 0; m < 4; ++m)
#pragma unroll
                for (int bj = 0; bj < 2; ++bj) { u32x4 o[2]; epi_xpose(st, fr, fq, lane, __builtin_bit_cast(u32x4, acc[ai][bj][m][0]), __builtin_bit_cast(u32x4, acc[ai][bj][m][1]), o[0], o[1]);
#pragma unroll
                    for (int s = 0; s < 2; ++s) { const size_t off = o00 + (size_t)(ai * HALF + m * 16 + 8 * s) * D + bj * 32; const u32x2 gq = g[m][bj][s];
                        const f32x4 gv = (f32x4){bflo(gq.x), bfhi(gq.x), bflo(gq.y), bfhi(gq.y)}; const f32x4 tv = __builtin_bit_cast(f32x4, o[s]) * gv;
                        u32x2 tw; tw.x = cvt_pk_bf16(tv[0], tv[1]); tw.y = cvt_pk_bf16(tv[2], tv[3]); EPI_ST(u32x2, T1 + off, tw); } }
        }
    }
};
struct EpiMg {
    static constexpr bool PERM = false;
    const bf16_t* GB; const bf16_t* T1; bf16_t* MG;
    __device__ __forceinline__ void binit(const Unit&, int, int, f32x4 (&bv)[2][2]) const { bv[0][0] = bv[0][1] = bv[1][0] = bv[1][1] = (f32x4){0.f, 0.f, 0.f, 0.f}; }
    __device__ __forceinline__ void operator()(LAS unsigned char* lds, AccRef acc, const Unit& u, int wr, int wc, int fr, int fq) const {
        EPI_LOCALS();
        const size_t o00 = (size_t)(u.pm * BM + wr * 64 + lr) * D + u.pn * BM + wc * 64 + lc * 4;
#pragma unroll
        for (int ai = 0; ai < 2; ++ai) {
            u32x2 g[4][2][2], tq[4][2][2];
#pragma unroll
            for (int m = 0; m < 4; ++m)
#pragma unroll
                for (int bj = 0; bj < 2; ++bj)
#pragma unroll
                    for (int s = 0; s < 2; ++s) { const size_t off = o00 + (size_t)(ai * HALF + m * 16 + 8 * s) * D + bj * 32; g[m][bj][s] = *(const u32x2*)(GB + off); tq[m][bj][s] = *(const u32x2*)(T1 + off); }
            asm volatile("" ::: "memory");
#pragma unroll
            for (int m = 0; m < 4; ++m)
#pragma unroll
                for (int bj = 0; bj < 2; ++bj) { u32x4 o[2]; epi_xpose(st, fr, fq, lane, __builtin_bit_cast(u32x4, acc[ai][bj][m][0]), __builtin_bit_cast(u32x4, acc[ai][bj][m][1]), o[0], o[1]);
#pragma unroll
                    for (int s = 0; s < 2; ++s) { const size_t off = o00 + (size_t)(ai * HALF + m * 16 + 8 * s) * D + bj * 32; const u32x2 gq = g[m][bj][s], t2 = tq[m][bj][s];
                        const f32x4 t = (f32x4){bflo(t2.x), bfhi(t2.x), bflo(t2.y), bfhi(t2.y)};
                        const f32x4 v = t + __builtin_bit_cast(f32x4, o[s]) * (f32x4){bflo(gq.x), bfhi(gq.x), bflo(gq.y), bfhi(gq.y)};
                        u32x2 w; w.x = cvt_pk_bf16(v[0], v[1]); w.y = cvt_pk_bf16(v[2], v[3]); EPI_ST(u32x2, MG + off, w); } }
        }
    }
};
struct EpiMg2 {
    static constexpr bool PERM = false;
    const bf16_t* GA; const bf16_t* GB; bf16_t* MG;
    __device__ __forceinline__ void mid(LAS unsigned char* lds, f32x4 (&acc)[2][2][4][2], const Unit& u, int wr, int wc, int fr, int fq) const {
        EPI_LOCALS();
        const size_t o00 = (size_t)(u.pm * BM + wr * 64 + lr) * D + u.pn * BM + wc * 64 + lc * 4;
#pragma unroll
        for (int q = 0; q < 4; ++q) { const int ai = q >> 1, m0 = 2 * (q & 1);
            u32x2 ga[2][2][2], gb[2][2][2];
#pragma unroll
            for (int mm = 0; mm < 2; ++mm)
#pragma unroll
                for (int bj = 0; bj < 2; ++bj)
#pragma unroll
                    for (int s = 0; s < 2; ++s) { const size_t off = o00 + (size_t)(ai * HALF + (m0 + mm) * 16 + 8 * s) * D + bj * 32; ga[mm][bj][s] = *(const u32x2*)(GA + off); gb[mm][bj][s] = *(const u32x2*)(GB + off); }
            asm volatile("" ::: "memory");
#pragma unroll
            for (int mm = 0; mm < 2; ++mm)
#pragma unroll
                for (int bj = 0; bj < 2; ++bj) { const int m = m0 + mm;
#pragma unroll
                    for (int s = 0; s < 2; ++s) { const u32x2 a2 = ga[mm][bj][s], b2 = gb[mm][bj][s]; f32x4 r;
                        r[0] = bflo(a2.x) * __builtin_amdgcn_rcpf(fmaxf(bflo(b2.x), 1e-30f)); r[1] = bfhi(a2.x) * __builtin_amdgcn_rcpf(fmaxf(bfhi(b2.x), 1e-30f));
                        r[2] = bflo(a2.y) * __builtin_amdgcn_rcpf(fmaxf(bflo(b2.y), 1e-30f)); r[3] = bfhi(a2.y) * __builtin_amdgcn_rcpf(fmaxf(bfhi(b2.y), 1e-30f));
                        *(LAS f32x4*)(st + (8 * s + lr) * EPI_WSTR + lc * 16) = r; }
                    const f32x4 r0 = *(const LAS f32x4*)(st + fr * EPI_WSTR + fq * 16), r1 = *(const LAS f32x4*)(st + fr * EPI_WSTR + 64 + fq * 16);
                    acc[ai][bj][m][0] *= r0; acc[ai][bj][m][1] *= r1; }
        }
    }
    __device__ __forceinline__ void operator()(LAS unsigned char* lds, AccRef acc, const Unit& u, int wr, int wc, int fr, int fq) const {
        EPI_LOCALS();
        const size_t o00 = (size_t)(u.pm * BM + wr * 64 + lr) * D + u.pn * BM + wc * 64 + lc * 4;
#pragma unroll
        for (int ai = 0; ai < 2; ++ai) {
            u32x2 g[4][2][2];
#pragma unroll
            for (int m = 0; m < 4; ++m)
#pragma unroll
                for (int bj = 0; bj < 2; ++bj)
#pragma unroll
                    for (int s = 0; s < 2; ++s) g[m][bj][s] = *(const u32x2*)(GB + o00 + (size_t)(ai * HALF + m * 16 + 8 * s) * D + bj * 32);
            asm volatile("" ::: "memory");
#pragma unroll
            for (int m = 0; m < 4; ++m)
#pragma unroll
                for (int bj = 0; bj < 2; ++bj) { u32x4 o[2]; epi_xpose(st, fr, fq, lane, __builtin_bit_cast(u32x4, acc[ai][bj][m][0]), __builtin_bit_cast(u32x4, acc[ai][bj][m][1]), o[0], o[1]);
#pragma unroll
                    for (int s = 0; s < 2; ++s) { const size_t off = o00 + (size_t)(ai * HALF + m * 16 + 8 * s) * D + bj * 32; const u32x2 gq = g[m][bj][s];
                        const f32x4 v = __builtin_bit_cast(f32x4, o[s]) * (f32x4){bflo(gq.x), bfhi(gq.x), bflo(gq.y), bfhi(gq.y)};
                        u32x2 w; w.x = cvt_pk_bf16(v[0], v[1]); w.y = cvt_pk_bf16(v[2], v[3]); EPI_ST(u32x2, MG + off, w); } }
        }
    }
};
struct EpiWo {
    static constexpr bool PERM = false;
    const float* xa; const float* xb; const bf16_t* XBres; y1_t* XF;
    __device__ __forceinline__ void binit(const Unit&, int, int, f32x4 (&bv)[2][2]) const { bv[0][0] = bv[0][1] = bv[1][0] = bv[1][1] = (f32x4){0.f, 0.f, 0.f, 0.f}; }
    __device__ __forceinline__ void operator()(LAS unsigned char* lds, AccRef acc, const Unit& u, int wr, int wc, int fr, int fq) const {
        EPI_LOCALS();
        const size_t o00 = (size_t)(u.pm * BM + wr * 64 + lr) * D + u.pn * BM + wc * 64 + lc * 4;
        const float* xr = (u.pm * BM < TP) ? xa : xb;
#pragma unroll
        for (int ai = 0; ai < 2; ++ai) {
            f32x4 xv[4][2][2];
            if (XBres) {
                u32x2 xq[4][2][2];
#pragma unroll
                for (int m = 0; m < 4; ++m)
#pragma unroll
                    for (int bj = 0; bj < 2; ++bj)
#pragma unroll
                        for (int s = 0; s < 2; ++s) xq[m][bj][s] = *(const u32x2*)(XBres + o00 + (size_t)(ai * HALF + m * 16 + 8 * s) * D + bj * 32);
#pragma unroll
                for (int m = 0; m < 4; ++m)
#pragma unroll
                    for (int bj = 0; bj < 2; ++bj)
#pragma unroll
                        for (int s = 0; s < 2; ++s) xv[m][bj][s] = (f32x4){bflo(xq[m][bj][s].x), bfhi(xq[m][bj][s].x), bflo(xq[m][bj][s].y), bfhi(xq[m][bj][s].y)};
            } else {
#pragma unroll
                for (int m = 0; m < 4; ++m)
#pragma unroll
                    for (int bj = 0; bj < 2; ++bj)
#pragma unroll
                        for (int s = 0; s < 2; ++s) xv[m][bj][s] = *(const f32x4*)(xr + o00 + (size_t)(ai * HALF + m * 16 + 8 * s) * D + bj * 32);
            }
            asm volatile("" ::: "memory");
#pragma unroll
            for (int m = 0; m < 4; ++m)
#pragma unroll
                for (int bj = 0; bj < 2; ++bj) { u32x4 o[2]; epi_xpose(st, fr, fq, lane, __builtin_bit_cast(u32x4, acc[ai][bj][m][0]), __builtin_bit_cast(u32x4, acc[ai][bj][m][1]), o[0], o[1]);
#pragma unroll
                    for (int s = 0; s < 2; ++s) { const size_t off = o00 + (size_t)(ai * HALF + m * 16 + 8 * s) * D + bj * 32;
                        const f32x4 yv = xv[m][bj][s] * DN_ALPHA + __builtin_bit_cast(f32x4, o[s]);
#if Y1_BF16
                        { u32x2 yw; yw.x = cvt_pk_bf16(yv[0], yv[1]); yw.y = cvt_pk_bf16(yv[2], yv[3]); EPI_ST(u32x2, XF + off, yw); }
#else
                        EPI_ST(f32x4, XF + off, yv);
#endif
                    } }
        }
    }
};
struct EpiGU {
    static constexpr bool PERM = true;
    const float* bgu; bf16_t* H;
    __device__ __forceinline__ void binit(const Unit& u, int wc, int fq, f32x4 (&bv)[2][2]) const {
        const float* bg = bgu + (size_t)u.e * 2048 + u.pn * HALF + wc * 32 + 8 * fq;
        bv[0][0] = *(const f32x4*)(bg); bv[0][1] = *(const f32x4*)(bg + 4); bv[1][0] = *(const f32x4*)(bg + 1024); bv[1][1] = *(const f32x4*)(bg + 1028);
    }
    __device__ __forceinline__ void operator()(LAS unsigned char* lds, AccRef acc, const Unit& u, int wr, int wc, int fr, int fq) const {
        EPI_LOCALS();
        bf16_t* p0 = H + (size_t)(u.pm * BM + wr * 64 + (lane >> 2)) * D + u.pn * HALF + wc * 32 + (lane & 3) * 8;
#pragma unroll
        for (int ai = 0; ai < 2; ++ai)
#pragma unroll
            for (int m = 0; m < 4; ++m) {
                f32x4 g0 = acc[ai][0][m][0], g1 = acc[ai][0][m][1], u0 = acc[ai][1][m][0], u1 = acc[ai][1][m][1], h0, h1;
#pragma unroll
                for (int j = 0; j < 4; ++j) {
                    const float ga = fminf(g0[j], 7.0f), gb = fminf(g1[j], 7.0f);
                    const float ua = fminf(fmaxf(u0[j], -7.0f), 7.0f), ub = fminf(fmaxf(u1[j], -7.0f), 7.0f);
                    h0[j] = (ua + 1.0f) * ga * sigmoidf_(1.702f * ga); h1[j] = (ub + 1.0f) * gb * sigmoidf_(1.702f * gb); }
                u32x4 w; w.x = cvt_pk_bf16(h0[0], h0[1]); w.y = cvt_pk_bf16(h0[2], h0[3]); w.z = cvt_pk_bf16(h1[0], h1[1]); w.w = cvt_pk_bf16(h1[2], h1[3]);
                u32x4 o; epi_xpose1(st, fr, fq, lane, w, o);
                if (ai == 0 && m == 0) EPI_DRAIN();
                EPI_ST(u32x4, p0 + (size_t)(ai * HALF + m * 16) * D, o); asm volatile("" ::: "memory"); }
    }
};
struct EpiDown {
    static constexpr bool PERM = true;
    const float* bd; bf16_t* YK;
    __device__ __forceinline__ void binit(const Unit& u, int wc, int fq, f32x4 (&bv)[2][2]) const {
#pragma unroll
        for (int bj = 0; bj < 2; ++bj)
#pragma unroll
            for (int n = 0; n < 2; ++n) bv[bj][n] = *(const f32x4*)(bd + (size_t)u.e * D + u.pn * BM + wc * 64 + bj * 32 + 8 * fq + 4 * n);
    }
    __device__ __forceinline__ void operator()(LAS unsigned char* lds, AccRef acc, const Unit& u, int wr, int wc, int fr, int fq) const {
        EPI_LOCALS();
        bf16_t* p0 = YK + (size_t)(u.pm * BM + wr * 64 + lr) * D + u.pn * BM + wc * 64 + lc * 8;
#pragma unroll
        for (int ai = 0; ai < 2; ++ai)
#pragma unroll
            for (int m = 0; m < 4; ++m) { u32x4 w[2];
#pragma unroll
                for (int bj = 0; bj < 2; ++bj) { const f32x4 v0 = acc[ai][bj][m][0], v1 = acc[ai][bj][m][1];
                    w[bj].x = cvt_pk_bf16(v0[0], v0[1]); w[bj].y = cvt_pk_bf16(v0[2], v0[3]); w[bj].z = cvt_pk_bf16(v1[0], v1[1]); w[bj].w = cvt_pk_bf16(v1[2], v1[3]); }
                u32x4 o0, o1; epi_xpose(st, fr, fq, lane, w[0], w[1], o0, o1);
                if (ai == 0 && m == 0) EPI_DRAIN();
                bf16_t* rp = p0 + (size_t)(ai * HALF + m * 16) * D;
                EPI_ST(u32x4, rp, o0); EPI_ST(u32x4, rp + (size_t)8 * D, o1); asm volatile("" ::: "memory"); }
    }
};
}

struct Args { const float* in[21]; float* out; unsigned char* ws; int ph_lo, ph_hi, sub, pad; };
enum { I_XP = 0, I_XS, I_WIN, I_BIN, I_LNVG, I_LNVB, I_WS, I_BS, I_WPA, I_WPB, I_WO, I_LN1G, I_LN1B, I_WR, I_BR, I_WGU, I_BGU, I_WD, I_BD, I_LN2G, I_LN2B };

__device__ __forceinline__ void tr_item(const float* W, int K, int N, bf16_t* WT, int k0, int n0, int nd0, LAS unsigned* scr, int lane, int ndhi = 32) {
    const int i = lane & 15, kp = lane >> 4;
    f32x4 a[8], b[8];
#pragma unroll
    for (int it = 0; it < 8; ++it) { const int k = it * 8 + kp * 2; a[it] = *(const f32x4*)(W + (size_t)(k0 + k) * N + n0 + 4 * i); b[it] = *(const f32x4*)(W + (size_t)(k0 + k + 1) * N + n0 + 4 * i); }
#pragma unroll
    for (int it = 0; it < 8; ++it) {
#pragma unroll
        for (int j = 0; j < 4; ++j) scr[(4 * i + j) * 33 + it * 4 + kp] = pk2(a[it][j], b[it][j]); }
    asm volatile("s_waitcnt lgkmcnt(0)" ::: "memory");
    const int nn = lane >> 3, c = lane & 7;
#pragma unroll
    for (int j = 0; j < 8; ++j) { const int n = nn + 8 * j; u32x4 o; o.x = scr[n * 33 + 4 * c]; o.y = scr[n * 33 + 4 * c + 1]; o.z = scr[n * 33 + 4 * c + 2]; o.w = scr[n * 33 + 4 * c + 3];
        *(u32x4*)(WT + (size_t)(nd0 + (n & 31) + (n >> 5) * ndhi) * K + k0 + 8 * c) = o; }
    asm volatile("s_waitcnt lgkmcnt(0)" ::: "memory");
}
__device__ __forceinline__ void p0_prologue(const Args& a, LAS unsigned char* lds, int G) {
    const int tid = opaque_v(threadIdx.x), lane = tid & 63, wave = tid >> 6;
    LAS unsigned* scr = (LAS unsigned*)(lds + wave * 8704);
    const int gw = blockIdx.x * 8 + wave, NGW = G * 8;
    unsigned char* ws = a.ws;
    constexpr int I_GU = DEPTH * NE * 16 * 32, I_D = DEPTH * NE * 16 * 16, I_IN = DEPTH * 16 * 136, I_PA = DEPTH * 256, I_PB = DEPTH * 8 * 16, I_O = DEPTH * 256;
    constexpr int NITEMS = I_GU + I_D + I_IN + I_PA + I_PB + I_O;
    for (int it = gw; it < NITEMS; it += NGW) {
        int r = it;
        if (r < I_GU) { const int mat = r / 512, q = r % 512, kb = q / 32, nb = q % 32, n0 = nb * 64, c = n0 & 1023, nd0 = (c >> 7) * 256 + ((c & 127) >> 5) * 64 + ((n0 >= 1024) ? 32 : 0);
            tr_item(a.in[I_WGU] + (size_t)mat * 1024 * 2048, 1024, 2048, (bf16_t*)(ws + WS_WGU) + (size_t)mat * 2048 * 1024, kb * 64, n0, nd0, scr, lane, 64); continue; }
        r -= I_GU;
        if (r < I_D) { const int mat = r / 256, q = r % 256, kb = q / 16, nb = q % 16;
            tr_item(a.in[I_WD] + (size_t)mat * 1024 * 1024, 1024, 1024, (bf16_t*)(ws + WS_WD) + (size_t)mat * 1024 * 1024, kb * 64, nb * 64, nb * 64, scr, lane); continue; }
        r -= I_D;
        if (r < I_IN) { const int mat = r / (16 * 136), q = r % (16 * 136), kb = q / 136, nb = q % 136;
            tr_item(a.in[I_WIN] + (size_t)mat * 1024 * DIN, 1024, DIN, (bf16_t*)(ws + WS_WIN) + (size_t)mat * DIN * 1024, kb * 64, nb * 64, nb * 64, scr, lane); continue; }
        r -= I_IN;
        if (r < I_PA) { const int mat = r / 256, q = r % 256, kb = q / 16, nb = q % 16;
            tr_item(a.in[I_WPA] + (size_t)mat * 1024 * 1024, 1024, 1024, (bf16_t*)(ws + WS_WPA) + (size_t)mat * 1024 * 1024, kb * 64, nb * 64, nb * 64, scr, lane); continue; }
        r -= I_PA;
        if (r < I_PB) { const int mat = r / 128, q = r % 128, kb = q / 16, nb = q % 16;
            tr_item(a.in[I_WPB] + (size_t)mat * 512 * 1024, 512, 1024, (bf16_t*)(ws + WS_WPB) + (size_t)mat * 1024 * 512, kb * 64, nb * 64, nb * 64, scr, lane); continue; }
        r -= I_PB;
        { const int mat = r / 256, q = r % 256, kb = q / 16, nb = q % 16;
            tr_item(a.in[I_WO] + (size_t)mat * 1024 * 1024, 1024, 1024, (bf16_t*)(ws + WS_WO) + (size_t)mat * 1024 * 1024, kb * 64, nb * 64, nb * 64, scr, lane); }
    }
    const size_t gt = (size_t)blockIdx.x * 512 + tid, NGT = (size_t)G * 512;
    { float* prm = (float*)(ws + WS_PRM);
#define CPY(idx, off, n) for (size_t i = gt; i < (size_t)(n) / 4; i += NGT) *(f32x4*)(prm + (off) + i * 4) = *(const f32x4*)(a.in[idx] + i * 4)
      CPY(I_BIN, PR_BIN, DEPTH * DIN); CPY(I_LNVG, PR_LNVG, DEPTH * D); CPY(I_LNVB, PR_LNVB, DEPTH * D); CPY(I_BS, PR_BS, DEPTH * D); CPY(I_LN1G, PR_LN1G, DEPTH * D); CPY(I_LN1B, PR_LN1B, DEPTH * D);
      CPY(I_WR, PR_WR, DEPTH * D * NE); CPY(I_BR, PR_BR, DEPTH * NE); CPY(I_BGU, PR_BGU, DEPTH * NE * 2048); CPY(I_BD, PR_BD, DEPTH * NE * D); CPY(I_LN2G, PR_LN2G, DEPTH * D); CPY(I_LN2B, PR_LN2B, DEPTH * D);
#undef CPY
    }
    { const float* src = a.in[I_WR]; bf16_t* img = (bf16_t*)(ws + WS_WRI);
      for (size_t i = gt; i < (size_t)DEPTH * D * NE; i += NGT) { const int l = (int)(i >> 15), k = (int)(i >> 5) & 1023, e = (int)i & 31; const float v = src[i]; const unsigned h = f2bf(v), lo = f2bf(v - __builtin_bit_cast(float, h << 16));
          img[(size_t)l * 65536 + e * 1024 + k] = (bf16_t)h; img[(size_t)l * 65536 + 32768 + e * 1024 + k] = (bf16_t)lo; } }
    { const float* src = a.in[I_WS]; bf16_t* dst = (bf16_t*)(ws + WS_WS);
      for (size_t i = gt; i < (size_t)DEPTH * 8 * 128 * 128 / 8; i += NGT) { const f32x4 x = *(const f32x4*)(src + i * 8), y = *(const f32x4*)(src + i * 8 + 4);
          u32x4 o; o.x = pk2(x[0], x[1]); o.y = pk2(x[2], x[3]); o.z = pk2(y[0], y[1]); o.w = pk2(y[2], y[3]); *(u32x4*)(dst + i * 8) = o; } }
    { bf16_t* dst = (bf16_t*)(ws + WS_XB);
      for (size_t i = gt; i < (size_t)T * D / 8; i += NGT) { const size_t e = i * 8; const float* src = (e < (size_t)TP * D) ? a.in[I_XP] + e : a.in[I_XS] + (e - (size_t)TP * D);
          const f32x4 x = *(const f32x4*)(src), y = *(const f32x4*)(src + 4);
          u32x4 o; o.x = pk2(x[0], x[1]); o.y = pk2(x[2], x[3]); o.z = pk2(y[0], y[1]); o.w = pk2(y[2], y[3]); *(u32x4*)(dst + e) = o; } }
}

template <int BASE> __device__ __forceinline__ void tr8(unsigned addr, s16x4 (&r)[8]) {
    asm volatile("ds_read_b64_tr_b16 %0, %8 offset:%9\n\tds_read_b64_tr_b16 %1, %8 offset:%10\n\tds_read_b64_tr_b16 %2, %8 offset:%11\n\tds_read_b64_tr_b16 %3, %8 offset:%12\n\t"
                 "ds_read_b64_tr_b16 %4, %8 offset:%13\n\tds_read_b64_tr_b16 %5, %8 offset:%14\n\tds_read_b64_tr_b16 %6, %8 offset:%15\n\tds_read_b64_tr_b16 %7, %8 offset:%16\n\t"
                 : "=&v"(r[0]), "=&v"(r[1]), "=&v"(r[2]), "=&v"(r[3]), "=&v"(r[4]), "=&v"(r[5]), "=&v"(r[6]), "=&v"(r[7])
                 : "v"(addr), "n"(BASE), "n"(BASE + 32), "n"(BASE + 64), "n"(BASE + 96), "n"(BASE + 128), "n"(BASE + 160), "n"(BASE + 192), "n"(BASE + 224) : "memory");
}
__device__ __forceinline__ bf16x8 cat4(s16x4 a, s16x4 b) { return (bf16x8){a[0], a[1], a[2], a[3], b[0], b[1], b[2], b[3]}; }

constexpr int AT_KSTR = 272, AT_VSTR = 288, AT_KBYTES = 256 * AT_KSTR, AT_VOFF = AT_KBYTES, AT_VBYTES = 256 * AT_VSTR;
constexpr int AT_EPI_OFF = AT_VOFF + AT_VBYTES;
static_assert(AT_EPI_OFF + 8 * 2304 <= SCR_BYTES, "attention LDS");

template <int ST> __device__ __forceinline__ void attn_pv_step(unsigned vaddr, const f32x4 (&s)[9], f32x4 (&o)[8]) {
    s16x4 r0[8], r1[8];
    tr8<ST * 32 * AT_VSTR>(vaddr, r0);
    tr8<ST * 32 * AT_VSTR + (ST < 4 ? 16 * AT_VSTR : 0)>(vaddr, r1);
    asm volatile("s_waitcnt lgkmcnt(0)" ::: "memory");
    __builtin_amdgcn_sched_barrier(0);
    u32x4 pw; pw.x = cvt_pk_bf16(s[2 * ST][0], s[2 * ST][1]); pw.y = cvt_pk_bf16(s[2 * ST][2], s[2 * ST][3]);
    if (ST < 4) { pw.z = cvt_pk_bf16(s[2 * ST + (ST < 4 ? 1 : 0)][0], s[2 * ST + (ST < 4 ? 1 : 0)][1]); pw.w = cvt_pk_bf16(s[2 * ST + (ST < 4 ? 1 : 0)][2], s[2 * ST + (ST < 4 ? 1 : 0)][3]); }
    else { pw.z = 0u; pw.w = 0u; }
    const bf16x8 pf = __builtin_bit_cast(bf16x8, pw);
#pragma unroll
    for (int db = 0; db < 8; ++db) o[db] = __builtin_amdgcn_mfma_f32_16x16x32_bf16(cat4(r0[db], r1[db]), pf, o[db], 0, 0, 0);
}

__device__ __forceinline__ void attn_load(const bf16_t* QKV, int unit, int tid, u32x4 (&kr)[8], u32x4 (&vr)[8]) {
    const int wsub = unit & 31, h = (unit >> 5) & 3, bg = unit >> 7, g = bg % 3, b = bg / 3;
    const int dsh = 2 * g, dil = 1 << dsh, L = SEQ >> dsh, nblk = L >> 7, r = wsub / nblk, blk = wsub % nblk, p0 = blk * 128;
    const int kc = g * 1536 + h * 128 + 512, vc = kc + 512;
#pragma unroll
    for (int j = 0; j < 8; ++j) { const int id = tid + 512 * j, kk = id >> 4, ch = id & 15, pk = p0 - 64 + kk; const bool ok = pk >= 0 && pk < L;
        const size_t ro = (size_t)(b * SEQ + (ok ? pk : 0) * dil + r) * QKVW; const u32x4 kx = *(const u32x4*)(QKV + ro + kc + ch * 8), vx = *(const u32x4*)(QKV + ro + vc + ch * 8);
        kr[j] = ok ? kx : (u32x4){0u, 0u, 0u, 0u}; vr[j] = ok ? vx : (u32x4){0u, 0u, 0u, 0u}; }
}
__device__ __forceinline__ void attn_unit(LAS unsigned char* lds, const bf16_t* QKV, bf16_t* OG, float* LSE, int unit, int unit_next, u32x4 (&kr)[8], u32x4 (&vr)[8]) {
    const int tid = opaque_v(threadIdx.x), lane = tid & 63, w = tid >> 6, ql = lane & 15, quad = lane >> 4;
    const int wsub = unit & 31, h = (unit >> 5) & 3, bg = unit >> 7, g = bg % 3, b = bg / 3;
    const int dsh = 2 * g, dil = 1 << dsh, L = SEQ >> dsh, nblk = L >> 7, r = wsub / nblk, blk = wsub % nblk, p0 = blk * 128;
    const int qc = g * 1536 + h * 128;
    const float slope = __builtin_amdgcn_exp2f(-(2.0f / 3.0f) * (float)(4 * g + h + 1));
    const float ca = slope * (float)dil * LOG2E, SC = 0.08838834764831845f * LOG2E;
#pragma unroll
    for (int j = 0; j < 8; ++j) { const int id = tid + 512 * j, kk = id >> 4, ch = id & 15;
        *(LAS u32x4*)(lds + kk * AT_KSTR + ch * 16) = kr[j]; *(LAS u32x4*)(lds + AT_VOFF + kk * AT_VSTR + ch * 16) = vr[j]; }
    const int qrow = b * SEQ + (p0 + 16 * w + ql) * dil + r;
    bf16x8 qf[4];
#pragma unroll
    for (int ks = 0; ks < 4; ++ks) qf[ks] = *(const bf16x8*)(QKV + (size_t)qrow * QKVW + qc + 32 * ks + 8 * quad);
    __syncthreads();
    asm volatile("" : "+v"(qf[0]), "+v"(qf[1]), "+v"(qf[2]), "+v"(qf[3]));
    attn_load(QKV, unit_next >= 0 ? unit_next : unit, tid, kr, vr);
    f32x4 s[9];
#pragma unroll
    for (int j = 0; j < 9; ++j) { s[j] = (f32x4){0.f, 0.f, 0.f, 0.f};
#pragma unroll
        for (int ks = 0; ks < 4; ++ks) { const bf16x8 kf = *(const LAS bf16x8*)(lds + (16 * w + 16 * j + ql) * AT_KSTR + (32 * ks + 8 * quad) * 2);
            s[j] = __builtin_amdgcn_mfma_f32_16x16x32_bf16(kf, qf[ks], s[j], 0, 0, 0); } }
    float mx = -1e30f;
#pragma unroll
    for (int j = 0; j < 9; ++j)
#pragma unroll
        for (int i = 0; i < 4; ++i) { const int rel = 16 * j + 4 * quad + i - 64 - ql, pk = p0 + 16 * w + ql + rel, ar = rel < 0 ? -rel : rel;
            const bool ok = (ar <= 64) && (pk >= 0) && (pk < L);
            const float v = ok ? (s[j][i] * SC - ca * (float)ar) : -1e30f; s[j][i] = v; mx = fmaxf(mx, v); }
    mx = fmaxf(mx, __shfl_xor(mx, 16)); mx = fmaxf(mx, __shfl_xor(mx, 32));
    float den = 0.f;
#pragma unroll
    for (int j = 0; j < 9; ++j)
#pragma unroll
        for (int i = 0; i < 4; ++i) { const float p = __builtin_amdgcn_exp2f(s[j][i] - mx); s[j][i] = p; den += p; }
    den += __shfl_xor(den, 16); den += __shfl_xor(den, 32);
    f32x4 o[8];
#pragma unroll
    for (int db = 0; db < 8; ++db) o[db] = (f32x4){0.f, 0.f, 0.f, 0.f};
    const unsigned vaddr = (unsigned)(uintptr_t)(lds + AT_VOFF) + (unsigned)((16 * w + 4 * quad + (ql >> 2)) * AT_VSTR + (ql & 3) * 8);
    attn_pv_step<0>(vaddr, s, o); attn_pv_step<1>(vaddr, s, o); attn_pv_step<2>(vaddr, s, o); attn_pv_step<3>(vaddr, s, o); attn_pv_step<4>(vaddr, s, o);
    const float inv = 1.0f / den;
    {
        LAS unsigned char* st = lds + AT_EPI_OFF + w * 2304;
        const int lr = lane >> 3, lc = lane & 7;
        bf16_t* od0 = OG + ((size_t)g * T + (size_t)(b * SEQ + (p0 + 16 * w + lr) * dil + r)) * 512 + h * 128 + lc * 8;
        bf16_t* od1 = OG + ((size_t)g * T + (size_t)(b * SEQ + (p0 + 16 * w + 8 + lr) * dil + r)) * 512 + h * 128 + lc * 8;
#pragma unroll
        for (int hh = 0; hh < 2; ++hh) {
#pragma unroll
            for (int d4 = 0; d4 < 4; ++d4) { const int db = 4 * hh + d4; u32x2 wv; wv.x = cvt_pk_bf16(o[db][0] * inv, o[db][1] * inv); wv.y = cvt_pk_bf16(o[db][2] * inv, o[db][3] * inv);
                *(LAS u32x2*)(st + ql * 144 + d4 * 32 + quad * 8) = wv; }
            const u32x4 r0 = *(const LAS u32x4*)(st + lr * 144 + lc * 16), r1 = *(const LAS u32x4*)(st + (8 + lr) * 144 + lc * 16);
            __builtin_nontemporal_store(r0, (u32x4*)(od0 + hh * 64)); __builtin_nontemporal_store(r1, (u32x4*)(od1 + hh * 64));
        }
    }
    if (quad == 0) LSE[((size_t)g * T + qrow) * 4 + h] = (mx + __builtin_amdgcn_logf(den)) * LN2;
    __syncthreads();
}

constexpr int SG_STR = 288, SG_TILE = 128 * SG_STR, SG_STATS = 2 * SG_TILE, SG_EPI_OFF = SG_STATS + 1024, SG_EPI_WBYTES = 16 * 528;
static_assert(SG_EPI_OFF + 8 * SG_EPI_WBYTES <= SCR_BYTES, "spatial gating LDS");
template <int KS> __device__ __forceinline__ void sg_step(unsigned vaddr, const bf16x8 wf, f32x4 (&acc)[8]) {
    s16x4 r0[8], r1[8];
    tr8<KS * 32 * SG_STR>(vaddr, r0);
    tr8<KS * 32 * SG_STR + 4 * SG_STR>(vaddr, r1);
    asm volatile("s_waitcnt lgkmcnt(0)" ::: "memory");
    __builtin_amdgcn_sched_barrier(0);
#pragma unroll
    for (int cb = 0; cb < 8; ++cb) acc[cb] = __builtin_amdgcn_mfma_f32_16x16x32_bf16(cat4(r0[cb], r1[cb]), wf, acc[cb], 0, 0, 0);
}
__device__ __forceinline__ void sg_unit(LAS unsigned char* lds, const bf16_t* U, const bf16_t* V, bf16_t* AOUT, const bf16_t* WsB, const float* bs, const float* lng, const float* lnb, const f32x2* PS, int unit) {
    const int tid = opaque_v(threadIdx.x), lane = tid & 63, w = tid >> 6, ql = lane & 15, quad = lane >> 4;
    const int ci = unit >> 1, hh = unit & 1, row0 = ci * 128;
    LAS float* stats = (LAS float*)(lds + SG_STATS);
    { const int row = tid >> 2, part = tid & 3; const f32x4 pa = *(const f32x4*)(PS + (size_t)(row0 + row) * 16 + part * 4), pb = *(const f32x4*)(PS + (size_t)(row0 + row) * 16 + part * 4 + 2);
      float sm = (pa[0] + pa[2]) + (pb[0] + pb[2]), sq = (pa[1] + pa[3]) + (pb[1] + pb[3]);
      sm += __shfl_xor(sm, 1); sq += __shfl_xor(sq, 1); sm += __shfl_xor(sm, 2); sq += __shfl_xor(sq, 2);
      const float mean = sm * (1.0f / D), rstd = 1.0f / sqrtf(fmaxf(sq * (1.0f / D) - mean * mean, 0.f) + LN_EPS);
      if (part == 0) { stats[2 * row] = mean; stats[2 * row + 1] = rstd; } }
    __syncthreads();
    const int ch = tid & 15;
    u32x4 vt[4]; bf16x8 wf[4]; f32x4 gab[4];
#define SG_LOADG(GI) do { const int g_ = 4 * hh + (GI); \
        _Pragma("unroll") for (int j = 0; j < 4; ++j) vt[j] = *(const u32x4*)(V + (size_t)(row0 + (tid >> 4) + 32 * j) * D + g_ * 128 + ch * 8); \
        gab[0] = *(const f32x4*)(lng + g_ * 128 + ch * 8); gab[1] = *(const f32x4*)(lng + g_ * 128 + ch * 8 + 4); gab[2] = *(const f32x4*)(lnb + g_ * 128 + ch * 8); gab[3] = *(const f32x4*)(lnb + g_ * 128 + ch * 8 + 4); \
        const bf16_t* Wg_ = WsB + (size_t)g_ * 128 * 128 + (size_t)(16 * w + ql) * 128 + 8 * quad; \
        _Pragma("unroll") for (int ks = 0; ks < 4; ++ks) wf[ks] = *(const bf16x8*)(Wg_ + 32 * ks); } while (0)
    SG_LOADG(0);
#pragma unroll 1
    for (int gi = 0; gi < 4; ++gi) {
        const int g = 4 * hh + gi; LAS unsigned char* tile = lds + (gi & 1) * SG_TILE;
#pragma unroll
        for (int j = 0; j < 4; ++j) { const int sr = (tid >> 4) + 32 * j; const u32x4 x = vt[j];
            const float mean = stats[2 * sr], rstd = stats[2 * sr + 1];
            const f32x4 a = ((f32x4){bflo(x.x), bfhi(x.x), bflo(x.y), bfhi(x.y)} - mean) * rstd * gab[0] + gab[2], bq = ((f32x4){bflo(x.z), bfhi(x.z), bflo(x.w), bfhi(x.w)} - mean) * rstd * gab[1] + gab[3];
            u32x4 o; o.x = cvt_pk_bf16(a[0], a[1]); o.y = cvt_pk_bf16(a[2], a[3]); o.z = cvt_pk_bf16(bq[0], bq[1]); o.w = cvt_pk_bf16(bq[2], bq[3]);
            *(LAS u32x4*)(tile + sr * SG_STR + ch * 16) = o; }
        bf16x8 wfc[4];
#pragma unroll
        for (int ks = 0; ks < 4; ++ks) { wfc[ks] = wf[ks]; asm volatile("" : "+v"(wfc[ks])); }
        __syncthreads();
        const size_t off = (size_t)(row0 + 16 * w + (lane >> 5)) * D + g * 128 + 4 * (lane & 31);
        u32x2 uu[8];
#pragma unroll
        for (int it = 0; it < 8; ++it) uu[it] = *(const u32x2*)(U + off + (size_t)(2 * it) * D);
        SG_LOADG(gi < 3 ? gi + 1 : 3);
        f32x4 acc[8];
#pragma unroll
        for (int cb = 0; cb < 8; ++cb) acc[cb] = (f32x4){0.f, 0.f, 0.f, 0.f};
        const unsigned vaddr = (unsigned)(uintptr_t)tile + (unsigned)((8 * quad + (ql >> 2)) * SG_STR + (ql & 3) * 8);
        sg_step<0>(vaddr, wfc[0], acc); sg_step<1>(vaddr, wfc[1], acc); sg_step<2>(vaddr, wfc[2], acc); sg_step<3>(vaddr, wfc[3], acc);
        const int t = 16 * w + ql; const float bst = bs[g * 128 + t];
        LAS unsigned char* st = lds + SG_EPI_OFF + w * SG_EPI_WBYTES;
#pragma unroll
        for (int cb = 0; cb < 8; ++cb) *(LAS f32x4*)(st + ql * 528 + 64 * cb + 16 * quad) = acc[cb] + bst;
#pragma unroll
        for (int it = 0; it < 8; ++it) { const f32x4 mv = *(const LAS f32x4*)(st + (2 * it + (lane >> 5)) * 528 + (lane & 31) * 16);
            u32x2 o; o.x = cvt_pk_bf16(bflo(uu[it].x) * mv[0], bfhi(uu[it].x) * mv[1]); o.y = cvt_pk_bf16(bflo(uu[it].y) * mv[2], bfhi(uu[it].y) * mv[3]);
            __builtin_nontemporal_store(o, (u32x2*)(AOUT + off + (size_t)(2 * it) * D)); }
    }
#undef SG_LOADG
    __syncthreads();
}

__device__ __forceinline__ void merge_phase(const bf16_t* OG, const float* LSE, bf16_t* BOUT, int G) {
    const int tid = opaque_v(threadIdx.x), lane = tid & 63, gw = blockIdx.x * 8 + (tid >> 6), NGW = G * 8, hd = lane >> 4;
    for (int row = gw; row < T; row += NGW) {
        const float l0 = LSE[((size_t)0 * T + row) * 4 + hd], l1 = LSE[((size_t)1 * T + row) * 4 + hd], l2 = LSE[((size_t)2 * T + row) * 4 + hd];
        const float m = fmaxf(l0, fmaxf(l1, l2));
        float w0 = __builtin_amdgcn_exp2f((l0 - m) * LOG2E), w1 = __builtin_amdgcn_exp2f((l1 - m) * LOG2E), w2 = __builtin_amdgcn_exp2f((l2 - m) * LOG2E);
        const float inv = 1.0f / (w0 + w1 + w2); w0 *= inv; w1 *= inv; w2 *= inv;
        const u32x4 a = *(const u32x4*)(OG + ((size_t)0 * T + row) * 512 + lane * 8), b = *(const u32x4*)(OG + ((size_t)1 * T + row) * 512 + lane * 8), c = *(const u32x4*)(OG + ((size_t)2 * T + row) * 512 + lane * 8);
        u32x4 o;
        o.x = cvt_pk_bf16(w0 * bflo(a.x) + w1 * bflo(b.x) + w2 * bflo(c.x), w0 * bfhi(a.x) + w1 * bfhi(b.x) + w2 * bfhi(c.x));
        o.y = cvt_pk_bf16(w0 * bflo(a.y) + w1 * bflo(b.y) + w2 * bflo(c.y), w0 * bfhi(a.y) + w1 * bfhi(b.y) + w2 * bfhi(c.y));
        o.z = cvt_pk_bf16(w0 * bflo(a.z) + w1 * bflo(b.z) + w2 * bflo(c.z), w0 * bfhi(a.z) + w1 * bfhi(b.z) + w2 * bfhi(c.z));
        o.w = cvt_pk_bf16(w0 * bflo(a.w) + w1 * bflo(b.w) + w2 * bflo(c.w), w0 * bfhi(a.w) + w1 * bfhi(b.w) + w2 * bfhi(c.w));
        __builtin_nontemporal_store(o, (u32x4*)(BOUT + (size_t)row * 512 + lane * 8));
    }
}

constexpr int RT_WSTR = 2064, RT_WL = 32 * RT_WSTR, RT_GB = 2 * RT_WL, RT_ST = RT_GB + 8192, RT_STW = 2560;
static_assert(RT_ST + 8 * RT_STW <= SCR_BYTES, "router LDS");
#if !Y1_BF16
#error "P5 keeps a wave's rows in registers: it needs the bf16 y1"
#endif
#define P5_UNPK(q) ((f32x4){bflo((q).x), bfhi((q).x), bflo((q).y), bfhi((q).y)})
template <bool HASB> __device__ __forceinline__ void p5_tile(LAS unsigned char* lds, u32x2 (&ra)[32], u32x2 (&rb)[32], bool liveA, bool liveB, int rowA, int rowB, f32x2* RS, bf16_t* XB,
                                                             int lane_, int w, const float (&bre)[8], float (&lg)[8]) {
    const int lane = opaque_v(lane_), r = lane & 15, quad = lane >> 4, lr = lane >> 3, lc = lane & 7;
    float smA = 0.f, sqA = 0.f, smB = 0.f, sqB = 0.f;
#pragma unroll
    for (int s = 0; s < 32; ++s) { const f32x4 a = P5_UNPK(ra[s]);
        smA += (a[0] + a[1]) + (a[2] + a[3]); sqA += (a[0] * a[0] + a[1] * a[1]) + (a[2] * a[2] + a[3] * a[3]);
        if (HASB) { const f32x4 b = P5_UNPK(rb[s]); smB += (b[0] + b[1]) + (b[2] + b[3]); sqB += (b[0] * b[0] + b[1] * b[1]) + (b[2] * b[2] + b[3] * b[3]); } }
#pragma unroll
    for (int o = 1; o < 8; o <<= 1) { smA += __shfl_xor(smA, o); sqA += __shfl_xor(sqA, o); if (HASB) { smB += __shfl_xor(smB, o); sqB += __shfl_xor(sqB, o); } }
    const float meanA = smA * (1.0f / D), rstdA = 1.0f / sqrtf(fmaxf(sqA * (1.0f / D) - meanA * meanA, 0.f) + LN_EPS);
    const float meanB = smB * (1.0f / D), rstdB = 1.0f / sqrtf(fmaxf(sqB * (1.0f / D) - meanB * meanB, 0.f) + LN_EPS);
    if (lc == 0) { if (liveA) RS[rowA] = (f32x2){meanA, rstdA}; if (HASB && liveB) RS[rowB] = (f32x2){meanB, rstdB}; }
#pragma unroll
    for (int s = 0; s < 32; ++s) { asm volatile("" : "+v"(ra[s])); if (HASB) asm volatile("" : "+v"(rb[s])); }
    f32x4 acc[2] = {(f32x4){0.f, 0.f, 0.f, 0.f}, (f32x4){0.f, 0.f, 0.f, 0.f}};
    const LAS unsigned char* wp = lds + r * RT_WSTR + 16 * quad;
    LAS unsigned char* stw = lds + RT_ST + w * RT_STW;
    const LAS float* gl = (const LAS float*)(lds + RT_GB) + 4 * lc; const LAS float* bl = gl + 1024;
    bf16_t* xoA = XB + (size_t)rowA * D + 4 * lc; bf16_t* xoB = XB + (size_t)rowB * D + 4 * lc;
#pragma unroll
    for (int s = 0; s < 32; ++s) {
        const f32x4 a = P5_UNPK(ra[s]);
        const f32x4 gv = *(const LAS f32x4*)(gl + 32 * s), bv = *(const LAS f32x4*)(bl + 32 * s);
        const f32x4 xa = (a - meanA) * rstdA * gv + bv;
        u32x2 ha, la;
        ha.x = cvt_pk_bf16(xa[0], xa[1]); ha.y = cvt_pk_bf16(xa[2], xa[3]);
        la.x = cvt_pk_bf16(xa[0] - bflo(ha.x), xa[1] - bfhi(ha.x)); la.y = cvt_pk_bf16(xa[2] - bflo(ha.y), xa[3] - bfhi(ha.y));
        if (liveA) *(u32x2*)(xoA + 32 * s) = ha;
        *(LAS u32x2*)(stw + lr * 80 + lc * 8) = ha; *(LAS u32x2*)(stw + 1280 + lr * 80 + lc * 8) = la;
        if (HASB) { const f32x4 b = P5_UNPK(rb[s]); const f32x4 xb = (b - meanB) * rstdB * gv + bv; u32x2 hb, lb;
            hb.x = cvt_pk_bf16(xb[0], xb[1]); hb.y = cvt_pk_bf16(xb[2], xb[3]); lb.x = cvt_pk_bf16(xb[0] - bflo(hb.x), xb[1] - bfhi(hb.x)); lb.y = cvt_pk_bf16(xb[2] - bflo(hb.y), xb[3] - bfhi(hb.y));
            if (liveB) *(u32x2*)(xoB + 32 * s) = hb;
            *(LAS u32x2*)(stw + (8 + lr) * 80 + lc * 8) = hb; *(LAS u32x2*)(stw + 1280 + (8 + lr) * 80 + lc * 8) = lb; }
        const bf16x8 xh = *(const LAS bf16x8*)(stw + r * 80 + quad * 16), xl = *(const LAS bf16x8*)(stw + 1280 + r * 80 + quad * 16);
#pragma unroll
        for (int eb = 0; eb < 2; ++eb) { const bf16x8 wh = *(const LAS bf16x8*)(wp + eb * 16 * RT_WSTR + 64 * s), wl = *(const LAS bf16x8*)(wp + RT_WL + eb * 16 * RT_WSTR + 64 * s);
            acc[eb] = __builtin_amdgcn_mfma_f32_16x16x32_bf16(wh, xh, acc[eb], 0, 0, 0); acc[eb] = __builtin_amdgcn_mfma_f32_16x16x32_bf16(wh, xl, acc[eb], 0, 0, 0); acc[eb] = __builtin_amdgcn_mfma_f32_16x16x32_bf16(wl, xh, acc[eb], 0, 0, 0); }
    }
#pragma unroll
    for (int eb = 0; eb < 2; ++eb)
#pragma unroll
        for (int i = 0; i < 4; ++i) lg[eb * 4 + i] = acc[eb][i] + bre[eb * 4 + i];
}
__device__ __forceinline__ void p5_route(float (&lg)[8], bool live, int row, int lane_, int tid_, volatile LAS unsigned* lcnt, volatile LAS unsigned* gbase, unsigned* gcnt, int* tokList, int* tokE, int* tokPos, float* gate) {
    const int lane = opaque_v(lane_), tid = opaque_v(tid_), quad = lane >> 4;
    float tv[4]; int ti[4];
#pragma unroll
    for (int k = 0; k < 4; ++k) { float bvv = lg[0]; int bi = 4 * quad;
#pragma unroll
        for (int j = 1; j < 8; ++j) { const int ej = 16 * (j >> 2) + 4 * quad + (j & 3); if (lg[j] > bvv) { bvv = lg[j]; bi = ej; } }
#pragma unroll
        for (int o = 16; o < 64; o <<= 1) { const float ov = __shfl_xor(bvv, o); const int oi = __shfl_xor(bi, o); if (ov > bvv || (ov == bvv && oi < bi)) { bvv = ov; bi = oi; } }
        tv[k] = bvv; ti[k] = bi;
#pragma unroll
        for (int j = 0; j < 8; ++j) { const int ej = 16 * (j >> 2) + 4 * quad + (j & 3); if (ej == bi) lg[j] = -3.0e38f; } }
    const float e1 = __builtin_amdgcn_exp2f((tv[1] - tv[0]) * LOG2E), e2 = __builtin_amdgcn_exp2f((tv[2] - tv[0]) * LOG2E), e3 = __builtin_amdgcn_exp2f((tv[3] - tv[0]) * LOG2E);
    const float inv = 1.0f / (1.0f + e1 + e2 + e3);
    const int ek = quad == 0 ? ti[0] : quad == 1 ? ti[1] : quad == 2 ? ti[2] : ti[3]; const float gk = (quad == 0 ? 1.0f : quad == 1 ? e1 : quad == 2 ? e2 : e3) * inv;
    int lp = -1;
    if (live) { lp = (int)__hip_atomic_fetch_add((LAS unsigned*)&lcnt[ek], 1u, __ATOMIC_RELAXED, __HIP_MEMORY_SCOPE_WORKGROUP);
        gate[(size_t)row * 4 + quad] = gk; tokE[(size_t)row * 4 + quad] = ek; }
    __syncthreads();
    if (tid < 32) { const unsigned n = lcnt[tid]; gbase[tid] = n ? __hip_atomic_fetch_add(gcnt + tid, n, __ATOMIC_RELAXED, __HIP_MEMORY_SCOPE_AGENT) : 0u; }
    __syncthreads();
    if (lp >= 0) { const int pos = (int)gbase[ek] + lp; tokList[(size_t)ek * T + pos] = row; tokPos[(size_t)row * 4 + quad] = pos; }
    if (tid < 32) lcnt[tid] = 0u;
    __syncthreads();
}
__device__ __forceinline__ void ln1_router_phase(LAS unsigned char* lds, volatile LAS unsigned* MISC, f32x2* RS, const y1_t* XFin, y1_t* XF, bf16_t* XB, const float* g1, const float* b1, const bf16_t* wri, const float* br,
                                                 unsigned* gcnt, int* tokList, int* tokE, int* tokPos, float* gate, int G) {
    const int tid = opaque_v(threadIdx.x), lane = tid & 63, w = tid >> 6, r = lane & 15, quad = lane >> 4, lr = lane >> 3, lc = lane & 7;
    volatile LAS unsigned* lcnt = MISC + 128; volatile LAS unsigned* gbase = MISC + 160;
    float bre[8];
#pragma unroll
    for (int eb = 0; eb < 2; ++eb)
#pragma unroll
        for (int i = 0; i < 4; ++i) bre[eb * 4 + i] = br[16 * eb + 4 * quad + i];
    constexpr int NCHUNK = T / 24;
    const int iters = (NCHUNK + 8 * G - 1) / (8 * G);
    for (int it = 0; it < iters; ++it) {
        const int chunk = (it * G + blockIdx.x) * 8 + w;
        const bool live_chunk = chunk < NCHUNK;
        const int row0 = opaque_v(live_chunk ? chunk * 24 : 0);
        u32x2 ra[32], rb[32];
        { const y1_t* xa_ = XFin + (size_t)(row0 + lr) * D + 4 * lc;
#pragma unroll
          for (int s = 0; s < 32; ++s) { ra[s] = *(const u32x2*)(xa_ + 32 * s); rb[s] = *(const u32x2*)(xa_ + (size_t)8 * D + 32 * s); } }
        if (it == 0) {
_Pragma("unroll 4")
            for (int j = 0; j < 16; ++j) { const int u = tid + 512 * j; const u32x4 v = ((const u32x4*)wri)[u]; *(LAS u32x4*)(lds + (u >> 12) * RT_WL + ((u >> 7) & 31) * RT_WSTR + (u & 127) * 16) = v; }
            for (int i = tid; i < 1024; i += 512) { ((LAS float*)(lds + RT_GB))[i] = g1[i]; ((LAS float*)(lds + RT_GB))[1024 + i] = b1[i]; }
            if (tid < 32) lcnt[tid] = 0u;
            __syncthreads();
        }
        float lg[8];
        p5_tile<true>(lds, ra, rb, live_chunk, live_chunk, row0 + lr, row0 + 8 + lr, RS, XB, lane, w, bre, lg);
        asm volatile("" ::: "memory");
        u32x2 rc[32];
        { const y1_t* xc_ = XFin + (size_t)(row0 + 16 + lr) * D + 4 * lc;
#pragma unroll
          for (int s = 0; s < 32; ++s) rc[s] = *(const u32x2*)(xc_ + 32 * s); }
        p5_route(lg, live_chunk, row0 + r, lane, tid, lcnt, gbase, gcnt, tokList, tokE, tokPos, gate);
        p5_tile<false>(lds, rc, rc, live_chunk, false, row0 + 16 + lr, row0 + 16 + lr, RS, XB, lane, w, bre, lg);
        p5_route(lg, live_chunk && (r < 8), row0 + 16 + (r & 7), lane, tid, lcnt, gbase, gcnt, tokList, tokE, tokPos, gate);
    }
}

__device__ __forceinline__ void combine_ln2_phase(volatile LAS unsigned* MISC, const f32x2* RS, const float* g1, const float* b1, const y1_t* XF, const bf16_t* YK, const int* tokE, const int* tokPos, const float* gate, const float* g2, const float* b2,
                                                  float* outF, bf16_t* XB, int G) {
    const int tid = opaque_v(threadIdx.x), lane = tid & 63, gw = blockIdx.x * 8 + (tid >> 6), NGW = G * 8;
    const volatile LAS int* tb = (const volatile LAS int*)(MISC + 16);
    f32x4 gv[4], bv[4];
#pragma unroll
    for (int j = 0; j < 4; ++j) { gv[j] = *(const f32x4*)(g2 + 256 * j + 4 * lane); bv[j] = *(const f32x4*)(b2 + 256 * j + 4 * lane); }
    f32x4 gv1[4], bv1[4];
#pragma unroll
    for (int j = 0; j < 4; ++j) { gv1[j] = *(const f32x4*)(g1 + 256 * j + 4 * lane); bv1[j] = *(const f32x4*)(b1 + 256 * j + 4 * lane); }
    typedef int i32x4 __attribute__((ext_vector_type(4)));
    i32x4 ne = *(const i32x4*)(tokE + (size_t)(gw < T ? gw : 0) * 4), np = *(const i32x4*)(tokPos + (size_t)(gw < T ? gw : 0) * 4); f32x4 ng = *(const f32x4*)(gate + (size_t)(gw < T ? gw : 0) * 4);
    for (int row = gw; row < T; row += NGW) {
        const i32x4 ce = ne, cpz = np; const f32x4 cg = ng;
        f32x4 v[4]; u32x2 y[4][4];
#pragma unroll
        for (int j = 0; j < 4; ++j) v[j] = Y1_LD4(XF + (size_t)row * D + 256 * j + 4 * lane);
        const f32x2 rs = RS[row];
#pragma unroll
        for (int k = 0; k < 4; ++k) { const size_t slot = (size_t)tb[ce[k]] * 256 + cpz[k];
#pragma unroll
            for (int j = 0; j < 4; ++j) y[k][j] = __builtin_nontemporal_load((const u32x2*)(YK + slot * D + 256 * j + 4 * lane)); }
        { const int rn = (row + NGW < T) ? row + NGW : row; ne = *(const i32x4*)(tokE + (size_t)rn * 4); np = *(const i32x4*)(tokPos + (size_t)rn * 4); ng = *(const f32x4*)(gate + (size_t)rn * 4); }
#pragma unroll
        for (int j = 0; j < 4; ++j) { v[j] = ((v[j] - rs[0]) * rs[1] * gv1[j] + bv1[j]) * DN_ALPHA;
#pragma unroll
            for (int k = 0; k < 4; ++k) v[j] += (f32x4){bflo(y[k][j].x), bfhi(y[k][j].x), bflo(y[k][j].y), bfhi(y[k][j].y)} * cg[k]; }
        float s = 0.f;
#pragma unroll
        for (int j = 0; j < 4; ++j) s += (v[j][0] + v[j][1]) + (v[j][2] + v[j][3]);
        const float mean = wave_sum(s) * (1.0f / D); float s2 = 0.f;
#pragma unroll
        for (int j = 0; j < 4; ++j) { v[j] = v[j] - mean; s2 += (v[j][0] * v[j][0] + v[j][1] * v[j][1]) + (v[j][2] * v[j][2] + v[j][3] * v[j][3]); }
        const float rstd = 1.0f / sqrtf(wave_sum(s2) * (1.0f / D) + LN_EPS);
#pragma unroll
        for (int j = 0; j < 4; ++j) { v[j] = v[j] * rstd * gv[j] + bv[j];
            if (outF) __builtin_nontemporal_store(v[j], (f32x4*)(outF + (size_t)row * D + 256 * j + 4 * lane));
            if (!outF) { u32x2 o; o.x = cvt_pk_bf16(v[j][0], v[j][1]); o.y = cvt_pk_bf16(v[j][2], v[j][3]); *(u32x2*)(XB + (size_t)row * D + 256 * j + 4 * lane) = o; } }
    }
}

__device__ __forceinline__ void moe_tables(volatile LAS unsigned* MISC, const unsigned* gcnt) {
    const int tid_ = opaque_v(threadIdx.x);
    if (tid_ < 64) {
        const int lane = tid_;
        const int n = lane < NE ? (int)__hip_atomic_load(gcnt + lane, __ATOMIC_RELAXED, __HIP_MEMORY_SCOPE_AGENT) : 0;
        const int nt = (n + 255) >> 8; int incl = nt;
#pragma unroll
        for (int o = 1; o < 32; o <<= 1) { const int v = __shfl_up(incl, o); if (lane >= o) incl += v; }
        if (lane < NE) { MISC[64 + lane] = (unsigned)n; MISC[16 + lane] = (unsigned)(incl - nt); }
        if (lane == NE - 1) MISC[16 + NE] = (unsigned)incl;
        if (lane < NE) { volatile LAS unsigned char* tmap = (volatile LAS unsigned char*)MISC - (MISC_OFF - TMAP_OFF); for (int k = 0; k < nt; ++k) tmap[incl - nt + k] = (unsigned char)lane; }
    }
    __syncthreads();
}

__device__ __forceinline__ void stagger(int span_ticks) {
    const unsigned long long t0 = __builtin_amdgcn_s_memrealtime(); const unsigned long long d = (unsigned long long)((((int)blockIdx.x >> 3) & 31) * span_ticks) >> 5;
    while (__builtin_amdgcn_s_memrealtime() - t0 < d) __builtin_amdgcn_s_sleep(8);
}
__global__ void __launch_bounds__(512, 2) fwd_kernel(Args args) {
    extern __shared__ __attribute__((aligned(16))) unsigned char lds_raw[];
    LAS unsigned char* lds = (LAS unsigned char*)lds_raw;
    volatile LAS unsigned* MISC = (volatile LAS unsigned*)(lds + MISC_OFF);
    const int tid = threadIdx.x, G = gridDim.x;
    unsigned char* const ws0 = args.ws;
    unsigned* ctl = (unsigned*)(ws0 + WS_CTL);
    for (int u = tid; u < 256; u += 512) MISC[u] = 0u;
    __syncthreads();
    const int lo = args.ph_lo, hi = args.ph_hi;
    XcdBarrier bar; bar.bar = ctl + CW_BAR; bar.x = 0; bar.st = MISC;
    if (hi - lo > 1) bar = xcd_barrier_post(ctl + CW_BAR, MISC);
#ifndef PH_MASK
#define PH_MASK 0x3ff
#endif
#define IN(k) (lo <= (k) && (k) < hi)
#define PON(p) (((PH_MASK) >> (p)) & 1)
#define SEAM(k) do { if (IN((k) + 1)) { XcdBarrier b2_ = bar; b2_.bar = opaque_p(bar.bar); { unsigned x_ = bar.x; asm volatile("" : "+s"(x_)); b2_.x = x_; } xcd_barrier(b2_); } } while (0)
#ifndef DUP_MASK
#define DUP_MASK 0
#endif
#define REP(p) _Pragma("unroll 1") for (int rep_ = 0; rep_ < ((((DUP_MASK) >> (p)) & 1) ? opaque_v(2) : 1); ++rep_)
#define WSP(T_, off) ((T_*)(ws + (off)))
#define PRM(off) ((const float*)(ws + WS_PRM) + (off))

    if (PON(9) && IN(0)) { REP(9) p0_prologue(args, lds, G); SEAM(0); }

#pragma unroll 1
    for (int l = 0; l < DEPTH; ++l) {
        const int pb = 1 + l * NPH;
        if (PON(0) && IN(pb + 0)) { unsigned char* ws = opaque_p(ws0); unsigned* ctl = (unsigned*)(ws + WS_CTL); (void)ctl; const int Gp = opaque_s(G), cp = opaque_s((int)blockIdx.x); (void)Gp; (void)cp;
            pg8::DenseSched S{WSP(const bf16_t, WS_XB), WSP(const bf16_t, WS_WIN) + (size_t)l * DIN * D, D, T / 256, DIN / 256, Gp, cp};
            pg8::EpiIn E{PRM(PR_BIN) + (size_t)l * DIN, WSP(bf16_t, WS_U), WSP(bf16_t, WS_V), WSP(bf16_t, WS_QKV), WSP(bf16_t, WS_GA), WSP(bf16_t, WS_GB), WSP(f32x2, WS_PS)};
#ifdef STAG_P1
            stagger(STAG_P1);
#endif
            REP(0) pg8::gemm_phase<pg8::EpiIn, pg8::DenseSched, true>(lds, S, E);
            SEAM(pb + 0);
        }
        if (PON(1) && IN(pb + 1)) { unsigned char* ws = opaque_p(ws0); unsigned* ctl = (unsigned*)(ws + WS_CTL); (void)ctl; const int Gp = opaque_s(G), cp = opaque_s((int)blockIdx.x); (void)Gp; (void)cp;
            const int vcu = (Gp % 8 == 0) ? (cp % 8) * (Gp / 8) + cp / 8 : cp;
            { constexpr int NU = 12 * 3 * 4 * 32, NS = 768;
                const int na = (NU - vcu + Gp - 1) / Gp;
                const int ka = (na * ((vcu >> 3) % 7)) / 6;
                const int usplit = vcu + (ka < na ? ka : na) * Gp;
                { u32x4 kr[8], vr[8];
                  _Pragma("unroll") for (int j = 0; j < 8; ++j) { kr[j] = (u32x4){0u, 0u, 0u, 0u}; vr[j] = (u32x4){0u, 0u, 0u, 0u}; }
                  if (vcu < usplit) attn_load(WSP(const bf16_t, WS_QKV), vcu, opaque_v(threadIdx.x), kr, vr);
                  for (int u = vcu; u < usplit; u += Gp) attn_unit(lds, WSP(const bf16_t, WS_QKV), WSP(bf16_t, WS_OG), WSP(float, WS_LSE), u, (u + Gp < usplit) ? u + Gp : -1, kr, vr); }
                for (int u = vcu; u < NS; u += Gp)
                    sg_unit(lds, WSP(const bf16_t, WS_U), WSP(const bf16_t, WS_V), WSP(bf16_t, WS_AOUT), WSP(const bf16_t, WS_WS) + (size_t)l * 8 * 128 * 128, PRM(PR_BS) + (size_t)l * 1024, PRM(PR_LNVG) + (size_t)l * 1024, PRM(PR_LNVB) + (size_t)l * 1024, WSP(const f32x2, WS_PS), u);
                { u32x4 kr[8], vr[8];
                  _Pragma("unroll") for (int j = 0; j < 8; ++j) { kr[j] = (u32x4){0u, 0u, 0u, 0u}; vr[j] = (u32x4){0u, 0u, 0u, 0u}; }
                  if (usplit < NU) attn_load(WSP(const bf16_t, WS_QKV), usplit, opaque_v(threadIdx.x), kr, vr);
                  for (int u = usplit; u < NU; u += Gp) attn_unit(lds, WSP(const bf16_t, WS_QKV), WSP(bf16_t, WS_OG), WSP(float, WS_LSE), u, (u + Gp < NU) ? u + Gp : -1, kr, vr); }
            }
            SEAM(pb + 1);
        }
        if (PON(2) && IN(pb + 2)) { unsigned char* ws = opaque_p(ws0); unsigned* ctl = (unsigned*)(ws + WS_CTL); (void)ctl; const int Gp = opaque_s(G), cp = opaque_s((int)blockIdx.x); (void)Gp; (void)cp; REP(2) merge_phase(WSP(const bf16_t, WS_OG), WSP(const float, WS_LSE), WSP(bf16_t, WS_BOUT), Gp); SEAM(pb + 2); }
        if (PON(3) && IN(pb + 3)) { unsigned char* ws = opaque_p(ws0); unsigned* ctl = (unsigned*)(ws + WS_CTL); (void)ctl; const int Gp = opaque_s(G), cp = opaque_s((int)blockIdx.x); (void)Gp; (void)cp;
            pg8::Dense2Sched S{WSP(const bf16_t, WS_AOUT), WSP(const bf16_t, WS_WPA) + (size_t)l * D * D, D, WSP(const bf16_t, WS_BOUT), WSP(const bf16_t, WS_WPB) + (size_t)l * D * 512, 512, T / 256, D / 256, Gp, cp};
            pg8::EpiMg2 E{WSP(const bf16_t, WS_GA), WSP(const bf16_t, WS_GB), WSP(bf16_t, WS_MG)};
            REP(3) pg8::gemm_phase2<pg8::EpiMg2>(lds, S, E);
            SEAM(pb + 3);
        }
        if (PON(4) && IN(pb + 4)) { unsigned char* ws = opaque_p(ws0); unsigned* ctl = (unsigned*)(ws + WS_CTL); (void)ctl; const int Gp = opaque_s(G), cp = opaque_s((int)blockIdx.x); (void)Gp; (void)cp;
            pg8::DenseSched S{WSP(const bf16_t, WS_MG), WSP(const bf16_t, WS_WO) + (size_t)l * D * D, D, T / 256, D / 256, Gp, cp};
            pg8::EpiWo E{args.in[I_XP], args.in[I_XS] - (size_t)TP * D, l == 0 ? (const bf16_t*)nullptr : WSP(const bf16_t, WS_XB), WSP(y1_t, WS_XF)};
            pg8::gemm_phase<pg8::EpiWo, pg8::DenseSched, true>(lds, S, E);
            SEAM(pb + 4);
        }
        if (PON(5) && IN(pb + 5)) { unsigned char* ws = opaque_p(ws0); unsigned* ctl = (unsigned*)(ws + WS_CTL); (void)ctl; const int Gp = opaque_s(G), cp = opaque_s((int)blockIdx.x); (void)Gp; (void)cp;
            if (((DUP_MASK) >> 5) & 1) ln1_router_phase(lds, MISC, WSP(f32x2, WS_RS), WSP(const y1_t, WS_XF), WSP(y1_t, WS_T1), WSP(bf16_t, WS_U), PRM(PR_LN1G) + (size_t)l * D, PRM(PR_LN1B) + (size_t)l * D, WSP(const bf16_t, WS_WRI) + (size_t)l * 65536, PRM(PR_BR) + (size_t)l * NE,
                             ctl + CW_CNT + 1024 + l * 64, WSP(int, WS_OG), WSP(int, WS_LSE), WSP(int, WS_BOUT), WSP(float, WS_AOUT), Gp);
            ln1_router_phase(lds, MISC, WSP(f32x2, WS_RS), WSP(const y1_t, WS_XF), WSP(y1_t, WS_XF), WSP(bf16_t, WS_XB), PRM(PR_LN1G) + (size_t)l * D, PRM(PR_LN1B) + (size_t)l * D, WSP(const bf16_t, WS_WRI) + (size_t)l * 65536, PRM(PR_BR) + (size_t)l * NE,
                             ctl + CW_CNT + l * 64, WSP(int, WS_TOKLIST), WSP(int, WS_TOKE), WSP(int, WS_TOKPOS), WSP(float, WS_GATE), Gp);
            SEAM(pb + 5);
        }
        if (PON(6) && IN(pb + 6)) { unsigned char* ws = opaque_p(ws0); unsigned* ctl = (unsigned*)(ws + WS_CTL); (void)ctl; const int Gp = opaque_s(G), cp = opaque_s((int)blockIdx.x); (void)Gp; (void)cp;
            moe_tables(MISC, ctl + CW_CNT + l * 64);
            pg8::MoeSched<true> S{WSP(const bf16_t, WS_XB), WSP(const bf16_t, WS_WGU) + (size_t)l * NE * 2048 * D, D, 8, Gp, cp, (size_t)2048 * D * 2, (const LAS int*)(lds + MISC_OFF + 64), (const LAS int*)(lds + MISC_OFF + 256), WSP(const int, WS_TOKLIST)};
            pg8::EpiGU E{PRM(PR_BGU) + (size_t)l * NE * 2048, WSP(bf16_t, WS_H)};
            REP(6) pg8::gemm_phase<pg8::EpiGU, pg8::MoeSched<true>, true>(lds, S, E);
            SEAM(pb + 6);
        }
        if (PON(7) && IN(pb + 7)) { unsigned char* ws = opaque_p(ws0); unsigned* ctl = (unsigned*)(ws + WS_CTL); (void)ctl; const int Gp = opaque_s(G), cp = opaque_s((int)blockIdx.x); (void)Gp; (void)cp;
            moe_tables(MISC, ctl + CW_CNT + l * 64);
            pg8::MoeSched<false> S{WSP(const bf16_t, WS_H), WSP(const bf16_t, WS_WD) + (size_t)l * NE * D * D, D, 4, Gp, cp, (size_t)D * D * 2, (const LAS int*)(lds + MISC_OFF + 64), (const LAS int*)(lds + MISC_OFF + 256), nullptr};
            pg8::EpiDown E{PRM(PR_BD) + (size_t)l * NE * D, WSP(bf16_t, WS_YK)};
            REP(7) pg8::gemm_phase<pg8::EpiDown, pg8::MoeSched<false>, true>(lds, S, E);
            SEAM(pb + 7);
        }
        if (PON(8) && IN(pb + 8)) { unsigned char* ws = opaque_p(ws0); unsigned* ctl = (unsigned*)(ws + WS_CTL); (void)ctl; const int Gp = opaque_s(G), cp = opaque_s((int)blockIdx.x); (void)Gp; (void)cp;
            moe_tables(MISC, ctl + CW_CNT + l * 64);
            combine_ln2_phase(MISC, WSP(const f32x2, WS_RS), PRM(PR_LN1G) + (size_t)l * D, PRM(PR_LN1B) + (size_t)l * D, WSP(const y1_t, WS_XF), WSP(const bf16_t, WS_YK), WSP(const int, WS_TOKE), WSP(const int, WS_TOKPOS), WSP(const float, WS_GATE), PRM(PR_LN2G) + (size_t)l * D, PRM(PR_LN2B) + (size_t)l * D,
                              l == DEPTH - 1 ? args.out : (float*)nullptr, WSP(bf16_t, WS_XB), Gp);
            SEAM(pb + 8);
        }
    }
#undef IN
#undef SEAM
}

extern "C" void kernel_launch(void* const* d_in, const int* in_sizes, int n_in, void* d_out, int out_size, void* d_ws, size_t ws_size, hipStream_t stream) {
    static int grid = 0;
    if (grid == 0) {
        if (n_in != 21 || out_size != T * D || ws_size < WS_END) { fprintf(stderr, "kernel_launch: unexpected shapes (n_in %d, out %d, ws %zu < %zu)\n", n_in, out_size, ws_size, (size_t)WS_END); grid = -1; return; }
        int dev = 0, cus = 0, per_cu = 0;
        if (hipGetDevice(&dev) != hipSuccess || hipDeviceGetAttribute(&cus, hipDeviceAttributeMultiprocessorCount, dev) != hipSuccess) { grid = -1; return; }
        if (hipFuncSetAttribute((const void*)fwd_kernel, hipFuncAttributeMaxDynamicSharedMemorySize, LDS_BYTES) != hipSuccess) { fprintf(stderr, "kernel_launch: hipFuncSetAttribute failed\n"); grid = -1; return; }
        if (hipOccupancyMaxActiveBlocksPerMultiprocessor(&per_cu, (const void*)fwd_kernel, 512, LDS_BYTES) != hipSuccess || per_cu < 1) fprintf(stderr, "kernel_launch: occupancy query says %d\n", per_cu);
        (void)hipGetLastError();
        grid = cus;
    }
    if (grid < 0) return;
    (void)hipMemsetAsync((char*)d_ws + WS_CTL, 0, CTL_BYTES, stream);
    Args a{};
    for (int i = 0; i < 21; ++i) a.in[i] = (const float*)d_in[i];
    a.out = (float*)d_out; a.ws = (unsigned char*)d_ws;
#if MK_SPLIT
    for (int p = 0; p < NPHASE; ++p) { a.ph_lo = p; a.ph_hi = p + 1; hipLaunchKernelGGL(fwd_kernel, dim3(grid), dim3(512), LDS_BYTES, stream, a); }
#else
    a.ph_lo = 0; a.ph_hi = NPHASE;
    hipLaunchKernelGGL(fwd_kernel, dim3(grid), dim3(512), LDS_BYTES, stream, a);
#ifdef PROBE_PHASE
    for (int r = 0; r < PROBE_REPS; ++r) { a.ph_lo = 1 + 2 * NPH + PROBE_PHASE; a.ph_hi = a.ph_lo + 1;
#ifdef PROBE_SUB
        a.sub = PROBE_SUB;
#endif
 hipLaunchKernelGGL(fwd_kernel, dim3(grid), dim3(512), LDS_BYTES, stream, a); }
#endif
#endif
}
```

```cpp
#include <hip/hip_runtime.h>
#include <cstdio>
#include <cstdint>

#ifndef Y1_BF16
#define Y1_BF16 1
#endif
#ifndef MK_SPLIT
#define MK_SPLIT 0
#endif

#define LAS __attribute__((address_space(3)))
#define GAS __attribute__((address_space(1)))
typedef unsigned short bf16_t;
typedef short bf16x8 __attribute__((ext_vector_type(8)));
typedef short s16x4 __attribute__((ext_vector_type(4)));
typedef float f32x4 __attribute__((ext_vector_type(4)));
typedef float f32x2 __attribute__((ext_vector_type(2)));
typedef unsigned u32x4 __attribute__((ext_vector_type(4)));
typedef unsigned u32x2 __attribute__((ext_vector_type(2)));

constexpr int D = 1024, T = 49152, TP = 32768, SEQ = 4096, DEPTH = 4, DIN = 8704, NE = 32, TOPK = 4, QKVW = 4608;
constexpr int NSLOT = T * TOPK + NE * 256;
constexpr float DN_ALPHA = 1.6817928305074290f;
constexpr float LN_EPS = 1e-5f;
constexpr float LOG2E = 1.4426950408889634f, LN2 = 0.6931471805599453f;
constexpr int NPH = 9, NPHASE = 1 + DEPTH * NPH;

constexpr size_t MiB = 1u << 20;
constexpr size_t WS_CTL = 0, CTL_BYTES = 128 * 1024;
constexpr size_t WS_PRM = 1 * MiB;
constexpr int PR_BIN = 0, PR_LNVG = PR_BIN + DEPTH * DIN, PR_LNVB = PR_LNVG + DEPTH * D, PR_BS = PR_LNVB + DEPTH * D, PR_LN1G = PR_BS + DEPTH * D, PR_LN1B = PR_LN1G + DEPTH * D,
              PR_WR = PR_LN1B + DEPTH * D, PR_BR = PR_WR + DEPTH * D * NE, PR_BGU = PR_BR + DEPTH * NE, PR_BD = PR_BGU + DEPTH * NE * 2048, PR_LN2G = PR_BD + DEPTH * NE * D, PR_LN2B = PR_LN2G + DEPTH * D,
              PR_END = PR_LN2B + DEPTH * D;
static_assert((size_t)PR_END * 4 <= 4 * MiB, "params region");
constexpr size_t WS_WIN = 5 * MiB;
constexpr size_t WS_WPA = WS_WIN + (size_t)DEPTH * DIN * D * 2;
constexpr size_t WS_WPB = WS_WPA + (size_t)DEPTH * D * D * 2;
constexpr size_t WS_WO = WS_WPB + (size_t)DEPTH * D * 512 * 2;
constexpr size_t WS_WS = WS_WO + (size_t)DEPTH * D * D * 2;
constexpr size_t WS_WGU = WS_WS + (size_t)DEPTH * 8 * 128 * 128 * 2;
constexpr size_t WS_WD = WS_WGU + (size_t)DEPTH * NE * 2048 * D * 2;
constexpr size_t WS_XF = WS_WD + (size_t)DEPTH * NE * D * D * 2;
constexpr size_t WS_WRI = WS_XF + (size_t)T * D * 2;
constexpr size_t WS_XB = WS_XF + (size_t)T * D * 4;
constexpr size_t WS_TOKLIST = WS_XB + (size_t)T * D * 2;
constexpr size_t WS_TOKE = WS_TOKLIST + (size_t)NE * T * 4;
constexpr size_t WS_TOKPOS = WS_TOKE + (size_t)T * 4 * 4;
constexpr size_t WS_GATE = WS_TOKPOS + (size_t)T * 4 * 4;
constexpr size_t WS_PS = WS_GATE + (size_t)T * 4 * 4;
constexpr size_t WS_RS = WS_PS + (size_t)T * 16 * 8;
constexpr size_t WS_R = WS_RS + (size_t)T * 8;
constexpr size_t WS_U = WS_R;
constexpr size_t WS_V = WS_U + (size_t)T * D * 2;
constexpr size_t WS_QKV = WS_V + (size_t)T * D * 2;
constexpr size_t WS_GA = WS_QKV + (size_t)T * QKVW * 2;
constexpr size_t WS_GB = WS_GA + (size_t)T * D * 2;
constexpr size_t WS_AOUT = WS_GB + (size_t)T * D * 2;
constexpr size_t WS_OG = WS_AOUT + (size_t)T * D * 2;
constexpr size_t WS_LSE = WS_OG + (size_t)3 * T * 512 * 2;
constexpr size_t WS_BOUT = WS_LSE + (size_t)3 * T * 4 * 4;
constexpr size_t WS_T1 = WS_BOUT + (size_t)T * 512 * 2;
constexpr size_t WS_MG = WS_T1 + (size_t)T * D * 4;
constexpr size_t WS_END_A = WS_MG + (size_t)T * D * 2;
constexpr size_t WS_H = WS_R;
constexpr size_t WS_YK = WS_H + (size_t)NSLOT * D * 2;
constexpr size_t WS_END_B = WS_YK + (size_t)NSLOT * D * 2;
constexpr size_t WS_END = WS_END_A > WS_END_B ? WS_END_A : WS_END_B;
constexpr int CW_BAR = 4096;
constexpr int CW_CNT = 16384;

constexpr int LDS_BYTES = 160 * 1024;
constexpr int MISC_OFF = LDS_BYTES - 2048, IDS_OFF = MISC_OFF + 1024;
constexpr int MISC_DOC = 0;
constexpr int TMAP_OFF = MISC_OFF - 1024;
constexpr int SCR_BYTES = MISC_OFF;

#if Y1_BF16
typedef unsigned short y1_t;
#define Y1_LD4(p) ({ const u32x2 q_ = *(const u32x2*)(p); (f32x4){__builtin_bit_cast(float, q_.x << 16), __builtin_bit_cast(float, q_.x & 0xffff0000u), __builtin_bit_cast(float, q_.y << 16), __builtin_bit_cast(float, q_.y & 0xffff0000u)}; })
#else
typedef float y1_t;
#define Y1_LD4(p) (*(const f32x4*)(p))
#endif
__device__ __forceinline__ int opaque_v(int x) { asm volatile("" : "+v"(x)); return x; }
__device__ __forceinline__ int opaque_s(int x) { asm volatile("" : "+s"(x)); return x; }
template <class P> __device__ __forceinline__ P* opaque_p(P* p) { unsigned long long z = 0; asm volatile("" : "+s"(z)); return (P*)((char*)p + z); }
__device__ __forceinline__ unsigned f2bf(float f) { unsigned u = __builtin_bit_cast(unsigned, f); return (u + 0x7fffu + ((u >> 16) & 1u)) >> 16; }
__device__ __forceinline__ unsigned pk2(float lo, float hi) { return f2bf(lo) | (f2bf(hi) << 16); }
__device__ __forceinline__ unsigned cvt_pk_bf16(float lo, float hi) { unsigned r; asm volatile("v_cvt_pk_bf16_f32 %0, %1, %2" : "=v"(r) : "v"(lo), "v"(hi)); return r; }
__device__ __forceinline__ float bflo(unsigned w) { return __builtin_bit_cast(float, w << 16); }
__device__ __forceinline__ float bfhi(unsigned w) { return __builtin_bit_cast(float, w & 0xffff0000u); }
__device__ __forceinline__ float wave_sum(float v) {
#pragma unroll
    for (int o = 1; o < 64; o <<= 1) v += __shfl_xor(v, o);
    return v;
}
__device__ __forceinline__ float sigmoidf_(float x) { return __builtin_amdgcn_rcpf(1.0f + __builtin_amdgcn_exp2f(-x * LOG2E)); }
__device__ __forceinline__ f32x2 gelu_pk(f32x2 v) {
    f32x2 t = v * v; t.x = fminf(t.x, 16.0f); t.y = fminf(t.y, 16.0f);
    f32x2 p = t * 9.567564795975869e-11f + (-8.026423969909047e-09f);
    p = p * t + 3.002628830017784e-07f; p = p * t + (-6.72069427309907e-06f); p = p * t + 0.00010251090134261176f; p = p * t + (-0.0011512201745063066f);
    p = p * t + 0.009921522811055183f; p = p * t + (-0.06646095216274261f); p = p * t + 0.3989395201206207f;
    f32x2 vc; vc.x = fminf(fmaxf(v.x, -4.0f), 4.0f); vc.y = fminf(fmaxf(v.y, -4.0f), 4.0f);
    return v * (vc * p + 0.5f);
}

#define XB_TMO      128
#define XB_XCNT(j)  (256  + 64 * (j))
#define XB_XSUB(j)  (1280 + 64 * (j))
#define XB_XGEN(j)  (2304 + 64 * (j))
#define XB_TOP      3328
#define XB_TOPGEN   3392
#define XCD_BAR_WORDS 3456
#define XB_SPIN_CAP (1u << 18)
__device__ __forceinline__ unsigned xb_ld(unsigned* p)              { return __hip_atomic_load(p, __ATOMIC_RELAXED, __HIP_MEMORY_SCOPE_AGENT); }
__device__ __forceinline__ unsigned xb_add(unsigned* p, unsigned v) { return __hip_atomic_fetch_add(p, v, __ATOMIC_RELAXED, __HIP_MEMORY_SCOPE_AGENT); }
__device__ __forceinline__ unsigned xb_xcc_id() { return (unsigned)__builtin_amdgcn_s_getreg((3 << 11) | 20) & 0xFu; }
#define XB_SPIN(cond, bar) do { unsigned _sp = 0; while (cond) { __builtin_amdgcn_s_sleep(1); \
    if ((++_sp & 255u) == 0u) { if (xb_ld(&(bar)[XB_TMO])) break; if (_sp > XB_SPIN_CAP) { atomicAdd(&(bar)[XB_TMO], 1u); break; } } } } while (0)
struct XcdBarrier { unsigned* bar; unsigned x; volatile LAS unsigned* st; };
__device__ __forceinline__ XcdBarrier xcd_barrier_post(unsigned* bar, volatile LAS unsigned* st) {
    XcdBarrier b; b.bar = bar; b.x = xb_xcc_id(); b.st = st;
    if (threadIdx.x == 0) (void)xb_add(&bar[XB_XCNT(b.x)], 1u);
    return b;
}
__device__ __forceinline__ void xcd_barrier_complete(unsigned* bar, unsigned x, unsigned& nloc, unsigned& nx) {
    const unsigned G = gridDim.x * gridDim.y * gridDim.z;
    unsigned sum, cnt, mine, sp = 0u;
    for (;;) {
        sum = 0u; cnt = 0u; mine = 0u;
#pragma unroll
        for (unsigned j = 0; j < 16; ++j) { const unsigned c = xb_ld(&bar[XB_XCNT(j)]); sum += c; cnt += (c > 0u) ? 1u : 0u; mine = (j == x) ? c : mine; }
        if (sum == G) break;
        __builtin_amdgcn_s_sleep(1);
        if ((++sp & 255u) == 0u) { if (xb_ld(&bar[XB_TMO])) break; if (sp > XB_SPIN_CAP) { atomicAdd(&bar[XB_TMO], 1u); break; } }
    }
    nloc = mine > 0u ? mine : 1u; nx = cnt > 0u ? cnt : 1u;
}
__device__ __forceinline__ void xcd_barrier(const XcdBarrier& b) {
    asm volatile("s_waitcnt vmcnt(0)" ::: "memory");
    __syncthreads();
    if (threadIdx.x == 0) {
        unsigned* bar = b.bar;
        __builtin_amdgcn_s_waitcnt(0);
        unsigned nloc = b.st[0], nx = b.st[1];
        if (nloc == 0u) { xcd_barrier_complete(bar, b.x, nloc, nx); b.st[0] = nloc; b.st[1] = nx; }
        const unsigned old = xb_add(&bar[XB_XSUB(b.x)], 1u);
        const unsigned gen = old / nloc;
        if (old + 1u == (gen + 1u) * nloc) {
            __builtin_amdgcn_fence(__ATOMIC_RELEASE, "agent");
            asm volatile("s_waitcnt vmcnt(0)" ::: "memory");
            const unsigned og = xb_add(&bar[XB_TOP], 1u);
            const unsigned tg = og / nx;
            if (og + 1u == (tg + 1u) * nx) xb_add(&bar[XB_TOPGEN], 1u);
            else XB_SPIN(xb_ld(&bar[XB_TOPGEN]) == tg, bar);
            __builtin_amdgcn_fence(__ATOMIC_ACQUIRE, "agent");
            xb_add(&bar[XB_XGEN(b.x)], 1u);
            asm volatile("s_waitcnt vmcnt(0)" ::: "memory");
        } else {
            XB_SPIN(xb_ld(&bar[XB_XGEN(b.x)]) == gen, bar);
            __builtin_amdgcn_fence(__ATOMIC_ACQUIRE, "agent");
            asm volatile("s_waitcnt vmcnt(0)" ::: "memory");
        }
    }
    __syncthreads();
}

#ifndef EPI_NT
#define EPI_NT 1
#endif
#if EPI_NT
#define EPI_ST(T_, p, v) __builtin_nontemporal_store((T_)(v), (T_*)(p))
#else
#define EPI_ST(T_, p, v) (*(T_*)(p) = (v))
#endif
namespace pg8 {
constexpr int BM = 256, BK = 64, HALF = 128, HTB = HALF * BK * 2, STAGE_BYTES = 8 * HTB, NXCD = 8, WGM = 4;
__host__ __device__ __forceinline__ int lds_byte(int r, int c) { const int st = (r >> 4) * 2 + (c >> 5), rr = r & 15, cc = c & 31, ob = rr * 64 + cc * 2; return st * 1024 + (ob ^ (((ob >> 9) & 1) << 5)); }
__host__ __device__ __forceinline__ void stage_rc(int b, int& R, int& C) { const int st = b / 1024, sb = b % 1024, swz = sb ^ (((sb >> 9) & 1) << 5); R = (st >> 1) * 16 + swz / 64; C = (st & 1) * 32 + (swz % 64) / 2; }
__host__ __device__ __forceinline__ int perm32(int rho) { const int n = rho >> 4, i = rho & 15; return 8 * (i >> 2) + 4 * n + (i & 3); }

struct Unit { int pm, pn, e, r0; };

__device__ __forceinline__ bool static_order(int i, int G, int c, int nM, int nN, int& pm, int& pn) {
    const int nwg = nM * nN; const long L = (long)i * G + c; if (L >= nwg) return false;
    int wgid = (int)L; { const int q = nwg / NXCD, r = nwg % NXCD, xcd = wgid % NXCD, off = wgid / NXCD; wgid = (xcd < r ? xcd * (q + 1) : r * (q + 1) + (xcd - r) * q) + off; }
    const int nig = WGM * nN, gid = wgid / nig, fm = gid * WGM, gsz = (nM - fm) < WGM ? (nM - fm) : WGM;
    const int wi = wgid % nig;
    if (gsz == WGM) { pm = fm + (wi % WGM); pn = wi / WGM; } else { pm = fm + (wi % gsz); pn = wi / gsz; }
    return true;
}
struct DenseSched {
    static constexpr bool GATHER = false;
    const bf16_t* A; const bf16_t* Bt; int K, nM, nN, G, c;
    __device__ __forceinline__ bool next(int i, Unit& u) const { u.e = 0; u.r0 = 0; return static_order(i, G, c, nM, nN, u.pm, u.pn); }
    __device__ __forceinline__ const char* a_base(const Unit& u) const { return (const char*)A + (size_t)u.pm * BM * K * 2; }
    __device__ __forceinline__ const char* b_base(const Unit& u) const { return (const char*)Bt + (size_t)u.pn * BM * K * 2; }
    __device__ __forceinline__ void a_offs(const Unit& u, const int (&R)[2], const int (&C)[2], unsigned (&o)[2][2]) const {
#pragma unroll
        for (int h = 0; h < 2; ++h)
#pragma unroll
            for (int i = 0; i < 2; ++i) o[h][i] = (unsigned)((u.pm * BM + h * HALF + R[i]) * K + C[i]) * 2u;
    }
    __device__ __forceinline__ int load_id(const Unit&, int) const { return 0; }
    __device__ __forceinline__ void a_offs_lds(const LAS int*, const int (&)[2], const int (&)[2], unsigned (&)[2][2]) const {}
};
template <bool GATHER_> struct MoeSched {
    static constexpr bool GATHER = GATHER_;
    const bf16_t* A; const bf16_t* Bt; int K, nN, G, c; size_t bstride;
    const LAS int* tb; const LAS int* cnt; const int* tokList;
    __device__ __forceinline__ bool next(int i, Unit& u) const {
        const int nM = tb[NE];
        if (!static_order(i, G, c, nM, nN, u.pm, u.pn)) return false;
        const int e = ((const LAS unsigned char*)tb)[TMAP_OFF - (MISC_OFF + 64) + u.pm];
        u.e = e; u.r0 = (u.pm - tb[e]) * BM; return true;
    }
    __device__ __forceinline__ const char* a_base(const Unit& u) const { return GATHER ? (const char*)A : (const char*)A + (size_t)u.pm * BM * K * 2; }
    __device__ __forceinline__ const char* b_base(const Unit& u) const { return (const char*)Bt + (size_t)u.e * bstride + (size_t)u.pn * BM * K * 2; }
    __device__ __forceinline__ int load_id(const Unit& u, int i) const { const int r = u.r0 + i; return (r < cnt[u.e]) ? tokList[(size_t)u.e * T + r] : 0; }
    __device__ __forceinline__ void a_offs(const Unit& u, const int (&R)[2], const int (&C)[2], unsigned (&o)[2][2]) const {
#pragma unroll
        for (int h = 0; h < 2; ++h)
#pragma unroll
            for (int i = 0; i < 2; ++i) o[h][i] = (unsigned)(load_id(u, h * HALF + R[i]) * K + C[i]) * 2u;
    }
    __device__ __forceinline__ void a_offs_lds(const LAS int* ids, const int (&R)[2], const int (&C)[2], unsigned (&o)[2][2]) const {
#pragma unroll
        for (int h = 0; h < 2; ++h)
#pragma unroll
            for (int i = 0; i < 2; ++i) o[h][i] = (unsigned)(ids[h * HALF + R[i]] * K + C[i]) * 2u;
    }
};


template <class Epi, class Sched, bool ALIGN_EPI>
__device__ __forceinline__ void gemm_phase(LAS unsigned char* lds, const Sched& S, const Epi& E) {
    constexpr bool GATHER = Sched::GATHER;
    const int tid = opaque_v(threadIdx.x), wid = __builtin_amdgcn_readfirstlane(tid >> 6), lane = tid & 63, wr = wid >> 2, wc = wid & 3, fr = lane & 15, fq = lane >> 4;
    const int K = S.K, nt = K / BK;
    int R[2], C[2]; unsigned voffA[2], voffB[2];
#pragma unroll
    for (int i = 0; i < 2; ++i) { stage_rc(tid * 16 + i * 8192, R[i], C[i]); const int Rb = 64 * (R[i] >> 5) + (Epi::PERM ? perm32(R[i] & 31) : (R[i] & 31));
        voffA[i] = (unsigned)(R[i] * K + C[i]) * 2u; voffB[i] = (unsigned)(Rb * K + C[i]) * 2u; }
    const size_t kstep = (size_t)(BK * 2);
    const size_t hstep = (size_t)HALF * K * 2;
    const size_t bhstep = (size_t)32 * K * 2;
    const unsigned ldsw = (unsigned)wid * 1024u;
    const int aoff = lds_byte(wr * 64 + fr, fq * 8), boff = lds_byte(wc * 32 + fr, fq * 8);
#define PG8_SA(b, h) (((b) * 2 + (h)) * HTB)
#define PG8_SB(b, h) ((4 + (b) * 2 + (h)) * HTB)
#define PG8_STAGE(bufoff, gbase, voff) do { _Pragma("unroll") for (int _i = 0; _i < 2; ++_i) \
        __builtin_amdgcn_global_load_lds((const unsigned*)((const char*)(gbase) + (voff)[_i]), (LAS unsigned*)(lds + (bufoff) + ldsw + _i * 8192), 16, 0, 0); } while (0)
#define PG8_STAGE_A(bufoff, ab, ao, h, kb) do { if constexpr (GATHER) { PG8_STAGE(bufoff, (ab) + (kb), (ao)[h]); } else { PG8_STAGE(bufoff, (ab) + (kb) + (h) * hstep, voffA); } } while (0)
#define PG8_LDA(dst, b, h) do { _Pragma("unroll") for (int m = 0; m < 4; ++m) _Pragma("unroll") for (int k = 0; k < 2; ++k) dst[m][k] = *(const LAS bf16x8*)(lds + PG8_SA(b, h) + aoff + m * 2048 + k * 1024); } while (0)
#define PG8_LDB(dst, b, h) do { _Pragma("unroll") for (int n = 0; n < 2; ++n) _Pragma("unroll") for (int k = 0; k < 2; ++k) dst[n][k] = *(const LAS bf16x8*)(lds + PG8_SB(b, h) + boff + n * 2048 + k * 1024); } while (0)
#define PG8_MMA(ai, bj, At, Bt) do { __builtin_amdgcn_s_setprio(1); _Pragma("unroll") for (int m = 0; m < 4; ++m) _Pragma("unroll") for (int n = 0; n < 2; ++n) _Pragma("unroll") for (int k = 0; k < 2; ++k) \
        acc[ai][bj][m][n] = __builtin_amdgcn_mfma_f32_16x16x32_bf16(Bt[n][k], At[m][k], acc[ai][bj][m][n], 0, 0, 0); __builtin_amdgcn_s_setprio(0); } while (0)
#define PG8_WAIT_V(n) asm volatile("s_waitcnt vmcnt(" #n ")" ::: "memory")
#define PG8_WAIT_L(n) asm volatile("s_waitcnt lgkmcnt(" #n ")" ::: "memory")
#define PG8_BAR __builtin_amdgcn_s_barrier()
#define PG8_SCHED __builtin_amdgcn_sched_barrier(0)
    Unit cur, nxt; int ui = 0;
    if (!S.next(0, cur)) return;
    f32x4 acc[2][2][4][2];
    { f32x4 bv[2][2]; E.binit(cur, wc, fq, bv);
#pragma unroll
    for (int a = 0; a < 2; ++a)
#pragma unroll
        for (int b = 0; b < 2; ++b)
#pragma unroll
            for (int m = 0; m < 4; ++m)
#pragma unroll
                for (int n = 0; n < 2; ++n) { acc[a][b][m][n] = bv[b][n]; asm volatile("" : "+v"(acc[a][b][m][n])); } }
    bf16x8 At[4][2], B0[2][2], B1[2][2];
    unsigned ca[2][2];
    LAS int* ids = (LAS int*)(lds + IDS_OFF);
    if constexpr (GATHER) { S.a_offs(cur, R, C, ca); Unit n1; if (S.next(1, n1) && tid < 256) ids[tid] = S.load_id(n1, tid); }
    const char* cA = S.a_base(cur);
    const char* cB = S.b_base(cur);
    PG8_STAGE(PG8_SB(0, 0), cB, voffB); PG8_STAGE(PG8_SB(0, 1), cB + bhstep, voffB); PG8_STAGE_A(PG8_SA(0, 0), cA, ca, 0, 0); PG8_STAGE_A(PG8_SA(0, 1), cA, ca, 1, 0);
    if (wr == 1) PG8_BAR;
    PG8_WAIT_V(2); PG8_BAR;
    PG8_STAGE(PG8_SB(1, 0), cB + kstep, voffB); PG8_STAGE_A(PG8_SA(1, 0), cA, ca, 0, kstep); PG8_STAGE(PG8_SB(1, 1), cB + bhstep + kstep, voffB);
    PG8_WAIT_V(6); PG8_BAR;
    for (;;) {
        const bool has_next = S.next(ui + 1, nxt);
        const char* nA = has_next ? S.a_base(nxt) : cA; const char* nB = has_next ? S.b_base(nxt) : cB;
#define PG8_TRIP(RELAX) do { \
            const bool last = (t == nt - 2); \
            const size_t k1 = (size_t)(t + 1) * kstep; \
            const size_t k2 = last ? 0 : (size_t)(t + 2) * kstep, k3 = k2 + kstep; \
            const char* a2 = last ? nA : cA; const char* b2 = (last ? nB : cB) + k2; const char* b3 = b2 + kstep; \
            PG8_LDB(B0, 0, 0); PG8_LDB(B1, 0, 1); PG8_SCHED; PG8_LDA(At, 0, 0); PG8_STAGE_A(PG8_SA(1, 1), cA, ca, 1, k1); \
            if (!(RELAX)) PG8_WAIT_V(8); PG8_WAIT_L(0); PG8_BAR; PG8_MMA(0, 0, At, B0); PG8_MMA(0, 1, At, B1); PG8_BAR; PG8_SCHED; \
            if constexpr (GATHER) { if (last && has_next) { int R2[2], C2[2]; const int t2 = opaque_v(tid); stage_rc(t2 * 16, R2[0], C2[0]); stage_rc(t2 * 16 + 8192, R2[1], C2[1]); S.a_offs_lds(ids, R2, C2, ca); } } \
            PG8_LDA(At, 0, 1); PG8_STAGE(PG8_SB(0, 0), b2, voffB); PG8_STAGE(PG8_SB(0, 1), b2 + bhstep, voffB); PG8_STAGE_A(PG8_SA(0, 0), a2, ca, 0, k2); \
            if (!(RELAX)) PG8_WAIT_V(8); PG8_WAIT_L(0); PG8_BAR; PG8_MMA(1, 0, At, B0); PG8_MMA(1, 1, At, B1); PG8_BAR; PG8_SCHED; \
            PG8_LDB(B0, 1, 0); PG8_LDB(B1, 1, 1); PG8_SCHED; PG8_LDA(At, 1, 0); PG8_STAGE_A(PG8_SA(0, 1), a2, ca, 1, k2); \
            PG8_WAIT_V(8); PG8_WAIT_L(0); PG8_BAR; PG8_MMA(0, 0, At, B0); PG8_MMA(0, 1, At, B1); PG8_BAR; PG8_SCHED; \
            PG8_LDA(At, 1, 1); PG8_STAGE(PG8_SB(1, 0), b3, voffB); PG8_STAGE(PG8_SB(1, 1), b3 + bhstep, voffB); PG8_STAGE_A(PG8_SA(1, 0), a2, ca, 0, k3); \
            PG8_WAIT_V(8); PG8_WAIT_L(0); PG8_BAR; PG8_MMA(1, 0, At, B0); PG8_MMA(1, 1, At, B1); PG8_BAR; PG8_SCHED; \
        } while (0)
        int t = 0;
#ifndef NO_RELAX
        if (ui > 0) { PG8_TRIP(true); t = 2; }
#endif
        for (; t < nt; t += 2) PG8_TRIP(false);
#undef PG8_TRIP
        if constexpr (ALIGN_EPI) { if (wr == 0) PG8_BAR; }
        int idv = 0; bool fill = false;
        if constexpr (GATHER) { Unit n2; fill = S.next(ui + 2, n2) && tid < 256; if (fill) idv = S.load_id(n2, tid); }
        f32x4 bvn[2][2];
        if (has_next) E.binit(nxt, wc, fq, bvn);
        E(lds, acc, cur, wr, wc, fr, fq);
        if constexpr (GATHER) { if (fill) ids[tid] = idv; }
        if (!has_next) break;
#pragma unroll
        for (int a = 0; a < 2; ++a)
#pragma unroll
            for (int b = 0; b < 2; ++b)
#pragma unroll
                for (int m = 0; m < 4; ++m)
#pragma unroll
                    for (int n = 0; n < 2; ++n) { acc[a][b][m][n] = bvn[b][n]; asm volatile("" : "+v"(acc[a][b][m][n])); }
        cur = nxt; cA = nA; cB = nB; ++ui;
        if constexpr (ALIGN_EPI) { if (wr == 1) PG8_BAR; }
    }
    PG8_WAIT_V(0);
    if constexpr (!ALIGN_EPI) { if (wr == 0) PG8_BAR; }
    PG8_BAR;
#undef PG8_SA
#undef PG8_SB
#undef PG8_STAGE
#undef PG8_STAGE_A
#undef PG8_LDA
#undef PG8_LDB
#undef PG8_MMA
#undef PG8_WAIT_V
#undef PG8_WAIT_L
#undef PG8_BAR
#undef PG8_SCHED
}

struct Dense2Sched {
    const bf16_t* A1; const bf16_t* B1; int K1; const bf16_t* A2; const bf16_t* B2; int K2; int nM, nN, G, c;
    __device__ __forceinline__ bool next(int i, Unit& u) const { u.e = 0; u.r0 = 0; return static_order(i, G, c, nM, nN, u.pm, u.pn); }
};
template <class Epi>
__device__ __forceinline__ void gemm_phase2(LAS unsigned char* lds, const Dense2Sched& S, const Epi& E) {
    const int tid = opaque_v(threadIdx.x), wid = __builtin_amdgcn_readfirstlane(tid >> 6), lane = tid & 63, wr = wid >> 2, wc = wid & 3, fr = lane & 15, fq = lane >> 4;
    const int K1 = S.K1, K2 = S.K2, nt1 = K1 / BK, nt = nt1 + K2 / BK;
    unsigned vRA[2], vRB[2], vC[2];
#pragma unroll
    for (int i = 0; i < 2; ++i) { int R, C; stage_rc(tid * 16 + i * 8192, R, C); const int Rb = 64 * (R >> 5) + (Epi::PERM ? perm32(R & 31) : (R & 31)); vRA[i] = (unsigned)R * 2u; vRB[i] = (unsigned)Rb * 2u; vC[i] = (unsigned)C * 2u; }
#define PG8_VOFF(dst, vR, Kx) unsigned dst[2]; _Pragma("unroll") for (int i_ = 0; i_ < 2; ++i_) dst[i_] = (vR)[i_] * (unsigned)(Kx) + (unsigned)opaque_v((int)vC[i_])
    const size_t kstep = (size_t)(BK * 2);
    const size_t hstep1 = (size_t)HALF * K1 * 2, bhstep1 = (size_t)32 * K1 * 2, hstep2 = (size_t)HALF * K2 * 2, bhstep2 = (size_t)32 * K2 * 2;
    const unsigned ldsw = (unsigned)wid * 1024u;
    const int aoff = lds_byte(wr * 64 + fr, fq * 8), boff = lds_byte(wc * 32 + fr, fq * 8);
#define PG8_SA(b, h) (((b) * 2 + (h)) * HTB)
#define PG8_SB(b, h) ((4 + (b) * 2 + (h)) * HTB)
#define PG8_STAGE(bufoff, gbase, voff) do { _Pragma("unroll") for (int _i = 0; _i < 2; ++_i) \
        __builtin_amdgcn_global_load_lds((const unsigned*)((const char*)(gbase) + (voff)[_i]), (LAS unsigned*)(lds + (bufoff) + ldsw + _i * 8192), 16, 0, 0); } while (0)
#define PG8_LDA(dst, b, h) do { _Pragma("unroll") for (int m = 0; m < 4; ++m) _Pragma("unroll") for (int k = 0; k < 2; ++k) dst[m][k] = *(const LAS bf16x8*)(lds + PG8_SA(b, h) + aoff + m * 2048 + k * 1024); } while (0)
#define PG8_LDB(dst, b, h) do { _Pragma("unroll") for (int n = 0; n < 2; ++n) _Pragma("unroll") for (int k = 0; k < 2; ++k) dst[n][k] = *(const LAS bf16x8*)(lds + PG8_SB(b, h) + boff + n * 2048 + k * 1024); } while (0)
#define PG8_MMA(ai, bj, At, Bt) do { __builtin_amdgcn_s_setprio(1); _Pragma("unroll") for (int m = 0; m < 4; ++m) _Pragma("unroll") for (int n = 0; n < 2; ++n) _Pragma("unroll") for (int k = 0; k < 2; ++k) \
        acc[ai][bj][m][n] = __builtin_amdgcn_mfma_f32_16x16x32_bf16(Bt[n][k], At[m][k], acc[ai][bj][m][n], 0, 0, 0); __builtin_amdgcn_s_setprio(0); } while (0)
#define PG8_WAIT_V(n) asm volatile("s_waitcnt vmcnt(" #n ")" ::: "memory")
#define PG8_WAIT_L(n) asm volatile("s_waitcnt lgkmcnt(" #n ")" ::: "memory")
#define PG8_BAR __builtin_amdgcn_s_barrier()
#define PG8_SCHED __builtin_amdgcn_sched_barrier(0)
    Unit cur, nxt; int ui = 0;
    if (!S.next(0, cur)) return;
    f32x4 acc[2][2][4][2];
#pragma unroll
    for (int a = 0; a < 2; ++a)
#pragma unroll
        for (int b = 0; b < 2; ++b)
#pragma unroll
            for (int m = 0; m < 4; ++m)
#pragma unroll
                for (int n = 0; n < 2; ++n) acc[a][b][m][n] = (f32x4){0.f, 0.f, 0.f, 0.f};
    bf16x8 At[4][2], B0[2][2], B1[2][2];
    const char* cA1 = (const char*)S.A1 + (size_t)cur.pm * BM * K1 * 2; const char* cB1 = (const char*)S.B1 + (size_t)cur.pn * BM * K1 * 2;
    const char* cA2 = (const char*)S.A2 + (size_t)cur.pm * BM * K2 * 2; const char* cB2 = (const char*)S.B2 + (size_t)cur.pn * BM * K2 * 2;
    { PG8_VOFF(voffA1, vRA, K1); PG8_VOFF(voffB1, vRB, K1);
    PG8_STAGE(PG8_SB(0, 0), cB1, voffB1); PG8_STAGE(PG8_SB(0, 1), cB1 + bhstep1, voffB1); PG8_STAGE(PG8_SA(0, 0), cA1, voffA1); PG8_STAGE(PG8_SA(0, 1), cA1 + hstep1, voffA1);
    if (wr == 1) PG8_BAR;
    PG8_WAIT_V(2); PG8_BAR;
    PG8_STAGE(PG8_SB(1, 0), cB1 + kstep, voffB1); PG8_STAGE(PG8_SA(1, 0), cA1 + kstep, voffA1); PG8_STAGE(PG8_SB(1, 1), cB1 + bhstep1 + kstep, voffB1);
    PG8_WAIT_V(6); PG8_BAR; }
    for (;;) {
        const bool has_next = S.next(ui + 1, nxt);
        const char* nA1 = has_next ? (const char*)S.A1 + (size_t)nxt.pm * BM * K1 * 2 : cA1; const char* nB1 = has_next ? (const char*)S.B1 + (size_t)nxt.pn * BM * K1 * 2 : cB1;
#define PG8_TRIP2(RELAX) do { \
            const bool last = (t == nt - 2), s1c = (t < nt1), s1n = last || (t + 2 < nt1); \
            const char* ac = s1c ? cA1 + (size_t)(t + 1) * kstep + hstep1 : cA2 + (size_t)(t + 1 - nt1) * kstep + hstep2; \
            const char* an = last ? nA1 : (s1n ? cA1 + (size_t)(t + 2) * kstep : cA2 + (size_t)(t + 2 - nt1) * kstep); \
            const char* bn = last ? nB1 : (s1n ? cB1 + (size_t)(t + 2) * kstep : cB2 + (size_t)(t + 2 - nt1) * kstep); \
            const size_t hsn = s1n ? hstep1 : hstep2, bhn = s1n ? bhstep1 : bhstep2; \
            const int Kc = s1c ? K1 : K2, Kn = s1n ? K1 : K2; \
            PG8_LDB(B0, 0, 0); PG8_LDB(B1, 0, 1); PG8_SCHED; PG8_LDA(At, 0, 0); { PG8_VOFF(vac, vRA, Kc); PG8_STAGE(PG8_SA(1, 1), ac, vac); } \
            if (!(RELAX)) PG8_WAIT_V(8); PG8_WAIT_L(0); PG8_BAR; PG8_MMA(0, 0, At, B0); PG8_MMA(0, 1, At, B1); PG8_BAR; PG8_SCHED; \
            PG8_LDA(At, 0, 1); { PG8_VOFF(vbn, vRB, Kn); PG8_VOFF(van, vRA, Kn); PG8_STAGE(PG8_SB(0, 0), bn, vbn); PG8_STAGE(PG8_SB(0, 1), bn + bhn, vbn); PG8_STAGE(PG8_SA(0, 0), an, van); } \
            if (!(RELAX)) PG8_WAIT_V(8); PG8_WAIT_L(0); PG8_BAR; PG8_MMA(1, 0, At, B0); PG8_MMA(1, 1, At, B1); PG8_BAR; PG8_SCHED; \
            PG8_LDB(B0, 1, 0); PG8_LDB(B1, 1, 1); PG8_SCHED; PG8_LDA(At, 1, 0); { PG8_VOFF(van, vRA, Kn); PG8_STAGE(PG8_SA(0, 1), an + hsn, van); } \
            PG8_WAIT_V(8); PG8_WAIT_L(0); PG8_BAR; PG8_MMA(0, 0, At, B0); PG8_MMA(0, 1, At, B1); PG8_BAR; PG8_SCHED; \
            PG8_LDA(At, 1, 1); { PG8_VOFF(vbn, vRB, Kn); PG8_VOFF(van, vRA, Kn); PG8_STAGE(PG8_SB(1, 0), bn + kstep, vbn); PG8_STAGE(PG8_SB(1, 1), bn + kstep + bhn, vbn); PG8_STAGE(PG8_SA(1, 0), an + kstep, van); } \
            PG8_WAIT_V(8); PG8_WAIT_L(0); PG8_BAR; PG8_MMA(1, 0, At, B0); PG8_MMA(1, 1, At, B1); PG8_BAR; PG8_SCHED; \
        } while (0)
        int t = 0;
        if (ui > 0) { PG8_TRIP2(true); t = 2; }
        for (; t < nt1; t += 2) PG8_TRIP2(false);
        E.mid(lds, acc, cur, wr, wc, fr, fq);
        for (; t < nt; t += 2) PG8_TRIP2(false);
#undef PG8_TRIP2
        if (wr == 0) PG8_BAR;
        E(lds, acc, cur, wr, wc, fr, fq);
        if (!has_next) break;
#pragma unroll
        for (int a = 0; a < 2; ++a)
#pragma unroll
            for (int b = 0; b < 2; ++b)
#pragma unroll
                for (int m = 0; m < 4; ++m)
#pragma unroll
                    for (int n = 0; n < 2; ++n) acc[a][b][m][n] = (f32x4){0.f, 0.f, 0.f, 0.f};
        cur = nxt; cA1 = nA1; cB1 = nB1; cA2 = (const char*)S.A2 + (size_t)cur.pm * BM * K2 * 2; cB2 = (const char*)S.B2 + (size_t)cur.pn * BM * K2 * 2; ++ui;
        if (wr == 1) PG8_BAR;
    }
    PG8_WAIT_V(0);
    PG8_BAR;
#undef PG8_VOFF
#undef PG8_SA
#undef PG8_SB
#undef PG8_STAGE
#undef PG8_LDA
#undef PG8_LDB
#undef PG8_MMA
#undef PG8_WAIT_V
#undef PG8_WAIT_L
#undef PG8_BAR
#undef PG8_SCHED
}

typedef const f32x4 (&AccRef)[2][2][4][2];
constexpr int EPI_OFF = STAGE_BYTES, EPI_WSTR = 144, EPI_WBYTES = 16 * EPI_WSTR;
__device__ __forceinline__ void epi_xpose(LAS unsigned char* st, int fr, int fq, int lane, u32x4 in0, u32x4 in1, u32x4& out0, u32x4& out1) {
    *(LAS u32x4*)(st + fr * EPI_WSTR + fq * 16) = in0; *(LAS u32x4*)(st + fr * EPI_WSTR + 64 + fq * 16) = in1;
    out0 = *(const LAS u32x4*)(st + (lane >> 3) * EPI_WSTR + (lane & 7) * 16); out1 = *(const LAS u32x4*)(st + (8 + (lane >> 3)) * EPI_WSTR + (lane & 7) * 16);
}
__device__ __forceinline__ void epi_xpose1(LAS unsigned char* st, int fr, int fq, int lane, u32x4 in0, u32x4& out0) {
    *(LAS u32x4*)(st + fr * 80 + fq * 16) = in0;
    out0 = *(const LAS u32x4*)(st + (lane >> 2) * 80 + (lane & 3) * 16);
}
#define EPI_DRAIN() asm volatile("s_waitcnt vmcnt(0)" ::: "memory")
#define EPI_LOCALS() const int lane = opaque_v(fq * 16 + fr), lr = lane >> 3, lc = lane & 7;        LAS unsigned char* st = lds + EPI_OFF + (wr * 4 + wc) * EPI_WBYTES; (void)lr; (void)lc

struct EpiIn {
    static constexpr bool PERM = true;
    const float* bias; bf16_t *U, *V, *QKV, *GA, *GB; f32x2* PS;
    __device__ __forceinline__ void binit(const Unit& u, int wc, int fq, f32x4 (&bv)[2][2]) const {
#pragma unroll
        for (int bj = 0; bj < 2; ++bj)
#pragma unroll
            for (int n = 0; n < 2; ++n) bv[bj][n] = *(const f32x4*)(bias + u.pn * BM + wc * 64 + bj * 32 + 8 * fq + 4 * n);
    }
    __device__ __forceinline__ void operator()(LAS unsigned char* lds, AccRef acc, const Unit& u, int wr, int wc, int fr, int fq) const {
        EPI_LOCALS();
        const int pn = u.pn; bf16_t* base; int ldc = D, colt, act;
        if (pn < 4) { base = U; colt = pn * 256; act = 1; }
        else if (pn < 8) { base = V; colt = (pn - 4) * 256; act = 1; }
        else if (pn < 26) { base = QKV; ldc = QKVW; colt = (pn - 8) * 256; act = 0; }
        else if (pn < 30) { base = GA; colt = (pn - 26) * 256; act = 2; }
        else { base = GB; colt = (pn - 30) * 256; act = 2; }
        bf16_t* p0 = base + (size_t)(u.pm * BM + wr * 64 + lr) * ldc + colt + wc * 64 + lc * 8;
        const bool vstats = (pn >= 4 && pn < 8);
        f32x2* ps0 = PS + (size_t)(u.pm * BM + wr * 64 + lr) * 16 + (pn - 4) * 4 + wc;
#pragma unroll
        for (int ai = 0; ai < 2; ++ai)
#pragma unroll
            for (int m = 0; m < 4; ++m) { u32x4 w[2];
#pragma unroll
                for (int bj = 0; bj < 2; ++bj) { f32x4 v0 = acc[ai][bj][m][0], v1 = acc[ai][bj][m][1];
                    if (act == 1) { f32x2 a = gelu_pk((f32x2){v0[0], v0[1]}), b = gelu_pk((f32x2){v0[2], v0[3]}), c = gelu_pk((f32x2){v1[0], v1[1]}), d = gelu_pk((f32x2){v1[2], v1[3]});
                        v0 = (f32x4){a.x, a.y, b.x, b.y}; v1 = (f32x4){c.x, c.y, d.x, d.y}; }
                    if (act == 2) {
#pragma unroll
                        for (int j = 0; j < 4; ++j) { v0[j] = sigmoidf_(v0[j]); v1[j] = sigmoidf_(v1[j]); } }
                    w[bj].x = cvt_pk_bf16(v0[0], v0[1]); w[bj].y = cvt_pk_bf16(v0[2], v0[3]); w[bj].z = cvt_pk_bf16(v1[0], v1[1]); w[bj].w = cvt_pk_bf16(v1[2], v1[3]); }
                u32x4 o0, o1; epi_xpose(st, fr, fq, lane, w[0], w[1], o0, o1);
                if (ai == 0 && m == 0) EPI_DRAIN();
                bf16_t* rp = p0 + (size_t)(ai * HALF + m * 16) * ldc;
                EPI_ST(u32x4, rp, o0); EPI_ST(u32x4, rp + (size_t)8 * ldc, o1);
                if (vstats) {
                    float s0 = 0.f, q0 = 0.f, s1 = 0.f, q1 = 0.f;
#pragma unroll
                    for (int c = 0; c < 4; ++c) { const float a = bflo(o0[c]), b = bfhi(o0[c]), d = bflo(o1[c]), e = bfhi(o1[c]); s0 += a + b; q0 += a * a + b * b; s1 += d + e; q1 += d * d + e * e; }
#pragma unroll
                    for (int o = 1; o < 8; o <<= 1) { s0 += __shfl_xor(s0, o); q0 += __shfl_xor(q0, o); s1 += __shfl_xor(s1, o); q1 += __shfl_xor(q1, o); }
                    if (lc == 0) { ps0[(size_t)(ai * HALF + m * 16) * 16] = (f32x2){s0, q0}; ps0[(size_t)(ai * HALF + m * 16 + 8) * 16] = (f32x2){s1, q1}; } }
                asm volatile("" ::: "memory"); }
    }
};
struct EpiT1 {
    static constexpr bool PERM = false;
    const bf16_t* GA; bf16_t* T1;
    __device__ __forceinline__ void binit(const Unit&, int, int, f32x4 (&bv)[2][2]) const { bv[0][0] = bv[0][1] = bv[1][0] = bv[1][1] = (f32x4){0.f, 0.f, 0.f, 0.f}; }
    __device__ __forceinline__ void operator()(LAS unsigned char* lds, AccRef acc, const Unit& u, int wr, int wc, int fr, int fq) const {
        EPI_LOCALS();
        const size_t o00 = (size_t)(u.pm * BM + wr * 64 + lr) * D + u.pn * BM + wc * 64 + lc * 4;
#pragma unroll
        for (int ai = 0; ai < 2; ++ai) {
            u32x2 g[4][2][2];
#pragma unroll
            for (int m = 0; m < 4; ++m)
#pragma unroll
                for (int bj = 0; bj < 2; ++bj)
#pragma unroll
                    for (int s = 0; s < 2; ++s) g[m][bj][s] = *(const u32x2*)(GA + o00 + (size_t)(ai * HALF + m * 16 + 8 * s) * D + bj * 32);
            asm volatile("" ::: "memory");
#pragma unroll
            for (int m = 0; m < 4; ++m)
#pragma unroll
                for (int bj = 0; bj < 2; ++bj) { u32x4 o[2]; epi_xpose(st, fr, fq, lane, __builtin_bit_cast(u32x4, acc[ai][bj][m][0]), __builtin_bit_cast(u32x4, acc[ai][bj][m][1]), o[0], o[1]);
#pragma unroll
                    for (int s = 0; s < 2; ++s) { const size_t off = o00 + (size_t)(ai * HALF + m * 16 + 8 * s) * D + bj * 32; const u32x2 gq = g[m][bj][s];
                        const f32x4 gv = (f32x4){bflo(gq.x), bfhi(gq.x), bflo(gq.y), bfhi(gq.y)}; const f32x4 tv = __builtin_bit_cast(f32x4, o[s]) * gv;
                        u32x2 tw; tw.x = cvt_pk_bf16(tv[0], tv[1]); tw.y = cvt_pk_bf16(tv[2], tv[3]); EPI_ST(u32x2, T1 + off, tw); } }
        }
    }
};
struct EpiMg {
    static constexpr bool PERM = false;
    const bf16_t* GB; const bf16_t* T1; bf16_t* MG;
    __device__ __forceinline__ void binit(const Unit&, int, int, f32x4 (&bv)[2][2]) const { bv[0][0] = bv[0][1] = bv[1][0] = bv[1][1] = (f32x4){0.f, 0.f, 0.f, 0.f}; }
    __device__ __forceinline__ void operator()(LAS unsigned char* lds, AccRef acc, const Unit& u, int wr, int wc, int fr, int fq) const {
        EPI_LOCALS();
        const size_t o00 = (size_t)(u.pm * BM + wr * 64 + lr) * D + u.pn * BM + wc * 64 + lc * 4;
#pragma unroll
        for (int ai = 0; ai < 2; ++ai) {
            u32x2 g[4][2][2], tq[4][2][2];
#pragma unroll
            for (int m = 0; m < 4; ++m)
#pragma unroll
                for (int bj = 0; bj < 2; ++bj)
#pragma unroll
                    for (int s = 0; s < 2; ++s) { const size_t off = o00 + (size_t)(ai * HALF + m * 16 + 8 * s) * D + bj * 32; g[m][bj][s] = *(const u32x2*)(GB + off); tq[m][bj][s] = *(const u32x2*)(T1 + off); }
            asm volatile("" ::: "memory");
#pragma unroll
            for (int m = 0; m < 4; ++m)
#pragma unroll
                for (int bj = 0; bj < 2; ++bj) { u32x4 o[2]; epi_xpose(st, fr, fq, lane, __builtin_bit_cast(u32x4, acc[ai][bj][m][0]), __builtin_bit_cast(u32x4, acc[ai][bj][m][1]), o[0], o[1]);
#pragma unroll
                    for (int s = 0; s < 2; ++s) { const size_t off = o00 + (size_t)(ai * HALF + m * 16 + 8 * s) * D + bj * 32; const u32x2 gq = g[m][bj][s], t2 = tq[m][bj][s];
                        const f32x4 t = (f32x4){bflo(t2.x), bfhi(t2.x), bflo(t2.y), bfhi(t2.y)};
                        const f32x4 v = t + __builtin_bit_cast(f32x4, o[s]) * (f32x4){bflo(gq.x), bfhi(gq.x), bflo(gq.y), bfhi(gq.y)};
                        u32x2 w; w.x = cvt_pk_bf16(v[0], v[1]); w.y = cvt_pk_bf16(v[2], v[3]); EPI_ST(u32x2, MG + off, w); } }
        }
    }
};
struct EpiMg2 {
    static constexpr bool PERM = false;
    const bf16_t* GA; const bf16_t* GB; bf16_t* MG;
    __device__ __forceinline__ void mid(LAS unsigned char* lds, f32x4 (&acc)[2][2][4][2], const Unit& u, int wr, int wc, int fr, int fq) const {
        EPI_LOCALS();
        const size_t o00 = (size_t)(u.pm * BM + wr * 64 + lr) * D + u.pn * BM + wc * 64 + lc * 4;
#pragma unroll
        for (int q = 0; q < 4; ++q) { const int ai = q >> 1, m0 = 2 * (q & 1);
            u32x2 ga[2][2][2], gb[2][2][2];
#pragma unroll
            for (int mm = 0; mm < 2; ++mm)
#pragma unroll
                for (int bj = 0; bj < 2; ++bj)
#pragma unroll
                    for (int s = 0; s < 2; ++s) { const size_t off = o00 + (size_t)(ai * HALF + (m0 + mm) * 16 + 8 * s) * D + bj * 32; ga[mm][bj][s] = *(const u32x2*)(GA + off); gb[mm][bj][s] = *(const u32x2*)(GB + off); }
            asm volatile("" ::: "memory");
#pragma unroll
            for (int mm = 0; mm < 2; ++mm)
#pragma unroll
                for (int bj = 0; bj < 2; ++bj) { const int m = m0 + mm;
#pragma unroll
                    for (int s = 0; s < 2; ++s) { const u32x2 a2 = ga[mm][bj][s], b2 = gb[mm][bj][s]; f32x4 r;
                        r[0] = bflo(a2.x) * __builtin_amdgcn_rcpf(fmaxf(bflo(b2.x), 1e-30f)); r[1] = bfhi(a2.x) * __builtin_amdgcn_rcpf(fmaxf(bfhi(b2.x), 1e-30f));
                        r[2] = bflo(a2.y) * __builtin_amdgcn_rcpf(fmaxf(bflo(b2.y), 1e-30f)); r[3] = bfhi(a2.y) * __builtin_amdgcn_rcpf(fmaxf(bfhi(b2.y), 1e-30f));
                        *(LAS f32x4*)(st + (8 * s + lr) * EPI_WSTR + lc * 16) = r; }
                    const f32x4 r0 = *(const LAS f32x4*)(st + fr * EPI_WSTR + fq * 16), r1 = *(const LAS f32x4*)(st + fr * EPI_WSTR + 64 + fq * 16);
                    acc[ai][bj][m][0] *= r0; acc[ai][bj][m][1] *= r1; }
        }
    }
    __device__ __forceinline__ void operator()(LAS unsigned char* lds, AccRef acc, const Unit& u, int wr, int wc, int fr, int fq) const {
        EPI_LOCALS();
        const size_t o00 = (size_t)(u.pm * BM + wr * 64 + lr) * D + u.pn * BM + wc * 64 + lc * 4;
#pragma unroll
        for (int ai = 0; ai < 2; ++ai) {
            u32x2 g[4][2][2];
#pragma unroll
            for (int m = 0; m < 4; ++m)
#pragma unroll
                for (int bj = 0; bj < 2; ++bj)
#pragma unroll
                    for (int s = 0; s < 2; ++s) g[m][bj][s] = *(const u32x2*)(GB + o00 + (size_t)(ai * HALF + m * 16 + 8 * s) * D + bj * 32);
            asm volatile("" ::: "memory");
#pragma unroll
            for (int m = 0; m < 4; ++m)
#pragma unroll
                for (int bj = 0; bj < 2; ++bj) { u32x4 o[2]; epi_xpose(st, fr, fq, lane, __builtin_bit_cast(u32x4, acc[ai][bj][m][0]), __builtin_bit_cast(u32x4, acc[ai][bj][m][1]), o[0], o[1]);
#pragma unroll
                    for (int s = 0; s < 2; ++s) { const size_t off = o00 + (size_t)(ai * HALF + m * 16 + 8 * s) * D + bj * 32; const u32x2 gq = g[m][bj][s];
                        const f32x4 v = __builtin_bit_cast(f32x4, o[s]) * (f32x4){bflo(gq.x), bfhi(gq.x), bflo(gq.y), bfhi(gq.y)};
                        u32x2 w; w.x = cvt_pk_bf16(v[0], v[1]); w.y = cvt_pk_bf16(v[2], v[3]); EPI_ST(u32x2, MG + off, w); } }
        }
    }
};
struct EpiWo {
    static constexpr bool PERM = false;
    const float* xa; const float* xb; const bf16_t* XBres; y1_t* XF;
    __device__ __forceinline__ void binit(const Unit&, int, int, f32x4 (&bv)[2][2]) const { bv[0][0] = bv[0][1] = bv[1][0] = bv[1][1] = (f32x4){0.f, 0.f, 0.f, 0.f}; }
    __device__ __forceinline__ void operator()(LAS unsigned char* lds, AccRef acc, const Unit& u, int wr, int wc, int fr, int fq) const {
        EPI_LOCALS();
        const size_t o00 = (size_t)(u.pm * BM + wr * 64 + lr) * D + u.pn * BM + wc * 64 + lc * 4;
        const float* xr = (u.pm * BM < TP) ? xa : xb;
        u32x2 xq[2][4][2][2];
        if (XBres) {
#pragma unroll
            for (int ai = 0; ai < 2; ++ai)
#pragma unroll
                for (int m = 0; m < 4; ++m)
#pragma unroll
                    for (int bj = 0; bj < 2; ++bj)
#pragma unroll
                        for (int s = 0; s < 2; ++s) xq[ai][m][bj][s] = *(const u32x2*)(XBres + o00 + (size_t)(ai * HALF + m * 16 + 8 * s) * D + bj * 32);
        } else {
#pragma unroll
            for (int ai = 0; ai < 2; ++ai)
#pragma unroll
                for (int m = 0; m < 4; ++m)
#pragma unroll
                    for (int bj = 0; bj < 2; ++bj)
#pragma unroll
                        for (int s = 0; s < 2; ++s) xq[ai][m][bj][s] = (u32x2){0u, 0u};
        }
        asm volatile("" ::: "memory");
#pragma unroll
        for (int ai = 0; ai < 2; ++ai) {
            f32x4 xv[4][2][2];
            if (XBres) {
#pragma unroll
                for (int m = 0; m < 4; ++m)
#pragma unroll
                    for (int bj = 0; bj < 2; ++bj)
#pragma unroll
                        for (int s = 0; s < 2; ++s) xv[m][bj][s] = (f32x4){bflo(xq[ai][m][bj][s].x), bfhi(xq[ai][m][bj][s].x), bflo(xq[ai][m][bj][s].y), bfhi(xq[ai][m][bj][s].y)};
            } else {
#pragma unroll
                for (int m = 0; m < 4; ++m)
#pragma unroll
                    for (int bj = 0; bj < 2; ++bj)
#pragma unroll
                        for (int s = 0; s < 2; ++s) xv[m][bj][s] = *(const f32x4*)(xr + o00 + (size_t)(ai * HALF + m * 16 + 8 * s) * D + bj * 32);
            }
            asm volatile("" ::: "memory");
#pragma unroll
            for (int m = 0; m < 4; ++m)
#pragma unroll
                for (int bj = 0; bj < 2; ++bj) { u32x4 o[2]; epi_xpose(st, fr, fq, lane, __builtin_bit_cast(u32x4, acc[ai][bj][m][0]), __builtin_bit_cast(u32x4, acc[ai][bj][m][1]), o[0], o[1]);
#pragma unroll
                    for (int s = 0; s < 2; ++s) { const size_t off = o00 + (size_t)(ai * HALF + m * 16 + 8 * s) * D + bj * 32;
                        const f32x4 yv = xv[m][bj][s] * DN_ALPHA + __builtin_bit_cast(f32x4, o[s]);
#if Y1_BF16
                        { u32x2 yw; yw.x = cvt_pk_bf16(yv[0], yv[1]); yw.y = cvt_pk_bf16(yv[2], yv[3]); EPI_ST(u32x2, XF + off, yw); }
#else
                        EPI_ST(f32x4, XF + off, yv);
#endif
                    } }
        }
    }
};
struct EpiGU {
    static constexpr bool PERM = true;
    const float* bgu; bf16_t* H;
    __device__ __forceinline__ void binit(const Unit& u, int wc, int fq, f32x4 (&bv)[2][2]) const {
        const float* bg = bgu + (size_t)u.e * 2048 + u.pn * HALF + wc * 32 + 8 * fq;
        bv[0][0] = *(const f32x4*)(bg); bv[0][1] = *(const f32x4*)(bg + 4); bv[1][0] = *(const f32x4*)(bg + 1024); bv[1][1] = *(const f32x4*)(bg + 1028);
    }
    __device__ __forceinline__ void operator()(LAS unsigned char* lds, AccRef acc, const Unit& u, int wr, int wc, int fr, int fq) const {
        EPI_LOCALS();
        bf16_t* p0 = H + (size_t)(u.pm * BM + wr * 64 + (lane >> 2)) * D + u.pn * HALF + wc * 32 + (lane & 3) * 8;
#pragma unroll
        for (int ai = 0; ai < 2; ++ai)
#pragma unroll
            for (int m = 0; m < 4; ++m) {
                f32x4 g0 = acc[ai][0][m][0], g1 = acc[ai][0][m][1], u0 = acc[ai][1][m][0], u1 = acc[ai][1][m][1], h0, h1;
#pragma unroll
                for (int j = 0; j < 4; ++j) {
                    const float ga = fminf(g0[j], 7.0f), gb = fminf(g1[j], 7.0f);
                    const float ua = fminf(fmaxf(u0[j], -7.0f), 7.0f), ub = fminf(fmaxf(u1[j], -7.0f), 7.0f);
                    h0[j] = (ua + 1.0f) * ga * sigmoidf_(1.702f * ga); h1[j] = (ub + 1.0f) * gb * sigmoidf_(1.702f * gb); }
                u32x4 w; w.x = cvt_pk_bf16(h0[0], h0[1]); w.y = cvt_pk_bf16(h0[2], h0[3]); w.z = cvt_pk_bf16(h1[0], h1[1]); w.w = cvt_pk_bf16(h1[2], h1[3]);
                u32x4 o; epi_xpose1(st, fr, fq, lane, w, o);
                if (ai == 0 && m == 0) EPI_DRAIN();
                EPI_ST(u32x4, p0 + (size_t)(ai * HALF + m * 16) * D, o); asm volatile("" ::: "memory"); }
    }
};
struct EpiDown {
    static constexpr bool PERM = true;
    const float* bd; bf16_t* YK;
    __device__ __forceinline__ void binit(const Unit& u, int wc, int fq, f32x4 (&bv)[2][2]) const {
#pragma unroll
        for (int bj = 0; bj < 2; ++bj)
#pragma unroll
            for (int n = 0; n < 2; ++n) bv[bj][n] = *(const f32x4*)(bd + (size_t)u.e * D + u.pn * BM + wc * 64 + bj * 32 + 8 * fq + 4 * n);
    }
    __device__ __forceinline__ void operator()(LAS unsigned char* lds, AccRef acc, const Unit& u, int wr, int wc, int fr, int fq) const {
        EPI_LOCALS();
        bf16_t* p0 = YK + (size_t)(u.pm * BM + wr * 64 + lr) * D + u.pn * BM + wc * 64 + lc * 8;
#pragma unroll
        for (int ai = 0; ai < 2; ++ai)
#pragma unroll
            for (int m = 0; m < 4; ++m) { u32x4 w[2];
#pragma unroll
                for (int bj = 0; bj < 2; ++bj) { const f32x4 v0 = acc[ai][bj][m][0], v1 = acc[ai][bj][m][1];
                    w[bj].x = cvt_pk_bf16(v0[0], v0[1]); w[bj].y = cvt_pk_bf16(v0[2], v0[3]); w[bj].z = cvt_pk_bf16(v1[0], v1[1]); w[bj].w = cvt_pk_bf16(v1[2], v1[3]); }
                u32x4 o0, o1; epi_xpose(st, fr, fq, lane, w[0], w[1], o0, o1);
                if (ai == 0 && m == 0) EPI_DRAIN();
                bf16_t* rp = p0 + (size_t)(ai * HALF + m * 16) * D;
                EPI_ST(u32x4, rp, o0); EPI_ST(u32x4, rp + (size_t)8 * D, o1); asm volatile("" ::: "memory"); }
    }
};
}

struct Args { const float* in[21]; float* out; unsigned char* ws; int ph_lo, ph_hi, sub, pad; };
enum { I_XP = 0, I_XS, I_WIN, I_BIN, I_LNVG, I_LNVB, I_WS, I_BS, I_WPA, I_WPB, I_WO, I_LN1G, I_LN1B, I_WR, I_BR, I_WGU, I_BGU, I_WD, I_BD, I_LN2G, I_LN2B };

__device__ __forceinline__ void tr_item(const float* W, int K, int N, bf16_t* WT, int k0, int n0, int nd0, LAS unsigned* scr, int lane, int ndhi = 32) {
    const int i = lane & 15, kp = lane >> 4;
    f32x4 a[8], b[8];
#pragma unroll
    for (int it = 0; it < 8; ++it) { const int k = it * 8 + kp * 2; a[it] = *(const f32x4*)(W + (size_t)(k0 + k) * N + n0 + 4 * i); b[it] = *(const f32x4*)(W + (size_t)(k0 + k + 1) * N + n0 + 4 * i); }
#pragma unroll
    for (int it = 0; it < 8; ++it) {
#pragma unroll
        for (int j = 0; j < 4; ++j) scr[(4 * i + j) * 33 + it * 4 + kp] = pk2(a[it][j], b[it][j]); }
    asm volatile("s_waitcnt lgkmcnt(0)" ::: "memory");
    const int nn = lane >> 3, c = lane & 7;
#pragma unroll
    for (int j = 0; j < 8; ++j) { const int n = nn + 8 * j; u32x4 o; o.x = scr[n * 33 + 4 * c]; o.y = scr[n * 33 + 4 * c + 1]; o.z = scr[n * 33 + 4 * c + 2]; o.w = scr[n * 33 + 4 * c + 3];
        *(u32x4*)(WT + (size_t)(nd0 + (n & 31) + (n >> 5) * ndhi) * K + k0 + 8 * c) = o; }
    asm volatile("s_waitcnt lgkmcnt(0)" ::: "memory");
}
__device__ __forceinline__ void p0_prologue(const Args& a, LAS unsigned char* lds, int G) {
    const int tid = opaque_v(threadIdx.x), lane = tid & 63, wave = tid >> 6;
    LAS unsigned* scr = (LAS unsigned*)(lds + wave * 8704);
    const int gw = blockIdx.x * 8 + wave, NGW = G * 8;
    unsigned char* ws = a.ws;
    constexpr int I_GU = DEPTH * NE * 16 * 32, I_D = DEPTH * NE * 16 * 16, I_IN = DEPTH * 16 * 136, I_PA = DEPTH * 256, I_PB = DEPTH * 8 * 16, I_O = DEPTH * 256;
    constexpr int NITEMS = I_GU + I_D + I_IN + I_PA + I_PB + I_O;
    for (int it = gw; it < NITEMS; it += NGW) {
        int r = it;
        if (r < I_GU) { const int mat = r / 512, q = r % 512, kb = q / 32, nb = q % 32, n0 = nb * 64, c = n0 & 1023, nd0 = (c >> 7) * 256 + ((c & 127) >> 5) * 64 + ((n0 >= 1024) ? 32 : 0);
            tr_item(a.in[I_WGU] + (size_t)mat * 1024 * 2048, 1024, 2048, (bf16_t*)(ws + WS_WGU) + (size_t)mat * 2048 * 1024, kb * 64, n0, nd0, scr, lane, 64); continue; }
        r -= I_GU;
        if (r < I_D) { const int mat = r / 256, q = r % 256, kb = q / 16, nb = q % 16;
            tr_item(a.in[I_WD] + (size_t)mat * 1024 * 1024, 1024, 1024, (bf16_t*)(ws + WS_WD) + (size_t)mat * 1024 * 1024, kb * 64, nb * 64, nb * 64, scr, lane); continue; }
        r -= I_D;
        if (r < I_IN) { const int mat = r / (16 * 136), q = r % (16 * 136), kb = q / 136, nb = q % 136;
            tr_item(a.in[I_WIN] + (size_t)mat * 1024 * DIN, 1024, DIN, (bf16_t*)(ws + WS_WIN) + (size_t)mat * DIN * 1024, kb * 64, nb * 64, nb * 64, scr, lane); continue; }
        r -= I_IN;
        if (r < I_PA) { const int mat = r / 256, q = r % 256, kb = q / 16, nb = q % 16;
            tr_item(a.in[I_WPA] + (size_t)mat * 1024 * 1024, 1024, 1024, (bf16_t*)(ws + WS_WPA) + (size_t)mat * 1024 * 1024, kb * 64, nb * 64, nb * 64, scr, lane); continue; }
        r -= I_PA;
        if (r < I_PB) { const int mat = r / 128, q = r % 128, kb = q / 16, nb = q % 16;
            tr_item(a.in[I_WPB] + (size_t)mat * 512 * 1024, 512, 1024, (bf16_t*)(ws + WS_WPB) + (size_t)mat * 1024 * 512, kb * 64, nb * 64, nb * 64, scr, lane); continue; }
        r -= I_PB;
        { const int mat = r / 256, q = r % 256, kb = q / 16, nb = q % 16;
            tr_item(a.in[I_WO] + (size_t)mat * 1024 * 1024, 1024, 1024, (bf16_t*)(ws + WS_WO) + (size_t)mat * 1024 * 1024, kb * 64, nb * 64, nb * 64, scr, lane); }
    }
    const size_t gt = (size_t)blockIdx.x * 512 + tid, NGT = (size_t)G * 512;
    { float* prm = (float*)(ws + WS_PRM);
#define CPY(idx, off, n) for (size_t i = gt; i < (size_t)(n) / 4; i += NGT) *(f32x4*)(prm + (off) + i * 4) = *(const f32x4*)(a.in[idx] + i * 4)
      CPY(I_BIN, PR_BIN, DEPTH * DIN); CPY(I_LNVG, PR_LNVG, DEPTH * D); CPY(I_LNVB, PR_LNVB, DEPTH * D); CPY(I_BS, PR_BS, DEPTH * D); CPY(I_LN1G, PR_LN1G, DEPTH * D); CPY(I_LN1B, PR_LN1B, DEPTH * D);
      CPY(I_WR, PR_WR, DEPTH * D * NE); CPY(I_BR, PR_BR, DEPTH * NE); CPY(I_BGU, PR_BGU, DEPTH * NE * 2048); CPY(I_BD, PR_BD, DEPTH * NE * D); CPY(I_LN2G, PR_LN2G, DEPTH * D); CPY(I_LN2B, PR_LN2B, DEPTH * D);
#undef CPY
    }
    { const float* src = a.in[I_WR]; bf16_t* img = (bf16_t*)(ws + WS_WRI);
      for (size_t i = gt; i < (size_t)DEPTH * D * NE; i += NGT) { const int l = (int)(i >> 15), k = (int)(i >> 5) & 1023, e = (int)i & 31; const float v = src[i]; const unsigned h = f2bf(v), lo = f2bf(v - __builtin_bit_cast(float, h << 16));
          img[(size_t)l * 65536 + e * 1024 + k] = (bf16_t)h; img[(size_t)l * 65536 + 32768 + e * 1024 + k] = (bf16_t)lo; } }
    { const float* src = a.in[I_WS]; bf16_t* dst = (bf16_t*)(ws + WS_WS);
      for (size_t i = gt; i < (size_t)DEPTH * 8 * 128 * 128 / 8; i += NGT) { const f32x4 x = *(const f32x4*)(src + i * 8), y = *(const f32x4*)(src + i * 8 + 4);
          u32x4 o; o.x = pk2(x[0], x[1]); o.y = pk2(x[2], x[3]); o.z = pk2(y[0], y[1]); o.w = pk2(y[2], y[3]); *(u32x4*)(dst + i * 8) = o; } }
    { bf16_t* dst = (bf16_t*)(ws + WS_XB);
      for (size_t i = gt; i < (size_t)T * D / 8; i += NGT) { const size_t e = i * 8; const float* src = (e < (size_t)TP * D) ? a.in[I_XP] + e : a.in[I_XS] + (e - (size_t)TP * D);
          const f32x4 x = *(const f32x4*)(src), y = *(const f32x4*)(src + 4);
          u32x4 o; o.x = pk2(x[0], x[1]); o.y = pk2(x[2], x[3]); o.z = pk2(y[0], y[1]); o.w = pk2(y[2], y[3]); *(u32x4*)(dst + e) = o; } }
}

template <int BASE> __device__ __forceinline__ void tr8(unsigned addr, s16x4 (&r)[8]) {
    asm volatile("ds_read_b64_tr_b16 %0, %8 offset:%9\n\tds_read_b64_tr_b16 %1, %8 offset:%10\n\tds_read_b64_tr_b16 %2, %8 offset:%11\n\tds_read_b64_tr_b16 %3, %8 offset:%12\n\t"
                 "ds_read_b64_tr_b16 %4, %8 offset:%13\n\tds_read_b64_tr_b16 %5, %8 offset:%14\n\tds_read_b64_tr_b16 %6, %8 offset:%15\n\tds_read_b64_tr_b16 %7, %8 offset:%16\n\t"
                 : "=&v"(r[0]), "=&v"(r[1]), "=&v"(r[2]), "=&v"(r[3]), "=&v"(r[4]), "=&v"(r[5]), "=&v"(r[6]), "=&v"(r[7])
                 : "v"(addr), "n"(BASE), "n"(BASE + 32), "n"(BASE + 64), "n"(BASE + 96), "n"(BASE + 128), "n"(BASE + 160), "n"(BASE + 192), "n"(BASE + 224) : "memory");
}
__device__ __forceinline__ bf16x8 cat4(s16x4 a, s16x4 b) { return (bf16x8){a[0], a[1], a[2], a[3], b[0], b[1], b[2], b[3]}; }

constexpr int AT_KSTR = 272, AT_VSTR = 288, AT_KBYTES = 256 * AT_KSTR, AT_VOFF = AT_KBYTES, AT_VBYTES = 256 * AT_VSTR;
constexpr int AT_EPI_OFF = AT_VOFF + AT_VBYTES;
static_assert(AT_EPI_OFF + 8 * 2304 <= SCR_BYTES, "attention LDS");

template <int ST> __device__ __forceinline__ void attn_pv_step(unsigned vaddr, const f32x4 (&s)[9], f32x4 (&o)[8]) {
    s16x4 r0[8], r1[8];
    tr8<ST * 32 * AT_VSTR>(vaddr, r0);
    tr8<ST * 32 * AT_VSTR + (ST < 4 ? 16 * AT_VSTR : 0)>(vaddr, r1);
    asm volatile("s_waitcnt lgkmcnt(0)" ::: "memory");
    __builtin_amdgcn_sched_barrier(0);
    u32x4 pw; pw.x = cvt_pk_bf16(s[2 * ST][0], s[2 * ST][1]); pw.y = cvt_pk_bf16(s[2 * ST][2], s[2 * ST][3]);
    if (ST < 4) { pw.z = cvt_pk_bf16(s[2 * ST + (ST < 4 ? 1 : 0)][0], s[2 * ST + (ST < 4 ? 1 : 0)][1]); pw.w = cvt_pk_bf16(s[2 * ST + (ST < 4 ? 1 : 0)][2], s[2 * ST + (ST < 4 ? 1 : 0)][3]); }
    else { pw.z = 0u; pw.w = 0u; }
    const bf16x8 pf = __builtin_bit_cast(bf16x8, pw);
#pragma unroll
    for (int db = 0; db < 8; ++db) o[db] = __builtin_amdgcn_mfma_f32_16x16x32_bf16(cat4(r0[db], r1[db]), pf, o[db], 0, 0, 0);
}

__device__ __forceinline__ void attn_load(const bf16_t* QKV, int unit, int tid, u32x4 (&kr)[8], u32x4 (&vr)[8]) {
    const int wsub = unit & 31, h = (unit >> 5) & 3, bg = unit >> 7, g = bg % 3, b = bg / 3;
    const int dsh = 2 * g, dil = 1 << dsh, L = SEQ >> dsh, nblk = L >> 7, r = wsub / nblk, blk = wsub % nblk, p0 = blk * 128;
    const int kc = g * 1536 + h * 128 + 512, vc = kc + 512;
#pragma unroll
    for (int j = 0; j < 8; ++j) { const int id = tid + 512 * j, kk = id >> 4, ch = id & 15, pk = p0 - 64 + kk; const bool ok = pk >= 0 && pk < L;
        const size_t ro = (size_t)(b * SEQ + (ok ? pk : 0) * dil + r) * QKVW; const u32x4 kx = *(const u32x4*)(QKV + ro + kc + ch * 8), vx = *(const u32x4*)(QKV + ro + vc + ch * 8);
        kr[j] = ok ? kx : (u32x4){0u, 0u, 0u, 0u}; vr[j] = ok ? vx : (u32x4){0u, 0u, 0u, 0u}; }
}
__device__ __forceinline__ void attn_unit(LAS unsigned char* lds, const bf16_t* QKV, bf16_t* OG, float* LSE, int unit, int unit_next, u32x4 (&kr)[8], u32x4 (&vr)[8]) {
    const int tid = opaque_v(threadIdx.x), lane = tid & 63, w = tid >> 6, ql = lane & 15, quad = lane >> 4;
    const int wsub = unit & 31, h = (unit >> 5) & 3, bg = unit >> 7, g = bg % 3, b = bg / 3;
    const int dsh = 2 * g, dil = 1 << dsh, L = SEQ >> dsh, nblk = L >> 7, r = wsub / nblk, blk = wsub % nblk, p0 = blk * 128;
    const int qc = g * 1536 + h * 128;
    const float slope = __builtin_amdgcn_exp2f(-(2.0f / 3.0f) * (float)(4 * g + h + 1));
    const float ca = slope * (float)dil * LOG2E, SC = 0.08838834764831845f * LOG2E;
#pragma unroll
    for (int j = 0; j < 8; ++j) { const int id = tid + 512 * j, kk = id >> 4, ch = id & 15;
        *(LAS u32x4*)(lds + kk * AT_KSTR + ch * 16) = kr[j]; *(LAS u32x4*)(lds + AT_VOFF + kk * AT_VSTR + ch * 16) = vr[j]; }
    const int qrow = b * SEQ + (p0 + 16 * w + ql) * dil + r;
    bf16x8 qf[4];
#pragma unroll
    for (int ks = 0; ks < 4; ++ks) qf[ks] = *(const bf16x8*)(QKV + (size_t)qrow * QKVW + qc + 32 * ks + 8 * quad);
    __syncthreads();
    asm volatile("" : "+v"(qf[0]), "+v"(qf[1]), "+v"(qf[2]), "+v"(qf[3]));
    attn_load(QKV, unit_next >= 0 ? unit_next : unit, tid, kr, vr);
    f32x4 s[9];
#pragma unroll
    for (int j = 0; j < 9; ++j) { s[j] = (f32x4){0.f, 0.f, 0.f, 0.f};
#pragma unroll
        for (int ks = 0; ks < 4; ++ks) { const bf16x8 kf = *(const LAS bf16x8*)(lds + (16 * w + 16 * j + ql) * AT_KSTR + (32 * ks + 8 * quad) * 2);
            s[j] = __builtin_amdgcn_mfma_f32_16x16x32_bf16(kf, qf[ks], s[j], 0, 0, 0); } }
    float mx = -1e30f;
#pragma unroll
    for (int j = 0; j < 9; ++j)
#pragma unroll
        for (int i = 0; i < 4; ++i) { const int rel = 16 * j + 4 * quad + i - 64 - ql, pk = p0 + 16 * w + ql + rel, ar = rel < 0 ? -rel : rel;
            const bool ok = (ar <= 64) && (pk >= 0) && (pk < L);
            const float v = ok ? (s[j][i] * SC - ca * (float)ar) : -1e30f; s[j][i] = v; mx = fmaxf(mx, v); }
    mx = fmaxf(mx, __shfl_xor(mx, 16)); mx = fmaxf(mx, __shfl_xor(mx, 32));
    float den = 0.f;
#pragma unroll
    for (int j = 0; j < 9; ++j)
#pragma unroll
        for (int i = 0; i < 4; ++i) { const float p = __builtin_amdgcn_exp2f(s[j][i] - mx); s[j][i] = p; den += p; }
    den += __shfl_xor(den, 16); den += __shfl_xor(den, 32);
    f32x4 o[8];
#pragma unroll
    for (int db = 0; db < 8; ++db) o[db] = (f32x4){0.f, 0.f, 0.f, 0.f};
    const unsigned vaddr = (unsigned)(uintptr_t)(lds + AT_VOFF) + (unsigned)((16 * w + 4 * quad + (ql >> 2)) * AT_VSTR + (ql & 3) * 8);
    attn_pv_step<0>(vaddr, s, o); attn_pv_step<1>(vaddr, s, o); attn_pv_step<2>(vaddr, s, o); attn_pv_step<3>(vaddr, s, o); attn_pv_step<4>(vaddr, s, o);
    const float inv = 1.0f / den;
    {
        LAS unsigned char* st = lds + AT_EPI_OFF + w * 2304;
        const int lr = lane >> 3, lc = lane & 7;
        bf16_t* od0 = OG + ((size_t)g * T + (size_t)(b * SEQ + (p0 + 16 * w + lr) * dil + r)) * 512 + h * 128 + lc * 8;
        bf16_t* od1 = OG + ((size_t)g * T + (size_t)(b * SEQ + (p0 + 16 * w + 8 + lr) * dil + r)) * 512 + h * 128 + lc * 8;
#pragma unroll
        for (int hh = 0; hh < 2; ++hh) {
#pragma unroll
            for (int d4 = 0; d4 < 4; ++d4) { const int db = 4 * hh + d4; u32x2 wv; wv.x = cvt_pk_bf16(o[db][0] * inv, o[db][1] * inv); wv.y = cvt_pk_bf16(o[db][2] * inv, o[db][3] * inv);
                *(LAS u32x2*)(st + ql * 144 + d4 * 32 + quad * 8) = wv; }
            const u32x4 r0 = *(const LAS u32x4*)(st + lr * 144 + lc * 16), r1 = *(const LAS u32x4*)(st + (8 + lr) * 144 + lc * 16);
            __builtin_nontemporal_store(r0, (u32x4*)(od0 + hh * 64)); __builtin_nontemporal_store(r1, (u32x4*)(od1 + hh * 64));
        }
    }
    if (quad == 0) LSE[((size_t)g * T + qrow) * 4 + h] = (mx + __builtin_amdgcn_logf(den)) * LN2;
    __syncthreads();
}

constexpr int SG_STR = 288, SG_TILE = 128 * SG_STR, SG_STATS = 2 * SG_TILE, SG_EPI_OFF = SG_STATS + 1024, SG_EPI_WBYTES = 16 * 528;
static_assert(SG_EPI_OFF + 8 * SG_EPI_WBYTES <= SCR_BYTES, "spatial gating LDS");
template <int KS> __device__ __forceinline__ void sg_step(unsigned vaddr, const bf16x8 wf, f32x4 (&acc)[8]) {
    s16x4 r0[8], r1[8];
    tr8<KS * 32 * SG_STR>(vaddr, r0);
    tr8<KS * 32 * SG_STR + 4 * SG_STR>(vaddr, r1);
    asm volatile("s_waitcnt lgkmcnt(0)" ::: "memory");
    __builtin_amdgcn_sched_barrier(0);
#pragma unroll
    for (int cb = 0; cb < 8; ++cb) acc[cb] = __builtin_amdgcn_mfma_f32_16x16x32_bf16(cat4(r0[cb], r1[cb]), wf, acc[cb], 0, 0, 0);
}
__device__ __forceinline__ void sg_unit(LAS unsigned char* lds, const bf16_t* U, const bf16_t* V, bf16_t* AOUT, const bf16_t* WsB, const float* bs, const float* lng, const float* lnb, const f32x2* PS, int unit) {
    const int tid = opaque_v(threadIdx.x), lane = tid & 63, w = tid >> 6, ql = lane & 15, quad = lane >> 4;
    const int ci = unit >> 1, hh = unit & 1, row0 = ci * 128;
    LAS float* stats = (LAS float*)(lds + SG_STATS);
    { const int row = tid >> 2, part = tid & 3; const f32x4 pa = *(const f32x4*)(PS + (size_t)(row0 + row) * 16 + part * 4), pb = *(const f32x4*)(PS + (size_t)(row0 + row) * 16 + part * 4 + 2);
      float sm = (pa[0] + pa[2]) + (pb[0] + pb[2]), sq = (pa[1] + pa[3]) + (pb[1] + pb[3]);
      sm += __shfl_xor(sm, 1); sq += __shfl_xor(sq, 1); sm += __shfl_xor(sm, 2); sq += __shfl_xor(sq, 2);
      const float mean = sm * (1.0f / D), rstd = 1.0f / sqrtf(fmaxf(sq * (1.0f / D) - mean * mean, 0.f) + LN_EPS);
      if (part == 0) { stats[2 * row] = mean; stats[2 * row + 1] = rstd; } }
    __syncthreads();
    const int ch = tid & 15;
    u32x4 vt[4]; bf16x8 wf[4]; f32x4 gab[4];
#define SG_LOADG(GI) do { const int g_ = 4 * hh + (GI); \
        _Pragma("unroll") for (int j = 0; j < 4; ++j) vt[j] = *(const u32x4*)(V + (size_t)(row0 + (tid >> 4) + 32 * j) * D + g_ * 128 + ch * 8); \
        gab[0] = *(const f32x4*)(lng + g_ * 128 + ch * 8); gab[1] = *(const f32x4*)(lng + g_ * 128 + ch * 8 + 4); gab[2] = *(const f32x4*)(lnb + g_ * 128 + ch * 8); gab[3] = *(const f32x4*)(lnb + g_ * 128 + ch * 8 + 4); \
        const bf16_t* Wg_ = WsB + (size_t)g_ * 128 * 128 + (size_t)(16 * w + ql) * 128 + 8 * quad; \
        _Pragma("unroll") for (int ks = 0; ks < 4; ++ks) wf[ks] = *(const bf16x8*)(Wg_ + 32 * ks); } while (0)
    SG_LOADG(0);
#pragma unroll 1
    for (int gi = 0; gi < 4; ++gi) {
        const int g = 4 * hh + gi; LAS unsigned char* tile = lds + (gi & 1) * SG_TILE;
#pragma unroll
        for (int j = 0; j < 4; ++j) { const int sr = (tid >> 4) + 32 * j; const u32x4 x = vt[j];
            const float mean = stats[2 * sr], rstd = stats[2 * sr + 1];
            const f32x4 a = ((f32x4){bflo(x.x), bfhi(x.x), bflo(x.y), bfhi(x.y)} - mean) * rstd * gab[0] + gab[2], bq = ((f32x4){bflo(x.z), bfhi(x.z), bflo(x.w), bfhi(x.w)} - mean) * rstd * gab[1] + gab[3];
            u32x4 o; o.x = cvt_pk_bf16(a[0], a[1]); o.y = cvt_pk_bf16(a[2], a[3]); o.z = cvt_pk_bf16(bq[0], bq[1]); o.w = cvt_pk_bf16(bq[2], bq[3]);
            *(LAS u32x4*)(tile + sr * SG_STR + ch * 16) = o; }
        bf16x8 wfc[4];
#pragma unroll
        for (int ks = 0; ks < 4; ++ks) { wfc[ks] = wf[ks]; asm volatile("" : "+v"(wfc[ks])); }
        __syncthreads();
        const size_t off = (size_t)(row0 + 16 * w + (lane >> 5)) * D + g * 128 + 4 * (lane & 31);
        u32x2 uu[8];
#pragma unroll
        for (int it = 0; it < 8; ++it) uu[it] = *(const u32x2*)(U + off + (size_t)(2 * it) * D);
        SG_LOADG(gi < 3 ? gi + 1 : 3);
        f32x4 acc[8];
#pragma unroll
        for (int cb = 0; cb < 8; ++cb) acc[cb] = (f32x4){0.f, 0.f, 0.f, 0.f};
        const unsigned vaddr = (unsigned)(uintptr_t)tile + (unsigned)((8 * quad + (ql >> 2)) * SG_STR + (ql & 3) * 8);
        sg_step<0>(vaddr, wfc[0], acc); sg_step<1>(vaddr, wfc[1], acc); sg_step<2>(vaddr, wfc[2], acc); sg_step<3>(vaddr, wfc[3], acc);
        const int t = 16 * w + ql; const float bst = bs[g * 128 + t];
        LAS unsigned char* st = lds + SG_EPI_OFF + w * SG_EPI_WBYTES;
#pragma unroll
        for (int cb = 0; cb < 8; ++cb) *(LAS f32x4*)(st + ql * 528 + 64 * cb + 16 * quad) = acc[cb] + bst;
#pragma unroll
        for (int it = 0; it < 8; ++it) { const f32x4 mv = *(const LAS f32x4*)(st + (2 * it + (lane >> 5)) * 528 + (lane & 31) * 16);
            u32x2 o; o.x = cvt_pk_bf16(bflo(uu[it].x) * mv[0], bfhi(uu[it].x) * mv[1]); o.y = cvt_pk_bf16(bflo(uu[it].y) * mv[2], bfhi(uu[it].y) * mv[3]);
            __builtin_nontemporal_store(o, (u32x2*)(AOUT + off + (size_t)(2 * it) * D)); }
    }
#undef SG_LOADG
    __syncthreads();
}

__device__ __forceinline__ void merge_phase(const bf16_t* OG, const float* LSE, bf16_t* BOUT, int G) {
    const int tid = opaque_v(threadIdx.x), lane = tid & 63, gw = blockIdx.x * 8 + (tid >> 6), NGW = G * 8, hd = lane >> 4;
    for (int row = gw; row < T; row += NGW) {
        const float l0 = LSE[((size_t)0 * T + row) * 4 + hd], l1 = LSE[((size_t)1 * T + row) * 4 + hd], l2 = LSE[((size_t)2 * T + row) * 4 + hd];
        const float m = fmaxf(l0, fmaxf(l1, l2));
        float w0 = __builtin_amdgcn_exp2f((l0 - m) * LOG2E), w1 = __builtin_amdgcn_exp2f((l1 - m) * LOG2E), w2 = __builtin_amdgcn_exp2f((l2 - m) * LOG2E);
        const float inv = 1.0f / (w0 + w1 + w2); w0 *= inv; w1 *= inv; w2 *= inv;
        const u32x4 a = *(const u32x4*)(OG + ((size_t)0 * T + row) * 512 + lane * 8), b = *(const u32x4*)(OG + ((size_t)1 * T + row) * 512 + lane * 8), c = *(const u32x4*)(OG + ((size_t)2 * T + row) * 512 + lane * 8);
        u32x4 o;
        o.x = cvt_pk_bf16(w0 * bflo(a.x) + w1 * bflo(b.x) + w2 * bflo(c.x), w0 * bfhi(a.x) + w1 * bfhi(b.x) + w2 * bfhi(c.x));
        o.y = cvt_pk_bf16(w0 * bflo(a.y) + w1 * bflo(b.y) + w2 * bflo(c.y), w0 * bfhi(a.y) + w1 * bfhi(b.y) + w2 * bfhi(c.y));
        o.z = cvt_pk_bf16(w0 * bflo(a.z) + w1 * bflo(b.z) + w2 * bflo(c.z), w0 * bfhi(a.z) + w1 * bfhi(b.z) + w2 * bfhi(c.z));
        o.w = cvt_pk_bf16(w0 * bflo(a.w) + w1 * bflo(b.w) + w2 * bflo(c.w), w0 * bfhi(a.w) + w1 * bfhi(b.w) + w2 * bfhi(c.w));
        __builtin_nontemporal_store(o, (u32x4*)(BOUT + (size_t)row * 512 + lane * 8));
    }
}

constexpr int RT_WSTR = 2064, RT_WL = 32 * RT_WSTR, RT_GB = 2 * RT_WL, RT_ST = RT_GB + 8192, RT_STW = 2560;
static_assert(RT_ST + 8 * RT_STW <= SCR_BYTES, "router LDS");
#if !Y1_BF16
#error "P5 keeps a wave's rows in registers: it needs the bf16 y1"
#endif
#define P5_UNPK(q) ((f32x4){bflo((q).x), bfhi((q).x), bflo((q).y), bfhi((q).y)})
template <bool HASB> __device__ __forceinline__ void p5_tile(LAS unsigned char* lds, u32x2 (&ra)[32], u32x2 (&rb)[32], bool liveA, bool liveB, int rowA, int rowB, f32x2* RS, bf16_t* XB,
                                                             int lane_, int w, const float (&bre)[8], float (&lg)[8]) {
    const int lane = opaque_v(lane_), r = lane & 15, quad = lane >> 4, lr = lane >> 3, lc = lane & 7;
    float smA = 0.f, sqA = 0.f, smB = 0.f, sqB = 0.f;
#pragma unroll
    for (int s = 0; s < 32; ++s) { const f32x4 a = P5_UNPK(ra[s]);
        smA += (a[0] + a[1]) + (a[2] + a[3]); sqA += (a[0] * a[0] + a[1] * a[1]) + (a[2] * a[2] + a[3] * a[3]);
        if (HASB) { const f32x4 b = P5_UNPK(rb[s]); smB += (b[0] + b[1]) + (b[2] + b[3]); sqB += (b[0] * b[0] + b[1] * b[1]) + (b[2] * b[2] + b[3] * b[3]); } }
#pragma unroll
    for (int o = 1; o < 8; o <<= 1) { smA += __shfl_xor(smA, o); sqA += __shfl_xor(sqA, o); if (HASB) { smB += __shfl_xor(smB, o); sqB += __shfl_xor(sqB, o); } }
    const float meanA = smA * (1.0f / D), rstdA = 1.0f / sqrtf(fmaxf(sqA * (1.0f / D) - meanA * meanA, 0.f) + LN_EPS);
    const float meanB = smB * (1.0f / D), rstdB = 1.0f / sqrtf(fmaxf(sqB * (1.0f / D) - meanB * meanB, 0.f) + LN_EPS);
    if (lc == 0) { if (liveA) RS[rowA] = (f32x2){meanA, rstdA}; if (HASB && liveB) RS[rowB] = (f32x2){meanB, rstdB}; }
#pragma unroll
    for (int s = 0; s < 32; ++s) { asm volatile("" : "+v"(ra[s])); if (HASB) asm volatile("" : "+v"(rb[s])); }
    f32x4 acc[2] = {(f32x4){0.f, 0.f, 0.f, 0.f}, (f32x4){0.f, 0.f, 0.f, 0.f}};
    const LAS unsigned char* wp = lds + r * RT_WSTR + 16 * quad;
    LAS unsigned char* stw = lds + RT_ST + w * RT_STW;
    const LAS float* gl = (const LAS float*)(lds + RT_GB) + 4 * lc; const LAS float* bl = gl + 1024;
    bf16_t* xoA = XB + (size_t)rowA * D + 4 * lc; bf16_t* xoB = XB + (size_t)rowB * D + 4 * lc;
#pragma unroll
    for (int s = 0; s < 32; ++s) {
        const f32x4 a = P5_UNPK(ra[s]);
        const f32x4 gv = *(const LAS f32x4*)(gl + 32 * s), bv = *(const LAS f32x4*)(bl + 32 * s);
        const f32x4 xa = (a - meanA) * rstdA * gv + bv;
        u32x2 ha, la;
        ha.x = cvt_pk_bf16(xa[0], xa[1]); ha.y = cvt_pk_bf16(xa[2], xa[3]);
        la.x = cvt_pk_bf16(xa[0] - bflo(ha.x), xa[1] - bfhi(ha.x)); la.y = cvt_pk_bf16(xa[2] - bflo(ha.y), xa[3] - bfhi(ha.y));
        if (liveA) *(u32x2*)(xoA + 32 * s) = ha;
        *(LAS u32x2*)(stw + lr * 80 + lc * 8) = ha; *(LAS u32x2*)(stw + 1280 + lr * 80 + lc * 8) = la;
        if (HASB) { const f32x4 b = P5_UNPK(rb[s]); const f32x4 xb = (b - meanB) * rstdB * gv + bv; u32x2 hb, lb;
            hb.x = cvt_pk_bf16(xb[0], xb[1]); hb.y = cvt_pk_bf16(xb[2], xb[3]); lb.x = cvt_pk_bf16(xb[0] - bflo(hb.x), xb[1] - bfhi(hb.x)); lb.y = cvt_pk_bf16(xb[2] - bflo(hb.y), xb[3] - bfhi(hb.y));
            if (liveB) *(u32x2*)(xoB + 32 * s) = hb;
            *(LAS u32x2*)(stw + (8 + lr) * 80 + lc * 8) = hb; *(LAS u32x2*)(stw + 1280 + (8 + lr) * 80 + lc * 8) = lb; }
        const bf16x8 xh = *(const LAS bf16x8*)(stw + r * 80 + quad * 16), xl = *(const LAS bf16x8*)(stw + 1280 + r * 80 + quad * 16);
#pragma unroll
        for (int eb = 0; eb < 2; ++eb) { const bf16x8 wh = *(const LAS bf16x8*)(wp + eb * 16 * RT_WSTR + 64 * s), wl = *(const LAS bf16x8*)(wp + RT_WL + eb * 16 * RT_WSTR + 64 * s);
            acc[eb] = __builtin_amdgcn_mfma_f32_16x16x32_bf16(wh, xh, acc[eb], 0, 0, 0); acc[eb] = __builtin_amdgcn_mfma_f32_16x16x32_bf16(wh, xl, acc[eb], 0, 0, 0); acc[eb] = __builtin_amdgcn_mfma_f32_16x16x32_bf16(wl, xh, acc[eb], 0, 0, 0); }
    }
#pragma unroll
    for (int eb = 0; eb < 2; ++eb)
#pragma unroll
        for (int i = 0; i < 4; ++i) lg[eb * 4 + i] = acc[eb][i] + bre[eb * 4 + i];
}
__device__ __forceinline__ void p5_route(float (&lg)[8], bool live, int row, int lane_, int tid_, volatile LAS unsigned* lcnt, volatile LAS unsigned* gbase, unsigned* gcnt, int* tokList, int* tokE, int* tokPos, float* gate) {
    const int lane = opaque_v(lane_), tid = opaque_v(tid_), quad = lane >> 4;
    float tv[4]; int ti[4];
#pragma unroll
    for (int k = 0; k < 4; ++k) { float bvv = lg[0]; int bi = 4 * quad;
#pragma unroll
        for (int j = 1; j < 8; ++j) { const int ej = 16 * (j >> 2) + 4 * quad + (j & 3); if (lg[j] > bvv) { bvv = lg[j]; bi = ej; } }
#pragma unroll
        for (int o = 16; o < 64; o <<= 1) { const float ov = __shfl_xor(bvv, o); const int oi = __shfl_xor(bi, o); if (ov > bvv || (ov == bvv && oi < bi)) { bvv = ov; bi = oi; } }
        tv[k] = bvv; ti[k] = bi;
#pragma unroll
        for (int j = 0; j < 8; ++j) { const int ej = 16 * (j >> 2) + 4 * quad + (j & 3); if (ej == bi) lg[j] = -3.0e38f; } }
    const float e1 = __builtin_amdgcn_exp2f((tv[1] - tv[0]) * LOG2E), e2 = __builtin_amdgcn_exp2f((tv[2] - tv[0]) * LOG2E), e3 = __builtin_amdgcn_exp2f((tv[3] - tv[0]) * LOG2E);
    const float inv = 1.0f / (1.0f + e1 + e2 + e3);
    const int ek = quad == 0 ? ti[0] : quad == 1 ? ti[1] : quad == 2 ? ti[2] : ti[3]; const float gk = (quad == 0 ? 1.0f : quad == 1 ? e1 : quad == 2 ? e2 : e3) * inv;
    int lp = -1;
    if (live) { lp = (int)__hip_atomic_fetch_add((LAS unsigned*)&lcnt[ek], 1u, __ATOMIC_RELAXED, __HIP_MEMORY_SCOPE_WORKGROUP);
        gate[(size_t)row * 4 + quad] = gk; tokE[(size_t)row * 4 + quad] = ek; }
    __syncthreads();
    if (tid < 32) { const unsigned n = lcnt[tid]; gbase[tid] = n ? __hip_atomic_fetch_add(gcnt + tid, n, __ATOMIC_RELAXED, __HIP_MEMORY_SCOPE_AGENT) : 0u; }
    __syncthreads();
    if (lp >= 0) { const int pos = (int)gbase[ek] + lp; tokList[(size_t)ek * T + pos] = row; tokPos[(size_t)row * 4 + quad] = pos; }
    if (tid < 32) lcnt[tid] = 0u;
    __syncthreads();
}
__device__ __forceinline__ void ln1_router_phase(LAS unsigned char* lds, volatile LAS unsigned* MISC, f32x2* RS, const y1_t* XFin, y1_t* XF, bf16_t* XB, const float* g1, const float* b1, const bf16_t* wri, const float* br,
                                                 unsigned* gcnt, int* tokList, int* tokE, int* tokPos, float* gate, int G) {
    const int tid = opaque_v(threadIdx.x), lane = tid & 63, w = tid >> 6, r = lane & 15, quad = lane >> 4, lr = lane >> 3, lc = lane & 7;
    volatile LAS unsigned* lcnt = MISC + 128; volatile LAS unsigned* gbase = MISC + 160;
    float bre[8];
#pragma unroll
    for (int eb = 0; eb < 2; ++eb)
#pragma unroll
        for (int i = 0; i < 4; ++i) bre[eb * 4 + i] = br[16 * eb + 4 * quad + i];
    constexpr int NCHUNK = T / 24;
    const int iters = (NCHUNK + 8 * G - 1) / (8 * G);
    for (int it = 0; it < iters; ++it) {
        const int chunk = (it * G + blockIdx.x) * 8 + w;
        const bool live_chunk = chunk < NCHUNK;
        const int row0 = opaque_v(live_chunk ? chunk * 24 : 0);
        u32x2 ra[32], rb[32];
        { const y1_t* xa_ = XFin + (size_t)(row0 + lr) * D + 4 * lc;
#pragma unroll
          for (int s = 0; s < 32; ++s) { ra[s] = *(const u32x2*)(xa_ + 32 * s); rb[s] = *(const u32x2*)(xa_ + (size_t)8 * D + 32 * s); } }
        if (it == 0) {
_Pragma("unroll 4")
            for (int j = 0; j < 16; ++j) { const int u = tid + 512 * j; const u32x4 v = ((const u32x4*)wri)[u]; *(LAS u32x4*)(lds + (u >> 12) * RT_WL + ((u >> 7) & 31) * RT_WSTR + (u & 127) * 16) = v; }
            for (int i = tid; i < 1024; i += 512) { ((LAS float*)(lds + RT_GB))[i] = g1[i]; ((LAS float*)(lds + RT_GB))[1024 + i] = b1[i]; }
            if (tid < 32) lcnt[tid] = 0u;
            __syncthreads();
        }
        float lg[8];
        p5_tile<true>(lds, ra, rb, live_chunk, live_chunk, row0 + lr, row0 + 8 + lr, RS, XB, lane, w, bre, lg);
        asm volatile("" ::: "memory");
        u32x2 rc[32];
        { const y1_t* xc_ = XFin + (size_t)(row0 + 16 + lr) * D + 4 * lc;
#pragma unroll
          for (int s = 0; s < 32; ++s) rc[s] = *(const u32x2*)(xc_ + 32 * s); }
        p5_route(lg, live_chunk, row0 + r, lane, tid, lcnt, gbase, gcnt, tokList, tokE, tokPos, gate);
        p5_tile<false>(lds, rc, rc, live_chunk, false, row0 + 16 + lr, row0 + 16 + lr, RS, XB, lane, w, bre, lg);
        p5_route(lg, live_chunk && (r < 8), row0 + 16 + (r & 7), lane, tid, lcnt, gbase, gcnt, tokList, tokE, tokPos, gate);
    }
}

__device__ __forceinline__ void combine_ln2_phase(volatile LAS unsigned* MISC, const f32x2* RS, const float* g1, const float* b1, const y1_t* XF, const bf16_t* YK, const int* tokE, const int* tokPos, const float* gate, const float* g2, const float* b2,
                                                  float* outF, bf16_t* XB, int G) {
    const int tid = opaque_v(threadIdx.x), lane = tid & 63, gw = blockIdx.x * 8 + (tid >> 6), NGW = G * 8;
    const volatile LAS int* tb = (const volatile LAS int*)(MISC + 16);
    f32x4 gv[4], bv[4];
#pragma unroll
    for (int j = 0; j < 4; ++j) { gv[j] = *(const f32x4*)(g2 + 256 * j + 4 * lane); bv[j] = *(const f32x4*)(b2 + 256 * j + 4 * lane); }
    f32x4 gv1[4], bv1[4];
#pragma unroll
    for (int j = 0; j < 4; ++j) { gv1[j] = *(const f32x4*)(g1 + 256 * j + 4 * lane); bv1[j] = *(const f32x4*)(b1 + 256 * j + 4 * lane); }
    typedef int i32x4 __attribute__((ext_vector_type(4)));
    i32x4 ne = *(const i32x4*)(tokE + (size_t)(gw < T ? gw : 0) * 4), np = *(const i32x4*)(tokPos + (size_t)(gw < T ? gw : 0) * 4); f32x4 ng = *(const f32x4*)(gate + (size_t)(gw < T ? gw : 0) * 4);
    for (int row = gw; row < T; row += NGW) {
        const i32x4 ce = ne, cpz = np; const f32x4 cg = ng;
        f32x4 v[4]; u32x2 y[4][4];
#pragma unroll
        for (int j = 0; j < 4; ++j) v[j] = Y1_LD4(XF + (size_t)row * D + 256 * j + 4 * lane);
        const f32x2 rs = RS[row];
#pragma unroll
        for (int k = 0; k < 4; ++k) { const size_t slot = (size_t)tb[ce[k]] * 256 + cpz[k];
#pragma unroll
            for (int j = 0; j < 4; ++j) y[k][j] = __builtin_nontemporal_load((const u32x2*)(YK + slot * D + 256 * j + 4 * lane)); }
        { const int rn = (row + NGW < T) ? row + NGW : row; ne = *(const i32x4*)(tokE + (size_t)rn * 4); np = *(const i32x4*)(tokPos + (size_t)rn * 4); ng = *(const f32x4*)(gate + (size_t)rn * 4); }
#pragma unroll
        for (int j = 0; j < 4; ++j) { v[j] = ((v[j] - rs[0]) * rs[1] * gv1[j] + bv1[j]) * DN_ALPHA;
#pragma unroll
            for (int k = 0; k < 4; ++k) v[j] += (f32x4){bflo(y[k][j].x), bfhi(y[k][j].x), bflo(y[k][j].y), bfhi(y[k][j].y)} * cg[k]; }
        float s = 0.f;
#pragma unroll
        for (int j = 0; j < 4; ++j) s += (v[j][0] + v[j][1]) + (v[j][2] + v[j][3]);
        const float mean = wave_sum(s) * (1.0f / D); float s2 = 0.f;
#pragma unroll
        for (int j = 0; j < 4; ++j) { v[j] = v[j] - mean; s2 += (v[j][0] * v[j][0] + v[j][1] * v[j][1]) + (v[j][2] * v[j][2] + v[j][3] * v[j][3]); }
        const float rstd = 1.0f / sqrtf(wave_sum(s2) * (1.0f / D) + LN_EPS);
#pragma unroll
        for (int j = 0; j < 4; ++j) { v[j] = v[j] * rstd * gv[j] + bv[j];
            if (outF) __builtin_nontemporal_store(v[j], (f32x4*)(outF + (size_t)row * D + 256 * j + 4 * lane));
            if (!outF) { u32x2 o; o.x = cvt_pk_bf16(v[j][0], v[j][1]); o.y = cvt_pk_bf16(v[j][2], v[j][3]); *(u32x2*)(XB + (size_t)row * D + 256 * j + 4 * lane) = o; } }
    }
}

__device__ __forceinline__ void moe_tables(volatile LAS unsigned* MISC, const unsigned* gcnt) {
    const int tid_ = opaque_v(threadIdx.x);
    if (tid_ < 64) {
        const int lane = tid_;
        const int n = lane < NE ? (int)__hip_atomic_load(gcnt + lane, __ATOMIC_RELAXED, __HIP_MEMORY_SCOPE_AGENT) : 0;
        const int nt = (n + 255) >> 8; int incl = nt;
#pragma unroll
        for (int o = 1; o < 32; o <<= 1) { const int v = __shfl_up(incl, o); if (lane >= o) incl += v; }
        if (lane < NE) { MISC[64 + lane] = (unsigned)n; MISC[16 + lane] = (unsigned)(incl - nt); }
        if (lane == NE - 1) MISC[16 + NE] = (unsigned)incl;
        if (lane < NE) { volatile LAS unsigned char* tmap = (volatile LAS unsigned char*)MISC - (MISC_OFF - TMAP_OFF); for (int k = 0; k < nt; ++k) tmap[incl - nt + k] = (unsigned char)lane; }
    }
    __syncthreads();
}

__device__ __forceinline__ void stagger(int span_ticks) {
    const unsigned long long t0 = __builtin_amdgcn_s_memrealtime(); const unsigned long long d = (unsigned long long)((((int)blockIdx.x >> 3) & 31) * span_ticks) >> 5;
    while (__builtin_amdgcn_s_memrealtime() - t0 < d) __builtin_amdgcn_s_sleep(8);
}
__global__ void __launch_bounds__(512, 2) fwd_kernel(Args args) {
    extern __shared__ __attribute__((aligned(16))) unsigned char lds_raw[];
    LAS unsigned char* lds = (LAS unsigned char*)lds_raw;
    volatile LAS unsigned* MISC = (volatile LAS unsigned*)(lds + MISC_OFF);
    const int tid = threadIdx.x, G = gridDim.x;
    unsigned char* const ws0 = args.ws;
    unsigned* ctl = (unsigned*)(ws0 + WS_CTL);
    for (int u = tid; u < 256; u += 512) MISC[u] = 0u;
    __syncthreads();
    const int lo = args.ph_lo, hi = args.ph_hi;
    XcdBarrier bar; bar.bar = ctl + CW_BAR; bar.x = 0; bar.st = MISC;
    if (hi - lo > 1) bar = xcd_barrier_post(ctl + CW_BAR, MISC);
#ifndef PH_MASK
#define PH_MASK 0x3ff
#endif
#define IN(k) (lo <= (k) && (k) < hi)
#define PON(p) (((PH_MASK) >> (p)) & 1)
#define SEAM(k) do { if (IN((k) + 1)) { XcdBarrier b2_ = bar; b2_.bar = opaque_p(bar.bar); { unsigned x_ = bar.x; asm volatile("" : "+s"(x_)); b2_.x = x_; } xcd_barrier(b2_); } } while (0)
#ifndef DUP_MASK
#define DUP_MASK 0
#endif
#define REP(p) _Pragma("unroll 1") for (int rep_ = 0; rep_ < ((((DUP_MASK) >> (p)) & 1) ? opaque_v(2) : 1); ++rep_)
#define WSP(T_, off) ((T_*)(ws + (off)))
#define PRM(off) ((const float*)(ws + WS_PRM) + (off))

    if (PON(9) && IN(0)) { REP(9) p0_prologue(args, lds, G); SEAM(0); }

#pragma unroll 1
    for (int l = 0; l < DEPTH; ++l) {
        const int pb = 1 + l * NPH;
        if (PON(0) && IN(pb + 0)) { unsigned char* ws = opaque_p(ws0); unsigned* ctl = (unsigned*)(ws + WS_CTL); (void)ctl; const int Gp = opaque_s(G), cp = opaque_s((int)blockIdx.x); (void)Gp; (void)cp;
            pg8::DenseSched S{WSP(const bf16_t, WS_XB), WSP(const bf16_t, WS_WIN) + (size_t)l * DIN * D, D, T / 256, DIN / 256, Gp, cp};
            pg8::EpiIn E{PRM(PR_BIN) + (size_t)l * DIN, WSP(bf16_t, WS_U), WSP(bf16_t, WS_V), WSP(bf16_t, WS_QKV), WSP(bf16_t, WS_GA), WSP(bf16_t, WS_GB), WSP(f32x2, WS_PS)};
#ifdef STAG_P1
            stagger(STAG_P1);
#endif
            REP(0) pg8::gemm_phase<pg8::EpiIn, pg8::DenseSched, true>(lds, S, E);
            SEAM(pb + 0);
        }
        if (PON(1) && IN(pb + 1)) { unsigned char* ws = opaque_p(ws0); unsigned* ctl = (unsigned*)(ws + WS_CTL); (void)ctl; const int Gp = opaque_s(G), cp = opaque_s((int)blockIdx.x); (void)Gp; (void)cp;
            const int vcu = (Gp % 8 == 0) ? (cp % 8) * (Gp / 8) + cp / 8 : cp;
            { constexpr int NU = 12 * 3 * 4 * 32, NS = 768;
                const int na = (NU - vcu + Gp - 1) / Gp;
                const int ka = (na * ((vcu >> 3) % 7)) / 6;
                const int usplit = vcu + (ka < na ? ka : na) * Gp;
                { u32x4 kr[8], vr[8];
                  _Pragma("unroll") for (int j = 0; j < 8; ++j) { kr[j] = (u32x4){0u, 0u, 0u, 0u}; vr[j] = (u32x4){0u, 0u, 0u, 0u}; }
                  if (vcu < usplit) attn_load(WSP(const bf16_t, WS_QKV), vcu, opaque_v(threadIdx.x), kr, vr);
                  for (int u = vcu; u < usplit; u += Gp) attn_unit(lds, WSP(const bf16_t, WS_QKV), WSP(bf16_t, WS_OG), WSP(float, WS_LSE), u, (u + Gp < usplit) ? u + Gp : -1, kr, vr); }
                for (int u = vcu; u < NS; u += Gp)
                    sg_unit(lds, WSP(const bf16_t, WS_U), WSP(const bf16_t, WS_V), WSP(bf16_t, WS_AOUT), WSP(const bf16_t, WS_WS) + (size_t)l * 8 * 128 * 128, PRM(PR_BS) + (size_t)l * 1024, PRM(PR_LNVG) + (size_t)l * 1024, PRM(PR_LNVB) + (size_t)l * 1024, WSP(const f32x2, WS_PS), u);
                { u32x4 kr[8], vr[8];
                  _Pragma("unroll") for (int j = 0; j < 8; ++j) { kr[j] = (u32x4){0u, 0u, 0u, 0u}; vr[j] = (u32x4){0u, 0u, 0u, 0u}; }
                  if (usplit < NU) attn_load(WSP(const bf16_t, WS_QKV), usplit, opaque_v(threadIdx.x), kr, vr);
                  for (int u = usplit; u < NU; u += Gp) attn_unit(lds, WSP(const bf16_t, WS_QKV), WSP(bf16_t, WS_OG), WSP(float, WS_LSE), u, (u + Gp < NU) ? u + Gp : -1, kr, vr); }
            }
            SEAM(pb + 1);
        }
        if (PON(2) && IN(pb + 2)) { unsigned char* ws = opaque_p(ws0); unsigned* ctl = (unsigned*)(ws + WS_CTL); (void)ctl; const int Gp = opaque_s(G), cp = opaque_s((int)blockIdx.x); (void)Gp; (void)cp; REP(2) merge_phase(WSP(const bf16_t, WS_OG), WSP(const float, WS_LSE), WSP(bf16_t, WS_BOUT), Gp); SEAM(pb + 2); }
        if (PON(3) && IN(pb + 3)) { unsigned char* ws = opaque_p(ws0); unsigned* ctl = (unsigned*)(ws + WS_CTL); (void)ctl; const int Gp = opaque_s(G), cp = opaque_s((int)blockIdx.x); (void)Gp; (void)cp;
            pg8::Dense2Sched S{WSP(const bf16_t, WS_AOUT), WSP(const bf16_t, WS_WPA) + (size_t)l * D * D, D, WSP(const bf16_t, WS_BOUT), WSP(const bf16_t, WS_WPB) + (size_t)l * D * 512, 512, T / 256, D / 256, Gp, cp};
            pg8::EpiMg2 E{WSP(const bf16_t, WS_GA), WSP(const bf16_t, WS_GB), WSP(bf16_t, WS_MG)};
            REP(3) pg8::gemm_phase2<pg8::EpiMg2>(lds, S, E);
            SEAM(pb + 3);
        }
        if (PON(4) && IN(pb + 4)) { unsigned char* ws = opaque_p(ws0); unsigned* ctl = (unsigned*)(ws + WS_CTL); (void)ctl; const int Gp = opaque_s(G), cp = opaque_s((int)blockIdx.x); (void)Gp; (void)cp;
            pg8::DenseSched S{WSP(const bf16_t, WS_MG), WSP(const bf16_t, WS_WO) + (size_t)l * D * D, D, T / 256, D / 256, Gp, cp};
            pg8::EpiWo E{args.in[I_XP], args.in[I_XS] - (size_t)TP * D, l == 0 ? (const bf16_t*)nullptr : WSP(const bf16_t, WS_XB), WSP(y1_t, WS_XF)};
            pg8::gemm_phase<pg8::EpiWo, pg8::DenseSched, true>(lds, S, E);
            SEAM(pb + 4);
        }
        if (PON(5) && IN(pb + 5)) { unsigned char* ws = opaque_p(ws0); unsigned* ctl = (unsigned*)(ws + WS_CTL); (void)ctl; const int Gp = opaque_s(G), cp = opaque_s((int)blockIdx.x); (void)Gp; (void)cp;
            if (((DUP_MASK) >> 5) & 1) ln1_router_phase(lds, MISC, WSP(f32x2, WS_RS), WSP(const y1_t, WS_XF), WSP(y1_t, WS_T1), WSP(bf16_t, WS_U), PRM(PR_LN1G) + (size_t)l * D, PRM(PR_LN1B) + (size_t)l * D, WSP(const bf16_t, WS_WRI) + (size_t)l * 65536, PRM(PR_BR) + (size_t)l * NE,
                             ctl + CW_CNT + 1024 + l * 64, WSP(int, WS_OG), WSP(int, WS_LSE), WSP(int, WS_BOUT), WSP(float, WS_AOUT), Gp);
            ln1_router_phase(lds, MISC, WSP(f32x2, WS_RS), WSP(const y1_t, WS_XF), WSP(y1_t, WS_XF), WSP(bf16_t, WS_XB), PRM(PR_LN1G) + (size_t)l * D, PRM(PR_LN1B) + (size_t)l * D, WSP(const bf16_t, WS_WRI) + (size_t)l * 65536, PRM(PR_BR) + (size_t)l * NE,
                             ctl + CW_CNT + l * 64, WSP(int, WS_TOKLIST), WSP(int, WS_TOKE), WSP(int, WS_TOKPOS), WSP(float, WS_GATE), Gp);
            SEAM(pb + 5);
        }
        if (PON(6) && IN(pb + 6)) { unsigned char* ws = opaque_p(ws0); unsigned* ctl = (unsigned*)(ws + WS_CTL); (void)ctl; const int Gp = opaque_s(G), cp = opaque_s((int)blockIdx.x); (void)Gp; (void)cp;
            moe_tables(MISC, ctl + CW_CNT + l * 64);
            pg8::MoeSched<true> S{WSP(const bf16_t, WS_XB), WSP(const bf16_t, WS_WGU) + (size_t)l * NE * 2048 * D, D, 8, Gp, cp, (size_t)2048 * D * 2, (const LAS int*)(lds + MISC_OFF + 64), (const LAS int*)(lds + MISC_OFF + 256), WSP(const int, WS_TOKLIST)};
            pg8::EpiGU E{PRM(PR_BGU) + (size_t)l * NE * 2048, WSP(bf16_t, WS_H)};
            REP(6) pg8::gemm_phase<pg8::EpiGU, pg8::MoeSched<true>, true>(lds, S, E);
            SEAM(pb + 6);
        }
        if (PON(7) && IN(pb + 7)) { unsigned char* ws = opaque_p(ws0); unsigned* ctl = (unsigned*)(ws + WS_CTL); (void)ctl; const int Gp = opaque_s(G), cp = opaque_s((int)blockIdx.x); (void)Gp; (void)cp;
            moe_tables(MISC, ctl + CW_CNT + l * 64);
            pg8::MoeSched<false> S{WSP(const bf16_t, WS_H), WSP(const bf16_t, WS_WD) + (size_t)l * NE * D * D, D, 4, Gp, cp, (size_t)D * D * 2, (const LAS int*)(lds + MISC_OFF + 64), (const LAS int*)(lds + MISC_OFF + 256), nullptr};
            pg8::EpiDown E{PRM(PR_BD) + (size_t)l * NE * D, WSP(bf16_t, WS_YK)};
            REP(7) pg8::gemm_phase<pg8::EpiDown, pg8::MoeSched<false>, true>(lds, S, E);
            SEAM(pb + 7);
        }
        if (PON(8) && IN(pb + 8)) { unsigned char* ws = opaque_p(ws0); unsigned* ctl = (unsigned*)(ws + WS_CTL); (void)ctl; const int Gp = opaque_s(G), cp = opaque_s((int)blockIdx.x); (void)Gp; (void)cp;
            moe_tables(MISC, ctl + CW_CNT + l * 64);
            combine_ln2_phase(MISC, WSP(const f32x2, WS_RS), PRM(PR_LN1G) + (size_t)l * D, PRM(PR_LN1B) + (size_t)l * D, WSP(const y1_t, WS_XF), WSP(const bf16_t, WS_YK), WSP(const int, WS_TOKE), WSP(const int, WS_TOKPOS), WSP(const float, WS_GATE), PRM(PR_LN2G) + (size_t)l * D, PRM(PR_LN2B) + (size_t)l * D,
                              l == DEPTH - 1 ? args.out : (float*)nullptr, WSP(bf16_t, WS_XB), Gp);
            SEAM(pb + 8);
        }
    }
#undef IN
#undef SEAM
}

extern "C" void kernel_launch(void* const* d_in, const int* in_sizes, int n_in, void* d_out, int out_size, void* d_ws, size_t ws_size, hipStream_t stream) {
    static int grid = 0;
    if (grid == 0) {
        if (n_in != 21 || out_size != T * D || ws_size < WS_END) { fprintf(stderr, "kernel_launch: unexpected shapes (n_in %d, out %d, ws %zu < %zu)\n", n_in, out_size, ws_size, (size_t)WS_END); grid = -1; return; }
        int dev = 0, cus = 0, per_cu = 0;
        if (hipGetDevice(&dev) != hipSuccess || hipDeviceGetAttribute(&cus, hipDeviceAttributeMultiprocessorCount, dev) != hipSuccess) { grid = -1; return; }
        if (hipFuncSetAttribute((const void*)fwd_kernel, hipFuncAttributeMaxDynamicSharedMemorySize, LDS_BYTES) != hipSuccess) { fprintf(stderr, "kernel_launch: hipFuncSetAttribute failed\n"); grid = -1; return; }
        if (hipOccupancyMaxActiveBlocksPerMultiprocessor(&per_cu, (const void*)fwd_kernel, 512, LDS_BYTES) != hipSuccess || per_cu < 1) fprintf(stderr, "kernel_launch: occupancy query says %d\n", per_cu);
        (void)hipGetLastError();
        grid = cus;
    }
    if (grid < 0) return;
    (void)hipMemsetAsync((char*)d_ws + WS_CTL, 0, CTL_BYTES, stream);
    Args a{};
    for (int i = 0; i < 21; ++i) a.in[i] = (const float*)d_in[i];
    a.out = (float*)d_out; a.ws = (unsigned char*)d_ws;
#if MK_SPLIT
    for (int p = 0; p < NPHASE; ++p) { a.ph_lo = p; a.ph_hi = p + 1; hipLaunchKernelGGL(fwd_kernel, dim3(grid), dim3(512), LDS_BYTES, stream, a); }
#else
    a.ph_lo = 0; a.ph_hi = NPHASE;
    hipLaunchKernelGGL(fwd_kernel, dim3(grid), dim3(512), LDS_BYTES, stream, a);
#ifdef PROBE_PHASE
    for (int r = 0; r < PROBE_REPS; ++r) { a.ph_lo = 1 + 2 * NPH + PROBE_PHASE; a.ph_hi = a.ph_lo + 1;
#ifdef PROBE_SUB
        a.sub = PROBE_SUB;
#endif
 hipLaunchKernelGGL(fwd_kernel, dim3(grid), dim3(512), LDS_BYTES, stream, a); }
#endif
#endif
}
```

```cpp
#include <hip/hip_runtime.h>
#include <cstdio>
#include <cstdint>

#ifndef Y1_BF16
#define Y1_BF16 1
#endif
#ifndef MK_SPLIT
#define MK_SPLIT 0
#endif

#define LAS __attribute__((address_space(3)))
#define GAS __attribute__((address_space(1)))
typedef unsigned short bf16_t;
typedef short bf16x8 __attribute__((ext_vector_type(8)));
typedef short s16x4 __attribute__((ext_vector_type(4)));
typedef float f32x4 __attribute__((ext_vector_type(4)));
typedef float f32x2 __attribute__((ext_vector_type(2)));
typedef unsigned u32x4 __attribute__((ext_vector_type(4)));
typedef unsigned u32x2 __attribute__((ext_vector_type(2)));

constexpr int D = 1024, T = 49152, TP = 32768, SEQ = 4096, DEPTH = 4, DIN = 8704, NE = 32, TOPK = 4, QKVW = 4608;
constexpr int NSLOT = T * TOPK + NE * 256;
constexpr float DN_ALPHA = 1.6817928305074290f;
constexpr float LN_EPS = 1e-5f;
constexpr float LOG2E = 1.4426950408889634f, LN2 = 0.6931471805599453f;
constexpr int NPH = 9, NPHASE = 1 + DEPTH * NPH;

constexpr size_t MiB = 1u << 20;
constexpr size_t WS_CTL = 0, CTL_BYTES = 128 * 1024;
constexpr size_t WS_PRM = 1 * MiB;
constexpr int PR_BIN = 0, PR_LNVG = PR_BIN + DEPTH * DIN, PR_LNVB = PR_LNVG + DEPTH * D, PR_BS = PR_LNVB + DEPTH * D, PR_LN1G = PR_BS + DEPTH * D, PR_LN1B = PR_LN1G + DEPTH * D,
              PR_WR = PR_LN1B + DEPTH * D, PR_BR = PR_WR + DEPTH * D * NE, PR_BGU = PR_BR + DEPTH * NE, PR_BD = PR_BGU + DEPTH * NE * 2048, PR_LN2G = PR_BD + DEPTH * NE * D, PR_LN2B = PR_LN2G + DEPTH * D,
              PR_END = PR_LN2B + DEPTH * D;
static_assert((size_t)PR_END * 4 <= 4 * MiB, "params region");
constexpr size_t WS_WIN = 5 * MiB;
constexpr size_t WS_WPA = WS_WIN + (size_t)DEPTH * DIN * D * 2;
constexpr size_t WS_WPB = WS_WPA + (size_t)DEPTH * D * D * 2;
constexpr size_t WS_WO = WS_WPB + (size_t)DEPTH * D * 512 * 2;
constexpr size_t WS_WS = WS_WO + (size_t)DEPTH * D * D * 2;
constexpr size_t WS_WGU = WS_WS + (size_t)DEPTH * 8 * 128 * 128 * 2;
constexpr size_t WS_WD = WS_WGU + (size_t)DEPTH * NE * 2048 * D * 2;
constexpr size_t WS_XF = WS_WD + (size_t)DEPTH * NE * D * D * 2;
constexpr size_t WS_WRI = WS_XF + (size_t)T * D * 2;
constexpr size_t WS_XB = WS_XF + (size_t)T * D * 4;
constexpr size_t WS_TOKLIST = WS_XB + (size_t)T * D * 2;
constexpr size_t WS_TOKE = WS_TOKLIST + (size_t)NE * T * 4;
constexpr size_t WS_TOKPOS = WS_TOKE + (size_t)T * 4 * 4;
constexpr size_t WS_GATE = WS_TOKPOS + (size_t)T * 4 * 4;
constexpr size_t WS_PS = WS_GATE + (size_t)T * 4 * 4;
constexpr size_t WS_RS = WS_PS + (size_t)T * 16 * 8;
constexpr size_t WS_R = WS_RS + (size_t)T * 8;
constexpr size_t WS_U = WS_R;
constexpr size_t WS_V = WS_U + (size_t)T * D * 2;
constexpr size_t WS_QKV = WS_V + (size_t)T * D * 2;
constexpr size_t WS_GA = WS_QKV + (size_t)T * QKVW * 2;
constexpr size_t WS_GB = WS_GA + (size_t)T * D * 2;
constexpr size_t WS_AOUT = WS_GB + (size_t)T * D * 2;
constexpr size_t WS_OG = WS_AOUT + (size_t)T * D * 2;
constexpr size_t WS_LSE = WS_OG + (size_t)3 * T * 512 * 2;
constexpr size_t WS_BOUT = WS_LSE + (size_t)3 * T * 4 * 4;
constexpr size_t WS_T1 = WS_BOUT + (size_t)T * 512 * 2;
constexpr size_t WS_MG = WS_T1 + (size_t)T * D * 4;
constexpr size_t WS_END_A = WS_MG + (size_t)T * D * 2;
constexpr size_t WS_H = WS_R;
constexpr size_t WS_YK = WS_H + (size_t)NSLOT * D * 2;
constexpr size_t WS_END_B = WS_YK + (size_t)NSLOT * D * 2;
constexpr size_t WS_END = WS_END_A > WS_END_B ? WS_END_A : WS_END_B;
constexpr int CW_BAR = 4096;
constexpr int CW_CNT = 16384;

constexpr int LDS_BYTES = 160 * 1024;
constexpr int MISC_OFF = LDS_BYTES - 2048, IDS_OFF = MISC_OFF + 1024;
constexpr int MISC_DOC = 0;
constexpr int TMAP_OFF = MISC_OFF - 1024;
constexpr int SCR_BYTES = MISC_OFF;

#if Y1_BF16
typedef unsigned short y1_t;
#define Y1_LD4(p) ({ const u32x2 q_ = *(const u32x2*)(p); (f32x4){__builtin_bit_cast(float, q_.x << 16), __builtin_bit_cast(float, q_.x & 0xffff0000u), __builtin_bit_cast(float, q_.y << 16), __builtin_bit_cast(float, q_.y & 0xffff0000u)}; })
#else
typedef float y1_t;
#define Y1_LD4(p) (*(const f32x4*)(p))
#endif
__device__ __forceinline__ int opaque_v(int x) { asm volatile("" : "+v"(x)); return x; }
__device__ __forceinline__ int opaque_s(int x) { asm volatile("" : "+s"(x)); return x; }
template <class P> __device__ __forceinline__ P* opaque_p(P* p) { unsigned long long z = 0; asm volatile("" : "+s"(z)); return (P*)((char*)p + z); }
__device__ __forceinline__ unsigned f2bf(float f) { unsigned u = __builtin_bit_cast(unsigned, f); return (u + 0x7fffu + ((u >> 16) & 1u)) >> 16; }
__device__ __forceinline__ unsigned pk2(float lo, float hi) { return f2bf(lo) | (f2bf(hi) << 16); }
__device__ __forceinline__ unsigned cvt_pk_bf16(float lo, float hi) { unsigned r; asm volatile("v_cvt_pk_bf16_f32 %0, %1, %2" : "=v"(r) : "v"(lo), "v"(hi)); return r; }
__device__ __forceinline__ float bflo(unsigned w) { return __builtin_bit_cast(float, w << 16); }
__device__ __forceinline__ float bfhi(unsigned w) { return __builtin_bit_cast(float, w & 0xffff0000u); }
__device__ __forceinline__ float wave_sum(float v) {
#pragma unroll
    for (int o = 1; o < 64; o <<= 1) v += __shfl_xor(v, o);
    return v;
}
__device__ __forceinline__ float sigmoidf_(float x) { return __builtin_amdgcn_rcpf(1.0f + __builtin_amdgcn_exp2f(-x * LOG2E)); }
__device__ __forceinline__ f32x2 sigmoid2(f32x2 x) {
    const f32x2 a = x * (f32x2){-LOG2E, -LOG2E}; f32x2 e; e.x = __builtin_amdgcn_exp2f(a.x); e.y = __builtin_amdgcn_exp2f(a.y);
    const f32x2 d = e + (f32x2){1.0f, 1.0f}; f32x2 r; r.x = __builtin_amdgcn_rcpf(d.x); r.y = __builtin_amdgcn_rcpf(d.y); return r;
}
__device__ __forceinline__ f32x2 swiglu2(f32x2 g, f32x2 u) {
    f32x2 gc, uc; gc.x = __builtin_amdgcn_fmed3f(g.x, -3.0e38f, 7.0f); gc.y = __builtin_amdgcn_fmed3f(g.y, -3.0e38f, 7.0f); uc.x = __builtin_amdgcn_fmed3f(u.x, -7.0f, 7.0f); uc.y = __builtin_amdgcn_fmed3f(u.y, -7.0f, 7.0f);
    const f32x2 a = gc * (f32x2){-1.702f * LOG2E, -1.702f * LOG2E}; f32x2 e; e.x = __builtin_amdgcn_exp2f(a.x); e.y = __builtin_amdgcn_exp2f(a.y);
    const f32x2 d = e + (f32x2){1.0f, 1.0f}; f32x2 r; r.x = __builtin_amdgcn_rcpf(d.x); r.y = __builtin_amdgcn_rcpf(d.y);
    return (uc + (f32x2){1.0f, 1.0f}) * gc * r;
}
__device__ __forceinline__ f32x2 gelu_pk(f32x2 v) {
    f32x2 t = v * v; t.x = fminf(t.x, 16.0f); t.y = fminf(t.y, 16.0f);
    f32x2 p = t * 9.567564795975869e-11f + (-8.026423969909047e-09f);
    p = p * t + 3.002628830017784e-07f; p = p * t + (-6.72069427309907e-06f); p = p * t + 0.00010251090134261176f; p = p * t + (-0.0011512201745063066f);
    p = p * t + 0.009921522811055183f; p = p * t + (-0.06646095216274261f); p = p * t + 0.3989395201206207f;
    f32x2 vc; vc.x = __builtin_amdgcn_fmed3f(v.x, -4.0f, 4.0f); vc.y = __builtin_amdgcn_fmed3f(v.y, -4.0f, 4.0f);
    return v * (vc * p + 0.5f);
}

#define XB_TMO      128
#define XB_XCNT(j)  (256  + 64 * (j))
#define XB_XSUB(j)  (1280 + 64 * (j))
#define XB_XGEN(j)  (2304 + 64 * (j))
#define XB_TOP      3328
#define XB_TOPGEN   3392
#define XCD_BAR_WORDS 3456
#define XB_SPIN_CAP (1u << 18)
__device__ __forceinline__ unsigned xb_ld(unsigned* p)              { return __hip_atomic_load(p, __ATOMIC_RELAXED, __HIP_MEMORY_SCOPE_AGENT); }
__device__ __forceinline__ unsigned xb_add(unsigned* p, unsigned v) { return __hip_atomic_fetch_add(p, v, __ATOMIC_RELAXED, __HIP_MEMORY_SCOPE_AGENT); }
__device__ __forceinline__ unsigned xb_xcc_id() { return (unsigned)__builtin_amdgcn_s_getreg((3 << 11) | 20) & 0xFu; }
#define XB_SPIN(cond, bar) do { unsigned _sp = 0; while (cond) { __builtin_amdgcn_s_sleep(1); \
    if ((++_sp & 255u) == 0u) { if (xb_ld(&(bar)[XB_TMO])) break; if (_sp > XB_SPIN_CAP) { atomicAdd(&(bar)[XB_TMO], 1u); break; } } } } while (0)
struct XcdBarrier { unsigned* bar; unsigned x; volatile LAS unsigned* st; };
__device__ __forceinline__ XcdBarrier xcd_barrier_post(unsigned* bar, volatile LAS unsigned* st) {
    XcdBarrier b; b.bar = bar; b.x = xb_xcc_id(); b.st = st;
    if (threadIdx.x == 0) (void)xb_add(&bar[XB_XCNT(b.x)], 1u);
    return b;
}
__device__ __forceinline__ void xcd_barrier_complete(unsigned* bar, unsigned x, unsigned& nloc, unsigned& nx) {
    const unsigned G = gridDim.x * gridDim.y * gridDim.z;
    unsigned sum, cnt, mine, sp = 0u;
    for (;;) {
        sum = 0u; cnt = 0u; mine = 0u;
#pragma unroll
        for (unsigned j = 0; j < 16; ++j) { const unsigned c = xb_ld(&bar[XB_XCNT(j)]); sum += c; cnt += (c > 0u) ? 1u : 0u; mine = (j == x) ? c : mine; }
        if (sum == G) break;
        __builtin_amdgcn_s_sleep(1);
        if ((++sp & 255u) == 0u) { if (xb_ld(&bar[XB_TMO])) break; if (sp > XB_SPIN_CAP) { atomicAdd(&bar[XB_TMO], 1u); break; } }
    }
    nloc = mine > 0u ? mine : 1u; nx = cnt > 0u ? cnt : 1u;
}
__device__ __forceinline__ void xcd_barrier(const XcdBarrier& b) {
    asm volatile("s_waitcnt vmcnt(0)" ::: "memory");
    __syncthreads();
    if (threadIdx.x == 0) {
        unsigned* bar = b.bar;
        __builtin_amdgcn_s_waitcnt(0);
        unsigned nloc = b.st[0], nx = b.st[1];
        if (nloc == 0u) { xcd_barrier_complete(bar, b.x, nloc, nx); b.st[0] = nloc; b.st[1] = nx; }
        const unsigned old = xb_add(&bar[XB_XSUB(b.x)], 1u);
        const unsigned gen = old / nloc;
        if (old + 1u == (gen + 1u) * nloc) {
            __builtin_amdgcn_fence(__ATOMIC_RELEASE, "agent");
            asm volatile("s_waitcnt vmcnt(0)" ::: "memory");
            const unsigned og = xb_add(&bar[XB_TOP], 1u);
            const unsigned tg = og / nx;
            if (og + 1u == (tg + 1u) * nx) xb_add(&bar[XB_TOPGEN], 1u);
            else XB_SPIN(xb_ld(&bar[XB_TOPGEN]) == tg, bar);
            __builtin_amdgcn_fence(__ATOMIC_ACQUIRE, "agent");
            xb_add(&bar[XB_XGEN(b.x)], 1u);
            asm volatile("s_waitcnt vmcnt(0)" ::: "memory");
        } else {
            XB_SPIN(xb_ld(&bar[XB_XGEN(b.x)]) == gen, bar);
            __builtin_amdgcn_fence(__ATOMIC_ACQUIRE, "agent");
            asm volatile("s_waitcnt vmcnt(0)" ::: "memory");
        }
    }
    __syncthreads();
}

#ifndef EPI_NT
#define EPI_NT 1
#endif
#if EPI_NT
#define EPI_ST(T_, p, v) __builtin_nontemporal_store((T_)(v), (T_*)(p))
#else
#define EPI_ST(T_, p, v) (*(T_*)(p) = (v))
#endif
namespace pg8 {
constexpr int BM = 256, BK = 64, HALF = 128, HTB = HALF * BK * 2, STAGE_BYTES = 8 * HTB, NXCD = 8, WGM = 4;
__host__ __device__ __forceinline__ int lds_byte(int r, int c) { const int st = (r >> 4) * 2 + (c >> 5), rr = r & 15, cc = c & 31, ob = rr * 64 + cc * 2; return st * 1024 + (ob ^ (((ob >> 9) & 1) << 5)); }
__host__ __device__ __forceinline__ void stage_rc(int b, int& R, int& C) { const int st = b / 1024, sb = b % 1024, swz = sb ^ (((sb >> 9) & 1) << 5); R = (st >> 1) * 16 + swz / 64; C = (st & 1) * 32 + (swz % 64) / 2; }
__host__ __device__ __forceinline__ int perm32(int rho) { const int n = rho >> 4, i = rho & 15; return 8 * (i >> 2) + 4 * n + (i & 3); }

struct Unit { int pm, pn, e, r0; };

__device__ __forceinline__ bool static_order(int i, int G, int c, int nM, int nN, int& pm, int& pn) {
    const int nwg = nM * nN; const long L = (long)i * G + c; if (L >= nwg) return false;
    int wgid = (int)L; { const int q = nwg / NXCD, r = nwg % NXCD, xcd = wgid % NXCD, off = wgid / NXCD; wgid = (xcd < r ? xcd * (q + 1) : r * (q + 1) + (xcd - r) * q) + off; }
    const int nig = WGM * nN, gid = wgid / nig, fm = gid * WGM, gsz = (nM - fm) < WGM ? (nM - fm) : WGM;
    const int wi = wgid % nig;
    if (gsz == WGM) { pm = fm + (wi % WGM); pn = wi / WGM; } else { pm = fm + (wi % gsz); pn = wi / gsz; }
    return true;
}
struct DenseSched {
    static constexpr bool GATHER = false;
    const bf16_t* A; const bf16_t* Bt; int K, nM, nN, G, c;
    __device__ __forceinline__ bool next(int i, Unit& u) const { u.e = 0; u.r0 = 0; return static_order(i, G, c, nM, nN, u.pm, u.pn); }
    __device__ __forceinline__ const char* a_base(const Unit& u) const { return (const char*)A + (size_t)u.pm * BM * K * 2; }
    __device__ __forceinline__ const char* b_base(const Unit& u) const { return (const char*)Bt + (size_t)u.pn * BM * K * 2; }
    __device__ __forceinline__ void a_offs(const Unit& u, const int (&R)[2], const int (&C)[2], unsigned (&o)[2][2]) const {
#pragma unroll
        for (int h = 0; h < 2; ++h)
#pragma unroll
            for (int i = 0; i < 2; ++i) o[h][i] = (unsigned)((u.pm * BM + h * HALF + R[i]) * K + C[i]) * 2u;
    }
    __device__ __forceinline__ int load_id(const Unit&, int) const { return 0; }
    __device__ __forceinline__ void a_offs_lds(const LAS int*, const int (&)[2], const int (&)[2], unsigned (&)[2][2]) const {}
};
template <bool GATHER_> struct MoeSched {
    static constexpr bool GATHER = GATHER_;
    const bf16_t* A; const bf16_t* Bt; int K, nN, G, c; size_t bstride;
    const LAS int* tb; const LAS int* cnt; const int* tokList;
    __device__ __forceinline__ bool next(int i, Unit& u) const {
        const int nM = tb[NE];
        if (!static_order(i, G, c, nM, nN, u.pm, u.pn)) return false;
        const int e = ((const LAS unsigned char*)tb)[TMAP_OFF - (MISC_OFF + 64) + u.pm];
        u.e = e; u.r0 = (u.pm - tb[e]) * BM; return true;
    }
    __device__ __forceinline__ const char* a_base(const Unit& u) const { return GATHER ? (const char*)A : (const char*)A + (size_t)u.pm * BM * K * 2; }
    __device__ __forceinline__ const char* b_base(const Unit& u) const { return (const char*)Bt + (size_t)u.e * bstride + (size_t)u.pn * BM * K * 2; }
    __device__ __forceinline__ int load_id(const Unit& u, int i) const { const int r = u.r0 + i; return (r < cnt[u.e]) ? tokList[(size_t)u.e * T + r] : 0; }
    __device__ __forceinline__ void a_offs(const Unit& u, const int (&R)[2], const int (&C)[2], unsigned (&o)[2][2]) const {
#pragma unroll
        for (int h = 0; h < 2; ++h)
#pragma unroll
            for (int i = 0; i < 2; ++i) o[h][i] = (unsigned)(load_id(u, h * HALF + R[i]) * K + C[i]) * 2u;
    }
    __device__ __forceinline__ void a_offs_lds(const LAS int* ids, const int (&R)[2], const int (&C)[2], unsigned (&o)[2][2]) const {
#pragma unroll
        for (int h = 0; h < 2; ++h)
#pragma unroll
            for (int i = 0; i < 2; ++i) o[h][i] = (unsigned)(ids[h * HALF + R[i]] * K + C[i]) * 2u;
    }
};


template <class Epi, class Sched, bool ALIGN_EPI>
__device__ __forceinline__ void gemm_phase(LAS unsigned char* lds, const Sched& S, const Epi& E) {
    constexpr bool GATHER = Sched::GATHER;
    const int tid = opaque_v(threadIdx.x), wid = __builtin_amdgcn_readfirstlane(tid >> 6), lane = tid & 63, wr = wid >> 2, wc = wid & 3, fr = lane & 15, fq = lane >> 4;
    const int K = S.K, nt = K / BK;
    int R[2], C[2]; unsigned voffA[2], voffB[2];
#pragma unroll
    for (int i = 0; i < 2; ++i) { stage_rc(tid * 16 + i * 8192, R[i], C[i]); const int Rb = 64 * (R[i] >> 5) + (Epi::PERM ? perm32(R[i] & 31) : (R[i] & 31));
        voffA[i] = (unsigned)(R[i] * K + C[i]) * 2u; voffB[i] = (unsigned)(Rb * K + C[i]) * 2u; }
    const size_t kstep = (size_t)(BK * 2);
    const size_t hstep = (size_t)HALF * K * 2;
    const size_t bhstep = (size_t)32 * K * 2;
    const unsigned ldsw = (unsigned)wid * 1024u;
    const int aoff = lds_byte(wr * 64 + fr, fq * 8), boff = lds_byte(wc * 32 + fr, fq * 8);
#define PG8_SA(b, h) (((b) * 2 + (h)) * HTB)
#define PG8_SB(b, h) ((4 + (b) * 2 + (h)) * HTB)
#define PG8_STAGE(bufoff, gbase, voff) do { _Pragma("unroll") for (int _i = 0; _i < 2; ++_i) \
        __builtin_amdgcn_global_load_lds((const unsigned*)((const char*)(gbase) + (voff)[_i]), (LAS unsigned*)(lds + (bufoff) + ldsw + _i * 8192), 16, 0, 0); } while (0)
#define PG8_STAGE_A(bufoff, ab, ao, h, kb) do { if constexpr (GATHER) { PG8_STAGE(bufoff, (ab) + (kb), (ao)[h]); } else { PG8_STAGE(bufoff, (ab) + (kb) + (h) * hstep, voffA); } } while (0)
#define PG8_LDA(dst, b, h) do { _Pragma("unroll") for (int m = 0; m < 4; ++m) _Pragma("unroll") for (int k = 0; k < 2; ++k) dst[m][k] = *(const LAS bf16x8*)(lds + PG8_SA(b, h) + aoff + m * 2048 + k * 1024); } while (0)
#define PG8_LDB(dst, b, h) do { _Pragma("unroll") for (int n = 0; n < 2; ++n) _Pragma("unroll") for (int k = 0; k < 2; ++k) dst[n][k] = *(const LAS bf16x8*)(lds + PG8_SB(b, h) + boff + n * 2048 + k * 1024); } while (0)
#define PG8_MMA(ai, bj, At, Bt) do { __builtin_amdgcn_s_setprio(1); _Pragma("unroll") for (int m = 0; m < 4; ++m) _Pragma("unroll") for (int n = 0; n < 2; ++n) _Pragma("unroll") for (int k = 0; k < 2; ++k) \
        acc[ai][bj][m][n] = __builtin_amdgcn_mfma_f32_16x16x32_bf16(Bt[n][k], At[m][k], acc[ai][bj][m][n], 0, 0, 0); __builtin_amdgcn_s_setprio(0); } while (0)
#define PG8_WAIT_V(n) asm volatile("s_waitcnt vmcnt(" #n ")" ::: "memory")
#define PG8_WAIT_L(n) asm volatile("s_waitcnt lgkmcnt(" #n ")" ::: "memory")
#define PG8_BAR __builtin_amdgcn_s_barrier()
#define PG8_SCHED __builtin_amdgcn_sched_barrier(0)
    Unit cur, nxt; int ui = 0;
    if (!S.next(0, cur)) return;
    f32x4 acc[2][2][4][2];
    { f32x4 bv[2][2]; E.binit(cur, wc, fq, bv);
#pragma unroll
    for (int a = 0; a < 2; ++a)
#pragma unroll
        for (int b = 0; b < 2; ++b)
#pragma unroll
            for (int m = 0; m < 4; ++m)
#pragma unroll
                for (int n = 0; n < 2; ++n) { acc[a][b][m][n] = bv[b][n]; asm volatile("" : "+v"(acc[a][b][m][n])); } }
    bf16x8 At[4][2], B0[2][2], B1[2][2];
    unsigned ca[2][2];
    LAS int* ids = (LAS int*)(lds + IDS_OFF);
    if constexpr (GATHER) { S.a_offs(cur, R, C, ca); Unit n1; if (S.next(1, n1) && tid < 256) ids[tid] = S.load_id(n1, tid); }
    const char* cA = S.a_base(cur);
    const char* cB = S.b_base(cur);
    PG8_STAGE(PG8_SB(0, 0), cB, voffB); PG8_STAGE(PG8_SB(0, 1), cB + bhstep, voffB); PG8_STAGE_A(PG8_SA(0, 0), cA, ca, 0, 0); PG8_STAGE_A(PG8_SA(0, 1), cA, ca, 1, 0);
    if (wr == 1) PG8_BAR;
    PG8_WAIT_V(2); PG8_BAR;
    PG8_STAGE(PG8_SB(1, 0), cB + kstep, voffB); PG8_STAGE_A(PG8_SA(1, 0), cA, ca, 0, kstep); PG8_STAGE(PG8_SB(1, 1), cB + bhstep + kstep, voffB);
    PG8_WAIT_V(6); PG8_BAR;
    for (;;) {
        const bool has_next = S.next(ui + 1, nxt);
        const char* nA = has_next ? S.a_base(nxt) : cA; const char* nB = has_next ? S.b_base(nxt) : cB;
#define PG8_TRIP(RELAX) do { \
            const bool last = (t == nt - 2); \
            const size_t k1 = (size_t)(t + 1) * kstep; \
            const size_t k2 = last ? 0 : (size_t)(t + 2) * kstep, k3 = k2 + kstep; \
            const char* a2 = last ? nA : cA; const char* b2 = (last ? nB : cB) + k2; const char* b3 = b2 + kstep; \
            PG8_LDB(B0, 0, 0); PG8_LDB(B1, 0, 1); PG8_SCHED; PG8_LDA(At, 0, 0); PG8_STAGE_A(PG8_SA(1, 1), cA, ca, 1, k1); \
            if (!(RELAX)) PG8_WAIT_V(8); PG8_WAIT_L(0); PG8_BAR; PG8_MMA(0, 0, At, B0); PG8_MMA(0, 1, At, B1); PG8_BAR; PG8_SCHED; \
            if constexpr (GATHER) { if (last && has_next) { int R2[2], C2[2]; const int t2 = opaque_v(tid); stage_rc(t2 * 16, R2[0], C2[0]); stage_rc(t2 * 16 + 8192, R2[1], C2[1]); S.a_offs_lds(ids, R2, C2, ca); } } \
            PG8_LDA(At, 0, 1); PG8_STAGE(PG8_SB(0, 0), b2, voffB); PG8_STAGE(PG8_SB(0, 1), b2 + bhstep, voffB); PG8_STAGE_A(PG8_SA(0, 0), a2, ca, 0, k2); \
            if (!(RELAX)) PG8_WAIT_V(8); PG8_WAIT_L(0); PG8_BAR; PG8_MMA(1, 0, At, B0); PG8_MMA(1, 1, At, B1); PG8_BAR; PG8_SCHED; \
            PG8_LDB(B0, 1, 0); PG8_LDB(B1, 1, 1); PG8_SCHED; PG8_LDA(At, 1, 0); PG8_STAGE_A(PG8_SA(0, 1), a2, ca, 1, k2); \
            PG8_WAIT_V(8); PG8_WAIT_L(0); PG8_BAR; PG8_MMA(0, 0, At, B0); PG8_MMA(0, 1, At, B1); PG8_BAR; PG8_SCHED; \
            PG8_LDA(At, 1, 1); PG8_STAGE(PG8_SB(1, 0), b3, voffB); PG8_STAGE(PG8_SB(1, 1), b3 + bhstep, voffB); PG8_STAGE_A(PG8_SA(1, 0), a2, ca, 0, k3); \
            PG8_WAIT_V(8); PG8_WAIT_L(0); PG8_BAR; PG8_MMA(1, 0, At, B0); PG8_MMA(1, 1, At, B1); PG8_BAR; PG8_SCHED; \
        } while (0)
        int t = 0;
#ifndef NO_RELAX
        if (ui > 0) { PG8_TRIP(true); t = 2; }
#endif
        for (; t < nt; t += 2) PG8_TRIP(false);
#undef PG8_TRIP
        if constexpr (ALIGN_EPI) { if (wr == 0) PG8_BAR; }
        int idv = 0; bool fill = false;
        if constexpr (GATHER) { Unit n2; fill = S.next(ui + 2, n2) && tid < 256; if (fill) idv = S.load_id(n2, tid); }
        f32x4 bvn[2][2];
        if (has_next) E.binit(nxt, wc, fq, bvn);
        E(lds, acc, cur, wr, wc, fr, fq);
        if constexpr (GATHER) { if (fill) ids[tid] = idv; }
        if (!has_next) break;
#pragma unroll
        for (int a = 0; a < 2; ++a)
#pragma unroll
            for (int b = 0; b < 2; ++b)
#pragma unroll
                for (int m = 0; m < 4; ++m)
#pragma unroll
                    for (int n = 0; n < 2; ++n) { acc[a][b][m][n] = bvn[b][n]; asm volatile("" : "+v"(acc[a][b][m][n])); }
        cur = nxt; cA = nA; cB = nB; ++ui;
        if constexpr (ALIGN_EPI) { if (wr == 1) PG8_BAR; }
    }
    PG8_WAIT_V(0);
    if constexpr (!ALIGN_EPI) { if (wr == 0) PG8_BAR; }
    PG8_BAR;
#undef PG8_SA
#undef PG8_SB
#undef PG8_STAGE
#undef PG8_STAGE_A
#undef PG8_LDA
#undef PG8_LDB
#undef PG8_MMA
#undef PG8_WAIT_V
#undef PG8_WAIT_L
#undef PG8_BAR
#undef PG8_SCHED
}

struct Dense2Sched {
    const bf16_t* A1; const bf16_t* B1; int K1; const bf16_t* A2; const bf16_t* B2; int K2; int nM, nN, G, c;
    __device__ __forceinline__ bool next(int i, Unit& u) const { u.e = 0; u.r0 = 0; return static_order(i, G, c, nM, nN, u.pm, u.pn); }
};
template <class Epi>
__device__ __forceinline__ void gemm_phase2(LAS unsigned char* lds, const Dense2Sched& S, const Epi& E) {
    const int tid = opaque_v(threadIdx.x), wid = __builtin_amdgcn_readfirstlane(tid >> 6), lane = tid & 63, wr = wid >> 2, wc = wid & 3, fr = lane & 15, fq = lane >> 4;
    const int K1 = S.K1, K2 = S.K2, nt1 = K1 / BK, nt = nt1 + K2 / BK;
    unsigned vRA[2], vRB[2], vC[2];
#pragma unroll
    for (int i = 0; i < 2; ++i) { int R, C; stage_rc(tid * 16 + i * 8192, R, C); const int Rb = 64 * (R >> 5) + (Epi::PERM ? perm32(R & 31) : (R & 31)); vRA[i] = (unsigned)R * 2u; vRB[i] = (unsigned)Rb * 2u; vC[i] = (unsigned)C * 2u; }
#define PG8_VOFF(dst, vR, Kx) unsigned dst[2]; _Pragma("unroll") for (int i_ = 0; i_ < 2; ++i_) dst[i_] = (vR)[i_] * (unsigned)(Kx) + (unsigned)opaque_v((int)vC[i_])
    const size_t kstep = (size_t)(BK * 2);
    const size_t hstep1 = (size_t)HALF * K1 * 2, bhstep1 = (size_t)32 * K1 * 2, hstep2 = (size_t)HALF * K2 * 2, bhstep2 = (size_t)32 * K2 * 2;
    const unsigned ldsw = (unsigned)wid * 1024u;
    const int aoff = lds_byte(wr * 64 + fr, fq * 8), boff = lds_byte(wc * 32 + fr, fq * 8);
#define PG8_SA(b, h) (((b) * 2 + (h)) * HTB)
#define PG8_SB(b, h) ((4 + (b) * 2 + (h)) * HTB)
#define PG8_STAGE(bufoff, gbase, voff) do { _Pragma("unroll") for (int _i = 0; _i < 2; ++_i) \
        __builtin_amdgcn_global_load_lds((const unsigned*)((const char*)(gbase) + (voff)[_i]), (LAS unsigned*)(lds + (bufoff) + ldsw + _i * 8192), 16, 0, 0); } while (0)
#define PG8_LDA(dst, b, h) do { _Pragma("unroll") for (int m = 0; m < 4; ++m) _Pragma("unroll") for (int k = 0; k < 2; ++k) dst[m][k] = *(const LAS bf16x8*)(lds + PG8_SA(b, h) + aoff + m * 2048 + k * 1024); } while (0)
#define PG8_LDB(dst, b, h) do { _Pragma("unroll") for (int n = 0; n < 2; ++n) _Pragma("unroll") for (int k = 0; k < 2; ++k) dst[n][k] = *(const LAS bf16x8*)(lds + PG8_SB(b, h) + boff + n * 2048 + k * 1024); } while (0)
#define PG8_MMA(ai, bj, At, Bt) do { __builtin_amdgcn_s_setprio(1); _Pragma("unroll") for (int m = 0; m < 4; ++m) _Pragma("unroll") for (int n = 0; n < 2; ++n) _Pragma("unroll") for (int k = 0; k < 2; ++k) \
        acc[ai][bj][m][n] = __builtin_amdgcn_mfma_f32_16x16x32_bf16(Bt[n][k], At[m][k], acc[ai][bj][m][n], 0, 0, 0); __builtin_amdgcn_s_setprio(0); } while (0)
#define PG8_WAIT_V(n) asm volatile("s_waitcnt vmcnt(" #n ")" ::: "memory")
#define PG8_WAIT_L(n) asm volatile("s_waitcnt lgkmcnt(" #n ")" ::: "memory")
#define PG8_BAR __builtin_amdgcn_s_barrier()
#define PG8_SCHED __builtin_amdgcn_sched_barrier(0)
    Unit cur, nxt; int ui = 0;
    if (!S.next(0, cur)) return;
    f32x4 acc[2][2][4][2];
#pragma unroll
    for (int a = 0; a < 2; ++a)
#pragma unroll
        for (int b = 0; b < 2; ++b)
#pragma unroll
            for (int m = 0; m < 4; ++m)
#pragma unroll
                for (int n = 0; n < 2; ++n) acc[a][b][m][n] = (f32x4){0.f, 0.f, 0.f, 0.f};
    bf16x8 At[4][2], B0[2][2], B1[2][2];
    const char* cA1 = (const char*)S.A1 + (size_t)cur.pm * BM * K1 * 2; const char* cB1 = (const char*)S.B1 + (size_t)cur.pn * BM * K1 * 2;
    const char* cA2 = (const char*)S.A2 + (size_t)cur.pm * BM * K2 * 2; const char* cB2 = (const char*)S.B2 + (size_t)cur.pn * BM * K2 * 2;
    { PG8_VOFF(voffA1, vRA, K1); PG8_VOFF(voffB1, vRB, K1);
    PG8_STAGE(PG8_SB(0, 0), cB1, voffB1); PG8_STAGE(PG8_SB(0, 1), cB1 + bhstep1, voffB1); PG8_STAGE(PG8_SA(0, 0), cA1, voffA1); PG8_STAGE(PG8_SA(0, 1), cA1 + hstep1, voffA1);
    if (wr == 1) PG8_BAR;
    PG8_WAIT_V(2); PG8_BAR;
    PG8_STAGE(PG8_SB(1, 0), cB1 + kstep, voffB1); PG8_STAGE(PG8_SA(1, 0), cA1 + kstep, voffA1); PG8_STAGE(PG8_SB(1, 1), cB1 + bhstep1 + kstep, voffB1);
    PG8_WAIT_V(6); PG8_BAR; }
    for (;;) {
        const bool has_next = S.next(ui + 1, nxt);
        const char* nA1 = has_next ? (const char*)S.A1 + (size_t)nxt.pm * BM * K1 * 2 : cA1; const char* nB1 = has_next ? (const char*)S.B1 + (size_t)nxt.pn * BM * K1 * 2 : cB1;
#define PG8_TRIP2(RELAX) do { \
            const bool last = (t == nt - 2), s1c = (t < nt1), s1n = last || (t + 2 < nt1); \
            const char* ac = s1c ? cA1 + (size_t)(t + 1) * kstep + hstep1 : cA2 + (size_t)(t + 1 - nt1) * kstep + hstep2; \
            const char* an = last ? nA1 : (s1n ? cA1 + (size_t)(t + 2) * kstep : cA2 + (size_t)(t + 2 - nt1) * kstep); \
            const char* bn = last ? nB1 : (s1n ? cB1 + (size_t)(t + 2) * kstep : cB2 + (size_t)(t + 2 - nt1) * kstep); \
            const size_t hsn = s1n ? hstep1 : hstep2, bhn = s1n ? bhstep1 : bhstep2; \
            const int Kc = s1c ? K1 : K2, Kn = s1n ? K1 : K2; \
            PG8_LDB(B0, 0, 0); PG8_LDB(B1, 0, 1); PG8_SCHED; PG8_LDA(At, 0, 0); { PG8_VOFF(vac, vRA, Kc); PG8_STAGE(PG8_SA(1, 1), ac, vac); } \
            if (!(RELAX)) PG8_WAIT_V(8); PG8_WAIT_L(0); PG8_BAR; PG8_MMA(0, 0, At, B0); PG8_MMA(0, 1, At, B1); PG8_BAR; PG8_SCHED; \
            PG8_LDA(At, 0, 1); { PG8_VOFF(vbn, vRB, Kn); PG8_VOFF(van, vRA, Kn); PG8_STAGE(PG8_SB(0, 0), bn, vbn); PG8_STAGE(PG8_SB(0, 1), bn + bhn, vbn); PG8_STAGE(PG8_SA(0, 0), an, van); } \
            if (!(RELAX)) PG8_WAIT_V(8); PG8_WAIT_L(0); PG8_BAR; PG8_MMA(1, 0, At, B0); PG8_MMA(1, 1, At, B1); PG8_BAR; PG8_SCHED; \
            PG8_LDB(B0, 1, 0); PG8_LDB(B1, 1, 1); PG8_SCHED; PG8_LDA(At, 1, 0); { PG8_VOFF(van, vRA, Kn); PG8_STAGE(PG8_SA(0, 1), an + hsn, van); } \
            PG8_WAIT_V(8); PG8_WAIT_L(0); PG8_BAR; PG8_MMA(0, 0, At, B0); PG8_MMA(0, 1, At, B1); PG8_BAR; PG8_SCHED; \
            PG8_LDA(At, 1, 1); { PG8_VOFF(vbn, vRB, Kn); PG8_VOFF(van, vRA, Kn); PG8_STAGE(PG8_SB(1, 0), bn + kstep, vbn); PG8_STAGE(PG8_SB(1, 1), bn + kstep + bhn, vbn); PG8_STAGE(PG8_SA(1, 0), an + kstep, van); } \
            PG8_WAIT_V(8); PG8_WAIT_L(0); PG8_BAR; PG8_MMA(1, 0, At, B0); PG8_MMA(1, 1, At, B1); PG8_BAR; PG8_SCHED; \
        } while (0)
        int t = 0;
        if (ui > 0) { PG8_TRIP2(true); t = 2; }
        for (; t < nt1; t += 2) PG8_TRIP2(false);
        E.mid(lds, acc, cur, wr, wc, fr, fq);
        for (; t < nt; t += 2) PG8_TRIP2(false);
#undef PG8_TRIP2
        if (wr == 0) PG8_BAR;
        E(lds, acc, cur, wr, wc, fr, fq);
        if (!has_next) break;
#pragma unroll
        for (int a = 0; a < 2; ++a)
#pragma unroll
            for (int b = 0; b < 2; ++b)
#pragma unroll
                for (int m = 0; m < 4; ++m)
#pragma unroll
                    for (int n = 0; n < 2; ++n) acc[a][b][m][n] = (f32x4){0.f, 0.f, 0.f, 0.f};
        cur = nxt; cA1 = nA1; cB1 = nB1; cA2 = (const char*)S.A2 + (size_t)cur.pm * BM * K2 * 2; cB2 = (const char*)S.B2 + (size_t)cur.pn * BM * K2 * 2; ++ui;
        if (wr == 1) PG8_BAR;
    }
    PG8_WAIT_V(0);
    PG8_BAR;
#undef PG8_VOFF
#undef PG8_SA
#undef PG8_SB
#undef PG8_STAGE
#undef PG8_LDA
#undef PG8_LDB
#undef PG8_MMA
#undef PG8_WAIT_V
#undef PG8_WAIT_L
#undef PG8_BAR
#undef PG8_SCHED
}

typedef const f32x4 (&AccRef)[2][2][4][2];
constexpr int EPI_OFF = STAGE_BYTES, EPI_WSTR = 144, EPI_WBYTES = 16 * EPI_WSTR;
__device__ __forceinline__ void epi_xpose(LAS unsigned char* st, int fr, int fq, int lane, u32x4 in0, u32x4 in1, u32x4& out0, u32x4& out1) {
    *(LAS u32x4*)(st + fr * EPI_WSTR + fq * 16) = in0; *(LAS u32x4*)(st + fr * EPI_WSTR + 64 + fq * 16) = in1;
    out0 = *(const LAS u32x4*)(st + (lane >> 3) * EPI_WSTR + (lane & 7) * 16); out1 = *(const LAS u32x4*)(st + (8 + (lane >> 3)) * EPI_WSTR + (lane & 7) * 16);
}
__device__ __forceinline__ void epi_xpose1(LAS unsigned char* st, int fr, int fq, int lane, u32x4 in0, u32x4& out0) {
    *(LAS u32x4*)(st + fr * 80 + fq * 16) = in0;
    out0 = *(const LAS u32x4*)(st + (lane >> 2) * 80 + (lane & 3) * 16);
}
#define EPI_DRAIN() asm volatile("s_waitcnt vmcnt(0)" ::: "memory")
#define EPI_LOCALS() const int lane = opaque_v(fq * 16 + fr), lr = lane >> 3, lc = lane & 7;        LAS unsigned char* st = lds + EPI_OFF + (wr * 4 + wc) * EPI_WBYTES; (void)lr; (void)lc

struct EpiIn {
    static constexpr bool PERM = true;
    const float* bias; bf16_t *U, *V, *QKV, *GA, *GB; f32x2* PS;
    __device__ __forceinline__ void binit(const Unit& u, int wc, int fq, f32x4 (&bv)[2][2]) const {
#pragma unroll
        for (int bj = 0; bj < 2; ++bj)
#pragma unroll
            for (int n = 0; n < 2; ++n) bv[bj][n] = *(const f32x4*)(bias + u.pn * BM + wc * 64 + bj * 32 + 8 * fq + 4 * n);
    }
    __device__ __forceinline__ void operator()(LAS unsigned char* lds, AccRef acc, const Unit& u, int wr, int wc, int fr, int fq) const {
        EPI_LOCALS();
        const int pn = u.pn; bf16_t* base; int ldc = D, colt, act;
        if (pn < 4) { base = U; colt = pn * 256; act = 1; }
        else if (pn < 8) { base = V; colt = (pn - 4) * 256; act = 1; }
        else if (pn < 26) { base = QKV; ldc = QKVW; colt = (pn - 8) * 256; act = 0; }
        else if (pn < 30) { base = GA; colt = (pn - 26) * 256; act = 2; }
        else { base = GB; colt = (pn - 30) * 256; act = 2; }
        bf16_t* p0 = base + (size_t)(u.pm * BM + wr * 64 + lr) * ldc + colt + wc * 64 + lc * 8;
        const bool vstats = (pn >= 4 && pn < 8);
        f32x2* ps0 = PS + (size_t)(u.pm * BM + wr * 64 + lr) * 16 + (pn - 4) * 4 + wc;
#pragma unroll
        for (int ai = 0; ai < 2; ++ai)
#pragma unroll
            for (int m = 0; m < 4; ++m) { u32x4 w[2];
#pragma unroll
                for (int bj = 0; bj < 2; ++bj) { f32x4 v0 = acc[ai][bj][m][0], v1 = acc[ai][bj][m][1];
                    if (act == 1) { f32x2 a = gelu_pk((f32x2){v0[0], v0[1]}), b = gelu_pk((f32x2){v0[2], v0[3]}), c = gelu_pk((f32x2){v1[0], v1[1]}), d = gelu_pk((f32x2){v1[2], v1[3]});
                        v0 = (f32x4){a.x, a.y, b.x, b.y}; v1 = (f32x4){c.x, c.y, d.x, d.y}; }
                    if (act == 2) { const f32x2 a = sigmoid2((f32x2){v0[0], v0[1]}), b = sigmoid2((f32x2){v0[2], v0[3]}), c = sigmoid2((f32x2){v1[0], v1[1]}), d = sigmoid2((f32x2){v1[2], v1[3]});
                        v0 = (f32x4){a.x, a.y, b.x, b.y}; v1 = (f32x4){c.x, c.y, d.x, d.y}; }
                    w[bj].x = cvt_pk_bf16(v0[0], v0[1]); w[bj].y = cvt_pk_bf16(v0[2], v0[3]); w[bj].z = cvt_pk_bf16(v1[0], v1[1]); w[bj].w = cvt_pk_bf16(v1[2], v1[3]); }
                u32x4 o0, o1; epi_xpose(st, fr, fq, lane, w[0], w[1], o0, o1);
                if (ai == 0 && m == 0) EPI_DRAIN();
                bf16_t* rp = p0 + (size_t)(ai * HALF + m * 16) * ldc;
                EPI_ST(u32x4, rp, o0); EPI_ST(u32x4, rp + (size_t)8 * ldc, o1);
                if (vstats) {
                    float s0 = 0.f, q0 = 0.f, s1 = 0.f, q1 = 0.f;
#pragma unroll
                    for (int c = 0; c < 4; ++c) { const float a = bflo(o0[c]), b = bfhi(o0[c]), d = bflo(o1[c]), e = bfhi(o1[c]); s0 += a + b; q0 += a * a + b * b; s1 += d + e; q1 += d * d + e * e; }
#pragma unroll
                    for (int o = 1; o < 8; o <<= 1) { s0 += __shfl_xor(s0, o); q0 += __shfl_xor(q0, o); s1 += __shfl_xor(s1, o); q1 += __shfl_xor(q1, o); }
                    if (lc == 0) { ps0[(size_t)(ai * HALF + m * 16) * 16] = (f32x2){s0, q0}; ps0[(size_t)(ai * HALF + m * 16 + 8) * 16] = (f32x2){s1, q1}; } }
                asm volatile("" ::: "memory"); }
    }
};
struct EpiT1 {
    static constexpr bool PERM = false;
    const bf16_t* GA; bf16_t* T1;
    __device__ __forceinline__ void binit(const Unit&, int, int, f32x4 (&bv)[2][2]) const { bv[0][0] = bv[0][1] = bv[1][0] = bv[1][1] = (f32x4){0.f, 0.f, 0.f, 0.f}; }
    __device__ __forceinline__ void operator()(LAS unsigned char* lds, AccRef acc, const Unit& u, int wr, int wc, int fr, int fq) const {
        EPI_LOCALS();
        const size_t o00 = (size_t)(u.pm * BM + wr * 64 + lr) * D + u.pn * BM + wc * 64 + lc * 4;
#pragma unroll
        for (int ai = 0; ai < 2; ++ai) {
            u32x2 g[4][2][2];
#pragma unroll
            for (int m = 0; m < 4; ++m)
#pragma unroll
                for (int bj = 0; bj < 2; ++bj)
#pragma unroll
                    for (int s = 0; s < 2; ++s) g[m][bj][s] = *(const u32x2*)(GA + o00 + (size_t)(ai * HALF + m * 16 + 8 * s) * D + bj * 32);
            asm volatile("" ::: "memory");
#pragma unroll
            for (int m = 0; m < 4; ++m)
#pragma unroll
                for (int bj = 0; bj < 2; ++bj) { u32x4 o[2]; epi_xpose(st, fr, fq, lane, __builtin_bit_cast(u32x4, acc[ai][bj][m][0]), __builtin_bit_cast(u32x4, acc[ai][bj][m][1]), o[0], o[1]);
#pragma unroll
                    for (int s = 0; s < 2; ++s) { const size_t off = o00 + (size_t)(ai * HALF + m * 16 + 8 * s) * D + bj * 32; const u32x2 gq = g[m][bj][s];
                        const f32x4 gv = (f32x4){bflo(gq.x), bfhi(gq.x), bflo(gq.y), bfhi(gq.y)}; const f32x4 tv = __builtin_bit_cast(f32x4, o[s]) * gv;
                        u32x2 tw; tw.x = cvt_pk_bf16(tv[0], tv[1]); tw.y = cvt_pk_bf16(tv[2], tv[3]); EPI_ST(u32x2, T1 + off, tw); } }
        }
    }
};
struct EpiMg {
    static constexpr bool PERM = false;
    const bf16_t* GB; const bf16_t* T1; bf16_t* MG;
    __device__ __forceinline__ void binit(const Unit&, int, int, f32x4 (&bv)[2][2]) const { bv[0][0] = bv[0][1] = bv[1][0] = bv[1][1] = (f32x4){0.f, 0.f, 0.f, 0.f}; }
    __device__ __forceinline__ void operator()(LAS unsigned char* lds, AccRef acc, const Unit& u, int wr, int wc, int fr, int fq) const {
        EPI_LOCALS();
        const size_t o00 = (size_t)(u.pm * BM + wr * 64 + lr) * D + u.pn * BM + wc * 64 + lc * 4;
#pragma unroll
        for (int ai = 0; ai < 2; ++ai) {
            u32x2 g[4][2][2], tq[4][2][2];
#pragma unroll
            for (int m = 0; m < 4; ++m)
#pragma unroll
                for (int bj = 0; bj < 2; ++bj)
#pragma unroll
                    for (int s = 0; s < 2; ++s) { const size_t off = o00 + (size_t)(ai * HALF + m * 16 + 8 * s) * D + bj * 32; g[m][bj][s] = *(const u32x2*)(GB + off); tq[m][bj][s] = *(const u32x2*)(T1 + off); }
            asm volatile("" ::: "memory");
#pragma unroll
            for (int m = 0; m < 4; ++m)
#pragma unroll
                for (int bj = 0; bj < 2; ++bj) { u32x4 o[2]; epi_xpose(st, fr, fq, lane, __builtin_bit_cast(u32x4, acc[ai][bj][m][0]), __builtin_bit_cast(u32x4, acc[ai][bj][m][1]), o[0], o[1]);
#pragma unroll
                    for (int s = 0; s < 2; ++s) { const size_t off = o00 + (size_t)(ai * HALF + m * 16 + 8 * s) * D + bj * 32; const u32x2 gq = g[m][bj][s], t2 = tq[m][bj][s];
                        const f32x4 t = (f32x4){bflo(t2.x), bfhi(t2.x), bflo(t2.y), bfhi(t2.y)};
                        const f32x4 v = t + __builtin_bit_cast(f32x4, o[s]) * (f32x4){bflo(gq.x), bfhi(gq.x), bflo(gq.y), bfhi(gq.y)};
                        u32x2 w; w.x = cvt_pk_bf16(v[0], v[1]); w.y = cvt_pk_bf16(v[2], v[3]); EPI_ST(u32x2, MG + off, w); } }
        }
    }
};
struct EpiMg2 {
    static constexpr bool PERM = false;
    const bf16_t* GA; const bf16_t* GB; bf16_t* MG;
    __device__ __forceinline__ void mid(LAS unsigned char* lds, f32x4 (&acc)[2][2][4][2], const Unit& u, int wr, int wc, int fr, int fq) const {
        EPI_LOCALS();
        const size_t o00 = (size_t)(u.pm * BM + wr * 64 + lr) * D + u.pn * BM + wc * 64 + lc * 4;
#pragma unroll
        for (int q = 0; q < 4; ++q) { const int ai = q >> 1, m0 = 2 * (q & 1);
            u32x2 ga[2][2][2], gb[2][2][2];
#pragma unroll
            for (int mm = 0; mm < 2; ++mm)
#pragma unroll
                for (int bj = 0; bj < 2; ++bj)
#pragma unroll
                    for (int s = 0; s < 2; ++s) { const size_t off = o00 + (size_t)(ai * HALF + (m0 + mm) * 16 + 8 * s) * D + bj * 32; ga[mm][bj][s] = *(const u32x2*)(GA + off); gb[mm][bj][s] = *(const u32x2*)(GB + off); }
            asm volatile("" ::: "memory");
#pragma unroll
            for (int mm = 0; mm < 2; ++mm)
#pragma unroll
                for (int bj = 0; bj < 2; ++bj) { const int m = m0 + mm;
#pragma unroll
                    for (int s = 0; s < 2; ++s) { const u32x2 a2 = ga[mm][bj][s], b2 = gb[mm][bj][s]; f32x4 r;
                        r[0] = bflo(a2.x) * __builtin_amdgcn_rcpf(fmaxf(bflo(b2.x), 1e-30f)); r[1] = bfhi(a2.x) * __builtin_amdgcn_rcpf(fmaxf(bfhi(b2.x), 1e-30f));
                        r[2] = bflo(a2.y) * __builtin_amdgcn_rcpf(fmaxf(bflo(b2.y), 1e-30f)); r[3] = bfhi(a2.y) * __builtin_amdgcn_rcpf(fmaxf(bfhi(b2.y), 1e-30f));
                        *(LAS f32x4*)(st + (8 * s + lr) * EPI_WSTR + lc * 16) = r; }
                    const f32x4 r0 = *(const LAS f32x4*)(st + fr * EPI_WSTR + fq * 16), r1 = *(const LAS f32x4*)(st + fr * EPI_WSTR + 64 + fq * 16);
                    acc[ai][bj][m][0] *= r0; acc[ai][bj][m][1] *= r1; }
        }
    }
    __device__ __forceinline__ void operator()(LAS unsigned char* lds, AccRef acc, const Unit& u, int wr, int wc, int fr, int fq) const {
        EPI_LOCALS();
        const size_t o00 = (size_t)(u.pm * BM + wr * 64 + lr) * D + u.pn * BM + wc * 64 + lc * 4;
#pragma unroll
        for (int ai = 0; ai < 2; ++ai) {
            u32x2 g[4][2][2];
#pragma unroll
            for (int m = 0; m < 4; ++m)
#pragma unroll
                for (int bj = 0; bj < 2; ++bj)
#pragma unroll
                    for (int s = 0; s < 2; ++s) g[m][bj][s] = *(const u32x2*)(GB + o00 + (size_t)(ai * HALF + m * 16 + 8 * s) * D + bj * 32);
            asm volatile("" ::: "memory");
#pragma unroll
            for (int m = 0; m < 4; ++m)
#pragma unroll
                for (int bj = 0; bj < 2; ++bj) { u32x4 o[2]; epi_xpose(st, fr, fq, lane, __builtin_bit_cast(u32x4, acc[ai][bj][m][0]), __builtin_bit_cast(u32x4, acc[ai][bj][m][1]), o[0], o[1]);
#pragma unroll
                    for (int s = 0; s < 2; ++s) { const size_t off = o00 + (size_t)(ai * HALF + m * 16 + 8 * s) * D + bj * 32; const u32x2 gq = g[m][bj][s];
                        const f32x4 v = __builtin_bit_cast(f32x4, o[s]) * (f32x4){bflo(gq.x), bfhi(gq.x), bflo(gq.y), bfhi(gq.y)};
                        u32x2 w; w.x = cvt_pk_bf16(v[0], v[1]); w.y = cvt_pk_bf16(v[2], v[3]); EPI_ST(u32x2, MG + off, w); } }
        }
    }
};
struct EpiWo {
    static constexpr bool PERM = false;
    const float* xa; const float* xb; const bf16_t* XBres; y1_t* XF;
    __device__ __forceinline__ void binit(const Unit&, int, int, f32x4 (&bv)[2][2]) const { bv[0][0] = bv[0][1] = bv[1][0] = bv[1][1] = (f32x4){0.f, 0.f, 0.f, 0.f}; }
    __device__ __forceinline__ void operator()(LAS unsigned char* lds, AccRef acc, const Unit& u, int wr, int wc, int fr, int fq) const {
        EPI_LOCALS();
        const size_t o00 = (size_t)(u.pm * BM + wr * 64 + lr) * D + u.pn * BM + wc * 64 + lc * 4;
        const float* xr = (u.pm * BM < TP) ? xa : xb;
        u32x2 xq[2][4][2][2];
        if (XBres) {
#pragma unroll
            for (int ai = 0; ai < 2; ++ai)
#pragma unroll
                for (int m = 0; m < 4; ++m)
#pragma unroll
                    for (int bj = 0; bj < 2; ++bj)
#pragma unroll
                        for (int s = 0; s < 2; ++s) xq[ai][m][bj][s] = *(const u32x2*)(XBres + o00 + (size_t)(ai * HALF + m * 16 + 8 * s) * D + bj * 32);
        } else {
#pragma unroll
            for (int ai = 0; ai < 2; ++ai)
#pragma unroll
                for (int m = 0; m < 4; ++m)
#pragma unroll
                    for (int bj = 0; bj < 2; ++bj)
#pragma unroll
                        for (int s = 0; s < 2; ++s) xq[ai][m][bj][s] = (u32x2){0u, 0u};
        }
        asm volatile("" ::: "memory");
#pragma unroll
        for (int ai = 0; ai < 2; ++ai) {
            f32x4 xv[4][2][2];
            if (XBres) {
#pragma unroll
                for (int m = 0; m < 4; ++m)
#pragma unroll
                    for (int bj = 0; bj < 2; ++bj)
#pragma unroll
                        for (int s = 0; s < 2; ++s) xv[m][bj][s] = (f32x4){bflo(xq[ai][m][bj][s].x), bfhi(xq[ai][m][bj][s].x), bflo(xq[ai][m][bj][s].y), bfhi(xq[ai][m][bj][s].y)};
            } else {
#pragma unroll
                for (int m = 0; m < 4; ++m)
#pragma unroll
                    for (int bj = 0; bj < 2; ++bj)
#pragma unroll
                        for (int s = 0; s < 2; ++s) xv[m][bj][s] = *(const f32x4*)(xr + o00 + (size_t)(ai * HALF + m * 16 + 8 * s) * D + bj * 32);
            }
            asm volatile("" ::: "memory");
#pragma unroll
            for (int m = 0; m < 4; ++m)
#pragma unroll
                for (int bj = 0; bj < 2; ++bj) { u32x4 o[2]; epi_xpose(st, fr, fq, lane, __builtin_bit_cast(u32x4, acc[ai][bj][m][0]), __builtin_bit_cast(u32x4, acc[ai][bj][m][1]), o[0], o[1]);
#pragma unroll
                    for (int s = 0; s < 2; ++s) { const size_t off = o00 + (size_t)(ai * HALF + m * 16 + 8 * s) * D + bj * 32;
                        const f32x4 yv = xv[m][bj][s] * DN_ALPHA + __builtin_bit_cast(f32x4, o[s]);
#if Y1_BF16
                        { u32x2 yw; yw.x = cvt_pk_bf16(yv[0], yv[1]); yw.y = cvt_pk_bf16(yv[2], yv[3]); EPI_ST(u32x2, XF + off, yw); }
#else
                        EPI_ST(f32x4, XF + off, yv);
#endif
                    } }
        }
    }
};
struct EpiGU {
    static constexpr bool PERM = true;
    const float* bgu; bf16_t* H;
    __device__ __forceinline__ void binit(const Unit& u, int wc, int fq, f32x4 (&bv)[2][2]) const {
        const float* bg = bgu + (size_t)u.e * 2048 + u.pn * HALF + wc * 32 + 8 * fq;
        bv[0][0] = *(const f32x4*)(bg); bv[0][1] = *(const f32x4*)(bg + 4); bv[1][0] = *(const f32x4*)(bg + 1024); bv[1][1] = *(const f32x4*)(bg + 1028);
    }
    __device__ __forceinline__ void operator()(LAS unsigned char* lds, AccRef acc, const Unit& u, int wr, int wc, int fr, int fq) const {
        EPI_LOCALS();
        bf16_t* p0 = H + (size_t)(u.pm * BM + wr * 64 + (lane >> 2)) * D + u.pn * HALF + wc * 32 + (lane & 3) * 8;
#pragma unroll
        for (int ai = 0; ai < 2; ++ai)
#pragma unroll
            for (int m = 0; m < 4; ++m) {
                f32x4 g0 = acc[ai][0][m][0], g1 = acc[ai][0][m][1], u0 = acc[ai][1][m][0], u1 = acc[ai][1][m][1], h0, h1;
                { const f32x2 a = swiglu2((f32x2){g0[0], g0[1]}, (f32x2){u0[0], u0[1]}), b = swiglu2((f32x2){g0[2], g0[3]}, (f32x2){u0[2], u0[3]}),
                              c = swiglu2((f32x2){g1[0], g1[1]}, (f32x2){u1[0], u1[1]}), d = swiglu2((f32x2){g1[2], g1[3]}, (f32x2){u1[2], u1[3]});
                  h0 = (f32x4){a.x, a.y, b.x, b.y}; h1 = (f32x4){c.x, c.y, d.x, d.y}; }
                u32x4 w; w.x = cvt_pk_bf16(h0[0], h0[1]); w.y = cvt_pk_bf16(h0[2], h0[3]); w.z = cvt_pk_bf16(h1[0], h1[1]); w.w = cvt_pk_bf16(h1[2], h1[3]);
                u32x4 o; epi_xpose1(st, fr, fq, lane, w, o);
                if (ai == 0 && m == 0) EPI_DRAIN();
                EPI_ST(u32x4, p0 + (size_t)(ai * HALF + m * 16) * D, o); asm volatile("" ::: "memory"); }
    }
};
struct EpiDown {
    static constexpr bool PERM = true;
    const float* bd; bf16_t* YK;
    __device__ __forceinline__ void binit(const Unit& u, int wc, int fq, f32x4 (&bv)[2][2]) const {
#pragma unroll
        for (int bj = 0; bj < 2; ++bj)
#pragma unroll
            for (int n = 0; n < 2; ++n) bv[bj][n] = *(const f32x4*)(bd + (size_t)u.e * D + u.pn * BM + wc * 64 + bj * 32 + 8 * fq + 4 * n);
    }
    __device__ __forceinline__ void operator()(LAS unsigned char* lds, AccRef acc, const Unit& u, int wr, int wc, int fr, int fq) const {
        EPI_LOCALS();
        bf16_t* p0 = YK + (size_t)(u.pm * BM + wr * 64 + lr) * D + u.pn * BM + wc * 64 + lc * 8;
#pragma unroll
        for (int ai = 0; ai < 2; ++ai)
#pragma unroll
            for (int m = 0; m < 4; ++m) { u32x4 w[2];
#pragma unroll
                for (int bj = 0; bj < 2; ++bj) { const f32x4 v0 = acc[ai][bj][m][0], v1 = acc[ai][bj][m][1];
                    w[bj].x = cvt_pk_bf16(v0[0], v0[1]); w[bj].y = cvt_pk_bf16(v0[2], v0[3]); w[bj].z = cvt_pk_bf16(v1[0], v1[1]); w[bj].w = cvt_pk_bf16(v1[2], v1[3]); }
                u32x4 o0, o1; epi_xpose(st, fr, fq, lane, w[0], w[1], o0, o1);
                if (ai == 0 && m == 0) EPI_DRAIN();
                bf16_t* rp = p0 + (size_t)(ai * HALF + m * 16) * D;
                EPI_ST(u32x4, rp, o0); EPI_ST(u32x4, rp + (size_t)8 * D, o1); asm volatile("" ::: "memory"); }
    }
};
}

struct Args { const float* in[21]; float* out; unsigned char* ws; int ph_lo, ph_hi, sub, pad; };
enum { I_XP = 0, I_XS, I_WIN, I_BIN, I_LNVG, I_LNVB, I_WS, I_BS, I_WPA, I_WPB, I_WO, I_LN1G, I_LN1B, I_WR, I_BR, I_WGU, I_BGU, I_WD, I_BD, I_LN2G, I_LN2B };

__device__ __forceinline__ void tr_item(const float* W, int K, int N, bf16_t* WT, int k0, int n0, int nd0, LAS unsigned* scr, int lane, int ndhi = 32) {
    const int i = lane & 15, kp = lane >> 4;
    f32x4 a[8], b[8];
#pragma unroll
    for (int it = 0; it < 8; ++it) { const int k = it * 8 + kp * 2; a[it] = *(const f32x4*)(W + (size_t)(k0 + k) * N + n0 + 4 * i); b[it] = *(const f32x4*)(W + (size_t)(k0 + k + 1) * N + n0 + 4 * i); }
#pragma unroll
    for (int it = 0; it < 8; ++it) {
#pragma unroll
        for (int j = 0; j < 4; ++j) scr[(4 * i + j) * 33 + it * 4 + kp] = pk2(a[it][j], b[it][j]); }
    asm volatile("s_waitcnt lgkmcnt(0)" ::: "memory");
    const int nn = lane >> 3, c = lane & 7;
#pragma unroll
    for (int j = 0; j < 8; ++j) { const int n = nn + 8 * j; u32x4 o; o.x = scr[n * 33 + 4 * c]; o.y = scr[n * 33 + 4 * c + 1]; o.z = scr[n * 33 + 4 * c + 2]; o.w = scr[n * 33 + 4 * c + 3];
        *(u32x4*)(WT + (size_t)(nd0 + (n & 31) + (n >> 5) * ndhi) * K + k0 + 8 * c) = o; }
    asm volatile("s_waitcnt lgkmcnt(0)" ::: "memory");
}
__device__ __forceinline__ void p0_prologue(const Args& a, LAS unsigned char* lds, int G) {
    const int tid = opaque_v(threadIdx.x), lane = tid & 63, wave = tid >> 6;
    LAS unsigned* scr = (LAS unsigned*)(lds + wave * 8704);
    const int gw = blockIdx.x * 8 + wave, NGW = G * 8;
    unsigned char* ws = a.ws;
    constexpr int I_GU = DEPTH * NE * 16 * 32, I_D = DEPTH * NE * 16 * 16, I_IN = DEPTH * 16 * 136, I_PA = DEPTH * 256, I_PB = DEPTH * 8 * 16, I_O = DEPTH * 256;
    constexpr int NITEMS = I_GU + I_D + I_IN + I_PA + I_PB + I_O;
    for (int it = gw; it < NITEMS; it += NGW) {
        int r = it;
        if (r < I_GU) { const int mat = r / 512, q = r % 512, kb = q / 32, nb = q % 32, n0 = nb * 64, c = n0 & 1023, nd0 = (c >> 7) * 256 + ((c & 127) >> 5) * 64 + ((n0 >= 1024) ? 32 : 0);
            tr_item(a.in[I_WGU] + (size_t)mat * 1024 * 2048, 1024, 2048, (bf16_t*)(ws + WS_WGU) + (size_t)mat * 2048 * 1024, kb * 64, n0, nd0, scr, lane, 64); continue; }
        r -= I_GU;
        if (r < I_D) { const int mat = r / 256, q = r % 256, kb = q / 16, nb = q % 16;
            tr_item(a.in[I_WD] + (size_t)mat * 1024 * 1024, 1024, 1024, (bf16_t*)(ws + WS_WD) + (size_t)mat * 1024 * 1024, kb * 64, nb * 64, nb * 64, scr, lane); continue; }
        r -= I_D;
        if (r < I_IN) { const int mat = r / (16 * 136), q = r % (16 * 136), kb = q / 136, nb = q % 136;
            tr_item(a.in[I_WIN] + (size_t)mat * 1024 * DIN, 1024, DIN, (bf16_t*)(ws + WS_WIN) + (size_t)mat * DIN * 1024, kb * 64, nb * 64, nb * 64, scr, lane); continue; }
        r -= I_IN;
        if (r < I_PA) { const int mat = r / 256, q = r % 256, kb = q / 16, nb = q % 16;
            tr_item(a.in[I_WPA] + (size_t)mat * 1024 * 1024, 1024, 1024, (bf16_t*)(ws + WS_WPA) + (size_t)mat * 1024 * 1024, kb * 64, nb * 64, nb * 64, scr, lane); continue; }
        r -= I_PA;
        if (r < I_PB) { const int mat = r / 128, q = r % 128, kb = q / 16, nb = q % 16;
            tr_item(a.in[I_WPB] + (size_t)mat * 512 * 1024, 512, 1024, (bf16_t*)(ws + WS_WPB) + (size_t)mat * 1024 * 512, kb * 64, nb * 64, nb * 64, scr, lane); continue; }
        r -= I_PB;
        { const int mat = r / 256, q = r % 256, kb = q / 16, nb = q % 16;
            tr_item(a.in[I_WO] + (size_t)mat * 1024 * 1024, 1024, 1024, (bf16_t*)(ws + WS_WO) + (size_t)mat * 1024 * 1024, kb * 64, nb * 64, nb * 64, scr, lane); }
    }
    const size_t gt = (size_t)blockIdx.x * 512 + tid, NGT = (size_t)G * 512;
    { float* prm = (float*)(ws + WS_PRM);
#define CPY(idx, off, n) for (size_t i = gt; i < (size_t)(n) / 4; i += NGT) *(f32x4*)(prm + (off) + i * 4) = *(const f32x4*)(a.in[idx] + i * 4)
      CPY(I_BIN, PR_BIN, DEPTH * DIN); CPY(I_LNVG, PR_LNVG, DEPTH * D); CPY(I_LNVB, PR_LNVB, DEPTH * D); CPY(I_BS, PR_BS, DEPTH * D); CPY(I_LN1G, PR_LN1G, DEPTH * D); CPY(I_LN1B, PR_LN1B, DEPTH * D);
      CPY(I_WR, PR_WR, DEPTH * D * NE); CPY(I_BR, PR_BR, DEPTH * NE); CPY(I_BGU, PR_BGU, DEPTH * NE * 2048); CPY(I_BD, PR_BD, DEPTH * NE * D); CPY(I_LN2G, PR_LN2G, DEPTH * D); CPY(I_LN2B, PR_LN2B, DEPTH * D);
#undef CPY
    }
    { const float* src = a.in[I_WR]; bf16_t* img = (bf16_t*)(ws + WS_WRI);
      for (size_t i = gt; i < (size_t)DEPTH * D * NE; i += NGT) { const int l = (int)(i >> 15), k = (int)(i >> 5) & 1023, e = (int)i & 31; const float v = src[i]; const unsigned h = f2bf(v), lo = f2bf(v - __builtin_bit_cast(float, h << 16));
          img[(size_t)l * 65536 + e * 1024 + k] = (bf16_t)h; img[(size_t)l * 65536 + 32768 + e * 1024 + k] = (bf16_t)lo; } }
    { const float* src = a.in[I_WS]; bf16_t* dst = (bf16_t*)(ws + WS_WS);
      for (size_t i = gt; i < (size_t)DEPTH * 8 * 128 * 128 / 8; i += NGT) { const f32x4 x = *(const f32x4*)(src + i * 8), y = *(const f32x4*)(src + i * 8 + 4);
          u32x4 o; o.x = pk2(x[0], x[1]); o.y = pk2(x[2], x[3]); o.z = pk2(y[0], y[1]); o.w = pk2(y[2], y[3]); *(u32x4*)(dst + i * 8) = o; } }
    { bf16_t* dst = (bf16_t*)(ws + WS_XB);
      for (size_t i = gt; i < (size_t)T * D / 8; i += NGT) { const size_t e = i * 8; const float* src = (e < (size_t)TP * D) ? a.in[I_XP] + e : a.in[I_XS] + (e - (size_t)TP * D);
          const f32x4 x = *(const f32x4*)(src), y = *(const f32x4*)(src + 4);
          u32x4 o; o.x = pk2(x[0], x[1]); o.y = pk2(x[2], x[3]); o.z = pk2(y[0], y[1]); o.w = pk2(y[2], y[3]); *(u32x4*)(dst + e) = o; } }
}

template <int BASE> __device__ __forceinline__ void tr8(unsigned addr, s16x4 (&r)[8]) {
    asm volatile("ds_read_b64_tr_b16 %0, %8 offset:%9\n\tds_read_b64_tr_b16 %1, %8 offset:%10\n\tds_read_b64_tr_b16 %2, %8 offset:%11\n\tds_read_b64_tr_b16 %3, %8 offset:%12\n\t"
                 "ds_read_b64_tr_b16 %4, %8 offset:%13\n\tds_read_b64_tr_b16 %5, %8 offset:%14\n\tds_read_b64_tr_b16 %6, %8 offset:%15\n\tds_read_b64_tr_b16 %7, %8 offset:%16\n\t"
                 : "=&v"(r[0]), "=&v"(r[1]), "=&v"(r[2]), "=&v"(r[3]), "=&v"(r[4]), "=&v"(r[5]), "=&v"(r[6]), "=&v"(r[7])
                 : "v"(addr), "n"(BASE), "n"(BASE + 32), "n"(BASE + 64), "n"(BASE + 96), "n"(BASE + 128), "n"(BASE + 160), "n"(BASE + 192), "n"(BASE + 224) : "memory");
}
__device__ __forceinline__ bf16x8 cat4(s16x4 a, s16x4 b) { return (bf16x8){a[0], a[1], a[2], a[3], b[0], b[1], b[2], b[3]}; }

constexpr int AT_KSTR = 272, AT_VSTR = 288, AT_KBYTES = 256 * AT_KSTR, AT_VOFF = AT_KBYTES, AT_VBYTES = 256 * AT_VSTR;
constexpr int AT_EPI_OFF = AT_VOFF + AT_VBYTES;
static_assert(AT_EPI_OFF + 8 * 2304 <= SCR_BYTES, "attention LDS");

template <int ST> __device__ __forceinline__ void attn_pv_step(unsigned vaddr, const f32x4 (&s)[9], f32x4 (&o)[8]) {
    s16x4 r0[8], r1[8];
    tr8<ST * 32 * AT_VSTR>(vaddr, r0);
    tr8<ST * 32 * AT_VSTR + (ST < 4 ? 16 * AT_VSTR : 0)>(vaddr, r1);
    asm volatile("s_waitcnt lgkmcnt(0)" ::: "memory");
    __builtin_amdgcn_sched_barrier(0);
    u32x4 pw; pw.x = cvt_pk_bf16(s[2 * ST][0], s[2 * ST][1]); pw.y = cvt_pk_bf16(s[2 * ST][2], s[2 * ST][3]);
    if (ST < 4) { pw.z = cvt_pk_bf16(s[2 * ST + (ST < 4 ? 1 : 0)][0], s[2 * ST + (ST < 4 ? 1 : 0)][1]); pw.w = cvt_pk_bf16(s[2 * ST + (ST < 4 ? 1 : 0)][2], s[2 * ST + (ST < 4 ? 1 : 0)][3]); }
    else { pw.z = 0u; pw.w = 0u; }
    const bf16x8 pf = __builtin_bit_cast(bf16x8, pw);
#pragma unroll
    for (int db = 0; db < 8; ++db) o[db] = __builtin_amdgcn_mfma_f32_16x16x32_bf16(cat4(r0[db], r1[db]), pf, o[db], 0, 0, 0);
}

__device__ __forceinline__ void attn_load(const bf16_t* QKV, int unit, int tid, u32x4 (&kr)[8], u32x4 (&vr)[8]) {
    const int wsub = unit & 31, h = (unit >> 5) & 3, bg = unit >> 7, g = bg % 3, b = bg / 3;
    const int dsh = 2 * g, dil = 1 << dsh, L = SEQ >> dsh, nblk = L >> 7, r = wsub / nblk, blk = wsub % nblk, p0 = blk * 128;
    const int kc = g * 1536 + h * 128 + 512, vc = kc + 512;
#pragma unroll
    for (int j = 0; j < 8; ++j) { const int id = tid + 512 * j, kk = id >> 4, ch = id & 15, pk = p0 - 64 + kk; const bool ok = pk >= 0 && pk < L;
        const size_t ro = (size_t)(b * SEQ + (ok ? pk : 0) * dil + r) * QKVW; const u32x4 kx = *(const u32x4*)(QKV + ro + kc + ch * 8), vx = *(const u32x4*)(QKV + ro + vc + ch * 8);
        kr[j] = ok ? kx : (u32x4){0u, 0u, 0u, 0u}; vr[j] = ok ? vx : (u32x4){0u, 0u, 0u, 0u}; }
}
__device__ __forceinline__ void attn_unit(LAS unsigned char* lds, const bf16_t* QKV, bf16_t* OG, float* LSE, int unit, int unit_next, u32x4 (&kr)[8], u32x4 (&vr)[8]) {
    const int tid = opaque_v(threadIdx.x), lane = tid & 63, w = tid >> 6, ql = lane & 15, quad = lane >> 4;
    const int wsub = unit & 31, h = (unit >> 5) & 3, bg = unit >> 7, g = bg % 3, b = bg / 3;
    const int dsh = 2 * g, dil = 1 << dsh, L = SEQ >> dsh, nblk = L >> 7, r = wsub / nblk, blk = wsub % nblk, p0 = blk * 128;
    const int qc = g * 1536 + h * 128;
    const float slope = __builtin_amdgcn_exp2f(-(2.0f / 3.0f) * (float)(4 * g + h + 1));
    const float ca = slope * (float)dil * LOG2E, SC = 0.08838834764831845f * LOG2E;
#pragma unroll
    for (int j = 0; j < 8; ++j) { const int id = tid + 512 * j, kk = id >> 4, ch = id & 15;
        *(LAS u32x4*)(lds + kk * AT_KSTR + ch * 16) = kr[j]; *(LAS u32x4*)(lds + AT_VOFF + kk * AT_VSTR + ch * 16) = vr[j]; }
    const int qrow = b * SEQ + (p0 + 16 * w + ql) * dil + r;
    bf16x8 qf[4];
#pragma unroll
    for (int ks = 0; ks < 4; ++ks) qf[ks] = *(const bf16x8*)(QKV + (size_t)qrow * QKVW + qc + 32 * ks + 8 * quad);
    __syncthreads();
    asm volatile("" : "+v"(qf[0]), "+v"(qf[1]), "+v"(qf[2]), "+v"(qf[3]));
    attn_load(QKV, unit_next >= 0 ? unit_next : unit, tid, kr, vr);
    f32x4 s[9];
#pragma unroll
    for (int j = 0; j < 9; ++j) { s[j] = (f32x4){0.f, 0.f, 0.f, 0.f};
#pragma unroll
        for (int ks = 0; ks < 4; ++ks) { const bf16x8 kf = *(const LAS bf16x8*)(lds + (16 * w + 16 * j + ql) * AT_KSTR + (32 * ks + 8 * quad) * 2);
            s[j] = __builtin_amdgcn_mfma_f32_16x16x32_bf16(kf, qf[ks], s[j], 0, 0, 0); } }
    float mx = -1e30f;
#pragma unroll
    for (int j = 0; j < 9; ++j)
#pragma unroll
        for (int i = 0; i < 4; ++i) { const int rel = 16 * j + 4 * quad + i - 64 - ql, pk = p0 + 16 * w + ql + rel, ar = rel < 0 ? -rel : rel;
            const bool ok = (ar <= 64) && (pk >= 0) && (pk < L);
            const float v = ok ? (s[j][i] * SC - ca * (float)ar) : -1e30f; s[j][i] = v; mx = fmaxf(mx, v); }
    mx = fmaxf(mx, __shfl_xor(mx, 16)); mx = fmaxf(mx, __shfl_xor(mx, 32));
    float den = 0.f;
#pragma unroll
    for (int j = 0; j < 9; ++j)
#pragma unroll
        for (int i = 0; i < 4; ++i) { const float p = __builtin_amdgcn_exp2f(s[j][i] - mx); s[j][i] = p; den += p; }
    den += __shfl_xor(den, 16); den += __shfl_xor(den, 32);
    f32x4 o[8];
#pragma unroll
    for (int db = 0; db < 8; ++db) o[db] = (f32x4){0.f, 0.f, 0.f, 0.f};
    const unsigned vaddr = (unsigned)(uintptr_t)(lds + AT_VOFF) + (unsigned)((16 * w + 4 * quad + (ql >> 2)) * AT_VSTR + (ql & 3) * 8);
    attn_pv_step<0>(vaddr, s, o); attn_pv_step<1>(vaddr, s, o); attn_pv_step<2>(vaddr, s, o); attn_pv_step<3>(vaddr, s, o); attn_pv_step<4>(vaddr, s, o);
    const float inv = 1.0f / den;
    {
        LAS unsigned char* st = lds + AT_EPI_OFF + w * 2304;
        const int lr = lane >> 3, lc = lane & 7;
        bf16_t* od0 = OG + ((size_t)g * T + (size_t)(b * SEQ + (p0 + 16 * w + lr) * dil + r)) * 512 + h * 128 + lc * 8;
        bf16_t* od1 = OG + ((size_t)g * T + (size_t)(b * SEQ + (p0 + 16 * w + 8 + lr) * dil + r)) * 512 + h * 128 + lc * 8;
#pragma unroll
        for (int hh = 0; hh < 2; ++hh) {
#pragma unroll
            for (int d4 = 0; d4 < 4; ++d4) { const int db = 4 * hh + d4; u32x2 wv; wv.x = cvt_pk_bf16(o[db][0] * inv, o[db][1] * inv); wv.y = cvt_pk_bf16(o[db][2] * inv, o[db][3] * inv);
                *(LAS u32x2*)(st + ql * 144 + d4 * 32 + quad * 8) = wv; }
            const u32x4 r0 = *(const LAS u32x4*)(st + lr * 144 + lc * 16), r1 = *(const LAS u32x4*)(st + (8 + lr) * 144 + lc * 16);
            __builtin_nontemporal_store(r0, (u32x4*)(od0 + hh * 64)); __builtin_nontemporal_store(r1, (u32x4*)(od1 + hh * 64));
        }
    }
    if (quad == 0) LSE[((size_t)g * T + qrow) * 4 + h] = (mx + __builtin_amdgcn_logf(den)) * LN2;
    __syncthreads();
}

constexpr int SG_STR = 288, SG_TILE = 128 * SG_STR, SG_STATS = 2 * SG_TILE, SG_EPI_OFF = SG_STATS + 1024, SG_EPI_WBYTES = 16 * 528;
static_assert(SG_EPI_OFF + 8 * SG_EPI_WBYTES <= SCR_BYTES, "spatial gating LDS");
template <int KS> __device__ __forceinline__ void sg_step(unsigned vaddr, const bf16x8 wf, f32x4 (&acc)[8]) {
    s16x4 r0[8], r1[8];
    tr8<KS * 32 * SG_STR>(vaddr, r0);
    tr8<KS * 32 * SG_STR + 4 * SG_STR>(vaddr, r1);
    asm volatile("s_waitcnt lgkmcnt(0)" ::: "memory");
    __builtin_amdgcn_sched_barrier(0);
#pragma unroll
    for (int cb = 0; cb < 8; ++cb) acc[cb] = __builtin_amdgcn_mfma_f32_16x16x32_bf16(cat4(r0[cb], r1[cb]), wf, acc[cb], 0, 0, 0);
}
__device__ __forceinline__ void sg_unit(LAS unsigned char* lds, const bf16_t* U, const bf16_t* V, bf16_t* AOUT, const bf16_t* WsB, const float* bs, const float* lng, const float* lnb, const f32x2* PS, int unit) {
    const int tid = opaque_v(threadIdx.x), lane = tid & 63, w = tid >> 6, ql = lane & 15, quad = lane >> 4;
    const int ci = unit >> 1, hh = unit & 1, row0 = ci * 128;
    LAS float* stats = (LAS float*)(lds + SG_STATS);
    { const int row = tid >> 2, part = tid & 3; const f32x4 pa = *(const f32x4*)(PS + (size_t)(row0 + row) * 16 + part * 4), pb = *(const f32x4*)(PS + (size_t)(row0 + row) * 16 + part * 4 + 2);
      float sm = (pa[0] + pa[2]) + (pb[0] + pb[2]), sq = (pa[1] + pa[3]) + (pb[1] + pb[3]);
      sm += __shfl_xor(sm, 1); sq += __shfl_xor(sq, 1); sm += __shfl_xor(sm, 2); sq += __shfl_xor(sq, 2);
      const float mean = sm * (1.0f / D), rstd = 1.0f / sqrtf(fmaxf(sq * (1.0f / D) - mean * mean, 0.f) + LN_EPS);
      if (part == 0) { stats[2 * row] = mean; stats[2 * row + 1] = rstd; } }
    __syncthreads();
    const int ch = tid & 15;
    u32x4 vt[4]; bf16x8 wf[4]; f32x4 gab[4];
#define SG_LOADG(GI) do { const int g_ = 4 * hh + (GI); \
        _Pragma("unroll") for (int j = 0; j < 4; ++j) vt[j] = *(const u32x4*)(V + (size_t)(row0 + (tid >> 4) + 32 * j) * D + g_ * 128 + ch * 8); \
        gab[0] = *(const f32x4*)(lng + g_ * 128 + ch * 8); gab[1] = *(const f32x4*)(lng + g_ * 128 + ch * 8 + 4); gab[2] = *(const f32x4*)(lnb + g_ * 128 + ch * 8); gab[3] = *(const f32x4*)(lnb + g_ * 128 + ch * 8 + 4); \
        const bf16_t* Wg_ = WsB + (size_t)g_ * 128 * 128 + (size_t)(16 * w + ql) * 128 + 8 * quad; \
        _Pragma("unroll") for (int ks = 0; ks < 4; ++ks) wf[ks] = *(const bf16x8*)(Wg_ + 32 * ks); } while (0)
    SG_LOADG(0);
#pragma unroll 1
    for (int gi = 0; gi < 4; ++gi) {
        const int g = 4 * hh + gi; LAS unsigned char* tile = lds + (gi & 1) * SG_TILE;
#pragma unroll
        for (int j = 0; j < 4; ++j) { const int sr = (tid >> 4) + 32 * j; const u32x4 x = vt[j];
            const float mean = stats[2 * sr], rstd = stats[2 * sr + 1];
            const f32x4 a = ((f32x4){bflo(x.x), bfhi(x.x), bflo(x.y), bfhi(x.y)} - mean) * rstd * gab[0] + gab[2], bq = ((f32x4){bflo(x.z), bfhi(x.z), bflo(x.w), bfhi(x.w)} - mean) * rstd * gab[1] + gab[3];
            u32x4 o; o.x = cvt_pk_bf16(a[0], a[1]); o.y = cvt_pk_bf16(a[2], a[3]); o.z = cvt_pk_bf16(bq[0], bq[1]); o.w = cvt_pk_bf16(bq[2], bq[3]);
            *(LAS u32x4*)(tile + sr * SG_STR + ch * 16) = o; }
        bf16x8 wfc[4];
#pragma unroll
        for (int ks = 0; ks < 4; ++ks) { wfc[ks] = wf[ks]; asm volatile("" : "+v"(wfc[ks])); }
        __syncthreads();
        const size_t off = (size_t)(row0 + 16 * w + (lane >> 5)) * D + g * 128 + 4 * (lane & 31);
        u32x2 uu[8];
#pragma unroll
        for (int it = 0; it < 8; ++it) uu[it] = *(const u32x2*)(U + off + (size_t)(2 * it) * D);
        SG_LOADG(gi < 3 ? gi + 1 : 3);
        f32x4 acc[8];
#pragma unroll
        for (int cb = 0; cb < 8; ++cb) acc[cb] = (f32x4){0.f, 0.f, 0.f, 0.f};
        const unsigned vaddr = (unsigned)(uintptr_t)tile + (unsigned)((8 * quad + (ql >> 2)) * SG_STR + (ql & 3) * 8);
        sg_step<0>(vaddr, wfc[0], acc); sg_step<1>(vaddr, wfc[1], acc); sg_step<2>(vaddr, wfc[2], acc); sg_step<3>(vaddr, wfc[3], acc);
        const int t = 16 * w + ql; const float bst = bs[g * 128 + t];
        LAS unsigned char* st = lds + SG_EPI_OFF + w * SG_EPI_WBYTES;
#pragma unroll
        for (int cb = 0; cb < 8; ++cb) *(LAS f32x4*)(st + ql * 528 + 64 * cb + 16 * quad) = acc[cb] + bst;
#pragma unroll
        for (int it = 0; it < 8; ++it) { const f32x4 mv = *(const LAS f32x4*)(st + (2 * it + (lane >> 5)) * 528 + (lane & 31) * 16);
            u32x2 o; o.x = cvt_pk_bf16(bflo(uu[it].x) * mv[0], bfhi(uu[it].x) * mv[1]); o.y = cvt_pk_bf16(bflo(uu[it].y) * mv[2], bfhi(uu[it].y) * mv[3]);
            __builtin_nontemporal_store(o, (u32x2*)(AOUT + off + (size_t)(2 * it) * D)); }
    }
#undef SG_LOADG
    __syncthreads();
}

__device__ __forceinline__ void merge_phase(const bf16_t* OG, const float* LSE, bf16_t* BOUT, int G) {
    const int tid = opaque_v(threadIdx.x), lane = tid & 63, gw = blockIdx.x * 8 + (tid >> 6), NGW = G * 8, hd = lane >> 4;
    for (int row = gw; row < T; row += NGW) {
        const float l0 = LSE[((size_t)0 * T + row) * 4 + hd], l1 = LSE[((size_t)1 * T + row) * 4 + hd], l2 = LSE[((size_t)2 * T + row) * 4 + hd];
        const float m = fmaxf(l0, fmaxf(l1, l2));
        float w0 = __builtin_amdgcn_exp2f((l0 - m) * LOG2E), w1 = __builtin_amdgcn_exp2f((l1 - m) * LOG2E), w2 = __builtin_amdgcn_exp2f((l2 - m) * LOG2E);
        const float inv = 1.0f / (w0 + w1 + w2); w0 *= inv; w1 *= inv; w2 *= inv;
        const u32x4 a = *(const u32x4*)(OG + ((size_t)0 * T + row) * 512 + lane * 8), b = *(const u32x4*)(OG + ((size_t)1 * T + row) * 512 + lane * 8), c = *(const u32x4*)(OG + ((size_t)2 * T + row) * 512 + lane * 8);
        u32x4 o;
        o.x = cvt_pk_bf16(w0 * bflo(a.x) + w1 * bflo(b.x) + w2 * bflo(c.x), w0 * bfhi(a.x) + w1 * bfhi(b.x) + w2 * bfhi(c.x));
        o.y = cvt_pk_bf16(w0 * bflo(a.y) + w1 * bflo(b.y) + w2 * bflo(c.y), w0 * bfhi(a.y) + w1 * bfhi(b.y) + w2 * bfhi(c.y));
        o.z = cvt_pk_bf16(w0 * bflo(a.z) + w1 * bflo(b.z) + w2 * bflo(c.z), w0 * bfhi(a.z) + w1 * bfhi(b.z) + w2 * bfhi(c.z));
        o.w = cvt_pk_bf16(w0 * bflo(a.w) + w1 * bflo(b.w) + w2 * bflo(c.w), w0 * bfhi(a.w) + w1 * bfhi(b.w) + w2 * bfhi(c.w));
        __builtin_nontemporal_store(o, (u32x4*)(BOUT + (size_t)row * 512 + lane * 8));
    }
}

constexpr int RT_WSTR = 2064, RT_WL = 32 * RT_WSTR, RT_GB = 2 * RT_WL, RT_ST = RT_GB + 8192, RT_STW = 2560;
static_assert(RT_ST + 8 * RT_STW <= SCR_BYTES, "router LDS");
#if !Y1_BF16
#error "P5 keeps a wave's rows in registers: it needs the bf16 y1"
#endif
#define P5_UNPK(q) ((f32x4){bflo((q).x), bfhi((q).x), bflo((q).y), bfhi((q).y)})
template <bool HASB> __device__ __forceinline__ void p5_tile(LAS unsigned char* lds, u32x2 (&ra)[32], u32x2 (&rb)[32], bool liveA, bool liveB, int rowA, int rowB, f32x2* RS, bf16_t* XB,
                                                             int lane_, int w, const float (&bre)[8], float (&lg)[8]) {
    const int lane = opaque_v(lane_), r = lane & 15, quad = lane >> 4, lr = lane >> 3, lc = lane & 7;
    float smA = 0.f, sqA = 0.f, smB = 0.f, sqB = 0.f;
#pragma unroll
    for (int s = 0; s < 32; ++s) { const f32x4 a = P5_UNPK(ra[s]);
        smA += (a[0] + a[1]) + (a[2] + a[3]); sqA += (a[0] * a[0] + a[1] * a[1]) + (a[2] * a[2] + a[3] * a[3]);
        if (HASB) { const f32x4 b = P5_UNPK(rb[s]); smB += (b[0] + b[1]) + (b[2] + b[3]); sqB += (b[0] * b[0] + b[1] * b[1]) + (b[2] * b[2] + b[3] * b[3]); } }
#pragma unroll
    for (int o = 1; o < 8; o <<= 1) { smA += __shfl_xor(smA, o); sqA += __shfl_xor(sqA, o); if (HASB) { smB += __shfl_xor(smB, o); sqB += __shfl_xor(sqB, o); } }
    const float meanA = smA * (1.0f / D), rstdA = 1.0f / sqrtf(fmaxf(sqA * (1.0f / D) - meanA * meanA, 0.f) + LN_EPS);
    const float meanB = smB * (1.0f / D), rstdB = 1.0f / sqrtf(fmaxf(sqB * (1.0f / D) - meanB * meanB, 0.f) + LN_EPS);
    if (lc == 0) { if (liveA) RS[rowA] = (f32x2){meanA, rstdA}; if (HASB && liveB) RS[rowB] = (f32x2){meanB, rstdB}; }
#pragma unroll
    for (int s = 0; s < 32; ++s) { asm volatile("" : "+v"(ra[s])); if (HASB) asm volatile("" : "+v"(rb[s])); }
    f32x4 acc[2] = {(f32x4){0.f, 0.f, 0.f, 0.f}, (f32x4){0.f, 0.f, 0.f, 0.f}};
    const LAS unsigned char* wp = lds + r * RT_WSTR + 16 * quad;
    LAS unsigned char* stw = lds + RT_ST + w * RT_STW;
    const LAS float* gl = (const LAS float*)(lds + RT_GB) + 4 * lc; const LAS float* bl = gl + 1024;
    bf16_t* xoA = XB + (size_t)rowA * D + 4 * lc; bf16_t* xoB = XB + (size_t)rowB * D + 4 * lc;
#pragma unroll
    for (int s = 0; s < 32; ++s) {
        const f32x4 a = P5_UNPK(ra[s]);
        const f32x4 gv = *(const LAS f32x4*)(gl + 32 * s), bv = *(const LAS f32x4*)(bl + 32 * s);
        const f32x4 xa = (a - meanA) * rstdA * gv + bv;
        u32x2 ha, la;
        ha.x = cvt_pk_bf16(xa[0], xa[1]); ha.y = cvt_pk_bf16(xa[2], xa[3]);
        la.x = cvt_pk_bf16(xa[0] - bflo(ha.x), xa[1] - bfhi(ha.x)); la.y = cvt_pk_bf16(xa[2] - bflo(ha.y), xa[3] - bfhi(ha.y));
        if (liveA) *(u32x2*)(xoA + 32 * s) = ha;
        *(LAS u32x2*)(stw + lr * 80 + lc * 8) = ha; *(LAS u32x2*)(stw + 1280 + lr * 80 + lc * 8) = la;
        if (HASB) { const f32x4 b = P5_UNPK(rb[s]); const f32x4 xb = (b - meanB) * rstdB * gv + bv; u32x2 hb, lb;
            hb.x = cvt_pk_bf16(xb[0], xb[1]); hb.y = cvt_pk_bf16(xb[2], xb[3]); lb.x = cvt_pk_bf16(xb[0] - bflo(hb.x), xb[1] - bfhi(hb.x)); lb.y = cvt_pk_bf16(xb[2] - bflo(hb.y), xb[3] - bfhi(hb.y));
            if (liveB) *(u32x2*)(xoB + 32 * s) = hb;
            *(LAS u32x2*)(stw + (8 + lr) * 80 + lc * 8) = hb; *(LAS u32x2*)(stw + 1280 + (8 + lr) * 80 + lc * 8) = lb; }
        const bf16x8 xh = *(const LAS bf16x8*)(stw + r * 80 + quad * 16), xl = *(const LAS bf16x8*)(stw + 1280 + r * 80 + quad * 16);
#pragma unroll
        for (int eb = 0; eb < 2; ++eb) { const bf16x8 wh = *(const LAS bf16x8*)(wp + eb * 16 * RT_WSTR + 64 * s), wl = *(const LAS bf16x8*)(wp + RT_WL + eb * 16 * RT_WSTR + 64 * s);
            acc[eb] = __builtin_amdgcn_mfma_f32_16x16x32_bf16(wh, xh, acc[eb], 0, 0, 0); acc[eb] = __builtin_amdgcn_mfma_f32_16x16x32_bf16(wh, xl, acc[eb], 0, 0, 0); acc[eb] = __builtin_amdgcn_mfma_f32_16x16x32_bf16(wl, xh, acc[eb], 0, 0, 0); }
    }
#pragma unroll
    for (int eb = 0; eb < 2; ++eb)
#pragma unroll
        for (int i = 0; i < 4; ++i) lg[eb * 4 + i] = acc[eb][i] + bre[eb * 4 + i];
}
__device__ __forceinline__ void p5_route(float (&lg)[8], bool live, int row, int lane_, int tid_, volatile LAS unsigned* lcnt, volatile LAS unsigned* gbase, unsigned* gcnt, int* tokList, int* tokE, int* tokPos, float* gate) {
    const int lane = opaque_v(lane_), tid = opaque_v(tid_), quad = lane >> 4;
    float tv[4]; int ti[4];
#pragma unroll
    for (int k = 0; k < 4; ++k) { float bvv = lg[0]; int bi = 4 * quad;
#pragma unroll
        for (int j = 1; j < 8; ++j) { const int ej = 16 * (j >> 2) + 4 * quad + (j & 3); if (lg[j] > bvv) { bvv = lg[j]; bi = ej; } }
#pragma unroll
        for (int o = 16; o < 64; o <<= 1) { const float ov = __shfl_xor(bvv, o); const int oi = __shfl_xor(bi, o); if (ov > bvv || (ov == bvv && oi < bi)) { bvv = ov; bi = oi; } }
        tv[k] = bvv; ti[k] = bi;
#pragma unroll
        for (int j = 0; j < 8; ++j) { const int ej = 16 * (j >> 2) + 4 * quad + (j & 3); if (ej == bi) lg[j] = -3.0e38f; } }
    const float e1 = __builtin_amdgcn_exp2f((tv[1] - tv[0]) * LOG2E), e2 = __builtin_amdgcn_exp2f((tv[2] - tv[0]) * LOG2E), e3 = __builtin_amdgcn_exp2f((tv[3] - tv[0]) * LOG2E);
    const float inv = 1.0f / (1.0f + e1 + e2 + e3);
    const int ek = quad == 0 ? ti[0] : quad == 1 ? ti[1] : quad == 2 ? ti[2] : ti[3]; const float gk = (quad == 0 ? 1.0f : quad == 1 ? e1 : quad == 2 ? e2 : e3) * inv;
    int lp = -1;
    if (live) { lp = (int)__hip_atomic_fetch_add((LAS unsigned*)&lcnt[ek], 1u, __ATOMIC_RELAXED, __HIP_MEMORY_SCOPE_WORKGROUP);
        gate[(size_t)row * 4 + quad] = gk; tokE[(size_t)row * 4 + quad] = ek; }
    __syncthreads();
    if (tid < 32) { const unsigned n = lcnt[tid]; gbase[tid] = n ? __hip_atomic_fetch_add(gcnt + tid, n, __ATOMIC_RELAXED, __HIP_MEMORY_SCOPE_AGENT) : 0u; }
    __syncthreads();
    if (lp >= 0) { const int pos = (int)gbase[ek] + lp; tokList[(size_t)ek * T + pos] = row; tokPos[(size_t)row * 4 + quad] = pos; }
    if (tid < 32) lcnt[tid] = 0u;
    __syncthreads();
}
__device__ __forceinline__ void ln1_router_phase(LAS unsigned char* lds, volatile LAS unsigned* MISC, f32x2* RS, const y1_t* XFin, y1_t* XF, bf16_t* XB, const float* g1, const float* b1, const bf16_t* wri, const float* br,
                                                 unsigned* gcnt, int* tokList, int* tokE, int* tokPos, float* gate, int G) {
    const int tid = opaque_v(threadIdx.x), lane = tid & 63, w = tid >> 6, r = lane & 15, quad = lane >> 4, lr = lane >> 3, lc = lane & 7;
    volatile LAS unsigned* lcnt = MISC + 128; volatile LAS unsigned* gbase = MISC + 160;
    float bre[8];
#pragma unroll
    for (int eb = 0; eb < 2; ++eb)
#pragma unroll
        for (int i = 0; i < 4; ++i) bre[eb * 4 + i] = br[16 * eb + 4 * quad + i];
    constexpr int NCHUNK = T / 24;
    const int iters = (NCHUNK + 8 * G - 1) / (8 * G);
    for (int it = 0; it < iters; ++it) {
        const int chunk = (it * G + blockIdx.x) * 8 + w;
        const bool live_chunk = chunk < NCHUNK;
        const int row0 = opaque_v(live_chunk ? chunk * 24 : 0);
        u32x2 ra[32], rb[32];
        { const y1_t* xa_ = XFin + (size_t)(row0 + lr) * D + 4 * lc;
#pragma unroll
          for (int s = 0; s < 32; ++s) { ra[s] = *(const u32x2*)(xa_ + 32 * s); rb[s] = *(const u32x2*)(xa_ + (size_t)8 * D + 32 * s); } }
        if (it == 0) {
_Pragma("unroll 4")
            for (int j = 0; j < 16; ++j) { const int u = tid + 512 * j; const u32x4 v = ((const u32x4*)wri)[u]; *(LAS u32x4*)(lds + (u >> 12) * RT_WL + ((u >> 7) & 31) * RT_WSTR + (u & 127) * 16) = v; }
            for (int i = tid; i < 1024; i += 512) { ((LAS float*)(lds + RT_GB))[i] = g1[i]; ((LAS float*)(lds + RT_GB))[1024 + i] = b1[i]; }
            if (tid < 32) lcnt[tid] = 0u;
            __syncthreads();
        }
        float lg[8];
        p5_tile<true>(lds, ra, rb, live_chunk, live_chunk, row0 + lr, row0 + 8 + lr, RS, XB, lane, w, bre, lg);
        asm volatile("" ::: "memory");
        u32x2 rc[32];
        { const y1_t* xc_ = XFin + (size_t)(row0 + 16 + lr) * D + 4 * lc;
#pragma unroll
          for (int s = 0; s < 32; ++s) rc[s] = *(const u32x2*)(xc_ + 32 * s); }
        p5_route(lg, live_chunk, row0 + r, lane, tid, lcnt, gbase, gcnt, tokList, tokE, tokPos, gate);
        p5_tile<false>(lds, rc, rc, live_chunk, false, row0 + 16 + lr, row0 + 16 + lr, RS, XB, lane, w, bre, lg);
        p5_route(lg, live_chunk && (r < 8), row0 + 16 + (r & 7), lane, tid, lcnt, gbase, gcnt, tokList, tokE, tokPos, gate);
    }
}

__device__ __forceinline__ void combine_ln2_phase(volatile LAS unsigned* MISC, const f32x2* RS, const float* g1, const float* b1, const y1_t* XF, const bf16_t* YK, const int* tokE, const int* tokPos, const float* gate, const float* g2, const float* b2,
                                                  float* outF, bf16_t* XB, int G) {
    const int tid = opaque_v(threadIdx.x), lane = tid & 63, gw = blockIdx.x * 8 + (tid >> 6), NGW = G * 8;
    const volatile LAS int* tb = (const volatile LAS int*)(MISC + 16);
    f32x4 gv[4], bv[4];
#pragma unroll
    for (int j = 0; j < 4; ++j) { gv[j] = *(const f32x4*)(g2 + 256 * j + 4 * lane); bv[j] = *(const f32x4*)(b2 + 256 * j + 4 * lane); }
    f32x4 gv1[4], bv1[4];
#pragma unroll
    for (int j = 0; j < 4; ++j) { gv1[j] = *(const f32x4*)(g1 + 256 * j + 4 * lane); bv1[j] = *(const f32x4*)(b1 + 256 * j + 4 * lane); }
    typedef int i32x4 __attribute__((ext_vector_type(4)));
    i32x4 ne = *(const i32x4*)(tokE + (size_t)(gw < T ? gw : 0) * 4), np = *(const i32x4*)(tokPos + (size_t)(gw < T ? gw : 0) * 4); f32x4 ng = *(const f32x4*)(gate + (size_t)(gw < T ? gw : 0) * 4);
    for (int row = gw; row < T; row += NGW) {
        const i32x4 ce = ne, cpz = np; const f32x4 cg = ng;
        f32x4 v[4]; u32x2 y[4][4];
#pragma unroll
        for (int j = 0; j < 4; ++j) v[j] = Y1_LD4(XF + (size_t)row * D + 256 * j + 4 * lane);
        const f32x2 rs = RS[row];
#pragma unroll
        for (int k = 0; k < 4; ++k) { const size_t slot = (size_t)tb[ce[k]] * 256 + cpz[k];
#pragma unroll
            for (int j = 0; j < 4; ++j) y[k][j] = __builtin_nontemporal_load((const u32x2*)(YK + slot * D + 256 * j + 4 * lane)); }
        { const int rn = (row + NGW < T) ? row + NGW : row; ne = *(const i32x4*)(tokE + (size_t)rn * 4); np = *(const i32x4*)(tokPos + (size_t)rn * 4); ng = *(const f32x4*)(gate + (size_t)rn * 4); }
#pragma unroll
        for (int j = 0; j < 4; ++j) { v[j] = ((v[j] - rs[0]) * rs[1] * gv1[j] + bv1[j]) * DN_ALPHA;
#pragma unroll
            for (int k = 0; k < 4; ++k) v[j] += (f32x4){bflo(y[k][j].x), bfhi(y[k][j].x), bflo(y[k][j].y), bfhi(y[k][j].y)} * cg[k]; }
        float s = 0.f;
#pragma unroll
        for (int j = 0; j < 4; ++j) s += (v[j][0] + v[j][1]) + (v[j][2] + v[j][3]);
        const float mean = wave_sum(s) * (1.0f / D); float s2 = 0.f;
#pragma unroll
        for (int j = 0; j < 4; ++j) { v[j] = v[j] - mean; s2 += (v[j][0] * v[j][0] + v[j][1] * v[j][1]) + (v[j][2] * v[j][2] + v[j][3] * v[j][3]); }
        const float rstd = 1.0f / sqrtf(wave_sum(s2) * (1.0f / D) + LN_EPS);
#pragma unroll
        for (int j = 0; j < 4; ++j) { v[j] = v[j] * rstd * gv[j] + bv[j];
            if (outF) __builtin_nontemporal_store(v[j], (f32x4*)(outF + (size_t)row * D + 256 * j + 4 * lane));
            if (!outF) { u32x2 o; o.x = cvt_pk_bf16(v[j][0], v[j][1]); o.y = cvt_pk_bf16(v[j][2], v[j][3]); *(u32x2*)(XB + (size_t)row * D + 256 * j + 4 * lane) = o; } }
    }
}

__device__ __forceinline__ void moe_tables(volatile LAS unsigned* MISC, const unsigned* gcnt) {
    const int tid_ = opaque_v(threadIdx.x);
    if (tid_ < 64) {
        const int lane = tid_;
        const int n = lane < NE ? (int)__hip_atomic_load(gcnt + lane, __ATOMIC_RELAXED, __HIP_MEMORY_SCOPE_AGENT) : 0;
        const int nt = (n + 255) >> 8; int incl = nt;
#pragma unroll
        for (int o = 1; o < 32; o <<= 1) { const int v = __shfl_up(incl, o); if (lane >= o) incl += v; }
        if (lane < NE) { MISC[64 + lane] = (unsigned)n; MISC[16 + lane] = (unsigned)(incl - nt); }
        if (lane == NE - 1) MISC[16 + NE] = (unsigned)incl;
        if (lane < NE) { volatile LAS unsigned char* tmap = (volatile LAS unsigned char*)MISC - (MISC_OFF - TMAP_OFF); for (int k = 0; k < nt; ++k) tmap[incl - nt + k] = (unsigned char)lane; }
    }
    __syncthreads();
}

__device__ __forceinline__ void stagger(int span_ticks) {
    const unsigned long long t0 = __builtin_amdgcn_s_memrealtime(); const unsigned long long d = (unsigned long long)((((int)blockIdx.x >> 3) & 31) * span_ticks) >> 5;
    while (__builtin_amdgcn_s_memrealtime() - t0 < d) __builtin_amdgcn_s_sleep(8);
}
__global__ void __launch_bounds__(512, 2) fwd_kernel(Args args) {
    extern __shared__ __attribute__((aligned(16))) unsigned char lds_raw[];
    LAS unsigned char* lds = (LAS unsigned char*)lds_raw;
    volatile LAS unsigned* MISC = (volatile LAS unsigned*)(lds + MISC_OFF);
    const int tid = threadIdx.x, G = gridDim.x;
    unsigned char* const ws0 = args.ws;
    unsigned* ctl = (unsigned*)(ws0 + WS_CTL);
    for (int u = tid; u < 256; u += 512) MISC[u] = 0u;
    __syncthreads();
    const int lo = args.ph_lo, hi = args.ph_hi;
    XcdBarrier bar; bar.bar = ctl + CW_BAR; bar.x = 0; bar.st = MISC;
    if (hi - lo > 1) bar = xcd_barrier_post(ctl + CW_BAR, MISC);
#ifndef PH_MASK
#define PH_MASK 0x3ff
#endif
#define IN(k) (lo <= (k) && (k) < hi)
#define PON(p) (((PH_MASK) >> (p)) & 1)
#define SEAM(k) do { if (IN((k) + 1)) { XcdBarrier b2_ = bar; b2_.bar = opaque_p(bar.bar); { unsigned x_ = bar.x; asm volatile("" : "+s"(x_)); b2_.x = x_; } xcd_barrier(b2_); } } while (0)
#ifndef DUP_MASK
#define DUP_MASK 0
#endif
#define REP(p) _Pragma("unroll 1") for (int rep_ = 0; rep_ < ((((DUP_MASK) >> (p)) & 1) ? opaque_v(2) : 1); ++rep_)
#define WSP(T_, off) ((T_*)(ws + (off)))
#define PRM(off) ((const float*)(ws + WS_PRM) + (off))

    if (PON(9) && IN(0)) { REP(9) p0_prologue(args, lds, G); SEAM(0); }

#pragma unroll 1
    for (int l = 0; l < DEPTH; ++l) {
        const int pb = 1 + l * NPH;
        if (PON(0) && IN(pb + 0)) { unsigned char* ws = opaque_p(ws0); unsigned* ctl = (unsigned*)(ws + WS_CTL); (void)ctl; const int Gp = opaque_s(G), cp = opaque_s((int)blockIdx.x); (void)Gp; (void)cp;
            pg8::DenseSched S{WSP(const bf16_t, WS_XB), WSP(const bf16_t, WS_WIN) + (size_t)l * DIN * D, D, T / 256, DIN / 256, Gp, cp};
            pg8::EpiIn E{PRM(PR_BIN) + (size_t)l * DIN, WSP(bf16_t, WS_U), WSP(bf16_t, WS_V), WSP(bf16_t, WS_QKV), WSP(bf16_t, WS_GA), WSP(bf16_t, WS_GB), WSP(f32x2, WS_PS)};
#ifdef STAG_P1
            stagger(STAG_P1);
#endif
            REP(0) pg8::gemm_phase<pg8::EpiIn, pg8::DenseSched, true>(lds, S, E);
            SEAM(pb + 0);
        }
        if (PON(1) && IN(pb + 1)) { unsigned char* ws = opaque_p(ws0); unsigned* ctl = (unsigned*)(ws + WS_CTL); (void)ctl; const int Gp = opaque_s(G), cp = opaque_s((int)blockIdx.x); (void)Gp; (void)cp;
            const int vcu = (Gp % 8 == 0) ? (cp % 8) * (Gp / 8) + cp / 8 : cp;
            { constexpr int NU = 12 * 3 * 4 * 32, NS = 768;
                const int na = (NU - vcu + Gp - 1) / Gp;
                const int ka = (na * ((vcu >> 3) % 7)) / 6;
                const int usplit = vcu + (ka < na ? ka : na) * Gp;
                { u32x4 kr[8], vr[8];
                  _Pragma("unroll") for (int j = 0; j < 8; ++j) { kr[j] = (u32x4){0u, 0u, 0u, 0u}; vr[j] = (u32x4){0u, 0u, 0u, 0u}; }
                  if (vcu < usplit) attn_load(WSP(const bf16_t, WS_QKV), vcu, opaque_v(threadIdx.x), kr, vr);
                  for (int u = vcu; u < usplit; u += Gp) attn_unit(lds, WSP(const bf16_t, WS_QKV), WSP(bf16_t, WS_OG), WSP(float, WS_LSE), u, (u + Gp < usplit) ? u + Gp : -1, kr, vr); }
                for (int u = vcu; u < NS; u += Gp)
                    sg_unit(lds, WSP(const bf16_t, WS_U), WSP(const bf16_t, WS_V), WSP(bf16_t, WS_AOUT), WSP(const bf16_t, WS_WS) + (size_t)l * 8 * 128 * 128, PRM(PR_BS) + (size_t)l * 1024, PRM(PR_LNVG) + (size_t)l * 1024, PRM(PR_LNVB) + (size_t)l * 1024, WSP(const f32x2, WS_PS), u);
                { u32x4 kr[8], vr[8];
                  _Pragma("unroll") for (int j = 0; j < 8; ++j) { kr[j] = (u32x4){0u, 0u, 0u, 0u}; vr[j] = (u32x4){0u, 0u, 0u, 0u}; }
                  if (usplit < NU) attn_load(WSP(const bf16_t, WS_QKV), usplit, opaque_v(threadIdx.x), kr, vr);
                  for (int u = usplit; u < NU; u += Gp) attn_unit(lds, WSP(const bf16_t, WS_QKV), WSP(bf16_t, WS_OG), WSP(float, WS_LSE), u, (u + Gp < NU) ? u + Gp : -1, kr, vr); }
            }
            SEAM(pb + 1);
        }
        if (PON(2) && IN(pb + 2)) { unsigned char* ws = opaque_p(ws0); unsigned* ctl = (unsigned*)(ws + WS_CTL); (void)ctl; const int Gp = opaque_s(G), cp = opaque_s((int)blockIdx.x); (void)Gp; (void)cp; REP(2) merge_phase(WSP(const bf16_t, WS_OG), WSP(const float, WS_LSE), WSP(bf16_t, WS_BOUT), Gp); SEAM(pb + 2); }
        if (PON(3) && IN(pb + 3)) { unsigned char* ws = opaque_p(ws0); unsigned* ctl = (unsigned*)(ws + WS_CTL); (void)ctl; const int Gp = opaque_s(G), cp = opaque_s((int)blockIdx.x); (void)Gp; (void)cp;
            pg8::Dense2Sched S{WSP(const bf16_t, WS_AOUT), WSP(const bf16_t, WS_WPA) + (size_t)l * D * D, D, WSP(const bf16_t, WS_BOUT), WSP(const bf16_t, WS_WPB) + (size_t)l * D * 512, 512, T / 256, D / 256, Gp, cp};
            pg8::EpiMg2 E{WSP(const bf16_t, WS_GA), WSP(const bf16_t, WS_GB), WSP(bf16_t, WS_MG)};
            REP(3) pg8::gemm_phase2<pg8::EpiMg2>(lds, S, E);
            SEAM(pb + 3);
        }
        if (PON(4) && IN(pb + 4)) { unsigned char* ws = opaque_p(ws0); unsigned* ctl = (unsigned*)(ws + WS_CTL); (void)ctl; const int Gp = opaque_s(G), cp = opaque_s((int)blockIdx.x); (void)Gp; (void)cp;
            pg8::DenseSched S{WSP(const bf16_t, WS_MG), WSP(const bf16_t, WS_WO) + (size_t)l * D * D, D, T / 256, D / 256, Gp, cp};
            pg8::EpiWo E{args.in[I_XP], args.in[I_XS] - (size_t)TP * D, l == 0 ? (const bf16_t*)nullptr : WSP(const bf16_t, WS_XB), WSP(y1_t, WS_XF)};
            pg8::gemm_phase<pg8::EpiWo, pg8::DenseSched, true>(lds, S, E);
            SEAM(pb + 4);
        }
        if (PON(5) && IN(pb + 5)) { unsigned char* ws = opaque_p(ws0); unsigned* ctl = (unsigned*)(ws + WS_CTL); (void)ctl; const int Gp = opaque_s(G), cp = opaque_s((int)blockIdx.x); (void)Gp; (void)cp;
            if (((DUP_MASK) >> 5) & 1) ln1_router_phase(lds, MISC, WSP(f32x2, WS_RS), WSP(const y1_t, WS_XF), WSP(y1_t, WS_T1), WSP(bf16_t, WS_U), PRM(PR_LN1G) + (size_t)l * D, PRM(PR_LN1B) + (size_t)l * D, WSP(const bf16_t, WS_WRI) + (size_t)l * 65536, PRM(PR_BR) + (size_t)l * NE,
                             ctl + CW_CNT + 1024 + l * 64, WSP(int, WS_OG), WSP(int, WS_LSE), WSP(int, WS_BOUT), WSP(float, WS_AOUT), Gp);
            ln1_router_phase(lds, MISC, WSP(f32x2, WS_RS), WSP(const y1_t, WS_XF), WSP(y1_t, WS_XF), WSP(bf16_t, WS_XB), PRM(PR_LN1G) + (size_t)l * D, PRM(PR_LN1B) + (size_t)l * D, WSP(const bf16_t, WS_WRI) + (size_t)l * 65536, PRM(PR_BR) + (size_t)l * NE,
                             ctl + CW_CNT + l * 64, WSP(int, WS_TOKLIST), WSP(int, WS_TOKE), WSP(int, WS_TOKPOS), WSP(float, WS_GATE), Gp);
            SEAM(pb + 5);
        }
        if (PON(6) && IN(pb + 6)) { unsigned char* ws = opaque_p(ws0); unsigned* ctl = (unsigned*)(ws + WS_CTL); (void)ctl; const int Gp = opaque_s(G), cp = opaque_s((int)blockIdx.x); (void)Gp; (void)cp;
            moe_tables(MISC, ctl + CW_CNT + l * 64);
            pg8::MoeSched<true> S{WSP(const bf16_t, WS_XB), WSP(const bf16_t, WS_WGU) + (size_t)l * NE * 2048 * D, D, 8, Gp, cp, (size_t)2048 * D * 2, (const LAS int*)(lds + MISC_OFF + 64), (const LAS int*)(lds + MISC_OFF + 256), WSP(const int, WS_TOKLIST)};
            pg8::EpiGU E{PRM(PR_BGU) + (size_t)l * NE * 2048, WSP(bf16_t, WS_H)};
            REP(6) pg8::gemm_phase<pg8::EpiGU, pg8::MoeSched<true>, true>(lds, S, E);
            SEAM(pb + 6);
        }
        if (PON(7) && IN(pb + 7)) { unsigned char* ws = opaque_p(ws0); unsigned* ctl = (unsigned*)(ws + WS_CTL); (void)ctl; const int Gp = opaque_s(G), cp = opaque_s((int)blockIdx.x); (void)Gp; (void)cp;
            moe_tables(MISC, ctl + CW_CNT + l * 64);
            pg8::MoeSched<false> S{WSP(const bf16_t, WS_H), WSP(const bf16_t, WS_WD) + (size_t)l * NE * D * D, D, 4, Gp, cp, (size_t)D * D * 2, (const LAS int*)(lds + MISC_OFF + 64), (const LAS int*)(lds + MISC_OFF + 256), nullptr};
            pg8::EpiDown E{PRM(PR_BD) + (size_t)l * NE * D, WSP(bf16_t, WS_YK)};
            REP(7) pg8::gemm_phase<pg8::EpiDown, pg8::MoeSched<false>, true>(lds, S, E);
            SEAM(pb + 7);
        }
        if (PON(8) && IN(pb + 8)) { unsigned char* ws = opaque_p(ws0); unsigned* ctl = (unsigned*)(ws + WS_CTL); (void)ctl; const int Gp = opaque_s(G), cp = opaque_s((int)blockIdx.x); (void)Gp; (void)cp;
            moe_tables(MISC, ctl + CW_CNT + l * 64);
            combine_ln2_phase(MISC, WSP(const f32x2, WS_RS), PRM(PR_LN1G) + (size_t)l * D, PRM(PR_LN1B) + (size_t)l * D, WSP(const y1_t, WS_XF), WSP(const bf16_t, WS_YK), WSP(const int, WS_TOKE), WSP(const int, WS_TOKPOS), WSP(const float, WS_GATE), PRM(PR_LN2G) + (size_t)l * D, PRM(PR_LN2B) + (size_t)l * D,
                              l == DEPTH - 1 ? args.out : (float*)nullptr, WSP(bf16_t, WS_XB), Gp);
            SEAM(pb + 8);
        }
    }
#undef IN
#undef SEAM
}

extern "C" void kernel_launch(void* const* d_in, const int* in_sizes, int n_in, void* d_out, int out_size, void* d_ws, size_t ws_size, hipStream_t stream) {
    static int grid = 0;
    if (grid == 0) {
        if (n_in != 21 || out_size != T * D || ws_size < WS_END) { fprintf(stderr, "kernel_launch: unexpected shapes (n_in %d, out %d, ws %zu < %zu)\n", n_in, out_size, ws_size, (size_t)WS_END); grid = -1; return; }
        int dev = 0, cus = 0, per_cu = 0;
        if (hipGetDevice(&dev) != hipSuccess || hipDeviceGetAttribute(&cus, hipDeviceAttributeMultiprocessorCount, dev) != hipSuccess) { grid = -1; return; }
        if (hipFuncSetAttribute((const void*)fwd_kernel, hipFuncAttributeMaxDynamicSharedMemorySize, LDS_BYTES) != hipSuccess) { fprintf(stderr, "kernel_launch: hipFuncSetAttribute failed\n"); grid = -1; return; }
        if (hipOccupancyMaxActiveBlocksPerMultiprocessor(&per_cu, (const void*)fwd_kernel, 512, LDS_BYTES) != hipSuccess || per_cu < 1) fprintf(stderr, "kernel_launch: occupancy query says %d\n", per_cu);
        (void)hipGetLastError();
        grid = cus;
    }
    if (grid < 0) return;
    (void)hipMemsetAsync((char*)d_ws + WS_CTL, 0, CTL_BYTES, stream);
    Args a{};
    for (int i = 0; i < 21; ++i) a.in[i] = (const float*)d_in[i];
    a.out = (float*)d_out; a.ws = (unsigned char*)d_ws;
#if MK_SPLIT
    for (int p = 0; p < NPHASE; ++p) { a.ph_lo = p; a.ph_hi = p + 1; hipLaunchKernelGGL(fwd_kernel, dim3(grid), dim3(512), LDS_BYTES, stream, a); }
#else
    a.ph_lo = 0; a.ph_hi = NPHASE;
    hipLaunchKernelGGL(fwd_kernel, dim3(grid), dim3(512), LDS_BYTES, stream, a);
#ifdef PROBE_PHASE
    for (int r = 0; r < PROBE_REPS; ++r) { a.ph_lo = 1 + 2 * NPH + PROBE_PHASE; a.ph_hi = a.ph_lo + 1;
#ifdef PROBE_SUB
        a.sub = PROBE_SUB;
#endif
 hipLaunchKernelGGL(fwd_kernel, dim3(grid), dim3(512), LDS_BYTES, stream, a); }
#endif
#endif
}
```
